# Optimizing an MI355X kernel written in HIP

```python
import jax, jax.numpy as jnp
from jax import lax
import numpy as np

D_MODEL = 1024
BATCH = 8
SEQ = 2048
DEPTH = 1
DEC_BATCH = 128
DEC_SEQ = 1
PAST_LEN = 16384
PAGE_SIZE = 128

A_WIDTH = D_MODEL // 2
A_GROUPS = 8
A_GROUP_DIM = A_WIDTH // A_GROUPS
CHUNK = 128
B_WIDTH = D_MODEL - A_WIDTH
RWKV_HEAD = 64
RWKV_HEADS = B_WIDTH // RWKV_HEAD
DECAY_LORA = 64
AAA_LORA = 64
GATE_LORA = 160
B_PROJ = 3 * B_WIDTH + DECAY_LORA + AAA_LORA + GATE_LORA
IN_PROJ = 2 * A_WIDTH + B_PROJ
MIX_WIDTH = A_WIDTH + B_WIDTH
D_FF = 2816
N_MEM = 256
XA_HEADS = 4
XA_HEAD_DIM = D_MODEL // XA_HEADS
NORM_EPS = 1e-6
LN_EPS = 1e-5
GN_EPS = 64e-5

kernel_name = "hymba_gmlp_rwkv7_macaron_memxattn_step"


def rms_norm(x, g):
    xf = x.astype(jnp.float32)
    y = xf * lax.rsqrt(jnp.mean(xf * xf, axis=-1, keepdims=True) + NORM_EPS)
    return (y * g).astype(x.dtype)


def layer_norm(x, g, b):
    xf = x.astype(jnp.float32)
    mu = jnp.mean(xf, axis=-1, keepdims=True)
    var = jnp.mean(jnp.square(xf - mu), axis=-1, keepdims=True)
    return ((xf - mu) * lax.rsqrt(var + LN_EPS) * g + b).astype(x.dtype)


def swiglu(x, w_gate, w_up, w_down):
    return ((jax.nn.silu(x @ w_gate) * (x @ w_up)) @ w_down).astype(x.dtype)


def chunk_mix(v, w_s, b_s):
    bsz, t = v.shape[0], v.shape[1]
    n_c = -(-t // CHUNK)
    vp = jnp.pad(v, ((0, 0), (0, n_c * CHUNK - t), (0, 0), (0, 0)))
    vp = vp.reshape(bsz, n_c, CHUNK, A_GROUPS, A_GROUP_DIM)
    mask = jnp.tril(jnp.ones((CHUNK, CHUNK), dtype=bool))
    w = jnp.where(mask[None], w_s, 0).astype(v.dtype)
    mixed = jnp.einsum('gts,bcsgd->bctgd', w, vp) + jnp.swapaxes(b_s, 0, 1)[None, None, :, :, None]
    return mixed.reshape(bsz, n_c * CHUNK, A_GROUPS, A_GROUP_DIM)[:, :t]


def rwkv7_scan(state0, r, w, k, v, kk, a):
    def step(S, inp):
        r_t, w_t, k_t, v_t, kk_t, a_t = inp
        sa = jnp.einsum('bhvk,bhk->bhv', S, -kk_t)
        S = (S * w_t[:, :, None, :] + sa[..., None] * (kk_t * a_t)[:, :, None, :]
             + v_t[..., None] * k_t[:, :, None, :])
        return S, jnp.einsum('bhvk,bhk->bhv', S, r_t)
    xs = tuple(jnp.swapaxes(z, 0, 1) for z in (r, w, k, v, kk, a))
    S, out = lax.scan(step, state0, xs)
    return S, jnp.swapaxes(out, 0, 1)


def token_mix(h, shift_prev, rwkv_state, w_in, w_out, sgu_w, sgu_b, sgu_ln_g, sgu_ln_b,
              rwkv_mu, rwkv_w0, rwkv_w2, rwkv_a0, rwkv_a2, rwkv_g2, rwkv_k_k, rwkv_k_a,
              rwkv_r_k, rwkv_gn_g, rwkv_gn_b):
    f32 = jnp.float32
    bsz, t, _ = h.shape
    z = h @ w_in
    za = jax.nn.gelu(z[..., :2 * A_WIDTH])
    u, va = za[..., :A_WIDTH], za[..., A_WIDTH:]
    va = layer_norm(va, sgu_ln_g, sgu_ln_b)
    mixed = chunk_mix(va.reshape(bsz, t, A_GROUPS, A_GROUP_DIM), sgu_w, sgu_b)
    ya = (u * mixed.reshape(bsz, t, A_WIDTH)).astype(h.dtype)
    zb = z[..., 2 * A_WIDTH:]
    zb_prev = jnp.concatenate([shift_prev.astype(zb.dtype), zb[:, :-1]], axis=1)
    new_shift = zb[:, -1:]
    zs = (zb + (zb_prev - zb) * rwkv_mu).astype(f32)
    o1, o2, o3 = B_WIDTH, 2 * B_WIDTH, 3 * B_WIDTH
    o4, o5 = o3 + DECAY_LORA, o3 + DECAY_LORA + AAA_LORA
    r, k, v = zs[..., :o1], zs[..., o1:o2], zs[..., o2:o3]
    wd, ad, gd = zs[..., o3:o4], zs[..., o4:o5], zs[..., o5:]
    w_log = -jax.nn.softplus(-(rwkv_w0 + jnp.tanh(wd) @ rwkv_w2)) - 0.5
    decay = jnp.exp(-jnp.exp(w_log))
    a = jax.nn.sigmoid(rwkv_a0 + ad @ rwkv_a2)
    g = jax.nn.sigmoid(gd) @ rwkv_g2
    heads = lambda q: q.reshape(bsz, t, RWKV_HEADS, RWKV_HEAD)
    kk = heads(k * rwkv_k_k)
    kk = kk * lax.rsqrt(jnp.maximum(jnp.sum(kk * kk, axis=-1, keepdims=True), 1e-24))
    k = k * (1.0 + (a - 1.0) * rwkv_k_a)
    rh, kh, vh = heads(r), heads(k), heads(v)
    new_state, o = rwkv7_scan(rwkv_state.astype(f32), rh, heads(decay), kh, vh, kk, heads(a))
    mu = jnp.mean(o, axis=-1, keepdims=True)
    var = jnp.mean(jnp.square(o - mu), axis=-1, keepdims=True)
    o = ((o - mu) * lax.rsqrt(var + GN_EPS)).reshape(bsz, t, B_WIDTH) * rwkv_gn_g + rwkv_gn_b
    bonus = (jnp.sum(rh * kh * rwkv_r_k, axis=-1, keepdims=True) * vh).reshape(bsz, t, B_WIDTH)
    yb = ((o + bonus) * g).astype(h.dtype)
    y = jnp.concatenate([ya, yb], axis=-1) @ w_out
    return y.astype(h.dtype), new_state.astype(h.dtype), new_shift, va


def memory_kv(mem, mem_norm_g, w_k, w_v):
    m = rms_norm(mem, mem_norm_g)
    bsz = mem.shape[0]
    mk = (m @ w_k).reshape(bsz, N_MEM, XA_HEADS, XA_HEAD_DIM)
    mv = (m @ w_v).reshape(bsz, N_MEM, XA_HEADS, XA_HEAD_DIM)
    return mk, mv


def cross_attn(h, mk, mv, w_q, w_o):
    bsz, t, _ = h.shape
    q = (h @ w_q).reshape(bsz, t, XA_HEADS, XA_HEAD_DIM)
    s = jnp.einsum('bthd,bmhd->bhtm', q, mk).astype(jnp.float32) * (XA_HEAD_DIM ** -0.5)
    p = jax.nn.softmax(s, axis=-1).astype(h.dtype)
    o = jnp.einsum('bhtm,bmhd->bthd', p, mv.astype(h.dtype)).reshape(bsz, t, D_MODEL)
    return (o @ w_o).astype(h.dtype)


def decoder_layer(x, mem_k, mem_v, shift_prev, rwkv_state, *, ln_ffn1, ffn1_gate, ffn1_up,
                  ffn1_down, ln_mix, w_in, w_out, sgu_w, sgu_b, sgu_ln_g, sgu_ln_b, rwkv_mu,
                  rwkv_w0, rwkv_w2, rwkv_a0, rwkv_a2, rwkv_g2, rwkv_k_k, rwkv_k_a, rwkv_r_k,
                  rwkv_gn_g, rwkv_gn_b, ln_xattn, xa_q, xa_o, ln_ffn2, ffn2_gate, ffn2_up,
                  ffn2_down):
    x = x + 0.5 * swiglu(rms_norm(x, ln_ffn1), ffn1_gate, ffn1_up, ffn1_down)
    y, new_state, new_shift, va = token_mix(
        rms_norm(x, ln_mix), shift_prev, rwkv_state, w_in, w_out, sgu_w, sgu_b, sgu_ln_g,
        sgu_ln_b, rwkv_mu, rwkv_w0, rwkv_w2, rwkv_a0, rwkv_a2, rwkv_g2, rwkv_k_k, rwkv_k_a,
        rwkv_r_k, rwkv_gn_g, rwkv_gn_b)
    x = x + y
    x = x + cross_attn(rms_norm(x, ln_xattn), mem_k, mem_v, xa_q, xa_o)
    x = x + 0.5 * swiglu(rms_norm(x, ln_ffn2), ffn2_gate, ffn2_up, ffn2_down)
    return x, new_state, new_shift, va


def setup_inputs(seed: int = 0) -> dict:
    key = jax.random.key(seed)
    ks = iter(jax.random.split(key, 64))
    f32 = jnp.float32
    nrm = lambda shape, scale: jax.random.normal(next(ks), shape, f32) * scale
    gain = lambda shape: 1.0 + jax.random.normal(next(ks), shape, f32) * 0.05
    L = DEPTH
    return {
        "x_prompt": nrm((BATCH, SEQ, D_MODEL), 1.0),
        "x_sample": nrm((DEC_BATCH, DEC_SEQ, D_MODEL), 1.0),
        "state_rwkv": nrm((L, DEC_BATCH, RWKV_HEADS, RWKV_HEAD, RWKV_HEAD), 0.5),
        "state_shift": nrm((L, DEC_BATCH, 1, B_PROJ), 1.0),
        "cache_mem_k": nrm((L, DEC_BATCH, N_MEM, XA_HEADS, XA_HEAD_DIM), 1.0),
        "cache_mem_v": nrm((L, DEC_BATCH, N_MEM, XA_HEADS, XA_HEAD_DIM), 1.0),
        "mem_prompt": nrm((BATCH, N_MEM, D_MODEL), 1.0),
        "ln_ffn1": gain((L, D_MODEL)),
        "ffn1_gate": nrm((L, D_MODEL, D_FF), D_MODEL ** -0.5),
        "ffn1_up": nrm((L, D_MODEL, D_FF), D_MODEL ** -0.5),
        "ffn1_down": nrm((L, D_FF, D_MODEL), D_FF ** -0.5),
        "ln_mix": gain((L, D_MODEL)),
        "w_in": nrm((L, D_MODEL, IN_PROJ), D_MODEL ** -0.5),
        "w_out": nrm((L, MIX_WIDTH, D_MODEL), MIX_WIDTH ** -0.5),
        "sgu_w": nrm((L, A_GROUPS, CHUNK, CHUNK), 0.5 * CHUNK ** -0.5),
        "sgu_b": gain((L, A_GROUPS, CHUNK)),
        "sgu_ln_g": gain((L, A_WIDTH)),
        "sgu_ln_b": nrm((L, A_WIDTH), 0.01),
        "rwkv_mu": jax.random.uniform(next(ks), (L, B_PROJ), f32),
        "rwkv_w0": nrm((L, B_WIDTH), 0.5),
        "rwkv_w2": nrm((L, DECAY_LORA, B_WIDTH), DECAY_LORA ** -0.5),
        "rwkv_a0": nrm((L, B_WIDTH), 0.1),
        "rwkv_a2": nrm((L, AAA_LORA, B_WIDTH), AAA_LORA ** -0.5),
        "rwkv_g2": nrm((L, GATE_LORA, B_WIDTH), GATE_LORA ** -0.5),
        "rwkv_k_k": 0.85 + nrm((L, B_WIDTH), 0.05),
        "rwkv_k_a": gain((L, B_WIDTH)),
        "rwkv_r_k": nrm((L, RWKV_HEADS, RWKV_HEAD), 0.1),
        "rwkv_gn_g": gain((L, B_WIDTH)),
        "rwkv_gn_b": nrm((L, B_WIDTH), 0.01),
        "ln_xattn": gain((L, D_MODEL)),
        "mem_norm": gain((L, D_MODEL)),
        "xa_q": nrm((L, D_MODEL, D_MODEL), D_MODEL ** -0.5),
        "xa_k": nrm((L, D_MODEL, D_MODEL), D_MODEL ** -0.5),
        "xa_v": nrm((L, D_MODEL, D_MODEL), D_MODEL ** -0.5),
        "xa_o": nrm((L, D_MODEL, D_MODEL), D_MODEL ** -0.5),
        "ln_ffn2": gain((L, D_MODEL)),
        "ffn2_gate": nrm((L, D_MODEL, D_FF), D_MODEL ** -0.5),
        "ffn2_up": nrm((L, D_MODEL, D_FF), D_MODEL ** -0.5),
        "ffn2_down": nrm((L, D_FF, D_MODEL), D_FF ** -0.5),
        "final_norm": gain((D_MODEL,)),
    }


def reference(x_prompt, x_sample, state_rwkv, state_shift, cache_mem_k, cache_mem_v, mem_prompt,
              ln_ffn1, ffn1_gate, ffn1_up, ffn1_down, ln_mix, w_in, w_out, sgu_w, sgu_b,
              sgu_ln_g, sgu_ln_b, rwkv_mu, rwkv_w0, rwkv_w2, rwkv_a0, rwkv_a2, rwkv_g2,
              rwkv_k_k, rwkv_k_a, rwkv_r_k, rwkv_gn_g, rwkv_gn_b, ln_xattn, mem_norm, xa_q,
              xa_k, xa_v, xa_o, ln_ffn2, ffn2_gate, ffn2_up, ffn2_down, final_norm):
    hp, hs = x_prompt, x_sample
    bp = x_prompt.shape[0]
    sp_l, shp_l, mkp_l, mvp_l, ss_l, shs_l, vs_l = [], [], [], [], [], [], []
    for l in range(DEPTH):
        lp = dict(ln_ffn1=ln_ffn1[l], ffn1_gate=ffn1_gate[l], ffn1_up=ffn1_up[l],
                  ffn1_down=ffn1_down[l], ln_mix=ln_mix[l], w_in=w_in[l], w_out=w_out[l],
                  sgu_w=sgu_w[l], sgu_b=sgu_b[l], sgu_ln_g=sgu_ln_g[l], sgu_ln_b=sgu_ln_b[l],
                  rwkv_mu=rwkv_mu[l], rwkv_w0=rwkv_w0[l], rwkv_w2=rwkv_w2[l],
                  rwkv_a0=rwkv_a0[l], rwkv_a2=rwkv_a2[l], rwkv_g2=rwkv_g2[l],
                  rwkv_k_k=rwkv_k_k[l], rwkv_k_a=rwkv_k_a[l], rwkv_r_k=rwkv_r_k[l],
                  rwkv_gn_g=rwkv_gn_g[l], rwkv_gn_b=rwkv_gn_b[l], ln_xattn=ln_xattn[l],
                  xa_q=xa_q[l], xa_o=xa_o[l], ln_ffn2=ln_ffn2[l], ffn2_gate=ffn2_gate[l],
                  ffn2_up=ffn2_up[l], ffn2_down=ffn2_down[l])
        mk_p, mv_p = memory_kv(mem_prompt, mem_norm[l], xa_k[l], xa_v[l])
        zero_state = jnp.zeros((bp, RWKV_HEADS, RWKV_HEAD, RWKV_HEAD), jnp.float32)
        zero_shift = jnp.zeros((bp, 1, B_PROJ), hp.dtype)
        hp, s_p, sh_p, _ = decoder_layer(hp, mk_p, mv_p, zero_shift, zero_state, **lp)
        hs, s_s, sh_s, v_s = decoder_layer(hs, cache_mem_k[l], cache_mem_v[l], state_shift[l],
                                           state_rwkv[l], **lp)
        sp_l.append(s_p); shp_l.append(sh_p); mkp_l.append(mk_p); mvp_l.append(mv_p)
        ss_l.append(s_s); shs_l.append(sh_s); vs_l.append(v_s)
    y_prompt = rms_norm(hp, final_norm)
    y_sample = rms_norm(hs, final_norm)
    return (y_prompt, y_sample, jnp.stack(sp_l), jnp.stack(shp_l), jnp.stack(mkp_l),
            jnp.stack(mvp_l), jnp.stack(ss_l), jnp.stack(shs_l), jnp.stack(vs_l))
```

```cpp
#include <hip/hip_runtime.h>
#include <hip/hip_cooperative_groups.h>
#include <cstdio>
namespace cg = cooperative_groups;

#ifndef PHMASK
#define PHMASK 0xffff
#endif
#ifndef DUPMASK
#define DUPMASK 0
#endif
#ifndef ONE_LAUNCH
#define ONE_LAUNCH 1
#endif

#define LAS __attribute__((address_space(3)))
#define DEV __device__ __forceinline__
typedef unsigned short bf16_t;
typedef short bf16x8 __attribute__((ext_vector_type(8)));
typedef float f32x4 __attribute__((ext_vector_type(4)));
typedef unsigned u32x2 __attribute__((ext_vector_type(2)));
typedef unsigned u32x4 __attribute__((ext_vector_type(4)));

constexpr int DM = 1024, NTOK = 16384, NSMP = 128, MV = NTOK + NSMP, MP = 16640, SEQ = 2048;
constexpr int DFF = 2816, ZLD = 2848, BPROJ = 1824, NMEMR = 2048;
constexpr int NPH = 16;

constexpr size_t al256(size_t x) { return (x + 255) & ~(size_t)255; }
constexpr size_t O_WGU1 = 0;
constexpr size_t O_WD1 = O_WGU1 + al256((size_t)5632 * 1024 * 2);
constexpr size_t O_WIN = O_WD1 + al256((size_t)1024 * 2816 * 2);
constexpr size_t O_WOUT = O_WIN + al256((size_t)3072 * 1024 * 2);
constexpr size_t O_WQ = O_WOUT + 2097152, O_WK = O_WQ + 2097152, O_WV = O_WK + 2097152, O_WO = O_WV + 2097152;
constexpr size_t O_WGU2 = O_WO + 2097152;
constexpr size_t O_WD2 = O_WGU2 + al256((size_t)5632 * 1024 * 2);
constexpr size_t O_WLORA = O_WD2 + al256((size_t)1024 * 2816 * 2);
constexpr size_t O_MNB = O_WLORA + al256((size_t)1536 * 384 * 2);
constexpr size_t O_MKB = O_MNB + 4194304, O_VT = O_MKB + 4194304;
constexpr size_t O_RSTDM = O_VT + 4194304;
constexpr size_t RS_BYTES = (size_t)MP * 64;
constexpr size_t O_RS1 = O_RSTDM + 8192, O_RS2 = O_RS1 + RS_BYTES, O_RS3 = O_RS2 + RS_BYTES, O_RS4 = O_RS3 + RS_BYTES, O_RS5 = O_RS4 + RS_BYTES;
constexpr size_t O_PSUM = O_RS5 + RS_BYTES;
constexpr size_t HALFROW = (size_t)MP * 512 * 4;
constexpr size_t O_XB = O_PSUM + 1048576;
constexpr size_t O_XRES = O_XB + HALFROW;
constexpr size_t O_H = O_XRES + 2 * HALFROW;
constexpr size_t O_Z = O_H + al256((size_t)MP * DFF * 2);
constexpr size_t O_YMIX = O_Z + al256((size_t)MP * ZLD * 2);
constexpr size_t O_VAB = O_YMIX + HALFROW;
constexpr size_t O_LIN = O_VAB + HALFROW / 2;
constexpr size_t O_KK = O_LIN + al256((size_t)MP * 384 * 2);
constexpr size_t O_DEC = O_KK + HALFROW, O_KKA = O_DEC + HALFROW;
constexpr size_t O_BAR = O_KKA + HALFROW;
constexpr size_t WS_NEED = O_BAR + 16384;

constexpr size_t OUT_Y = 0, OUT_SP = (size_t)MV * 1024, OUT_SHP = OUT_SP + 262144, OUT_MK = OUT_SHP + 8 * 1824, OUT_MV = OUT_MK + 2097152,
                 OUT_SS = OUT_MV + 2097152, OUT_SHS = OUT_SS + 4194304, OUT_CV = OUT_SHS + 128 * 1824;

enum { I_XP = 0, I_XS, I_SRWKV, I_SSHIFT, I_CK, I_CV, I_MEM, I_LN1, I_G1, I_U1, I_D1, I_LNMIX, I_WIN, I_WOUT, I_SGUW, I_SGUB, I_SLNG, I_SLNB,
       I_MU, I_W0, I_W2, I_A0, I_A2, I_G2, I_KK, I_KA, I_RK, I_GNG, I_GNB, I_LNX, I_MEMN, I_XQ, I_XK, I_XV, I_XO, I_LN2, I_G2F, I_U2F, I_D2F, I_FIN };

struct Params { const float* in[40]; float* out; unsigned char* ws; };

DEV unsigned cvt_pk_bf16(float lo, float hi) { unsigned r; asm volatile("v_cvt_pk_bf16_f32 %0, %1, %2" : "=v"(r) : "v"(lo), "v"(hi)); return r; }
DEV float bf_lo(unsigned u) { return __uint_as_float(u << 16); }
DEV float bf_hi(unsigned u) { return __uint_as_float(u & 0xffff0000u); }
DEV f32x4 bf4(u32x2 u) { return (f32x4){__uint_as_float(u[0] << 16), __uint_as_float(u[0] & 0xffff0000u), __uint_as_float(u[1] << 16), __uint_as_float(u[1] & 0xffff0000u)}; }
DEV u32x2 pk4(f32x4 v) { u32x2 o; o[0] = cvt_pk_bf16(v[0], v[1]); o[1] = cvt_pk_bf16(v[2], v[3]); return o; }
DEV float bf2f(bf16_t b) { return __uint_as_float((unsigned)b << 16); }
DEV float sigmoidf_(float x) { return 1.f / (1.f + __expf(-x)); }
DEV float tanhf_(float y) { return 1.f - 2.f / (1.f + __expf(2.f * y)); }
DEV float gelu_t(float x) { return 0.5f * x * (1.f + tanhf_(0.7978845608028654f * (x + 0.044715f * x * x * x))); }
DEV float wsum64(float v) {
#pragma unroll
    for (int o = 32; o >= 1; o >>= 1) v += __shfl_xor(v, o);
    return v;
}
DEV float wmax64(float v) {
#pragma unroll
    for (int o = 32; o >= 1; o >>= 1) v = fmaxf(v, __shfl_xor(v, o));
    return v;
}
template <int CTRL> DEV float dpp_f(float x) { return __builtin_bit_cast(float, __builtin_amdgcn_update_dpp(0, __builtin_bit_cast(int, x), CTRL, 0xf, 0xf, false)); }
DEV float rowsum16(float x) {
    x += dpp_f<0x128>(x); x += dpp_f<0x124>(x); x += dpp_f<0x122>(x); x += dpp_f<0x121>(x); return x;
}
DEV int fresh_tid() { int t = threadIdx.x; asm volatile("" : "+v"(t)); return t; }
DEV float rstd_of(const float* rs, int r) { const f32x4* q = (const f32x4*)(rs + (size_t)r * 16); const f32x4 p = (q[0] + q[1]) + (q[2] + q[3]); return rsqrtf(((p[0] + p[1]) + (p[2] + p[3])) * (1.f / 1024.f) + 1e-6f); }

#define XB_TMO      128
#define XB_XCNT(j)  (256  + 64 * (j))
#define XB_XSUB(j)  (1280 + 64 * (j))
#define XB_XGEN(j)  (2304 + 64 * (j))
#define XB_TOP      3328
#define XB_TOPGEN   3392
#define XCD_BAR_WORDS 3456
#define XB_SPIN_CAP (1u << 18)
DEV unsigned xb_ld(unsigned* p)              { return __hip_atomic_load(p, __ATOMIC_RELAXED, __HIP_MEMORY_SCOPE_AGENT); }
DEV unsigned xb_add(unsigned* p, unsigned v) { return __hip_atomic_fetch_add(p, v, __ATOMIC_RELAXED, __HIP_MEMORY_SCOPE_AGENT); }
DEV unsigned xb_xcc_id() { return (unsigned)__builtin_amdgcn_s_getreg((3 << 11) | 20) & 0xFu; }
#define XB_SPIN(cond, bar) do { unsigned _sp = 0; while (cond) { __builtin_amdgcn_s_sleep(1); \
    if ((++_sp & 255u) == 0u) { if (xb_ld(&(bar)[XB_TMO])) break; if (_sp > XB_SPIN_CAP) { atomicAdd(&(bar)[XB_TMO], 1u); break; } } } } while (0)
struct XcdBarrier { unsigned* bar; unsigned x; volatile LAS unsigned* st; };
DEV XcdBarrier xcd_barrier_post(unsigned* bar, volatile LAS unsigned* st) {
    XcdBarrier b; b.bar = bar; b.x = xb_xcc_id(); b.st = st;
    if (threadIdx.x == 0) (void)xb_add(&bar[XB_XCNT(b.x)], 1u);
    return b;
}
DEV void xcd_barrier_complete(unsigned* bar, unsigned x, unsigned& nloc, unsigned& nx) {
    const unsigned G = gridDim.x * gridDim.y * gridDim.z;
    unsigned sum, cnt, mine, sp = 0u;
    for (;;) {
        sum = 0u; cnt = 0u; mine = 0u;
#pragma unroll
        for (unsigned j = 0; j < 16; ++j) { const unsigned c = xb_ld(&bar[XB_XCNT(j)]); sum += c; cnt += (c > 0u) ? 1u : 0u; mine = (j == x) ? c : mine; }
        if (sum == G) break;
        __builtin_amdgcn_s_sleep(1);
        if ((++sp & 255u) == 0u) { if (xb_ld(&bar[XB_TMO])) break; if (sp > XB_SPIN_CAP) { atomicAdd(&bar[XB_TMO], 1u); break; } }
    }
    nloc = mine > 0u ? mine : 1u; nx = cnt > 0u ? cnt : 1u;
}
DEV void xcd_barrier(const XcdBarrier& b) {
    asm volatile("s_waitcnt vmcnt(0)" ::: "memory");
    __syncthreads();
    if (threadIdx.x == 0) {
        unsigned* bar = b.bar;
        __builtin_amdgcn_s_waitcnt(0);
        unsigned nloc = b.st[0], nx = b.st[1];
        if (nloc == 0u) { xcd_barrier_complete(bar, b.x, nloc, nx); b.st[0] = nloc; b.st[1] = nx; }
        const unsigned old = xb_add(&bar[XB_XSUB(b.x)], 1u);
        const unsigned gen = old / nloc;
        if (old + 1u == (gen + 1u) * nloc) {
            __builtin_amdgcn_fence(__ATOMIC_RELEASE, "agent");
            asm volatile("s_waitcnt vmcnt(0)" ::: "memory");
            const unsigned og = xb_add(&bar[XB_TOP], 1u);
            const unsigned tg = og / nx;
            if (og + 1u == (tg + 1u) * nx) xb_add(&bar[XB_TOPGEN], 1u);
            else XB_SPIN(xb_ld(&bar[XB_TOPGEN]) == tg, bar);
            __builtin_amdgcn_fence(__ATOMIC_ACQUIRE, "agent");
            xb_add(&bar[XB_XGEN(b.x)], 1u);
            asm volatile("s_waitcnt vmcnt(0)" ::: "memory");
        } else {
            XB_SPIN(xb_ld(&bar[XB_XGEN(b.x)]) == gen, bar);
            __builtin_amdgcn_fence(__ATOMIC_ACQUIRE, "agent");
            asm volatile("s_waitcnt vmcnt(0)" ::: "memory");
        }
    }
    __syncthreads();
}

namespace pg8 {
constexpr int BM = 256, BK = 64, HALF = 128, HTB = HALF * BK * 2, STAGE_BYTES = 8 * HTB, NXCD = 8, WGM = 8;
DEV int lds_byte(int r, int c) { const int st = (r >> 4) * 2 + (c >> 5), rr = r & 15, cc = c & 31, ob = rr * 64 + cc * 2; return st * 1024 + (ob ^ (((ob >> 9) & 1) << 5)); }
DEV void stage_rc(int b, int& R, int& C) { const int st = b / 1024, sb = b % 1024, swz = sb ^ (((sb >> 9) & 1) << 5); R = (st >> 1) * 16 + swz / 64; C = (st & 1) * 32 + (swz % 64) / 2; }

struct Unit { int pm, pn; long ao, bo; int x0, x1; };
struct Gemm { const bf16_t* A; const bf16_t* Bt; int lda, ldb, K; };

struct GridSched {
    int nM, nN, nwg, G, c; long ta, tb;
    DEV void init(int nM_, int nN_, int shift, int lda, int ldb) { nM = nM_; nN = nN_; nwg = nM * nN; G = (int)gridDim.x; c = ((int)blockIdx.x + G - (shift % G)) % G; ta = 256L * lda; tb = 256L * ldb; }
    DEV bool next(int i, Unit& u) const {
        const long L = (long)i * G + c; if (L >= nwg) return false;
        int wgid = (int)L; { const int q = nwg / NXCD, r = nwg % NXCD, xcd = wgid % NXCD, off = wgid / NXCD; wgid = (xcd < r ? xcd * (q + 1) : r * (q + 1) + (xcd - r) * q) + off; }
        const int nig = WGM * nN, gid = wgid / nig, fm = gid * WGM, gsz = (nM - fm) < WGM ? (nM - fm) : WGM;
        u.pm = fm + ((wgid % nig) % gsz); u.pn = (wgid % nig) / gsz; u.ao = u.pm * ta; u.bo = u.pn * tb; u.x0 = 0; u.x1 = 0; return true;
    }
};
struct LoraSched {
    int G, c;
    DEV void init() { G = (int)gridDim.x; c = (int)blockIdx.x; }
    DEV bool next(int i, Unit& u) const {
        const long L = (long)i * G + c; if (L >= 65 * 6) return false;
        const int pn = (int)L % 6, pm = (int)L / 6, off = (pn >= 4) ? 128 : 0;
        u.pm = pm; u.pn = pn; u.x0 = 0; u.x1 = 0; u.ao = (long)pm * 256 * 384 + off; u.bo = (long)pn * 256 * 384 + off; return true;
    }
};
template <int WHICH> struct AttnSched {
    int G, c;
    DEV void init() { G = (int)gridDim.x; c = (int)blockIdx.x; }
    DEV bool next(int i, Unit& u) const {
        const long L = (long)i * G + c; if (L >= 256) return false;
        const int xcd = (int)L & 7, idx = (int)L >> 3, bh = xcd * 4 + (idx >> 3), mt = idx & 7, b = bh >> 2, h = bh & 3;
        u.pm = mt; u.pn = 0; u.x0 = bh; u.x1 = mt;
        if (WHICH == 0) { u.ao = ((long)b * 2048 + mt * 256) * 1024 + h * 256; u.bo = ((long)b * 256) * 1024 + h * 256; }
        else { u.ao = ((long)bh * 2048 + mt * 256) * 256; u.bo = ((long)h * 256) * 2048 + b * 256; }
        return true;
    }
};

template <class Epi, class Sched>
DEV void gemm_phase(LAS unsigned char* lds, const Gemm g, const Sched& S, const Epi& E) {
    int tid_ = threadIdx.x; asm volatile("" : "+v"(tid_));
    const int tid = tid_, wid = __builtin_amdgcn_readfirstlane(tid >> 6), lane = tid & 63, wr = wid >> 2, wc = wid & 3, fr = lane & 15, fq = lane >> 4;
    int K = g.K, lda_ = g.lda, ldb_ = g.ldb; asm volatile("" : "+s"(K), "+s"(lda_), "+s"(ldb_)); const int nt = K / BK;
    unsigned voffA[2], voffB[2];
#pragma unroll
    for (int i = 0; i < 2; ++i) { int R, C; stage_rc(tid * 16 + i * 8192, R, C); voffA[i] = (unsigned)(R * lda_ + C) * 2u; voffB[i] = (unsigned)(R * ldb_ + C) * 2u; }
    const size_t kstep = (size_t)(BK * 2);
    const size_t hstepA = (size_t)HALF * lda_ * 2, hstepB = (size_t)HALF * ldb_ * 2;
    const unsigned ldsw = (unsigned)wid * 1024u;
    const int aoff = lds_byte(wr * 64 + fr, fq * 8), boff = lds_byte(wc * 32 + fr, fq * 8);
#define PG8_SA(b, h) (((b) * 2 + (h)) * HTB)
#define PG8_SB(b, h) ((4 + (b) * 2 + (h)) * HTB)
#define PG8_STAGE(bufoff, gbase, voff) do { _Pragma("unroll") for (int _i = 0; _i < 2; ++_i) \
        __builtin_amdgcn_global_load_lds((const unsigned*)((const char*)(gbase) + (voff)[_i]), (LAS unsigned*)(lds + (bufoff) + ldsw + _i * 8192), 16, 0, 0); } while (0)
#define PG8_LDA(dst, b, h) do { _Pragma("unroll") for (int m = 0; m < 4; ++m) _Pragma("unroll") for (int k = 0; k < 2; ++k) dst[m][k] = *(const LAS bf16x8*)(lds + PG8_SA(b, h) + aoff + m * 2048 + k * 1024); } while (0)
#define PG8_LDB(dst, b, h) do { _Pragma("unroll") for (int n = 0; n < 2; ++n) _Pragma("unroll") for (int k = 0; k < 2; ++k) dst[n][k] = *(const LAS bf16x8*)(lds + PG8_SB(b, h) + boff + n * 2048 + k * 1024); } while (0)
#define PG8_MMA(ai, bj, At, Bt) do { __builtin_amdgcn_s_setprio(1); _Pragma("unroll") for (int m = 0; m < 4; ++m) _Pragma("unroll") for (int n = 0; n < 2; ++n) _Pragma("unroll") for (int k = 0; k < 2; ++k) \
        acc[ai][bj][m][n] = __builtin_amdgcn_mfma_f32_16x16x32_bf16(Bt[n][k], At[m][k], acc[ai][bj][m][n], 0, 0, 0); __builtin_amdgcn_s_setprio(0); } while (0)
#define PG8_WAIT_V(n) asm volatile("s_waitcnt vmcnt(" #n ")" ::: "memory")
#define PG8_WAIT_L(n) asm volatile("s_waitcnt lgkmcnt(" #n ")" ::: "memory")
#define PG8_BAR __builtin_amdgcn_s_barrier()
#define PG8_SCHED __builtin_amdgcn_sched_barrier(0)
    Unit cur, nxt; int ui = 0;
    if (!S.next(0, cur)) return;
    f32x4 acc[2][2][4][2];
#pragma unroll
    for (int a = 0; a < 2; ++a)
#pragma unroll
        for (int b = 0; b < 2; ++b)
#pragma unroll
            for (int m = 0; m < 4; ++m)
#pragma unroll
                for (int n = 0; n < 2; ++n) acc[a][b][m][n] = (f32x4){0.f, 0.f, 0.f, 0.f};
    bf16x8 At[4][2], B0[2][2], B1[2][2];
    const char* cA = (const char*)g.A + (size_t)cur.ao * 2; const char* cB = (const char*)g.Bt + (size_t)cur.bo * 2;
    PG8_STAGE(PG8_SB(0, 0), cB, voffB); PG8_STAGE(PG8_SA(0, 0), cA, voffA); PG8_STAGE(PG8_SB(0, 1), cB + hstepB, voffB); PG8_STAGE(PG8_SA(0, 1), cA + hstepA, voffA);
    if (wr == 1) PG8_BAR;
    PG8_WAIT_V(4); PG8_BAR;
    PG8_STAGE(PG8_SB(1, 0), cB + kstep, voffB); PG8_STAGE(PG8_SA(1, 0), cA + kstep, voffA); PG8_STAGE(PG8_SB(1, 1), cB + hstepB + kstep, voffB);
    PG8_WAIT_V(6); PG8_BAR;
    for (;;) {
        const bool has_next = S.next(ui + 1, nxt);
        const char* nA = has_next ? (const char*)g.A + (size_t)nxt.ao * 2 : cA; const char* nB = has_next ? (const char*)g.Bt + (size_t)nxt.bo * 2 : cB;
#pragma unroll 1
        for (int t = 0; t < nt; t += 2) {
            const bool last = (t == nt - 2);
            const char* a1 = cA + (size_t)(t + 1) * kstep;
            const char* a2 = last ? nA : cA + (size_t)(t + 2) * kstep; const char* b2 = last ? nB : cB + (size_t)(t + 2) * kstep;
            const char* a3 = a2 + kstep; const char* b3 = b2 + kstep;
            PG8_LDB(B0, 0, 0); PG8_SCHED; PG8_LDA(At, 0, 0); PG8_STAGE(PG8_SA(1, 1), a1 + hstepA, voffA);
            PG8_WAIT_L(8); PG8_BAR; PG8_WAIT_L(0); PG8_MMA(0, 0, At, B0); PG8_BAR; PG8_SCHED;
            PG8_LDB(B1, 0, 1); PG8_STAGE(PG8_SB(0, 0), b2, voffB);
            PG8_BAR; PG8_WAIT_L(0); PG8_MMA(0, 1, At, B1); PG8_BAR;
            PG8_LDA(At, 0, 1); PG8_STAGE(PG8_SA(0, 0), a2, voffA);
            PG8_BAR; PG8_WAIT_L(0); PG8_MMA(1, 0, At, B0); PG8_BAR; PG8_SCHED;
            PG8_STAGE(PG8_SB(0, 1), b2 + hstepB, voffB);
            PG8_WAIT_V(6); PG8_BAR; PG8_MMA(1, 1, At, B1); PG8_BAR;
            PG8_LDB(B0, 1, 0); PG8_SCHED; PG8_LDA(At, 1, 0); PG8_STAGE(PG8_SA(0, 1), a2 + hstepA, voffA);
            PG8_WAIT_L(8); PG8_BAR; PG8_WAIT_L(0); PG8_MMA(0, 0, At, B0); PG8_BAR; PG8_SCHED;
            PG8_LDB(B1, 1, 1); PG8_STAGE(PG8_SB(1, 0), b3, voffB);
            PG8_BAR; PG8_WAIT_L(0); PG8_MMA(0, 1, At, B1); PG8_BAR;
            PG8_LDA(At, 1, 1); PG8_STAGE(PG8_SA(1, 0), a3, voffA);
            PG8_BAR; PG8_WAIT_L(0); PG8_MMA(1, 0, At, B0); PG8_BAR; PG8_SCHED;
            PG8_STAGE(PG8_SB(1, 1), b3 + hstepB, voffB);
            PG8_WAIT_V(6); PG8_BAR; PG8_MMA(1, 1, At, B1); PG8_BAR;
        }
        E(acc, cur, wr, wc, fr, fq);
        if (!has_next) break;
#pragma unroll
        for (int a = 0; a < 2; ++a)
#pragma unroll
            for (int b = 0; b < 2; ++b)
#pragma unroll
                for (int m = 0; m < 4; ++m)
#pragma unroll
                    for (int n = 0; n < 2; ++n) acc[a][b][m][n] = (f32x4){0.f, 0.f, 0.f, 0.f};
        cur = nxt; cA = nA; cB = nB; ++ui;
    }
    PG8_WAIT_V(0);
    if (wr == 0) PG8_BAR;
    PG8_BAR;
#undef PG8_SA
#undef PG8_SB
#undef PG8_STAGE
#undef PG8_LDA
#undef PG8_LDB
#undef PG8_MMA
#undef PG8_WAIT_V
#undef PG8_WAIT_L
#undef PG8_BAR
#undef PG8_SCHED
}
}
using pg8::Unit;

typedef const f32x4 (&AccRef)[2][2][4][2];

struct EpiSwiglu {
    const float* rs; bf16_t* H;
    DEV void operator()(AccRef acc, const Unit& u, int wr, int wc, int fr, int fq) const {
        const int row0 = u.pm * 256 + wr * 64 + fr, hc0 = u.pn * 128 + wc * 16 + 4 * fq;
#pragma unroll
        for (int ai = 0; ai < 2; ++ai)
#pragma unroll
            for (int m = 0; m < 4; ++m) {
                const int r = row0 + ai * 128 + m * 16; const float rstd = rstd_of(rs, r);
#pragma unroll
                for (int bj = 0; bj < 2; ++bj) {
                    float hv[4];
#pragma unroll
                    for (int i = 0; i < 4; ++i) { const float gt = acc[ai][bj][m][0][i] * rstd, up = acc[ai][bj][m][1][i] * rstd; hv[i] = gt * sigmoidf_(gt) * up; }
                    u32x2 o; o[0] = cvt_pk_bf16(hv[0], hv[1]); o[1] = cvt_pk_bf16(hv[2], hv[3]);
                    *(u32x2*)(H + (size_t)r * DFF + hc0 + bj * 64) = o;
                }
            }
    }
};

struct EpiRes {
    const float* res; bf16_t* xb; float* rs_out; float alpha;
    DEV void operator()(AccRef acc, const Unit& u, int wr, int wc, int fr, int fq) const {
        const int row0 = u.pm * 256 + wr * 64 + fr, col0 = u.pn * 256 + wc * 32 + 4 * fq;
#pragma unroll
        for (int ai = 0; ai < 2; ++ai)
#pragma unroll
            for (int mh = 0; mh < 2; ++mh) {
                f32x4 x[2][2][2];
#pragma unroll
                for (int m2 = 0; m2 < 2; ++m2)
#pragma unroll
                    for (int bj = 0; bj < 2; ++bj)
#pragma unroll
                        for (int n = 0; n < 2; ++n) { const size_t o = (size_t)(row0 + ai * 128 + (mh * 2 + m2) * 16) * 1024 + col0 + bj * 128 + n * 16;
                            x[m2][bj][n] = res ? *(const f32x4*)(res + o) : bf4(*(const u32x2*)(xb + o)); }
#pragma unroll
                for (int m2 = 0; m2 < 2; ++m2) {
                    const int m = mh * 2 + m2, r = row0 + ai * 128 + m * 16; float s = 0.f;
#pragma unroll
                    for (int bj = 0; bj < 2; ++bj)
#pragma unroll
                        for (int n = 0; n < 2; ++n) {
                            const int c = col0 + bj * 128 + n * 16; const f32x4 v = x[m2][bj][n] + alpha * acc[ai][bj][m][n];
                            *(u32x2*)(xb + (size_t)r * 1024 + c) = pk4(v);
                            s += v[0] * v[0] + v[1] * v[1] + v[2] * v[2] + v[3] * v[3];
                        }
                    s += __shfl_xor(s, 16); s += __shfl_xor(s, 32);
                    if (fq == 0) rs_out[(size_t)r * 16 + u.pn * 4 + wc] = s;
                }
            }
    }
};

struct EpiScale {
    const float* rs; bf16_t* O; int ldo, ncols;
    DEV void operator()(AccRef acc, const Unit& u, int wr, int wc, int fr, int fq) const {
        const int row0 = u.pm * 256 + wr * 64 + fr, col0 = u.pn * 256 + wc * 32 + 4 * fq;
#pragma unroll
        for (int ai = 0; ai < 2; ++ai)
#pragma unroll
            for (int m = 0; m < 4; ++m) {
                const int r = row0 + ai * 128 + m * 16; const float rstd = rstd_of(rs, r);
#pragma unroll
                for (int bj = 0; bj < 2; ++bj)
#pragma unroll
                    for (int n = 0; n < 2; ++n) {
                        const int c = col0 + bj * 128 + n * 16;
                        if (c < ncols) { const f32x4 v = acc[ai][bj][m][n] * rstd; u32x2 o; o[0] = cvt_pk_bf16(v[0], v[1]); o[1] = cvt_pk_bf16(v[2], v[3]); *(u32x2*)(O + (size_t)r * ldo + c) = o; }
                    }
            }
    }
};

struct EpiLora {
    const float* w0; const float* a0; const float* k_a; float* dec; bf16_t* kbuf; const bf16_t* kkbuf; bf16_t* kka; bf16_t* gb;
    template <int REGION> DEV void run(AccRef acc, const Unit& u, int wr, int wc, int fr, int fq) const {
        const int row0 = u.pm * 256 + wr * 64 + fr, cb = (u.pn & 1) * 256 + wc * 32 + 4 * fq;
#pragma unroll
        for (int ai = 0; ai < 2; ++ai)
#pragma unroll
            for (int m = 0; m < 4; ++m) {
                const int r = row0 + ai * 128 + m * 16;
                {
#pragma unroll
                    for (int bj = 0; bj < 2; ++bj)
#pragma unroll
                        for (int n = 0; n < 2; ++n) {
                            const int cc = cb + bj * 128 + n * 16; const f32x4 a = acc[ai][bj][m][n]; const size_t o = (size_t)r * 512 + cc;
                            if (REGION == 0) {
                                const f32x4 b0 = *(const f32x4*)(w0 + cc); f32x4 d;
#pragma unroll
                                for (int i = 0; i < 4; ++i) { const float x = -(b0[i] + a[i]); const float sp = fmaxf(x, 0.f) + __logf(1.f + __expf(-fabsf(x))); d[i] = __expf(-__expf(-sp - 0.5f)); }
                                *(f32x4*)(dec + o) = d;
                            } else if (REGION == 1) {
                                const f32x4 b0 = *(const f32x4*)(a0 + cc), ka = *(const f32x4*)(k_a + cc), kv = bf4(*(const u32x2*)(kbuf + o)), kkv = bf4(*(const u32x2*)(kkbuf + o)); f32x4 kn, kkan;
#pragma unroll
                                for (int i = 0; i < 4; ++i) { const float av = sigmoidf_(b0[i] + a[i]); kn[i] = kv[i] * (1.f + (av - 1.f) * ka[i]); kkan[i] = kkv[i] * av; }
                                *(u32x2*)(kbuf + o) = pk4(kn); *(u32x2*)(kka + o) = pk4(kkan);
                            } else {
                                u32x2 ov; ov[0] = cvt_pk_bf16(a[0], a[1]); ov[1] = cvt_pk_bf16(a[2], a[3]); *(u32x2*)(gb + o) = ov;
                            }
                        }
                }
            }
    }
    DEV void operator()(AccRef acc, const Unit& u, int wr, int wc, int fr, int fq) const {
        const int region = u.pn >> 1;
        if (region == 0) run<0>(acc, u, wr, wc, fr, fq); else if (region == 1) run<1>(acc, u, wr, wc, fr, fq); else run<2>(acc, u, wr, wc, fr, fq);
    }
};

struct EpiK {
    const float* rstdm; float* outk; bf16_t* mkb;
    DEV void operator()(AccRef acc, const Unit& u, int wr, int wc, int fr, int fq) const {
        const int row0 = u.pm * 256 + wr * 64 + fr, col0 = u.pn * 256 + wc * 32 + 4 * fq;
#pragma unroll
        for (int ai = 0; ai < 2; ++ai)
#pragma unroll
            for (int m = 0; m < 4; ++m) {
                const int r = row0 + ai * 128 + m * 16; const float rstd = rstdm[r];
#pragma unroll
                for (int bj = 0; bj < 2; ++bj)
#pragma unroll
                    for (int n = 0; n < 2; ++n) {
                        const int c = col0 + bj * 128 + n * 16; const f32x4 v = acc[ai][bj][m][n] * rstd;
                        *(f32x4*)(outk + (size_t)r * 1024 + c) = v;
                        u32x2 o; o[0] = cvt_pk_bf16(v[0], v[1]); o[1] = cvt_pk_bf16(v[2], v[3]); *(u32x2*)(mkb + (size_t)r * 1024 + c) = o;
                    }
            }
    }
};
struct EpiVT {
    const float* rstdm; float* outv; bf16_t* vt;
    DEV void operator()(AccRef acc, const Unit& u, int wr, int wc, int fr, int fq) const {
        const int row0 = u.pm * 256 + wr * 64 + fr, col0 = u.pn * 256 + wc * 32 + 4 * fq;
#pragma unroll
        for (int bj = 0; bj < 2; ++bj)
#pragma unroll
            for (int n = 0; n < 2; ++n) {
                const int c = col0 + bj * 128 + n * 16; const f32x4 rsd = *(const f32x4*)(rstdm + c);
#pragma unroll
                for (int ai = 0; ai < 2; ++ai)
#pragma unroll
                    for (int m = 0; m < 4; ++m) {
                        const int r = row0 + ai * 128 + m * 16; const f32x4 v = acc[ai][bj][m][n] * rsd;
                        u32x2 o; o[0] = cvt_pk_bf16(v[0], v[1]); o[1] = cvt_pk_bf16(v[2], v[3]); *(u32x2*)(vt + (size_t)r * 2048 + c) = o;
#pragma unroll
                        for (int i = 0; i < 4; ++i) outv[(size_t)(c + i) * 1024 + r] = v[i];
                    }
            }
    }
};
struct EpiS {
    bf16_t* P; float* psum;
    DEV void operator()(AccRef acc, const Unit& u, int wr, int wc, int fr, int fq) const {
        const size_t prow0 = (size_t)u.x0 * 2048 + u.x1 * 256;
#pragma unroll
        for (int ai = 0; ai < 2; ++ai)
#pragma unroll
            for (int m = 0; m < 4; ++m) {
                const int rl = ai * 128 + wr * 64 + m * 16 + fr; float s = 0.f;
#pragma unroll
                for (int bj = 0; bj < 2; ++bj)
#pragma unroll
                    for (int n = 0; n < 2; ++n) {
                        const f32x4 a = acc[ai][bj][m][n]; u32x2 o;
                        o[0] = cvt_pk_bf16(__expf(a[0]), __expf(a[1])); o[1] = cvt_pk_bf16(__expf(a[2]), __expf(a[3]));
                        s += bf_lo(o[0]) + bf_hi(o[0]) + bf_lo(o[1]) + bf_hi(o[1]);
                        *(u32x2*)(P + (prow0 + rl) * 256 + bj * 128 + wc * 32 + n * 16 + 4 * fq) = o;
                    }
                s += __shfl_xor(s, 16); s += __shfl_xor(s, 32);
                if (fq == 0) psum[(prow0 + rl) * 4 + wc] = s;
            }
    }
};
struct EpiO {
    const float* psum; bf16_t* O;
    DEV void operator()(AccRef acc, const Unit& u, int wr, int wc, int fr, int fq) const {
        const int bh = u.x0, b = bh >> 2, h = bh & 3; const size_t prow0 = (size_t)bh * 2048 + u.x1 * 256; const size_t m0 = (size_t)b * 2048 + u.x1 * 256;
#pragma unroll
        for (int ai = 0; ai < 2; ++ai)
#pragma unroll
            for (int m = 0; m < 4; ++m) {
                const int rl = ai * 128 + wr * 64 + m * 16 + fr; const f32x4 p = *(const f32x4*)(psum + (prow0 + rl) * 4); const float inv = 1.f / (p[0] + p[1] + p[2] + p[3]);
#pragma unroll
                for (int bj = 0; bj < 2; ++bj)
#pragma unroll
                    for (int n = 0; n < 2; ++n) {
                        const f32x4 v = acc[ai][bj][m][n] * inv; u32x2 o; o[0] = cvt_pk_bf16(v[0], v[1]); o[1] = cvt_pk_bf16(v[2], v[3]);
                        *(u32x2*)(O + (m0 + rl) * 1024 + h * 256 + bj * 128 + wc * 32 + n * 16 + 4 * fq) = o;
                    }
            }
    }
};

struct SRes {
    const float* res; bf16_t* xb; float* rs_out; float alpha; int res_row0;
    DEV void operator()(int r, int c, f32x4 a, int slab, int l15) const {
        const f32x4 x0 = res ? *(const f32x4*)(res + (size_t)(r - res_row0) * 1024 + c) : bf4(*(const u32x2*)(xb + (size_t)r * 1024 + c));
        const f32x4 x = x0 + alpha * a;
        *(u32x2*)(xb + (size_t)r * 1024 + c) = pk4(x);
        const float s = rowsum16(x[0] * x[0] + x[1] * x[1] + x[2] * x[2] + x[3] * x[3]);
        if (l15 == 0) rs_out[(size_t)r * 16 + slab] = s;
    }
};
struct SScale {
    const float* rs; bf16_t* O; int ldo, ncols, col_off;
    DEV void operator()(int r, int c, f32x4 a, int, int) const {
        const int cc = c + col_off;
        if (cc < ncols) { const f32x4 v = a * rstd_of(rs, r); u32x2 o; o[0] = cvt_pk_bf16(v[0], v[1]); o[1] = cvt_pk_bf16(v[2], v[3]); *(u32x2*)(O + (size_t)r * ldo + cc) = o; }
    }
};
template <int NB, class Epi>
DEV void small_gemm(LAS unsigned char* lds, const bf16_t* A, int lda, const bf16_t* Bt, int ldb, int K, int row_base, int nrg, int nslab, const Epi& E) {
    const int tid = fresh_tid(), lane = tid & 63, w = tid >> 6, l15 = lane & 15, kg = lane >> 4;
    LAS float* red = (LAS float*)lds;
    const int kw = K >> 3;
    for (int item = blockIdx.x; item < nrg * nslab; item += gridDim.x) {
        const int rgi = item % nrg, slab = item / nrg, r0 = row_base + rgi * 32, c0 = slab * 64;
        f32x4 acc[2][4];
#pragma unroll
        for (int rb = 0; rb < 2; ++rb)
#pragma unroll
            for (int n = 0; n < 4; ++n) acc[rb][n] = (f32x4){0.f, 0.f, 0.f, 0.f};
        const bf16_t* ap = A + (size_t)(r0 + l15) * lda + w * kw + kg * 8;
        const bf16_t* bp = Bt + (size_t)(c0 + l15) * ldb + w * kw + kg * 8;
#pragma unroll 4
        for (int k = 0; k < kw; k += 32) {
            const bf16x8 a0 = *(const bf16x8*)(ap + k), a1 = *(const bf16x8*)(ap + (size_t)16 * lda + k);
            bf16x8 b[NB];
#pragma unroll
            for (int n = 0; n < NB; ++n) b[n] = *(const bf16x8*)(bp + (size_t)(n * 16) * ldb + k);
#pragma unroll
            for (int n = 0; n < NB; ++n) { acc[0][n] = __builtin_amdgcn_mfma_f32_16x16x32_bf16(b[n], a0, acc[0][n], 0, 0, 0); acc[1][n] = __builtin_amdgcn_mfma_f32_16x16x32_bf16(b[n], a1, acc[1][n], 0, 0, 0); }
        }
        __syncthreads();
#pragma unroll
        for (int rb = 0; rb < 2; ++rb)
#pragma unroll
            for (int n = 0; n < 4; ++n) *(LAS f32x4*)(red + ((w * 32 + rb * 16 + l15) * 64 + n * 16 + 4 * kg)) = acc[rb][n];
        __syncthreads();
        const int row = tid >> 4, c4 = (tid & 15) * 4; f32x4 sum = (f32x4){0.f, 0.f, 0.f, 0.f};
#pragma unroll
        for (int ww = 0; ww < 8; ++ww) sum = sum + *(const LAS f32x4*)(red + ((ww * 32 + row) * 64 + c4));
        E(r0 + row, c0 + c4, sum, slab, tid & 15);
    }
}

DEV void ld8bf(const bf16_t* p, float (&v)[8]) { const u32x4 u = *(const u32x4*)p;
#pragma unroll
    for (int i = 0; i < 4; ++i) { v[2 * i] = bf_lo(u[i]); v[2 * i + 1] = bf_hi(u[i]); } }
DEV void ld8f(const float* p, float (&v)[8]) { const f32x4 a = *(const f32x4*)p, b = *(const f32x4*)(p + 4);
#pragma unroll
    for (int i = 0; i < 4; ++i) { v[i] = a[i]; v[4 + i] = b[i]; } }
DEV void st8f(float* p, const float (&v)[8]) { *(f32x4*)p = (f32x4){v[0], v[1], v[2], v[3]}; *(f32x4*)(p + 4) = (f32x4){v[4], v[5], v[6], v[7]}; }
DEV void st8bf(bf16_t* p, const float (&v)[8]) { u32x4 o; o[0] = cvt_pk_bf16(v[0], v[1]); o[1] = cvt_pk_bf16(v[2], v[3]); o[2] = cvt_pk_bf16(v[4], v[5]); o[3] = cvt_pk_bf16(v[6], v[7]); *(u32x4*)p = o; }

DEV void tr_job(const float* __restrict__ src, int Ks, int Ns, int Nd, bf16_t* __restrict__ dst, int mode, const float* __restrict__ gain, float scale, LAS float* tile) {
    const int nk = Ks / 64, nn = Nd / 64, ntile = nk * nn, ldd = Ks; const int t = fresh_tid();
    f32x4 v0, v1;
    auto gl = [&](int ti) { const int tk = ti % nk, tn = ti / nk;
        { const int id = t, k = id >> 4, gn = tn * 64 + (id & 15) * 4; v0 = (gn < Ns) ? *(const f32x4*)(src + (size_t)(tk * 64 + k) * Ns + gn) : (f32x4){0.f, 0.f, 0.f, 0.f}; if (gain) v0 = v0 * (gain[tk * 64 + k] * scale); }
        { const int id = t + 512, k = id >> 4, gn = tn * 64 + (id & 15) * 4; v1 = (gn < Ns) ? *(const f32x4*)(src + (size_t)(tk * 64 + k) * Ns + gn) : (f32x4){0.f, 0.f, 0.f, 0.f}; if (gain) v1 = v1 * (gain[tk * 64 + k] * scale); } };
    int ti = blockIdx.x;
    if (ti < ntile) gl(ti);
    for (; ti < ntile; ti += gridDim.x) {
        const int tk = ti % nk, tn = ti / nk;
        *(LAS f32x4*)(tile + (t >> 4) * 68 + (t & 15) * 4) = v0; *(LAS f32x4*)(tile + ((t + 512) >> 4) * 68 + (t & 15) * 4) = v1;
        if (ti + (int)gridDim.x < ntile) gl(ti + gridDim.x);
        __syncthreads();
        { const int n = t & 63, k8 = (t >> 6) * 8, gn = tn * 64 + n; float v[8];
#pragma unroll
          for (int j = 0; j < 8; ++j) v[j] = tile[(k8 + j) * 68 + n];
          const int drow = mode == 0 ? gn : ((gn >> 4) * 32 + (mode == 2 ? 16 : 0) + (gn & 15));
          st8bf(dst + (size_t)drow * ldd + tk * 64 + k8, v); }
        __syncthreads();
    }
}

DEV void phase_prep(const Params& p, LAS unsigned char* lds) {
    unsigned char* ws = p.ws; LAS float* tile = (LAS float*)lds;
    const int tid = fresh_tid(), lane = tid & 63, gw = blockIdx.x * 8 + (tid >> 6), nw = gridDim.x * 8;
    bf16_t* xb = (bf16_t*)(ws + O_XB); float* rs1 = (float*)(ws + O_RS1);
#pragma unroll 2
    for (int r = gw; r < MP; r += nw) {
        float ss = 0.f;
        if (r < MV) {
            const float* xr = r < NTOK ? p.in[I_XP] + (size_t)r * 1024 : p.in[I_XS] + (size_t)(r - NTOK) * 1024;
#pragma unroll
            for (int i = 0; i < 4; ++i) { const int c = lane * 4 + 256 * i; const f32x4 v = *(const f32x4*)(xr + c); ss += v[0] * v[0] + v[1] * v[1] + v[2] * v[2] + v[3] * v[3];
                u32x2 o; o[0] = cvt_pk_bf16(v[0], v[1]); o[1] = cvt_pk_bf16(v[2], v[3]); *(u32x2*)(xb + (size_t)r * 1024 + c) = o; }
            ss = wsum64(ss);
        } else {
#pragma unroll
            for (int i = 0; i < 4; ++i) { u32x2 o; o[0] = 0; o[1] = 0; *(u32x2*)(xb + (size_t)r * 1024 + lane * 4 + 256 * i) = o; }
        }
        if (lane < 16) { rs1[(size_t)r * 16 + lane] = lane == 0 ? ss : 0.f;
            if (r >= MV) { ((float*)(ws + O_RS2))[(size_t)r * 16 + lane] = 0.f; ((float*)(ws + O_RS3))[(size_t)r * 16 + lane] = 0.f; ((float*)(ws + O_RS4))[(size_t)r * 16 + lane] = 0.f; ((float*)(ws + O_RS5))[(size_t)r * 16 + lane] = 0.f; } }
    }
    bf16_t* mnb = (bf16_t*)(ws + O_MNB); float* rstdm = (float*)(ws + O_RSTDM);
    for (int r = gw; r < NMEMR; r += nw) {
        const float* xr = p.in[I_MEM] + (size_t)r * 1024; float ss = 0.f;
#pragma unroll
        for (int i = 0; i < 4; ++i) { const int c = lane * 4 + 256 * i; const f32x4 v = *(const f32x4*)(xr + c); ss += v[0] * v[0] + v[1] * v[1] + v[2] * v[2] + v[3] * v[3];
            u32x2 o; o[0] = cvt_pk_bf16(v[0], v[1]); o[1] = cvt_pk_bf16(v[2], v[3]); *(u32x2*)(mnb + (size_t)r * 1024 + c) = o; }
        ss = wsum64(ss);
        if (lane == 0) rstdm[r] = rsqrtf(ss * (1.f / 1024.f) + 1e-6f);
    }
    { bf16_t* wl = (bf16_t*)(ws + O_WLORA);
      for (int i = blockIdx.x * 512 + tid; i < 1536 * 384; i += gridDim.x * 512) {
          const int n = i / 384, k = i % 384, reg = n >> 9, c = n & 511; float v = 0.f;
          if (reg == 0 && k < 64) v = p.in[I_W2][k * 512 + c];
          else if (reg == 1 && k >= 64 && k < 128) v = p.in[I_A2][(k - 64) * 512 + c];
          else if (reg == 2 && k >= 128 && k < 288) v = p.in[I_G2][(k - 128) * 512 + c];
          wl[i] = (bf16_t)(cvt_pk_bf16(v, 0.f) & 0xffffu);
      } }
    tr_job(p.in[I_G1], 1024, 2816, 2816, (bf16_t*)(ws + O_WGU1), 1, p.in[I_LN1], 1.f, tile);
    tr_job(p.in[I_U1], 1024, 2816, 2816, (bf16_t*)(ws + O_WGU1), 2, p.in[I_LN1], 1.f, tile);
    tr_job(p.in[I_XK], 1024, 1024, 1024, (bf16_t*)(ws + O_WK), 0, p.in[I_MEMN], 1.f, tile);
    tr_job(p.in[I_XV], 1024, 1024, 1024, (bf16_t*)(ws + O_WV), 0, p.in[I_MEMN], 1.f, tile);
    tr_job(p.in[I_D1], 2816, 1024, 1024, (bf16_t*)(ws + O_WD1), 0, nullptr, 1.f, tile);
    tr_job(p.in[I_WIN], 1024, 2848, 3072, (bf16_t*)(ws + O_WIN), 0, p.in[I_LNMIX], 1.f, tile);
    tr_job(p.in[I_WOUT], 1024, 1024, 1024, (bf16_t*)(ws + O_WOUT), 0, nullptr, 1.f, tile);
    tr_job(p.in[I_XQ], 1024, 1024, 1024, (bf16_t*)(ws + O_WQ), 0, p.in[I_LNX], 0.0625f, tile);
    tr_job(p.in[I_XO], 1024, 1024, 1024, (bf16_t*)(ws + O_WO), 0, nullptr, 1.f, tile);
    tr_job(p.in[I_G2F], 1024, 2816, 2816, (bf16_t*)(ws + O_WGU2), 1, p.in[I_LN2], 1.f, tile);
    tr_job(p.in[I_U2F], 1024, 2816, 2816, (bf16_t*)(ws + O_WGU2), 2, p.in[I_LN2], 1.f, tile);
    tr_job(p.in[I_D2F], 2816, 1024, 1024, (bf16_t*)(ws + O_WD2), 0, nullptr, 1.f, tile);
}

DEV void phase_mixprep(const Params& p) {
    unsigned char* ws = p.ws; const int tid = fresh_tid(), lane = tid & 63, gw = blockIdx.x * 8 + (tid >> 6), nw = gridDim.x * 8;
    const bf16_t* z = (const bf16_t*)(ws + O_Z); bf16_t* vab = (bf16_t*)(ws + O_VAB); bf16_t* lin = (bf16_t*)(ws + O_LIN); bf16_t* ymix = (bf16_t*)(ws + O_YMIX);
    bf16_t* rbuf = (bf16_t*)(ws + O_H); bf16_t* kbuf = (bf16_t*)(ws + O_H + HALFROW); bf16_t* vbuf = (bf16_t*)(ws + O_XRES); bf16_t* kkbuf = (bf16_t*)(ws + O_KK);
#pragma unroll 2
    for (int r = gw; r < MV; r += nw) {
        const bf16_t* zr = z + (size_t)r * ZLD; const bool smp = r >= NTOK; const int t = r & (SEQ - 1), si = r - NTOK;
        {
            const int c = lane * 8; float v[8]; ld8bf(zr + 512 + c, v); float s = 0.f;
#pragma unroll
            for (int i = 0; i < 8; ++i) { v[i] = gelu_t(v[i]); s += v[i]; }
            const float mu = wsum64(s) * (1.f / 512.f); float q = 0.f;
#pragma unroll
            for (int i = 0; i < 8; ++i) { v[i] -= mu; q += v[i] * v[i]; }
            const float rstd = rsqrtf(wsum64(q) * (1.f / 512.f) + 1e-5f); float g[8], b[8]; ld8f(p.in[I_SLNG] + c, g); ld8f(p.in[I_SLNB] + c, b);
#pragma unroll
            for (int i = 0; i < 8; ++i) v[i] = v[i] * rstd * g[i] + b[i];
            st8bf(vab + (size_t)r * 512 + c, v);
            if (smp) {
                st8f(p.out + OUT_CV + (size_t)si * 512 + c, v);
                const int grp = c >> 6; const float w00 = p.in[I_SGUW][grp * 16384], b0 = p.in[I_SGUB][grp * 128]; float uu[8]; ld8bf(zr + c, uu);
#pragma unroll
                for (int i = 0; i < 8; ++i) uu[i] = gelu_t(uu[i]) * (w00 * v[i] + b0);
                st8bf(ymix + (size_t)r * 1024 + c, uu);
            }
        }
#pragma unroll
        for (int it = 0; it < 4; ++it) {
            const int ch = lane + 64 * it; if (ch >= 228) break;
            const int cb = ch * 8; float cur[8], prv[8], mu[8], zs[8]; ld8bf(zr + 1024 + cb, cur);
            if (smp) ld8f(p.in[I_SSHIFT] + (size_t)si * BPROJ + cb, prv);
            else if (t == 0) {
#pragma unroll
                for (int i = 0; i < 8; ++i) prv[i] = 0.f;
            } else ld8bf(zr - ZLD + 1024 + cb, prv);
            ld8f(p.in[I_MU] + cb, mu);
#pragma unroll
            for (int i = 0; i < 8; ++i) zs[i] = cur[i] + (prv[i] - cur[i]) * mu[i];
            if (smp) st8f(p.out + OUT_SHS + (size_t)si * BPROJ + cb, cur);
            else if (t == SEQ - 1) st8f(p.out + OUT_SHP + (size_t)(r >> 11) * BPROJ + cb, cur);
            if (it == 0) st8bf(rbuf + (size_t)r * 512 + cb, zs);
            else if (it == 1) {
                const int c = cb - 512; st8bf(kbuf + (size_t)r * 512 + c, zs); float kkw[8], kk[8]; ld8f(p.in[I_KK] + c, kkw); float ss = 0.f;
#pragma unroll
                for (int i = 0; i < 8; ++i) { kk[i] = zs[i] * kkw[i]; ss += kk[i] * kk[i]; }
                ss += __shfl_xor(ss, 1); ss += __shfl_xor(ss, 2); ss += __shfl_xor(ss, 4);
                const float rn = rsqrtf(fmaxf(ss, 1e-24f));
#pragma unroll
                for (int i = 0; i < 8; ++i) kk[i] *= rn;
                st8bf(kkbuf + (size_t)r * 512 + c, kk);
            } else if (it == 2) st8bf(vbuf + (size_t)r * 512 + (cb - 1024), zs);
            else {
                const int l = ch - 192; float o[8];
#pragma unroll
                for (int i = 0; i < 8; ++i) o[i] = l < 8 ? tanhf_(zs[i]) : (l < 16 ? zs[i] : sigmoidf_(zs[i]));
                st8bf(lin + (size_t)r * 384 + l * 8, o);
            }
        }
        if (lane >= 36 && lane < 48) { const float zero[8] = {0.f, 0.f, 0.f, 0.f, 0.f, 0.f, 0.f, 0.f}; st8bf(lin + (size_t)r * 384 + lane * 8, zero); }
    }
}

DEV void phase_chunkmix(const Params& p, LAS unsigned char* lds) {
    unsigned char* ws = p.ws; const int tid = fresh_tid(), lane = tid & 63, w = tid >> 6, l15 = lane & 15, kg = lane >> 4;
    const bf16_t* z = (const bf16_t*)(ws + O_Z); const bf16_t* vab = (const bf16_t*)(ws + O_VAB); bf16_t* ymix = (bf16_t*)(ws + O_YMIX);
    LAS bf16_t* vaT = (LAS bf16_t*)lds;
    for (int item = blockIdx.x; item < 1024; item += gridDim.x) {
        const int g = item & 7, bc = item >> 3; const size_t m0 = (size_t)bc * 128;
        __syncthreads();
#pragma unroll
        for (int i = 0; i < 2; ++i) { const int id = tid + 512 * i, s = id >> 3, d8 = (id & 7) * 8; const u32x4 u = *(const u32x4*)(vab + (m0 + s) * 512 + g * 64 + d8);
#pragma unroll
            for (int j = 0; j < 4; ++j) { vaT[(d8 + 2 * j) * 136 + s] = (bf16_t)(u[j] & 0xffffu); vaT[(d8 + 2 * j + 1) * 136 + s] = (bf16_t)(u[j] >> 16); } }
        __syncthreads();
        f32x4 acc[4];
#pragma unroll
        for (int nb = 0; nb < 4; ++nb) acc[nb] = (f32x4){0.f, 0.f, 0.f, 0.f};
        const int trow = 16 * w + l15; const float* wrow = p.in[I_SGUW] + ((size_t)g * 128 + trow) * 128;
        const int nks = (16 * w + 16 + 31) >> 5;
        for (int ks = 0; ks < nks; ++ks) {
            const int s0 = 32 * ks + kg * 8; float a[8]; ld8f(wrow + s0, a);
#pragma unroll
            for (int i = 0; i < 8; ++i) a[i] = (s0 + i <= trow) ? a[i] : 0.f;
            u32x4 au; au[0] = cvt_pk_bf16(a[0], a[1]); au[1] = cvt_pk_bf16(a[2], a[3]); au[2] = cvt_pk_bf16(a[4], a[5]); au[3] = cvt_pk_bf16(a[6], a[7]);
            const bf16x8 av = __builtin_bit_cast(bf16x8, au);
#pragma unroll
            for (int nb = 0; nb < 4; ++nb) { const bf16x8 bv = *(const LAS bf16x8*)(vaT + (nb * 16 + l15) * 136 + s0); acc[nb] = __builtin_amdgcn_mfma_f32_16x16x32_bf16(av, bv, acc[nb], 0, 0, 0); }
        }
#pragma unroll
        for (int j = 0; j < 4; ++j) { const int t = 16 * w + kg * 4 + j; const float bias = p.in[I_SGUB][g * 128 + t]; const size_t m = m0 + t;
#pragma unroll
            for (int nb = 0; nb < 4; ++nb) { const int d = g * 64 + nb * 16 + l15; const float u = gelu_t(bf2f(z[m * ZLD + d])); ymix[m * 1024 + d] = (bf16_t)(cvt_pk_bf16(u * (acc[nb][j] + bias), 0.f) & 0xffffu); } }
    }
}

DEV void phase_scan(const Params& p, LAS unsigned char* lds) {
    unsigned char* ws = p.ws; const int tid = fresh_tid(), lane = tid & 63, w = tid >> 6, rg = lane >> 4, kq = lane & 15;
    const bf16_t* rbuf = (const bf16_t*)(ws + O_H); const bf16_t* kbuf = (const bf16_t*)(ws + O_H + HALFROW); const bf16_t* vbuf = (const bf16_t*)(ws + O_XRES);
    const bf16_t* kkbuf = (const bf16_t*)(ws + O_KK); const float* dec = (const float*)(ws + O_DEC); const bf16_t* kka = (const bf16_t*)(ws + O_KKA); bf16_t* obuf = (bf16_t*)(ws + O_XRES + HALFROW);
    constexpr int SL = 16, NCH = SEQ / SL, LB = 5 * SL * 64;
    LAS float* L = (LAS float*)lds;
    LAS float* Lv = L + 2 * LB;
    LAS float* Lp = Lv + 2 * SL * 16;
#define SCAN_BAR() do { asm volatile("s_waitcnt lgkmcnt(0)" ::: "memory"); __builtin_amdgcn_s_barrier(); asm volatile("" ::: "memory"); } while (0)
    for (int item = blockIdx.x; item < 256; item += gridDim.x) {
        const int bh = item >> 2, q = item & 3, b = bh >> 3, h = bh & 7; const size_t m0 = (size_t)b * SEQ;
        if (w >= 4) {
            const int lt = tid - 256, ls = lt >> 4, lc = (lt & 15) * 4;
            f32x4 p1; u32x2 p0, p2, p3, p4, pv; pv[0] = 0u; pv[1] = 0u;
            auto gload = [&](int ch) { const size_t o = (m0 + ch * SL + ls) * 512 + h * 64 + lc;
                p0 = *(const u32x2*)(kkbuf + o); p1 = *(const f32x4*)(dec + o); p2 = *(const u32x2*)(kbuf + o); p3 = *(const u32x2*)(kka + o); p4 = *(const u32x2*)(rbuf + o);
                if (lt < 64) pv = *(const u32x2*)(vbuf + (m0 + ch * SL + (lt >> 2)) * 512 + h * 64 + q * 16 + (lt & 3) * 4); };
            auto fill = [&](int ch) { LAS float* d = L + (ch & 1) * LB + ls * 64 + lc;
                *(LAS f32x4*)d = bf4(p0); *(LAS f32x4*)(d + SL * 64) = p1; *(LAS f32x4*)(d + 2 * SL * 64) = bf4(p2); *(LAS f32x4*)(d + 3 * SL * 64) = bf4(p3); *(LAS f32x4*)(d + 4 * SL * 64) = bf4(p4);
                if (lt < 64) *(LAS f32x4*)(Lv + (ch & 1) * SL * 16 + lt * 4) = bf4(pv); };
            auto reduce_slab = [&](int ch) { const int st = lt >> 4, row = lt & 15; const LAS float* pp = Lp + (ch & 1) * SL * 256 + st * 256 + (row >> 2) * 64 + (row & 3) * 16;
                const f32x4 a = *(const LAS f32x4*)pp, b4 = *(const LAS f32x4*)(pp + 4), c = *(const LAS f32x4*)(pp + 8), d = *(const LAS f32x4*)(pp + 12); const f32x4 t = (a + b4) + (c + d);
                obuf[(m0 + ch * SL + st) * 512 + h * 64 + q * 16 + row] = (bf16_t)(cvt_pk_bf16((t[0] + t[1]) + (t[2] + t[3]), 0.f) & 0xffffu); };
            gload(0); fill(0); gload(1);
            SCAN_BAR();
            for (int ch = 0; ch < NCH; ++ch) {
                if (ch + 1 < NCH) fill(ch + 1);
                if (ch + 2 < NCH) gload(ch + 2);
                if (ch >= 1) reduce_slab(ch - 1);
                SCAN_BAR();
            }
            reduce_slab(NCH - 1);
            {
                const int sidx = item * 4 + (w - 4), si = sidx >> 3, hh = sidx & 7; const size_t o = (size_t)(NTOK + si) * 512 + hh * 64 + kq * 4;
                const f32x4 kk4 = bf4(*(const u32x2*)(kkbuf + o)), w4 = *(const f32x4*)(dec + o), k4 = bf4(*(const u32x2*)(kbuf + o)), ka4 = bf4(*(const u32x2*)(kka + o)), r4 = bf4(*(const u32x2*)(rbuf + o));
                const float* sin = p.in[I_SRWKV] + (size_t)sidx * 4096; float* sout = p.out + OUT_SS + (size_t)sidx * 4096;
                for (int ps = 0; ps < 16; ++ps) {
                    const int v = ps * 4 + rg; f32x4 S = *(const f32x4*)(sin + v * 64 + kq * 4); const float vv = bf2f(vbuf[(size_t)(NTOK + si) * 512 + hh * 64 + v]);
                    const float sa = -rowsum16(S[0] * kk4[0] + S[1] * kk4[1] + S[2] * kk4[2] + S[3] * kk4[3]);
                    S = S * w4 + vv * k4 + sa * ka4;
                    *(f32x4*)(sout + v * 64 + kq * 4) = S;
                    const float op = rowsum16(S[0] * r4[0] + S[1] * r4[1] + S[2] * r4[2] + S[3] * r4[3]);
                    if (kq == 0) obuf[(size_t)(NTOK + si) * 512 + hh * 64 + v] = (bf16_t)(cvt_pk_bf16(op, 0.f) & 0xffffu);
                }
            }
        } else {
            float S0 = 0.f, S1 = 0.f, S2 = 0.f, S3 = 0.f; const int row = w * 4 + rg;
            SCAN_BAR();
            for (int ch = 0; ch < NCH; ++ch) {
                const LAS float* Lc = L + (ch & 1) * LB + kq * 4; const LAS float* Lvc = Lv + (ch & 1) * SL * 16 + row;
                LAS float* dst = Lp + (ch & 1) * SL * 256 + w * 64 + lane;
                f32x4 kk4 = *(const LAS f32x4*)Lc, w4 = *(const LAS f32x4*)(Lc + SL * 64), k4 = *(const LAS f32x4*)(Lc + 2 * SL * 64), ka4 = *(const LAS f32x4*)(Lc + 3 * SL * 64), r4 = *(const LAS f32x4*)(Lc + 4 * SL * 64);
                float vv = Lvc[0];
#pragma unroll 4
                for (int s = 0; s < SL; ++s) {
                    const int sn = s < SL - 1 ? s + 1 : SL - 1; const LAS float* bp = Lc + sn * 64;
                    const f32x4 nkk4 = *(const LAS f32x4*)bp, nw4 = *(const LAS f32x4*)(bp + SL * 64), nk4 = *(const LAS f32x4*)(bp + 2 * SL * 64), nka4 = *(const LAS f32x4*)(bp + 3 * SL * 64), nr4 = *(const LAS f32x4*)(bp + 4 * SL * 64);
                    const float nvv = Lvc[sn * 16];
                    const float sa = -rowsum16((S0 * kk4[0] + S1 * kk4[1]) + (S2 * kk4[2] + S3 * kk4[3]));
                    S0 = (S0 * w4[0] + vv * k4[0]) + sa * ka4[0]; S1 = (S1 * w4[1] + vv * k4[1]) + sa * ka4[1];
                    S2 = (S2 * w4[2] + vv * k4[2]) + sa * ka4[2]; S3 = (S3 * w4[3] + vv * k4[3]) + sa * ka4[3];
                    dst[s * 256] = (S0 * r4[0] + S1 * r4[1]) + (S2 * r4[2] + S3 * r4[3]);
                    kk4 = nkk4; w4 = nw4; k4 = nk4; ka4 = nka4; r4 = nr4; vv = nvv;
                }
                SCAN_BAR();
            }
            *(f32x4*)(p.out + OUT_SP + ((size_t)bh * 64 + q * 16 + row) * 64 + kq * 4) = (f32x4){S0, S1, S2, S3};
        }
        __syncthreads();
    }
#undef SCAN_BAR
}

DEV void phase_finalize(const Params& p) {
    unsigned char* ws = p.ws; const int tid = fresh_tid(), lane = tid & 63, gw = blockIdx.x * 8 + (tid >> 6), nw = gridDim.x * 8;
    const bf16_t* rbuf = (const bf16_t*)(ws + O_H); const bf16_t* kbuf = (const bf16_t*)(ws + O_H + HALFROW); const bf16_t* gb = (const bf16_t*)(ws + O_H + 2 * HALFROW);
    const bf16_t* vbuf = (const bf16_t*)(ws + O_XRES); const bf16_t* obuf = (const bf16_t*)(ws + O_XRES + HALFROW); bf16_t* ymix = (bf16_t*)(ws + O_YMIX);
    const int c = lane * 8; float rk[8], gg[8], gbb[8]; ld8f(p.in[I_RK] + c, rk); ld8f(p.in[I_GNG] + c, gg); ld8f(p.in[I_GNB] + c, gbb);
#pragma unroll 2
    for (int r = gw; r < MV; r += nw) {
        const size_t o = (size_t)r * 512 + c; float ov[8], rv[8], kv[8], vv[8], gv[8]; ld8bf(obuf + o, ov); ld8bf(rbuf + o, rv); ld8bf(kbuf + o, kv); ld8bf(vbuf + o, vv); ld8bf(gb + o, gv);
        float s = 0.f, bs = 0.f;
#pragma unroll
        for (int i = 0; i < 8; ++i) { s += ov[i]; bs += rv[i] * kv[i] * rk[i]; }
        s += __shfl_xor(s, 1); s += __shfl_xor(s, 2); s += __shfl_xor(s, 4); bs += __shfl_xor(bs, 1); bs += __shfl_xor(bs, 2); bs += __shfl_xor(bs, 4);
        const float mu = s * (1.f / 64.f); float q = 0.f;
#pragma unroll
        for (int i = 0; i < 8; ++i) { ov[i] -= mu; q += ov[i] * ov[i]; }
        q += __shfl_xor(q, 1); q += __shfl_xor(q, 2); q += __shfl_xor(q, 4);
        const float rstd = rsqrtf(q * (1.f / 64.f) + 64e-5f); float y[8];
#pragma unroll
        for (int i = 0; i < 8; ++i) y[i] = (ov[i] * rstd * gg[i] + gbb[i] + bs * vv[i]) * gv[i];
        st8bf(ymix + (size_t)r * 1024 + 512 + c, y);
    }
}

DEV void phase_sattn(const Params& p, LAS unsigned char* lds) {
    unsigned char* ws = p.ws; const int tid = fresh_tid(), lane = tid & 63, w = tid >> 6, kgrp = lane >> 4, dl = lane & 15;
    const bf16_t* qb = (const bf16_t*)(ws + O_Z + HALFROW); bf16_t* ob = (bf16_t*)(ws + O_YMIX);
    LAS float* pw = (LAS float*)lds;
    LAS float* wm = pw + 256;
    LAS float* wacc = wm + 16;
    for (int item = blockIdx.x; item < 512; item += gridDim.x) {
        const int si = item >> 2, h = item & 3; const float* Kp = p.in[I_CK] + (size_t)si * 262144 + h * 256; const float* Vp = p.in[I_CV] + (size_t)si * 262144 + h * 256;
        float q[16]; { float a[8], b[8]; ld8bf(qb + (size_t)(NTOK + si) * 1024 + h * 256 + dl * 16, a); ld8bf(qb + (size_t)(NTOK + si) * 1024 + h * 256 + dl * 16 + 8, b);
#pragma unroll
            for (int i = 0; i < 8; ++i) { q[i] = a[i]; q[8 + i] = b[i]; } }
        float sc[8];
#pragma unroll
        for (int j = 0; j < 8; ++j) {
            const float* kr = Kp + (size_t)(w * 32 + kgrp + 4 * j) * 1024 + dl * 16; float d = 0.f;
#pragma unroll
            for (int i = 0; i < 4; ++i) { const f32x4 k4 = *(const f32x4*)(kr + 4 * i); d += k4[0] * q[4 * i] + k4[1] * q[4 * i + 1] + k4[2] * q[4 * i + 2] + k4[3] * q[4 * i + 3]; }
            sc[j] = rowsum16(d);
        }
        float mx = sc[0];
#pragma unroll
        for (int j = 1; j < 8; ++j) mx = fmaxf(mx, sc[j]);
        mx = fmaxf(mx, __shfl_xor(mx, 16)); mx = fmaxf(mx, __shfl_xor(mx, 32));
        float sum = 0.f;
#pragma unroll
        for (int j = 0; j < 8; ++j) { sc[j] = __expf(sc[j] - mx); sum += sc[j]; }
        sum += __shfl_xor(sum, 16); sum += __shfl_xor(sum, 32);
        __syncthreads();
        if (dl == 0) {
#pragma unroll
            for (int j = 0; j < 8; ++j) pw[w * 32 + kgrp + 4 * j] = sc[j];
        }
        if (lane == 0) { wm[w] = mx; wm[8 + w] = sum; }
        asm volatile("s_waitcnt lgkmcnt(0)" ::: "memory"); __builtin_amdgcn_wave_barrier();
        f32x4 acc = (f32x4){0.f, 0.f, 0.f, 0.f};
#pragma unroll 16
        for (int j = 0; j < 32; ++j) { const f32x4 v4 = *(const f32x4*)(Vp + (size_t)(w * 32 + j) * 1024 + lane * 4); acc = acc + pw[w * 32 + j] * v4; }
        *(LAS f32x4*)(wacc + w * 256 + lane * 4) = acc;
        __syncthreads();
        if (tid < 256) {
            float M = wm[0];
#pragma unroll
            for (int j = 1; j < 8; ++j) M = fmaxf(M, wm[j]);
            float L = 0.f, o = 0.f;
#pragma unroll
            for (int j = 0; j < 8; ++j) { const float f = __expf(wm[j] - M); L += wm[8 + j] * f; o += wacc[j * 256 + tid] * f; }
            ob[(size_t)(NTOK + si) * 1024 + h * 256 + tid] = (bf16_t)(cvt_pk_bf16(o / L, 0.f) & 0xffffu);
        }
    }
}

DEV void phase_final(const Params& p) {
    unsigned char* ws = p.ws; const int tid = fresh_tid(), lane = tid & 63, gw = blockIdx.x * 8 + (tid >> 6), nw = gridDim.x * 8;
    const bf16_t* xb = (const bf16_t*)(ws + O_XB); const float* rs5 = (const float*)(ws + O_RS5);
    float g[16]; { float a[8], b[8]; ld8f(p.in[I_FIN] + lane * 8, a); ld8f(p.in[I_FIN] + 512 + lane * 8, b);
#pragma unroll
        for (int i = 0; i < 8; ++i) { g[i] = a[i]; g[8 + i] = b[i]; } }
#pragma unroll 2
    for (int r = gw; r < MV; r += nw) {
        const float rstd = rstd_of(rs5, r);
#pragma unroll
        for (int hf = 0; hf < 2; ++hf) { const int c = hf * 512 + lane * 8; float v[8]; ld8bf(xb + (size_t)r * 1024 + c, v);
#pragma unroll
            for (int i = 0; i < 8; ++i) v[i] = v[i] * rstd * g[hf * 8 + i];
            st8f(p.out + OUT_Y + (size_t)r * 1024 + c, v); }
    }
}

__global__ void __launch_bounds__(512, 2) mega(Params p) {
    extern __shared__ __attribute__((aligned(16))) unsigned char shm[];
    LAS unsigned char* lds = (LAS unsigned char*)shm;
    unsigned char* ws = p.ws;
    const int MT = MP / 256;
    {
        volatile LAS unsigned* st = (volatile LAS unsigned*)(lds + pg8::STAGE_BYTES);
        if (threadIdx.x < 2) st[threadIdx.x] = 0u;
        __syncthreads();
        if (threadIdx.x == 0) (void)xb_add(&((unsigned*)(ws + O_BAR))[XB_XCNT(xb_xcc_id())], 1u);
    }
#define XB_SYNC() do { XcdBarrier xb_; xb_.bar = (unsigned*)(p.ws + O_BAR); xb_.x = xb_xcc_id(); xb_.st = (volatile LAS unsigned*)(lds + pg8::STAGE_BYTES); xcd_barrier(xb_); } while (0)
    { phase_prep(p, lds); }
    XB_SYNC();
    { {
            { pg8::Gemm g{(const bf16_t*)(ws + O_XB), (const bf16_t*)(ws + O_WGU1), 1024, 1024, 1024}; pg8::GridSched S; S.init(MT, 22, 0, 1024, 1024);
              EpiSwiglu E{(const float*)(ws + O_RS1), (bf16_t*)(ws + O_H)}; pg8::gemm_phase(lds, g, S, E); }
            { pg8::Gemm g{(const bf16_t*)(ws + O_MNB), (const bf16_t*)(ws + O_WK), 1024, 1024, 1024}; pg8::GridSched S; S.init(8, 4, MT * 22, 1024, 1024);
              EpiK E{(const float*)(ws + O_RSTDM), p.out + OUT_MK, (bf16_t*)(ws + O_MKB)}; pg8::gemm_phase(lds, g, S, E); }
            { pg8::Gemm g{(const bf16_t*)(ws + O_WV), (const bf16_t*)(ws + O_MNB), 1024, 1024, 1024}; pg8::GridSched S; S.init(4, 8, MT * 22 + 32, 1024, 1024);
              EpiVT E{(const float*)(ws + O_RSTDM), p.out + OUT_MV, (bf16_t*)(ws + O_VT)}; pg8::gemm_phase(lds, g, S, E); }
        } }
    XB_SYNC();
    { { pg8::Gemm g{(const bf16_t*)(ws + O_H), (const bf16_t*)(ws + O_WD1), DFF, DFF, DFF}; pg8::GridSched S; S.init(64, 4, 0, DFF, DFF);
            EpiRes E{p.in[I_XP], (bf16_t*)(ws + O_XB), (float*)(ws + O_RS2), 0.5f}; pg8::gemm_phase(lds, g, S, E);
            SRes E2{p.in[I_XS], (bf16_t*)(ws + O_XB), (float*)(ws + O_RS2), 0.5f, NTOK};
            small_gemm<4>(lds, (const bf16_t*)(ws + O_H), DFF, (const bf16_t*)(ws + O_WD1), DFF, DFF, NTOK, 4, 16, E2); } }
    XB_SYNC();
    { { pg8::Gemm g{(const bf16_t*)(ws + O_XB), (const bf16_t*)(ws + O_WIN), 1024, 1024, 1024}; pg8::GridSched S; S.init(MT, 11, 0, 1024, 1024);
            EpiScale E{(const float*)(ws + O_RS2), (bf16_t*)(ws + O_Z), ZLD, ZLD}; pg8::gemm_phase(lds, g, S, E);
            SScale E2{(const float*)(ws + O_RS2), (bf16_t*)(ws + O_Z), ZLD, ZLD, 2816};
            small_gemm<2>(lds, (const bf16_t*)(ws + O_XB), 1024, (const bf16_t*)(ws + O_WIN) + (size_t)2816 * 1024, 1024, 1024, 0, MV / 32, 1, E2); } }
    XB_SYNC();
    { phase_mixprep(p); }
    XB_SYNC();
    { { pg8::Gemm g{(const bf16_t*)(ws + O_LIN), (const bf16_t*)(ws + O_WLORA), 384, 384, 256}; pg8::LoraSched S; S.init();
            EpiLora E{p.in[I_W0], p.in[I_A0], p.in[I_KA], (float*)(ws + O_DEC), (bf16_t*)(ws + O_H + HALFROW), (const bf16_t*)(ws + O_KK), (bf16_t*)(ws + O_KKA), (bf16_t*)(ws + O_H + 2 * HALFROW)};
            pg8::gemm_phase(lds, g, S, E); } }
    XB_SYNC();
    { phase_scan(p, lds); }
    XB_SYNC();
    {
        const bool mix_first = ((blockIdx.x >> 3) & 1) != 0;
        if (mix_first) phase_chunkmix(p, lds);
        phase_finalize(p);
        if (!mix_first) phase_chunkmix(p, lds); }
    XB_SYNC();
    { { pg8::Gemm g{(const bf16_t*)(ws + O_YMIX), (const bf16_t*)(ws + O_WOUT), 1024, 1024, 1024}; pg8::GridSched S; S.init(64, 4, 0, 1024, 1024);
            EpiRes E{nullptr, (bf16_t*)(ws + O_XB), (float*)(ws + O_RS3), 1.f}; pg8::gemm_phase(lds, g, S, E);
            SRes E2{nullptr, (bf16_t*)(ws + O_XB), (float*)(ws + O_RS3), 1.f, 0};
            small_gemm<4>(lds, (const bf16_t*)(ws + O_YMIX), 1024, (const bf16_t*)(ws + O_WOUT), 1024, 1024, NTOK, 4, 16, E2); } }
    XB_SYNC();
    { { pg8::Gemm g{(const bf16_t*)(ws + O_XB), (const bf16_t*)(ws + O_WQ), 1024, 1024, 1024}; pg8::GridSched S; S.init(64, 4, 0, 1024, 1024);
            EpiScale E{(const float*)(ws + O_RS3), (bf16_t*)(ws + O_Z + HALFROW), 1024, 1024}; pg8::gemm_phase(lds, g, S, E);
            SScale E2{(const float*)(ws + O_RS3), (bf16_t*)(ws + O_Z + HALFROW), 1024, 1024, 0};
            small_gemm<4>(lds, (const bf16_t*)(ws + O_XB), 1024, (const bf16_t*)(ws + O_WQ), 1024, 1024, NTOK, 4, 16, E2); } }
    XB_SYNC();
    { {
            const bool sattn_first = ((blockIdx.x >> 3) & 1) != 0;
            if (sattn_first) phase_sattn(p, lds);
            { pg8::Gemm g{(const bf16_t*)(ws + O_Z + HALFROW), (const bf16_t*)(ws + O_MKB), 1024, 1024, 256}; pg8::AttnSched<0> S; S.init();
              EpiS E{(bf16_t*)(ws + O_Z), (float*)(ws + O_PSUM)}; pg8::gemm_phase(lds, g, S, E); }
            asm volatile("s_waitcnt vmcnt(0)" ::: "memory"); __syncthreads();
            if (threadIdx.x == 0) { __builtin_amdgcn_fence(__ATOMIC_ACQUIRE, "agent"); asm volatile("s_waitcnt vmcnt(0)" ::: "memory"); }
            __syncthreads();
            { pg8::Gemm g{(const bf16_t*)(ws + O_Z), (const bf16_t*)(ws + O_VT), 256, 2048, 256}; pg8::AttnSched<1> S; S.init();
              EpiO E{(const float*)(ws + O_PSUM), (bf16_t*)(ws + O_YMIX)}; pg8::gemm_phase(lds, g, S, E); }
            if (!sattn_first) phase_sattn(p, lds);
        } }
    XB_SYNC();
    { { pg8::Gemm g{(const bf16_t*)(ws + O_YMIX), (const bf16_t*)(ws + O_WO), 1024, 1024, 1024}; pg8::GridSched S; S.init(64, 4, 0, 1024, 1024);
            EpiRes E{nullptr, (bf16_t*)(ws + O_XB), (float*)(ws + O_RS4), 1.f}; pg8::gemm_phase(lds, g, S, E);
            SRes E2{nullptr, (bf16_t*)(ws + O_XB), (float*)(ws + O_RS4), 1.f, 0};
            small_gemm<4>(lds, (const bf16_t*)(ws + O_YMIX), 1024, (const bf16_t*)(ws + O_WO), 1024, 1024, NTOK, 4, 16, E2); } }
    XB_SYNC();
    { { pg8::Gemm g{(const bf16_t*)(ws + O_XB), (const bf16_t*)(ws + O_WGU2), 1024, 1024, 1024}; pg8::GridSched S; S.init(MT, 22, 0, 1024, 1024);
            EpiSwiglu E{(const float*)(ws + O_RS4), (bf16_t*)(ws + O_H)}; pg8::gemm_phase(lds, g, S, E); } }
    XB_SYNC();
    { { pg8::Gemm g{(const bf16_t*)(ws + O_H), (const bf16_t*)(ws + O_WD2), DFF, DFF, DFF}; pg8::GridSched S; S.init(64, 4, 0, DFF, DFF);
            EpiRes E{nullptr, (bf16_t*)(ws + O_XB), (float*)(ws + O_RS5), 0.5f}; pg8::gemm_phase(lds, g, S, E);
            SRes E2{nullptr, (bf16_t*)(ws + O_XB), (float*)(ws + O_RS5), 0.5f, 0};
            small_gemm<4>(lds, (const bf16_t*)(ws + O_H), DFF, (const bf16_t*)(ws + O_WD2), DFF, DFF, NTOK, 4, 16, E2); } }
    XB_SYNC();
    { phase_final(p); }
#undef XB_SYNC
}

constexpr size_t LDS_BYTES = pg8::STAGE_BYTES + 4096;

extern "C" void kernel_launch(void* const* d_in, const int* in_sizes, int n_in, void* d_out, int out_size, void* d_ws, size_t ws_size, hipStream_t stream) {
    static int grid_blocks = 0;
    if (!grid_blocks) {
        int dev = 0, cus = 0, per_cu = 0;
        hipGetDevice(&dev);
        hipDeviceGetAttribute(&cus, hipDeviceAttributeMultiprocessorCount, dev);
        hipFuncSetAttribute((const void*)mega, hipFuncAttributeMaxDynamicSharedMemorySize, (int)LDS_BYTES);
        hipOccupancyMaxActiveBlocksPerMultiprocessor(&per_cu, mega, 512, LDS_BYTES);
        if (per_cu < 1) { fprintf(stderr, "occupancy query returned %d\n", per_cu); per_cu = 1; }
        grid_blocks = cus * (per_cu > 1 ? 1 : per_cu);
        if (ws_size < WS_NEED) fprintf(stderr, "workspace too small: %zu < %zu\n", ws_size, (size_t)WS_NEED);
    }
    Params p{};
    for (int i = 0; i < 40; ++i) p.in[i] = (const float*)d_in[i];
    p.out = (float*)d_out; p.ws = (unsigned char*)d_ws;
    hipMemsetAsync((unsigned char*)d_ws + O_BAR, 0, XCD_BAR_WORDS * 4, stream);
    hipLaunchKernelGGL(mega, dim3(grid_blocks), dim3(512), LDS_BYTES, stream, p);
}
```

```cpp
#include <hip/hip_runtime.h>
#include <hip/hip_cooperative_groups.h>
#include <cstdio>
namespace cg = cooperative_groups;

#ifndef PHMASK
#define PHMASK 0xffff
#endif
#ifndef DUPMASK
#define DUPMASK 0
#endif
#ifndef ONE_LAUNCH
#define ONE_LAUNCH 1
#endif

#define LAS __attribute__((address_space(3)))
#define DEV __device__ __forceinline__
typedef unsigned short bf16_t;
typedef short bf16x8 __attribute__((ext_vector_type(8)));
typedef float f32x4 __attribute__((ext_vector_type(4)));
typedef unsigned u32x2 __attribute__((ext_vector_type(2)));
typedef unsigned u32x4 __attribute__((ext_vector_type(4)));

constexpr int DM = 1024, NTOK = 16384, NSMP = 128, MV = NTOK + NSMP, MP = 16640, SEQ = 2048;
constexpr int DFF = 2816, ZLD = 2848, BPROJ = 1824, NMEMR = 2048;
constexpr int NPH = 16;

constexpr size_t al256(size_t x) { return (x + 255) & ~(size_t)255; }
constexpr size_t O_WGU1 = 0;
constexpr size_t O_WD1 = O_WGU1 + al256((size_t)5632 * 1024 * 2);
constexpr size_t O_WIN = O_WD1 + al256((size_t)1024 * 2816 * 2);
constexpr size_t O_WOUT = O_WIN + al256((size_t)3072 * 1024 * 2);
constexpr size_t O_WQ = O_WOUT + 2097152, O_WK = O_WQ + 2097152, O_WV = O_WK + 2097152, O_WO = O_WV + 2097152;
constexpr size_t O_WGU2 = O_WO + 2097152;
constexpr size_t O_WD2 = O_WGU2 + al256((size_t)5632 * 1024 * 2);
constexpr size_t O_WLORA = O_WD2 + al256((size_t)1024 * 2816 * 2);
constexpr size_t O_MNB = O_WLORA + al256((size_t)1536 * 384 * 2);
constexpr size_t O_MKB = O_MNB + 4194304, O_VT = O_MKB + 4194304;
constexpr size_t O_RSTDM = O_VT + 4194304;
constexpr size_t RS_BYTES = (size_t)MP * 64;
constexpr size_t O_RS1 = O_RSTDM + 8192, O_RS2 = O_RS1 + RS_BYTES, O_RS3 = O_RS2 + RS_BYTES, O_RS4 = O_RS3 + RS_BYTES, O_RS5 = O_RS4 + RS_BYTES;
constexpr size_t O_PSUM = O_RS5 + RS_BYTES;
constexpr size_t HALFROW = (size_t)MP * 512 * 4;
constexpr size_t O_XB = O_PSUM + 1048576;
constexpr size_t O_XRES = O_XB + HALFROW;
constexpr size_t O_H = O_XRES + 2 * HALFROW;
constexpr size_t O_Z = O_H + al256((size_t)MP * DFF * 2);
constexpr size_t O_YMIX = O_Z + al256((size_t)MP * ZLD * 2);
constexpr size_t O_VAB = O_YMIX + HALFROW;
constexpr size_t O_LIN = O_VAB + HALFROW / 2;
constexpr size_t O_KK = O_LIN + al256((size_t)MP * 384 * 2);
constexpr size_t O_DEC = O_KK + HALFROW, O_KKA = O_DEC + HALFROW;
constexpr size_t O_BAR = O_KKA + HALFROW;
constexpr size_t WS_NEED = O_BAR + 16384;

constexpr size_t OUT_Y = 0, OUT_SP = (size_t)MV * 1024, OUT_SHP = OUT_SP + 262144, OUT_MK = OUT_SHP + 8 * 1824, OUT_MV = OUT_MK + 2097152,
                 OUT_SS = OUT_MV + 2097152, OUT_SHS = OUT_SS + 4194304, OUT_CV = OUT_SHS + 128 * 1824;

enum { I_XP = 0, I_XS, I_SRWKV, I_SSHIFT, I_CK, I_CV, I_MEM, I_LN1, I_G1, I_U1, I_D1, I_LNMIX, I_WIN, I_WOUT, I_SGUW, I_SGUB, I_SLNG, I_SLNB,
       I_MU, I_W0, I_W2, I_A0, I_A2, I_G2, I_KK, I_KA, I_RK, I_GNG, I_GNB, I_LNX, I_MEMN, I_XQ, I_XK, I_XV, I_XO, I_LN2, I_G2F, I_U2F, I_D2F, I_FIN };

struct Params { const float* in[40]; float* out; unsigned char* ws; };

DEV unsigned cvt_pk_bf16(float lo, float hi) { unsigned r; asm volatile("v_cvt_pk_bf16_f32 %0, %1, %2" : "=v"(r) : "v"(lo), "v"(hi)); return r; }
DEV float bf_lo(unsigned u) { return __uint_as_float(u << 16); }
DEV float bf_hi(unsigned u) { return __uint_as_float(u & 0xffff0000u); }
DEV f32x4 bf4(u32x2 u) { return (f32x4){__uint_as_float(u[0] << 16), __uint_as_float(u[0] & 0xffff0000u), __uint_as_float(u[1] << 16), __uint_as_float(u[1] & 0xffff0000u)}; }
DEV u32x2 pk4(f32x4 v) { u32x2 o; o[0] = cvt_pk_bf16(v[0], v[1]); o[1] = cvt_pk_bf16(v[2], v[3]); return o; }
DEV float bf2f(bf16_t b) { return __uint_as_float((unsigned)b << 16); }
DEV float sigmoidf_(float x) { return __builtin_amdgcn_rcpf(1.f + __expf(-x)); }
DEV float tanhf_(float y) { return 1.f - 2.f * __builtin_amdgcn_rcpf(1.f + __expf(2.f * y)); }
DEV float gelu_t(float x) { return 0.5f * x * (1.f + tanhf_(0.7978845608028654f * (x + 0.044715f * x * x * x))); }
DEV float wsum64(float v) {
#pragma unroll
    for (int o = 32; o >= 1; o >>= 1) v += __shfl_xor(v, o);
    return v;
}
DEV float wmax64(float v) {
#pragma unroll
    for (int o = 32; o >= 1; o >>= 1) v = fmaxf(v, __shfl_xor(v, o));
    return v;
}
template <int CTRL> DEV float dpp_f(float x) { return __builtin_bit_cast(float, __builtin_amdgcn_update_dpp(0, __builtin_bit_cast(int, x), CTRL, 0xf, 0xf, false)); }
DEV float rowsum16(float x) {
    x += dpp_f<0x128>(x); x += dpp_f<0x124>(x); x += dpp_f<0x122>(x); x += dpp_f<0x121>(x); return x;
}
DEV int fresh_tid() { int t = threadIdx.x; asm volatile("" : "+v"(t)); return t; }
DEV float rstd_of(const float* rs, int r) { const f32x4* q = (const f32x4*)(rs + (size_t)r * 16); const f32x4 p = (q[0] + q[1]) + (q[2] + q[3]); return rsqrtf(((p[0] + p[1]) + (p[2] + p[3])) * (1.f / 1024.f) + 1e-6f); }

#define XB_TMO      128
#define XB_XCNT(j)  (256  + 64 * (j))
#define XB_XSUB(j)  (1280 + 64 * (j))
#define XB_XGEN(j)  (2304 + 64 * (j))
#define XB_TOP      3328
#define XB_TOPGEN   3392
#define XCD_BAR_WORDS 3456
#define XB_SPIN_CAP (1u << 18)
DEV unsigned xb_ld(unsigned* p)              { return __hip_atomic_load(p, __ATOMIC_RELAXED, __HIP_MEMORY_SCOPE_AGENT); }
DEV unsigned xb_add(unsigned* p, unsigned v) { return __hip_atomic_fetch_add(p, v, __ATOMIC_RELAXED, __HIP_MEMORY_SCOPE_AGENT); }
DEV unsigned xb_xcc_id() { return (unsigned)__builtin_amdgcn_s_getreg((3 << 11) | 20) & 0xFu; }
#define XB_SPIN(cond, bar) do { unsigned _sp = 0; while (cond) { __builtin_amdgcn_s_sleep(1); \
    if ((++_sp & 255u) == 0u) { if (xb_ld(&(bar)[XB_TMO])) break; if (_sp > XB_SPIN_CAP) { atomicAdd(&(bar)[XB_TMO], 1u); break; } } } } while (0)
struct XcdBarrier { unsigned* bar; unsigned x; volatile LAS unsigned* st; };
DEV XcdBarrier xcd_barrier_post(unsigned* bar, volatile LAS unsigned* st) {
    XcdBarrier b; b.bar = bar; b.x = xb_xcc_id(); b.st = st;
    if (threadIdx.x == 0) (void)xb_add(&bar[XB_XCNT(b.x)], 1u);
    return b;
}
DEV void xcd_barrier_complete(unsigned* bar, unsigned x, unsigned& nloc, unsigned& nx) {
    const unsigned G = gridDim.x * gridDim.y * gridDim.z;
    unsigned sum, cnt, mine, sp = 0u;
    for (;;) {
        sum = 0u; cnt = 0u; mine = 0u;
#pragma unroll
        for (unsigned j = 0; j < 16; ++j) { const unsigned c = xb_ld(&bar[XB_XCNT(j)]); sum += c; cnt += (c > 0u) ? 1u : 0u; mine = (j == x) ? c : mine; }
        if (sum == G) break;
        __builtin_amdgcn_s_sleep(1);
        if ((++sp & 255u) == 0u) { if (xb_ld(&bar[XB_TMO])) break; if (sp > XB_SPIN_CAP) { atomicAdd(&bar[XB_TMO], 1u); break; } }
    }
    nloc = mine > 0u ? mine : 1u; nx = cnt > 0u ? cnt : 1u;
}
DEV void xcd_barrier(const XcdBarrier& b) {
    asm volatile("s_waitcnt vmcnt(0)" ::: "memory");
    __syncthreads();
    if (threadIdx.x == 0) {
        unsigned* bar = b.bar;
        __builtin_amdgcn_s_waitcnt(0);
        unsigned nloc = b.st[0], nx = b.st[1];
        if (nloc == 0u) { xcd_barrier_complete(bar, b.x, nloc, nx); b.st[0] = nloc; b.st[1] = nx; }
        const unsigned old = xb_add(&bar[XB_XSUB(b.x)], 1u);
        const unsigned gen = old / nloc;
        if (old + 1u == (gen + 1u) * nloc) {
            __builtin_amdgcn_fence(__ATOMIC_RELEASE, "agent");
            asm volatile("s_waitcnt vmcnt(0)" ::: "memory");
            const unsigned og = xb_add(&bar[XB_TOP], 1u);
            const unsigned tg = og / nx;
            if (og + 1u == (tg + 1u) * nx) xb_add(&bar[XB_TOPGEN], 1u);
            else XB_SPIN(xb_ld(&bar[XB_TOPGEN]) == tg, bar);
            __builtin_amdgcn_fence(__ATOMIC_ACQUIRE, "agent");
            xb_add(&bar[XB_XGEN(b.x)], 1u);
            asm volatile("s_waitcnt vmcnt(0)" ::: "memory");
        } else {
            XB_SPIN(xb_ld(&bar[XB_XGEN(b.x)]) == gen, bar);
            __builtin_amdgcn_fence(__ATOMIC_ACQUIRE, "agent");
            asm volatile("s_waitcnt vmcnt(0)" ::: "memory");
        }
    }
    __syncthreads();
}

namespace pg8 {
constexpr int BM = 256, BK = 64, HALF = 128, HTB = HALF * BK * 2, STAGE_BYTES = 8 * HTB, NXCD = 8, WGM = 8;
DEV int lds_byte(int r, int c) { const int st = (r >> 4) * 2 + (c >> 5), rr = r & 15, cc = c & 31, ob = rr * 64 + cc * 2; return st * 1024 + (ob ^ (((ob >> 9) & 1) << 5)); }
DEV void stage_rc(int b, int& R, int& C) { const int st = b / 1024, sb = b % 1024, swz = sb ^ (((sb >> 9) & 1) << 5); R = (st >> 1) * 16 + swz / 64; C = (st & 1) * 32 + (swz % 64) / 2; }

struct Unit { int pm, pn; long ao, bo; int x0, x1; };
struct Gemm { const bf16_t* A; const bf16_t* Bt; int lda, ldb, K; };

struct GridSched {
    int nM, nN, nwg, G, c; long ta, tb;
    DEV void init(int nM_, int nN_, int shift, int lda, int ldb) { nM = nM_; nN = nN_; nwg = nM * nN; G = (int)gridDim.x; c = ((int)blockIdx.x + G - (shift % G)) % G; ta = 256L * lda; tb = 256L * ldb; }
    DEV bool next(int i, Unit& u) const {
        const long L = (long)i * G + c; if (L >= nwg) return false;
        int wgid = (int)L; { const int q = nwg / NXCD, r = nwg % NXCD, xcd = wgid % NXCD, off = wgid / NXCD; wgid = (xcd < r ? xcd * (q + 1) : r * (q + 1) + (xcd - r) * q) + off; }
        const int nig = WGM * nN, gid = wgid / nig, fm = gid * WGM, gsz = (nM - fm) < WGM ? (nM - fm) : WGM;
        u.pm = fm + ((wgid % nig) % gsz); u.pn = (wgid % nig) / gsz; u.ao = u.pm * ta; u.bo = u.pn * tb; u.x0 = 0; u.x1 = 0; return true;
    }
};
struct LoraSched {
    int G, c;
    DEV void init() { G = (int)gridDim.x; c = (int)blockIdx.x; }
    DEV bool next(int i, Unit& u) const {
        const long L = (long)i * G + c; if (L >= 65 * 6) return false;
        const int pn = (int)L % 6, pm = (int)L / 6, off = (pn >= 4) ? 128 : 0;
        u.pm = pm; u.pn = pn; u.x0 = 0; u.x1 = 0; u.ao = (long)pm * 256 * 384 + off; u.bo = (long)pn * 256 * 384 + off; return true;
    }
};
template <int WHICH> struct AttnSched {
    int G, c;
    DEV void init() { G = (int)gridDim.x; c = (int)blockIdx.x; }
    DEV bool next(int i, Unit& u) const {
        const long L = (long)i * G + c; if (L >= 256) return false;
        const int xcd = (int)L & 7, idx = (int)L >> 3, bh = xcd * 4 + (idx >> 3), mt = idx & 7, b = bh >> 2, h = bh & 3;
        u.pm = mt; u.pn = 0; u.x0 = bh; u.x1 = mt;
        if (WHICH == 0) { u.ao = ((long)b * 2048 + mt * 256) * 1024 + h * 256; u.bo = ((long)b * 256) * 1024 + h * 256; }
        else { u.ao = ((long)bh * 2048 + mt * 256) * 256; u.bo = ((long)h * 256) * 2048 + b * 256; }
        return true;
    }
};

template <class Epi, class Sched>
DEV void gemm_phase(LAS unsigned char* lds, const Gemm g, const Sched& S, const Epi& E) {
    int tid_ = threadIdx.x; asm volatile("" : "+v"(tid_));
    const int tid = tid_, wid = __builtin_amdgcn_readfirstlane(tid >> 6), lane = tid & 63, wr = wid >> 2, wc = wid & 3, fr = lane & 15, fq = lane >> 4;
    int K = g.K, lda_ = g.lda, ldb_ = g.ldb; asm volatile("" : "+s"(K), "+s"(lda_), "+s"(ldb_)); const int nt = K / BK;
    unsigned voffA[2], voffB[2];
#pragma unroll
    for (int i = 0; i < 2; ++i) { int R, C; stage_rc(tid * 16 + i * 8192, R, C); voffA[i] = (unsigned)(R * lda_ + C) * 2u; voffB[i] = (unsigned)(R * ldb_ + C) * 2u; }
    const size_t kstep = (size_t)(BK * 2);
    const size_t hstepA = (size_t)HALF * lda_ * 2, hstepB = (size_t)HALF * ldb_ * 2;
    const unsigned ldsw = (unsigned)wid * 1024u;
    const int aoff = lds_byte(wr * 64 + fr, fq * 8), boff = lds_byte(wc * 32 + fr, fq * 8);
#define PG8_SA(b, h) (((b) * 2 + (h)) * HTB)
#define PG8_SB(b, h) ((4 + (b) * 2 + (h)) * HTB)
#define PG8_STAGE(bufoff, gbase, voff) do { _Pragma("unroll") for (int _i = 0; _i < 2; ++_i) \
        __builtin_amdgcn_global_load_lds((const unsigned*)((const char*)(gbase) + (voff)[_i]), (LAS unsigned*)(lds + (bufoff) + ldsw + _i * 8192), 16, 0, 0); } while (0)
#define PG8_LDA(dst, b, h) do { _Pragma("unroll") for (int m = 0; m < 4; ++m) _Pragma("unroll") for (int k = 0; k < 2; ++k) dst[m][k] = *(const LAS bf16x8*)(lds + PG8_SA(b, h) + aoff + m * 2048 + k * 1024); } while (0)
#define PG8_LDB(dst, b, h) do { _Pragma("unroll") for (int n = 0; n < 2; ++n) _Pragma("unroll") for (int k = 0; k < 2; ++k) dst[n][k] = *(const LAS bf16x8*)(lds + PG8_SB(b, h) + boff + n * 2048 + k * 1024); } while (0)
#define PG8_MMA(ai, bj, At, Bt) do { __builtin_amdgcn_s_setprio(1); _Pragma("unroll") for (int m = 0; m < 4; ++m) _Pragma("unroll") for (int n = 0; n < 2; ++n) _Pragma("unroll") for (int k = 0; k < 2; ++k) \
        acc[ai][bj][m][n] = __builtin_amdgcn_mfma_f32_16x16x32_bf16(Bt[n][k], At[m][k], acc[ai][bj][m][n], 0, 0, 0); __builtin_amdgcn_s_setprio(0); } while (0)
#define PG8_WAIT_V(n) asm volatile("s_waitcnt vmcnt(" #n ")" ::: "memory")
#define PG8_WAIT_L(n) asm volatile("s_waitcnt lgkmcnt(" #n ")" ::: "memory")
#define PG8_BAR __builtin_amdgcn_s_barrier()
#define PG8_SCHED __builtin_amdgcn_sched_barrier(0)
    Unit cur, nxt; int ui = 0;
    if (!S.next(0, cur)) return;
    f32x4 acc[2][2][4][2];
#pragma unroll
    for (int a = 0; a < 2; ++a)
#pragma unroll
        for (int b = 0; b < 2; ++b)
#pragma unroll
            for (int m = 0; m < 4; ++m)
#pragma unroll
                for (int n = 0; n < 2; ++n) acc[a][b][m][n] = (f32x4){0.f, 0.f, 0.f, 0.f};
    bf16x8 At[4][2], B0[2][2], B1[2][2];
    const char* cA = (const char*)g.A + (size_t)cur.ao * 2; const char* cB = (const char*)g.Bt + (size_t)cur.bo * 2;
    PG8_STAGE(PG8_SB(0, 0), cB, voffB); PG8_STAGE(PG8_SA(0, 0), cA, voffA); PG8_STAGE(PG8_SB(0, 1), cB + hstepB, voffB); PG8_STAGE(PG8_SA(0, 1), cA + hstepA, voffA);
    if (wr == 1) PG8_BAR;
    PG8_WAIT_V(4); PG8_BAR;
    PG8_STAGE(PG8_SB(1, 0), cB + kstep, voffB); PG8_STAGE(PG8_SA(1, 0), cA + kstep, voffA); PG8_STAGE(PG8_SB(1, 1), cB + hstepB + kstep, voffB);
    PG8_WAIT_V(6); PG8_BAR;
    for (;;) {
        const bool has_next = S.next(ui + 1, nxt);
        const char* nA = has_next ? (const char*)g.A + (size_t)nxt.ao * 2 : cA; const char* nB = has_next ? (const char*)g.Bt + (size_t)nxt.bo * 2 : cB;
#pragma unroll 1
        for (int t = 0; t < nt; t += 2) {
            const bool last = (t == nt - 2);
            const char* a1 = cA + (size_t)(t + 1) * kstep;
            const char* a2 = last ? nA : cA + (size_t)(t + 2) * kstep; const char* b2 = last ? nB : cB + (size_t)(t + 2) * kstep;
            const char* a3 = a2 + kstep; const char* b3 = b2 + kstep;
            PG8_LDB(B0, 0, 0); PG8_SCHED; PG8_LDA(At, 0, 0); PG8_STAGE(PG8_SA(1, 1), a1 + hstepA, voffA);
            PG8_WAIT_L(8); PG8_BAR; PG8_WAIT_L(0); PG8_MMA(0, 0, At, B0); PG8_BAR; PG8_SCHED;
            PG8_LDB(B1, 0, 1); PG8_STAGE(PG8_SB(0, 0), b2, voffB);
            PG8_BAR; PG8_WAIT_L(0); PG8_MMA(0, 1, At, B1); PG8_BAR;
            PG8_LDA(At, 0, 1); PG8_STAGE(PG8_SA(0, 0), a2, voffA);
            PG8_BAR; PG8_WAIT_L(0); PG8_MMA(1, 0, At, B0); PG8_BAR; PG8_SCHED;
            PG8_STAGE(PG8_SB(0, 1), b2 + hstepB, voffB);
            PG8_WAIT_V(6); PG8_BAR; PG8_MMA(1, 1, At, B1); PG8_BAR;
            PG8_LDB(B0, 1, 0); PG8_SCHED; PG8_LDA(At, 1, 0); PG8_STAGE(PG8_SA(0, 1), a2 + hstepA, voffA);
            PG8_WAIT_L(8); PG8_BAR; PG8_WAIT_L(0); PG8_MMA(0, 0, At, B0); PG8_BAR; PG8_SCHED;
            PG8_LDB(B1, 1, 1); PG8_STAGE(PG8_SB(1, 0), b3, voffB);
            PG8_BAR; PG8_WAIT_L(0); PG8_MMA(0, 1, At, B1); PG8_BAR;
            PG8_LDA(At, 1, 1); PG8_STAGE(PG8_SA(1, 0), a3, voffA);
            PG8_BAR; PG8_WAIT_L(0); PG8_MMA(1, 0, At, B0); PG8_BAR; PG8_SCHED;
            PG8_STAGE(PG8_SB(1, 1), b3 + hstepB, voffB);
            PG8_WAIT_V(6); PG8_BAR; PG8_MMA(1, 1, At, B1); PG8_BAR;
        }
        E(acc, cur, wr, wc, fr, fq);
        if (!has_next) break;
#pragma unroll
        for (int a = 0; a < 2; ++a)
#pragma unroll
            for (int b = 0; b < 2; ++b)
#pragma unroll
                for (int m = 0; m < 4; ++m)
#pragma unroll
                    for (int n = 0; n < 2; ++n) acc[a][b][m][n] = (f32x4){0.f, 0.f, 0.f, 0.f};
        cur = nxt; cA = nA; cB = nB; ++ui;
    }
    PG8_WAIT_V(0);
    if (wr == 0) PG8_BAR;
    PG8_BAR;
#undef PG8_SA
#undef PG8_SB
#undef PG8_STAGE
#undef PG8_LDA
#undef PG8_LDB
#undef PG8_MMA
#undef PG8_WAIT_V
#undef PG8_WAIT_L
#undef PG8_BAR
#undef PG8_SCHED
}
}
using pg8::Unit;

typedef const f32x4 (&AccRef)[2][2][4][2];

struct EpiSwiglu {
    const float* rs; bf16_t* H;
    DEV void operator()(AccRef acc, const Unit& u, int wr, int wc, int fr, int fq) const {
        const int row0 = u.pm * 256 + wr * 64 + fr, hc0 = u.pn * 128 + wc * 16 + 4 * fq;
#pragma unroll
        for (int ai = 0; ai < 2; ++ai)
#pragma unroll
            for (int m = 0; m < 4; ++m) {
                const int r = row0 + ai * 128 + m * 16; const float rstd = rstd_of(rs, r);
#pragma unroll
                for (int bj = 0; bj < 2; ++bj) {
                    float hv[4];
#pragma unroll
                    for (int i = 0; i < 4; ++i) { const float gt = acc[ai][bj][m][0][i] * rstd, up = acc[ai][bj][m][1][i] * rstd; hv[i] = gt * sigmoidf_(gt) * up; }
                    u32x2 o; o[0] = cvt_pk_bf16(hv[0], hv[1]); o[1] = cvt_pk_bf16(hv[2], hv[3]);
                    *(u32x2*)(H + (size_t)r * DFF + hc0 + bj * 64) = o;
                }
            }
    }
};

struct EpiRes {
    const float* res; bf16_t* xb; float* rs_out; float alpha;
    DEV void operator()(AccRef acc, const Unit& u, int wr, int wc, int fr, int fq) const {
        const int row0 = u.pm * 256 + wr * 64 + fr, col0 = u.pn * 256 + wc * 32 + 4 * fq;
#pragma unroll
        for (int ai = 0; ai < 2; ++ai)
#pragma unroll
            for (int mh = 0; mh < 2; ++mh) {
                f32x4 x[2][2][2];
#pragma unroll
                for (int m2 = 0; m2 < 2; ++m2)
#pragma unroll
                    for (int bj = 0; bj < 2; ++bj)
#pragma unroll
                        for (int n = 0; n < 2; ++n) { const size_t o = (size_t)(row0 + ai * 128 + (mh * 2 + m2) * 16) * 1024 + col0 + bj * 128 + n * 16;
                            x[m2][bj][n] = res ? *(const f32x4*)(res + o) : bf4(*(const u32x2*)(xb + o)); }
#pragma unroll
                for (int m2 = 0; m2 < 2; ++m2) {
                    const int m = mh * 2 + m2, r = row0 + ai * 128 + m * 16; float s = 0.f;
#pragma unroll
                    for (int bj = 0; bj < 2; ++bj)
#pragma unroll
                        for (int n = 0; n < 2; ++n) {
                            const int c = col0 + bj * 128 + n * 16; const f32x4 v = x[m2][bj][n] + alpha * acc[ai][bj][m][n];
                            *(u32x2*)(xb + (size_t)r * 1024 + c) = pk4(v);
                            s += v[0] * v[0] + v[1] * v[1] + v[2] * v[2] + v[3] * v[3];
                        }
                    s += __shfl_xor(s, 16); s += __shfl_xor(s, 32);
                    if (fq == 0) rs_out[(size_t)r * 16 + u.pn * 4 + wc] = s;
                }
            }
    }
};

struct EpiScale {
    const float* rs; bf16_t* O; int ldo, ncols;
    DEV void operator()(AccRef acc, const Unit& u, int wr, int wc, int fr, int fq) const {
        const int row0 = u.pm * 256 + wr * 64 + fr, col0 = u.pn * 256 + wc * 32 + 4 * fq;
#pragma unroll
        for (int ai = 0; ai < 2; ++ai)
#pragma unroll
            for (int m = 0; m < 4; ++m) {
                const int r = row0 + ai * 128 + m * 16; const float rstd = rstd_of(rs, r);
#pragma unroll
                for (int bj = 0; bj < 2; ++bj)
#pragma unroll
                    for (int n = 0; n < 2; ++n) {
                        const int c = col0 + bj * 128 + n * 16;
                        if (c < ncols) { const f32x4 v = acc[ai][bj][m][n] * rstd; u32x2 o; o[0] = cvt_pk_bf16(v[0], v[1]); o[1] = cvt_pk_bf16(v[2], v[3]); *(u32x2*)(O + (size_t)r * ldo + c) = o; }
                    }
            }
    }
};

struct EpiLora {
    const float* w0; const float* a0; const float* k_a; float* dec; bf16_t* kbuf; const bf16_t* kkbuf; bf16_t* kka; bf16_t* gb;
    template <int REGION> DEV void run(AccRef acc, const Unit& u, int wr, int wc, int fr, int fq) const {
        const int row0 = u.pm * 256 + wr * 64 + fr, cb = (u.pn & 1) * 256 + wc * 32 + 4 * fq;
#pragma unroll
        for (int ai = 0; ai < 2; ++ai)
#pragma unroll
            for (int m = 0; m < 4; ++m) {
                const int r = row0 + ai * 128 + m * 16;
                {
#pragma unroll
                    for (int bj = 0; bj < 2; ++bj)
#pragma unroll
                        for (int n = 0; n < 2; ++n) {
                            const int cc = cb + bj * 128 + n * 16; const f32x4 a = acc[ai][bj][m][n]; const size_t o = (size_t)r * 512 + cc;
                            if (REGION == 0) {
                                const f32x4 b0 = *(const f32x4*)(w0 + cc); f32x4 d;
#pragma unroll
                                for (int i = 0; i < 4; ++i) { const float x = -(b0[i] + a[i]); const float sp = fmaxf(x, 0.f) + __logf(1.f + __expf(-fabsf(x))); d[i] = __expf(-__expf(-sp - 0.5f)); }
                                *(f32x4*)(dec + o) = d;
                            } else if (REGION == 1) {
                                const f32x4 b0 = *(const f32x4*)(a0 + cc), ka = *(const f32x4*)(k_a + cc), kv = bf4(*(const u32x2*)(kbuf + o)), kkv = bf4(*(const u32x2*)(kkbuf + o)); f32x4 kn, kkan;
#pragma unroll
                                for (int i = 0; i < 4; ++i) { const float av = sigmoidf_(b0[i] + a[i]); kn[i] = kv[i] * (1.f + (av - 1.f) * ka[i]); kkan[i] = kkv[i] * av; }
                                *(u32x2*)(kbuf + o) = pk4(kn); *(u32x2*)(kka + o) = pk4(kkan);
                            } else {
                                u32x2 ov; ov[0] = cvt_pk_bf16(a[0], a[1]); ov[1] = cvt_pk_bf16(a[2], a[3]); *(u32x2*)(gb + o) = ov;
                            }
                        }
                }
            }
    }
    DEV void operator()(AccRef acc, const Unit& u, int wr, int wc, int fr, int fq) const {
        const int region = u.pn >> 1;
        if (region == 0) run<0>(acc, u, wr, wc, fr, fq); else if (region == 1) run<1>(acc, u, wr, wc, fr, fq); else run<2>(acc, u, wr, wc, fr, fq);
    }
};

struct EpiK {
    const float* rstdm; float* outk; bf16_t* mkb;
    DEV void operator()(AccRef acc, const Unit& u, int wr, int wc, int fr, int fq) const {
        const int row0 = u.pm * 256 + wr * 64 + fr, col0 = u.pn * 256 + wc * 32 + 4 * fq;
#pragma unroll
        for (int ai = 0; ai < 2; ++ai)
#pragma unroll
            for (int m = 0; m < 4; ++m) {
                const int r = row0 + ai * 128 + m * 16; const float rstd = rstdm[r];
#pragma unroll
                for (int bj = 0; bj < 2; ++bj)
#pragma unroll
                    for (int n = 0; n < 2; ++n) {
                        const int c = col0 + bj * 128 + n * 16; const f32x4 v = acc[ai][bj][m][n] * rstd;
                        *(f32x4*)(outk + (size_t)r * 1024 + c) = v;
                        u32x2 o; o[0] = cvt_pk_bf16(v[0], v[1]); o[1] = cvt_pk_bf16(v[2], v[3]); *(u32x2*)(mkb + (size_t)r * 1024 + c) = o;
                    }
            }
    }
};
struct EpiVT {
    const float* rstdm; float* outv; bf16_t* vt;
    DEV void operator()(AccRef acc, const Unit& u, int wr, int wc, int fr, int fq) const {
        const int row0 = u.pm * 256 + wr * 64 + fr, col0 = u.pn * 256 + wc * 32 + 4 * fq;
#pragma unroll
        for (int bj = 0; bj < 2; ++bj)
#pragma unroll
            for (int n = 0; n < 2; ++n) {
                const int c = col0 + bj * 128 + n * 16; const f32x4 rsd = *(const f32x4*)(rstdm + c);
#pragma unroll
                for (int ai = 0; ai < 2; ++ai)
#pragma unroll
                    for (int m = 0; m < 4; ++m) {
                        const int r = row0 + ai * 128 + m * 16; const f32x4 v = acc[ai][bj][m][n] * rsd;
                        u32x2 o; o[0] = cvt_pk_bf16(v[0], v[1]); o[1] = cvt_pk_bf16(v[2], v[3]); *(u32x2*)(vt + (size_t)r * 2048 + c) = o;
#pragma unroll
                        for (int i = 0; i < 4; ++i) outv[(size_t)(c + i) * 1024 + r] = v[i];
                    }
            }
    }
};
struct EpiS {
    bf16_t* P; float* psum;
    DEV void operator()(AccRef acc, const Unit& u, int wr, int wc, int fr, int fq) const {
        const size_t prow0 = (size_t)u.x0 * 2048 + u.x1 * 256;
#pragma unroll
        for (int ai = 0; ai < 2; ++ai)
#pragma unroll
            for (int m = 0; m < 4; ++m) {
                const int rl = ai * 128 + wr * 64 + m * 16 + fr; float s = 0.f;
#pragma unroll
                for (int bj = 0; bj < 2; ++bj)
#pragma unroll
                    for (int n = 0; n < 2; ++n) {
                        const f32x4 a = acc[ai][bj][m][n]; u32x2 o;
                        o[0] = cvt_pk_bf16(__expf(a[0]), __expf(a[1])); o[1] = cvt_pk_bf16(__expf(a[2]), __expf(a[3]));
                        s += bf_lo(o[0]) + bf_hi(o[0]) + bf_lo(o[1]) + bf_hi(o[1]);
                        *(u32x2*)(P + (prow0 + rl) * 256 + bj * 128 + wc * 32 + n * 16 + 4 * fq) = o;
                    }
                s += __shfl_xor(s, 16); s += __shfl_xor(s, 32);
                if (fq == 0) psum[(prow0 + rl) * 4 + wc] = s;
            }
    }
};
struct EpiO {
    const float* psum; bf16_t* O;
    DEV void operator()(AccRef acc, const Unit& u, int wr, int wc, int fr, int fq) const {
        const int bh = u.x0, b = bh >> 2, h = bh & 3; const size_t prow0 = (size_t)bh * 2048 + u.x1 * 256; const size_t m0 = (size_t)b * 2048 + u.x1 * 256;
#pragma unroll
        for (int ai = 0; ai < 2; ++ai)
#pragma unroll
            for (int m = 0; m < 4; ++m) {
                const int rl = ai * 128 + wr * 64 + m * 16 + fr; const f32x4 p = *(const f32x4*)(psum + (prow0 + rl) * 4); const float inv = __builtin_amdgcn_rcpf(p[0] + p[1] + p[2] + p[3]);
#pragma unroll
                for (int bj = 0; bj < 2; ++bj)
#pragma unroll
                    for (int n = 0; n < 2; ++n) {
                        const f32x4 v = acc[ai][bj][m][n] * inv; u32x2 o; o[0] = cvt_pk_bf16(v[0], v[1]); o[1] = cvt_pk_bf16(v[2], v[3]);
                        *(u32x2*)(O + (m0 + rl) * 1024 + h * 256 + bj * 128 + wc * 32 + n * 16 + 4 * fq) = o;
                    }
            }
    }
};

struct SRes {
    const float* res; bf16_t* xb; float* rs_out; float alpha; int res_row0;
    DEV void operator()(int r, int c, f32x4 a, int slab, int l15) const {
        const f32x4 x0 = res ? *(const f32x4*)(res + (size_t)(r - res_row0) * 1024 + c) : bf4(*(const u32x2*)(xb + (size_t)r * 1024 + c));
        const f32x4 x = x0 + alpha * a;
        *(u32x2*)(xb + (size_t)r * 1024 + c) = pk4(x);
        const float s = rowsum16(x[0] * x[0] + x[1] * x[1] + x[2] * x[2] + x[3] * x[3]);
        if (l15 == 0) rs_out[(size_t)r * 16 + slab] = s;
    }
};
struct SScale {
    const float* rs; bf16_t* O; int ldo, ncols, col_off;
    DEV void operator()(int r, int c, f32x4 a, int, int) const {
        const int cc = c + col_off;
        if (cc < ncols) { const f32x4 v = a * rstd_of(rs, r); u32x2 o; o[0] = cvt_pk_bf16(v[0], v[1]); o[1] = cvt_pk_bf16(v[2], v[3]); *(u32x2*)(O + (size_t)r * ldo + cc) = o; }
    }
};
template <int NB, class Epi>
DEV void small_gemm(LAS unsigned char* lds, const bf16_t* A, int lda, const bf16_t* Bt, int ldb, int K, int row_base, int nrg, int nslab, const Epi& E) {
    const int tid = fresh_tid(), lane = tid & 63, w = tid >> 6, l15 = lane & 15, kg = lane >> 4;
    LAS float* red = (LAS float*)lds;
    const int kw = K >> 3;
    for (int item = blockIdx.x; item < nrg * nslab; item += gridDim.x) {
        const int rgi = item % nrg, slab = item / nrg, r0 = row_base + rgi * 32, c0 = slab * 64;
        f32x4 acc[2][4];
#pragma unroll
        for (int rb = 0; rb < 2; ++rb)
#pragma unroll
            for (int n = 0; n < 4; ++n) acc[rb][n] = (f32x4){0.f, 0.f, 0.f, 0.f};
        const bf16_t* ap = A + (size_t)(r0 + l15) * lda + w * kw + kg * 8;
        const bf16_t* bp = Bt + (size_t)(c0 + l15) * ldb + w * kw + kg * 8;
#pragma unroll 4
        for (int k = 0; k < kw; k += 32) {
            const bf16x8 a0 = *(const bf16x8*)(ap + k), a1 = *(const bf16x8*)(ap + (size_t)16 * lda + k);
            bf16x8 b[NB];
#pragma unroll
            for (int n = 0; n < NB; ++n) b[n] = *(const bf16x8*)(bp + (size_t)(n * 16) * ldb + k);
#pragma unroll
            for (int n = 0; n < NB; ++n) { acc[0][n] = __builtin_amdgcn_mfma_f32_16x16x32_bf16(b[n], a0, acc[0][n], 0, 0, 0); acc[1][n] = __builtin_amdgcn_mfma_f32_16x16x32_bf16(b[n], a1, acc[1][n], 0, 0, 0); }
        }
        __syncthreads();
#pragma unroll
        for (int rb = 0; rb < 2; ++rb)
#pragma unroll
            for (int n = 0; n < 4; ++n) *(LAS f32x4*)(red + ((w * 32 + rb * 16 + l15) * 64 + n * 16 + 4 * kg)) = acc[rb][n];
        __syncthreads();
        const int row = tid >> 4, c4 = (tid & 15) * 4; f32x4 sum = (f32x4){0.f, 0.f, 0.f, 0.f};
#pragma unroll
        for (int ww = 0; ww < 8; ++ww) sum = sum + *(const LAS f32x4*)(red + ((ww * 32 + row) * 64 + c4));
        E(r0 + row, c0 + c4, sum, slab, tid & 15);
    }
}

DEV void ld8bf(const bf16_t* p, float (&v)[8]) { const u32x4 u = *(const u32x4*)p;
#pragma unroll
    for (int i = 0; i < 4; ++i) { v[2 * i] = bf_lo(u[i]); v[2 * i + 1] = bf_hi(u[i]); } }
DEV void ld8f(const float* p, float (&v)[8]) { const f32x4 a = *(const f32x4*)p, b = *(const f32x4*)(p + 4);
#pragma unroll
    for (int i = 0; i < 4; ++i) { v[i] = a[i]; v[4 + i] = b[i]; } }
DEV void st8f(float* p, const float (&v)[8]) { *(f32x4*)p = (f32x4){v[0], v[1], v[2], v[3]}; *(f32x4*)(p + 4) = (f32x4){v[4], v[5], v[6], v[7]}; }
DEV void st8bf(bf16_t* p, const float (&v)[8]) { u32x4 o; o[0] = cvt_pk_bf16(v[0], v[1]); o[1] = cvt_pk_bf16(v[2], v[3]); o[2] = cvt_pk_bf16(v[4], v[5]); o[3] = cvt_pk_bf16(v[6], v[7]); *(u32x4*)p = o; }

DEV void tr_job(const float* __restrict__ src, int Ks, int Ns, int Nd, bf16_t* __restrict__ dst, int mode, const float* __restrict__ gain, float scale, LAS float* tile) {
    const int nk = Ks / 64, nn = Nd / 64, ntile = nk * nn, ldd = Ks; const int t = fresh_tid();
    f32x4 v0, v1;
    auto gl = [&](int ti) { const int tk = ti % nk, tn = ti / nk;
        { const int id = t, k = id >> 4, gn = tn * 64 + (id & 15) * 4; v0 = (gn < Ns) ? *(const f32x4*)(src + (size_t)(tk * 64 + k) * Ns + gn) : (f32x4){0.f, 0.f, 0.f, 0.f}; if (gain) v0 = v0 * (gain[tk * 64 + k] * scale); }
        { const int id = t + 512, k = id >> 4, gn = tn * 64 + (id & 15) * 4; v1 = (gn < Ns) ? *(const f32x4*)(src + (size_t)(tk * 64 + k) * Ns + gn) : (f32x4){0.f, 0.f, 0.f, 0.f}; if (gain) v1 = v1 * (gain[tk * 64 + k] * scale); } };
    int ti = blockIdx.x;
    if (ti < ntile) gl(ti);
    for (; ti < ntile; ti += gridDim.x) {
        const int tk = ti % nk, tn = ti / nk;
        *(LAS f32x4*)(tile + (t >> 4) * 68 + (t & 15) * 4) = v0; *(LAS f32x4*)(tile + ((t + 512) >> 4) * 68 + (t & 15) * 4) = v1;
        if (ti + (int)gridDim.x < ntile) gl(ti + gridDim.x);
        __syncthreads();
        { const int n = t & 63, k8 = (t >> 6) * 8, gn = tn * 64 + n; float v[8];
#pragma unroll
          for (int j = 0; j < 8; ++j) v[j] = tile[(k8 + j) * 68 + n];
          const int drow = mode == 0 ? gn : ((gn >> 4) * 32 + (mode == 2 ? 16 : 0) + (gn & 15));
          st8bf(dst + (size_t)drow * ldd + tk * 64 + k8, v); }
        __syncthreads();
    }
}

DEV void phase_prep(const Params& p, LAS unsigned char* lds) {
    unsigned char* ws = p.ws; LAS float* tile = (LAS float*)lds;
    const int tid = fresh_tid(), lane = tid & 63, gw = blockIdx.x * 8 + (tid >> 6), nw = gridDim.x * 8;
    bf16_t* xb = (bf16_t*)(ws + O_XB); float* rs1 = (float*)(ws + O_RS1);
#pragma unroll 2
    for (int r = gw; r < MP; r += nw) {
        float ss = 0.f;
        if (r < MV) {
            const float* xr = r < NTOK ? p.in[I_XP] + (size_t)r * 1024 : p.in[I_XS] + (size_t)(r - NTOK) * 1024;
#pragma unroll
            for (int i = 0; i < 4; ++i) { const int c = lane * 4 + 256 * i; const f32x4 v = *(const f32x4*)(xr + c); ss += v[0] * v[0] + v[1] * v[1] + v[2] * v[2] + v[3] * v[3];
                u32x2 o; o[0] = cvt_pk_bf16(v[0], v[1]); o[1] = cvt_pk_bf16(v[2], v[3]); *(u32x2*)(xb + (size_t)r * 1024 + c) = o; }
            ss = wsum64(ss);
        } else {
#pragma unroll
            for (int i = 0; i < 4; ++i) { u32x2 o; o[0] = 0; o[1] = 0; *(u32x2*)(xb + (size_t)r * 1024 + lane * 4 + 256 * i) = o; }
        }
        if (lane < 16) { rs1[(size_t)r * 16 + lane] = lane == 0 ? ss : 0.f;
            if (r >= MV) { ((float*)(ws + O_RS2))[(size_t)r * 16 + lane] = 0.f; ((float*)(ws + O_RS3))[(size_t)r * 16 + lane] = 0.f; ((float*)(ws + O_RS4))[(size_t)r * 16 + lane] = 0.f; ((float*)(ws + O_RS5))[(size_t)r * 16 + lane] = 0.f; } }
    }
    bf16_t* mnb = (bf16_t*)(ws + O_MNB); float* rstdm = (float*)(ws + O_RSTDM);
    for (int r = gw; r < NMEMR; r += nw) {
        const float* xr = p.in[I_MEM] + (size_t)r * 1024; float ss = 0.f;
#pragma unroll
        for (int i = 0; i < 4; ++i) { const int c = lane * 4 + 256 * i; const f32x4 v = *(const f32x4*)(xr + c); ss += v[0] * v[0] + v[1] * v[1] + v[2] * v[2] + v[3] * v[3];
            u32x2 o; o[0] = cvt_pk_bf16(v[0], v[1]); o[1] = cvt_pk_bf16(v[2], v[3]); *(u32x2*)(mnb + (size_t)r * 1024 + c) = o; }
        ss = wsum64(ss);
        if (lane == 0) rstdm[r] = rsqrtf(ss * (1.f / 1024.f) + 1e-6f);
    }
    { bf16_t* wl = (bf16_t*)(ws + O_WLORA);
      for (int i = blockIdx.x * 512 + tid; i < 1536 * 384; i += gridDim.x * 512) {
          const int n = i / 384, k = i % 384, reg = n >> 9, c = n & 511; float v = 0.f;
          if (reg == 0 && k < 64) v = p.in[I_W2][k * 512 + c];
          else if (reg == 1 && k >= 64 && k < 128) v = p.in[I_A2][(k - 64) * 512 + c];
          else if (reg == 2 && k >= 128 && k < 288) v = p.in[I_G2][(k - 128) * 512 + c];
          wl[i] = (bf16_t)(cvt_pk_bf16(v, 0.f) & 0xffffu);
      } }
    tr_job(p.in[I_G1], 1024, 2816, 2816, (bf16_t*)(ws + O_WGU1), 1, p.in[I_LN1], 1.f, tile);
    tr_job(p.in[I_U1], 1024, 2816, 2816, (bf16_t*)(ws + O_WGU1), 2, p.in[I_LN1], 1.f, tile);
    tr_job(p.in[I_XK], 1024, 1024, 1024, (bf16_t*)(ws + O_WK), 0, p.in[I_MEMN], 1.f, tile);
    tr_job(p.in[I_XV], 1024, 1024, 1024, (bf16_t*)(ws + O_WV), 0, p.in[I_MEMN], 1.f, tile);
    tr_job(p.in[I_D1], 2816, 1024, 1024, (bf16_t*)(ws + O_WD1), 0, nullptr, 1.f, tile);
    tr_job(p.in[I_WIN], 1024, 2848, 3072, (bf16_t*)(ws + O_WIN), 0, p.in[I_LNMIX], 1.f, tile);
    tr_job(p.in[I_WOUT], 1024, 1024, 1024, (bf16_t*)(ws + O_WOUT), 0, nullptr, 1.f, tile);
    tr_job(p.in[I_XQ], 1024, 1024, 1024, (bf16_t*)(ws + O_WQ), 0, p.in[I_LNX], 0.0625f, tile);
    tr_job(p.in[I_XO], 1024, 1024, 1024, (bf16_t*)(ws + O_WO), 0, nullptr, 1.f, tile);
    tr_job(p.in[I_G2F], 1024, 2816, 2816, (bf16_t*)(ws + O_WGU2), 1, p.in[I_LN2], 1.f, tile);
    tr_job(p.in[I_U2F], 1024, 2816, 2816, (bf16_t*)(ws + O_WGU2), 2, p.in[I_LN2], 1.f, tile);
    tr_job(p.in[I_D2F], 2816, 1024, 1024, (bf16_t*)(ws + O_WD2), 0, nullptr, 1.f, tile);
}

DEV void phase_mixprep(const Params& p) {
    unsigned char* ws = p.ws; const int tid = fresh_tid(), lane = tid & 63, gw = blockIdx.x * 8 + (tid >> 6), nw = gridDim.x * 8;
    const bf16_t* z = (const bf16_t*)(ws + O_Z); bf16_t* vab = (bf16_t*)(ws + O_VAB); bf16_t* lin = (bf16_t*)(ws + O_LIN); bf16_t* ymix = (bf16_t*)(ws + O_YMIX);
    bf16_t* rbuf = (bf16_t*)(ws + O_H); bf16_t* kbuf = (bf16_t*)(ws + O_H + HALFROW); bf16_t* vbuf = (bf16_t*)(ws + O_XRES); bf16_t* kkbuf = (bf16_t*)(ws + O_KK);
#pragma unroll 2
    for (int r = gw; r < MV; r += nw) {
        const bf16_t* zr = z + (size_t)r * ZLD; const bool smp = r >= NTOK; const int t = r & (SEQ - 1), si = r - NTOK;
        {
            const int c = lane * 8; float v[8]; ld8bf(zr + 512 + c, v); float s = 0.f;
#pragma unroll
            for (int i = 0; i < 8; ++i) { v[i] = gelu_t(v[i]); s += v[i]; }
            const float mu = wsum64(s) * (1.f / 512.f); float q = 0.f;
#pragma unroll
            for (int i = 0; i < 8; ++i) { v[i] -= mu; q += v[i] * v[i]; }
            const float rstd = rsqrtf(wsum64(q) * (1.f / 512.f) + 1e-5f); float g[8], b[8]; ld8f(p.in[I_SLNG] + c, g); ld8f(p.in[I_SLNB] + c, b);
#pragma unroll
            for (int i = 0; i < 8; ++i) v[i] = v[i] * rstd * g[i] + b[i];
            st8bf(vab + (size_t)r * 512 + c, v);
            if (smp) {
                st8f(p.out + OUT_CV + (size_t)si * 512 + c, v);
                const int grp = c >> 6; const float w00 = p.in[I_SGUW][grp * 16384], b0 = p.in[I_SGUB][grp * 128]; float uu[8]; ld8bf(zr + c, uu);
#pragma unroll
                for (int i = 0; i < 8; ++i) uu[i] = gelu_t(uu[i]) * (w00 * v[i] + b0);
                st8bf(ymix + (size_t)r * 1024 + c, uu);
            }
        }
#pragma unroll
        for (int it = 0; it < 4; ++it) {
            const int ch = lane + 64 * it; if (ch >= 228) break;
            const int cb = ch * 8; float cur[8], prv[8], mu[8], zs[8]; ld8bf(zr + 1024 + cb, cur);
            if (smp) ld8f(p.in[I_SSHIFT] + (size_t)si * BPROJ + cb, prv);
            else if (t == 0) {
#pragma unroll
                for (int i = 0; i < 8; ++i) prv[i] = 0.f;
            } else ld8bf(zr - ZLD + 1024 + cb, prv);
            ld8f(p.in[I_MU] + cb, mu);
#pragma unroll
            for (int i = 0; i < 8; ++i) zs[i] = cur[i] + (prv[i] - cur[i]) * mu[i];
            if (smp) st8f(p.out + OUT_SHS + (size_t)si * BPROJ + cb, cur);
            else if (t == SEQ - 1) st8f(p.out + OUT_SHP + (size_t)(r >> 11) * BPROJ + cb, cur);
            if (it == 0) st8bf(rbuf + (size_t)r * 512 + cb, zs);
            else if (it == 1) {
                const int c = cb - 512; st8bf(kbuf + (size_t)r * 512 + c, zs); float kkw[8], kk[8]; ld8f(p.in[I_KK] + c, kkw); float ss = 0.f;
#pragma unroll
                for (int i = 0; i < 8; ++i) { kk[i] = zs[i] * kkw[i]; ss += kk[i] * kk[i]; }
                ss += __shfl_xor(ss, 1); ss += __shfl_xor(ss, 2); ss += __shfl_xor(ss, 4);
                const float rn = rsqrtf(fmaxf(ss, 1e-24f));
#pragma unroll
                for (int i = 0; i < 8; ++i) kk[i] *= rn;
                st8bf(kkbuf + (size_t)r * 512 + c, kk);
            } else if (it == 2) st8bf(vbuf + (size_t)r * 512 + (cb - 1024), zs);
            else {
                const int l = ch - 192; float o[8];
#pragma unroll
                for (int i = 0; i < 8; ++i) o[i] = l < 8 ? tanhf_(zs[i]) : (l < 16 ? zs[i] : sigmoidf_(zs[i]));
                st8bf(lin + (size_t)r * 384 + l * 8, o);
            }
        }
        if (lane >= 36 && lane < 48) { const float zero[8] = {0.f, 0.f, 0.f, 0.f, 0.f, 0.f, 0.f, 0.f}; st8bf(lin + (size_t)r * 384 + lane * 8, zero); }
    }
}

DEV void phase_chunkmix(const Params& p, LAS unsigned char* lds) {
    unsigned char* ws = p.ws; const int tid = fresh_tid(), lane = tid & 63, w = tid >> 6, l15 = lane & 15, kg = lane >> 4;
    const bf16_t* z = (const bf16_t*)(ws + O_Z); const bf16_t* vab = (const bf16_t*)(ws + O_VAB); bf16_t* ymix = (bf16_t*)(ws + O_YMIX);
    LAS bf16_t* vaT = (LAS bf16_t*)lds;
    for (int item = blockIdx.x; item < 1024; item += gridDim.x) {
        const int g = item & 7, bc = item >> 3; const size_t m0 = (size_t)bc * 128;
        __syncthreads();
#pragma unroll
        for (int i = 0; i < 2; ++i) { const int id = tid + 512 * i, s = id >> 3, d8 = (id & 7) * 8; const u32x4 u = *(const u32x4*)(vab + (m0 + s) * 512 + g * 64 + d8);
#pragma unroll
            for (int j = 0; j < 4; ++j) { vaT[(d8 + 2 * j) * 136 + s] = (bf16_t)(u[j] & 0xffffu); vaT[(d8 + 2 * j + 1) * 136 + s] = (bf16_t)(u[j] >> 16); } }
        __syncthreads();
        f32x4 acc[4];
#pragma unroll
        for (int nb = 0; nb < 4; ++nb) acc[nb] = (f32x4){0.f, 0.f, 0.f, 0.f};
        const int trow = 16 * w + l15; const float* wrow = p.in[I_SGUW] + ((size_t)g * 128 + trow) * 128;
        const int nks = (16 * w + 16 + 31) >> 5;
        for (int ks = 0; ks < nks; ++ks) {
            const int s0 = 32 * ks + kg * 8; float a[8]; ld8f(wrow + s0, a);
#pragma unroll
            for (int i = 0; i < 8; ++i) a[i] = (s0 + i <= trow) ? a[i] : 0.f;
            u32x4 au; au[0] = cvt_pk_bf16(a[0], a[1]); au[1] = cvt_pk_bf16(a[2], a[3]); au[2] = cvt_pk_bf16(a[4], a[5]); au[3] = cvt_pk_bf16(a[6], a[7]);
            const bf16x8 av = __builtin_bit_cast(bf16x8, au);
#pragma unroll
            for (int nb = 0; nb < 4; ++nb) { const bf16x8 bv = *(const LAS bf16x8*)(vaT + (nb * 16 + l15) * 136 + s0); acc[nb] = __builtin_amdgcn_mfma_f32_16x16x32_bf16(av, bv, acc[nb], 0, 0, 0); }
        }
#pragma unroll
        for (int j = 0; j < 4; ++j) { const int t = 16 * w + kg * 4 + j; const float bias = p.in[I_SGUB][g * 128 + t]; const size_t m = m0 + t;
#pragma unroll
            for (int nb = 0; nb < 4; ++nb) { const int d = g * 64 + nb * 16 + l15; const float u = gelu_t(bf2f(z[m * ZLD + d])); ymix[m * 1024 + d] = (bf16_t)(cvt_pk_bf16(u * (acc[nb][j] + bias), 0.f) & 0xffffu); } }
    }
}

DEV void phase_scan(const Params& p, LAS unsigned char* lds) {
    unsigned char* ws = p.ws; const int tid = fresh_tid(), lane = tid & 63, w = tid >> 6, rg = lane >> 4, kq = lane & 15;
    const bf16_t* rbuf = (const bf16_t*)(ws + O_H); const bf16_t* kbuf = (const bf16_t*)(ws + O_H + HALFROW); const bf16_t* vbuf = (const bf16_t*)(ws + O_XRES);
    const bf16_t* kkbuf = (const bf16_t*)(ws + O_KK); const float* dec = (const float*)(ws + O_DEC); const bf16_t* kka = (const bf16_t*)(ws + O_KKA); bf16_t* obuf = (bf16_t*)(ws + O_Z);
    constexpr int SL = 16, NCH = SEQ / SL, LB = 5 * SL * 64;
    LAS float* L = (LAS float*)lds;
    LAS float* Lv = L + 2 * LB;
    LAS float* Lp = Lv + 2 * SL * 16;
#define SCAN_BAR() do { asm volatile("s_waitcnt lgkmcnt(0)" ::: "memory"); __builtin_amdgcn_s_barrier(); asm volatile("" ::: "memory"); } while (0)
    for (int item = blockIdx.x; item < 256; item += gridDim.x) {
        const int bh = item >> 2, q = item & 3, b = bh >> 3, h = bh & 7; const size_t m0 = (size_t)b * SEQ;
        if (w >= 4) {
            const int lt = tid - 256, ls = lt >> 4, lc = (lt & 15) * 4;
            f32x4 p1; u32x2 p0, p2, p3, p4, pv; pv[0] = 0u; pv[1] = 0u;
            auto gload = [&](int ch) { const size_t o = (m0 + ch * SL + ls) * 512 + h * 64 + lc;
                p0 = *(const u32x2*)(kkbuf + o); p1 = *(const f32x4*)(dec + o); p2 = *(const u32x2*)(kbuf + o); p3 = *(const u32x2*)(kka + o); p4 = *(const u32x2*)(rbuf + o);
                if (lt < 64) pv = *(const u32x2*)(vbuf + (m0 + ch * SL + (lt >> 2)) * 512 + h * 64 + q * 16 + (lt & 3) * 4); };
            auto fill = [&](int ch) { LAS float* d = L + (ch & 1) * LB + ls * 64 + lc;
                *(LAS f32x4*)d = bf4(p0); *(LAS f32x4*)(d + SL * 64) = p1; *(LAS f32x4*)(d + 2 * SL * 64) = bf4(p2); *(LAS f32x4*)(d + 3 * SL * 64) = bf4(p3); *(LAS f32x4*)(d + 4 * SL * 64) = bf4(p4);
                if (lt < 64) *(LAS f32x4*)(Lv + (ch & 1) * SL * 16 + lt * 4) = bf4(pv); };
            auto reduce_slab = [&](int ch) { const int st = lt >> 4, row = lt & 15; const LAS float* pp = Lp + (ch & 1) * SL * 256 + st * 256 + (row >> 2) * 64 + (row & 3) * 16;
                const f32x4 a = *(const LAS f32x4*)pp, b4 = *(const LAS f32x4*)(pp + 4), c = *(const LAS f32x4*)(pp + 8), d = *(const LAS f32x4*)(pp + 12); const f32x4 t = (a + b4) + (c + d);
                obuf[(m0 + ch * SL + st) * 512 + h * 64 + q * 16 + row] = (bf16_t)(cvt_pk_bf16((t[0] + t[1]) + (t[2] + t[3]), 0.f) & 0xffffu); };
            gload(0); fill(0); gload(1);
            SCAN_BAR();
            for (int ch = 0; ch < NCH; ++ch) {
                if (ch + 1 < NCH) fill(ch + 1);
                if (ch + 2 < NCH) gload(ch + 2);
                if (ch >= 1) reduce_slab(ch - 1);
                SCAN_BAR();
            }
            reduce_slab(NCH - 1);
            {
                const int sidx = item * 4 + (w - 4), si = sidx >> 3, hh = sidx & 7; const size_t o = (size_t)(NTOK + si) * 512 + hh * 64 + kq * 4;
                const f32x4 kk4 = bf4(*(const u32x2*)(kkbuf + o)), w4 = *(const f32x4*)(dec + o), k4 = bf4(*(const u32x2*)(kbuf + o)), ka4 = bf4(*(const u32x2*)(kka + o)), r4 = bf4(*(const u32x2*)(rbuf + o));
                const float* sin = p.in[I_SRWKV] + (size_t)sidx * 4096; float* sout = p.out + OUT_SS + (size_t)sidx * 4096;
                for (int ps = 0; ps < 16; ++ps) {
                    const int v = ps * 4 + rg; f32x4 S = *(const f32x4*)(sin + v * 64 + kq * 4); const float vv = bf2f(vbuf[(size_t)(NTOK + si) * 512 + hh * 64 + v]);
                    const float sa = -rowsum16(S[0] * kk4[0] + S[1] * kk4[1] + S[2] * kk4[2] + S[3] * kk4[3]);
                    S = S * w4 + vv * k4 + sa * ka4;
                    *(f32x4*)(sout + v * 64 + kq * 4) = S;
                    const float op = rowsum16(S[0] * r4[0] + S[1] * r4[1] + S[2] * r4[2] + S[3] * r4[3]);
                    if (kq == 0) obuf[(size_t)(NTOK + si) * 512 + hh * 64 + v] = (bf16_t)(cvt_pk_bf16(op, 0.f) & 0xffffu);
                }
            }
        } else {
            float S0 = 0.f, S1 = 0.f, S2 = 0.f, S3 = 0.f; const int row = w * 4 + rg;
            SCAN_BAR();
            for (int ch = 0; ch < NCH; ++ch) {
                const LAS float* Lc = L + (ch & 1) * LB + kq * 4; const LAS float* Lvc = Lv + (ch & 1) * SL * 16 + row;
                LAS float* dst = Lp + (ch & 1) * SL * 256 + w * 64 + lane;
                f32x4 kk4 = *(const LAS f32x4*)Lc, w4 = *(const LAS f32x4*)(Lc + SL * 64), k4 = *(const LAS f32x4*)(Lc + 2 * SL * 64), ka4 = *(const LAS f32x4*)(Lc + 3 * SL * 64), r4 = *(const LAS f32x4*)(Lc + 4 * SL * 64);
                float vv = Lvc[0];
#pragma unroll 4
                for (int s = 0; s < SL; ++s) {
                    const int sn = s < SL - 1 ? s + 1 : SL - 1; const LAS float* bp = Lc + sn * 64;
                    const f32x4 nkk4 = *(const LAS f32x4*)bp, nw4 = *(const LAS f32x4*)(bp + SL * 64), nk4 = *(const LAS f32x4*)(bp + 2 * SL * 64), nka4 = *(const LAS f32x4*)(bp + 3 * SL * 64), nr4 = *(const LAS f32x4*)(bp + 4 * SL * 64);
                    const float nvv = Lvc[sn * 16];
                    const float sa = -rowsum16((S0 * kk4[0] + S1 * kk4[1]) + (S2 * kk4[2] + S3 * kk4[3]));
                    S0 = (S0 * w4[0] + vv * k4[0]) + sa * ka4[0]; S1 = (S1 * w4[1] + vv * k4[1]) + sa * ka4[1];
                    S2 = (S2 * w4[2] + vv * k4[2]) + sa * ka4[2]; S3 = (S3 * w4[3] + vv * k4[3]) + sa * ka4[3];
                    dst[s * 256] = (S0 * r4[0] + S1 * r4[1]) + (S2 * r4[2] + S3 * r4[3]);
                    kk4 = nkk4; w4 = nw4; k4 = nk4; ka4 = nka4; r4 = nr4; vv = nvv;
                }
                SCAN_BAR();
            }
            *(f32x4*)(p.out + OUT_SP + ((size_t)bh * 64 + q * 16 + row) * 64 + kq * 4) = (f32x4){S0, S1, S2, S3};
        }
        __syncthreads();
    }
#undef SCAN_BAR
}

DEV void phase_finalize(const Params& p) {
    unsigned char* ws = p.ws; const int tid = fresh_tid(), lane = tid & 63, gw = blockIdx.x * 8 + (tid >> 6), nw = gridDim.x * 8;
    const bf16_t* rbuf = (const bf16_t*)(ws + O_H); const bf16_t* kbuf = (const bf16_t*)(ws + O_H + HALFROW); const bf16_t* gb = (const bf16_t*)(ws + O_H + 2 * HALFROW);
    const bf16_t* vbuf = (const bf16_t*)(ws + O_XRES); const bf16_t* obuf = (const bf16_t*)(ws + O_Z); bf16_t* ymix = (bf16_t*)(ws + O_YMIX);
    const int c = lane * 8; float rk[8], gg[8], gbb[8]; ld8f(p.in[I_RK] + c, rk); ld8f(p.in[I_GNG] + c, gg); ld8f(p.in[I_GNB] + c, gbb);
#pragma unroll 2
    for (int r = gw; r < MV; r += nw) {
        const size_t o = (size_t)r * 512 + c; float ov[8], rv[8], kv[8], vv[8], gv[8]; ld8bf(obuf + o, ov); ld8bf(rbuf + o, rv); ld8bf(kbuf + o, kv); ld8bf(vbuf + o, vv); ld8bf(gb + o, gv);
        float s = 0.f, bs = 0.f;
#pragma unroll
        for (int i = 0; i < 8; ++i) { s += ov[i]; bs += rv[i] * kv[i] * rk[i]; }
        s += __shfl_xor(s, 1); s += __shfl_xor(s, 2); s += __shfl_xor(s, 4); bs += __shfl_xor(bs, 1); bs += __shfl_xor(bs, 2); bs += __shfl_xor(bs, 4);
        const float mu = s * (1.f / 64.f); float q = 0.f;
#pragma unroll
        for (int i = 0; i < 8; ++i) { ov[i] -= mu; q += ov[i] * ov[i]; }
        q += __shfl_xor(q, 1); q += __shfl_xor(q, 2); q += __shfl_xor(q, 4);
        const float rstd = rsqrtf(q * (1.f / 64.f) + 64e-5f); float y[8];
#pragma unroll
        for (int i = 0; i < 8; ++i) y[i] = (ov[i] * rstd * gg[i] + gbb[i] + bs * vv[i]) * gv[i];
        st8bf(ymix + (size_t)r * 1024 + 512 + c, y);
    }
}

DEV void phase_sattn(const Params& p, LAS unsigned char* lds) {
    unsigned char* ws = p.ws; const int tid = fresh_tid(), lane = tid & 63, w = tid >> 6, kgrp = lane >> 4, dl = lane & 15;
    const bf16_t* qb = (const bf16_t*)(ws + O_Z + HALFROW); bf16_t* ob = (bf16_t*)(ws + O_YMIX);
    LAS float* pw = (LAS float*)lds;
    LAS float* wm = pw + 256;
    LAS float* wacc = wm + 16;
    for (int item = blockIdx.x; item < 512; item += gridDim.x) {
        const int si = item >> 2, h = item & 3; const float* Kp = p.in[I_CK] + (size_t)si * 262144 + h * 256; const float* Vp = p.in[I_CV] + (size_t)si * 262144 + h * 256;
        float q[16]; { float a[8], b[8]; ld8bf(qb + (size_t)(NTOK + si) * 1024 + h * 256 + dl * 16, a); ld8bf(qb + (size_t)(NTOK + si) * 1024 + h * 256 + dl * 16 + 8, b);
#pragma unroll
            for (int i = 0; i < 8; ++i) { q[i] = a[i]; q[8 + i] = b[i]; } }
        float sc[8];
#pragma unroll
        for (int j = 0; j < 8; ++j) {
            const float* kr = Kp + (size_t)(w * 32 + kgrp + 4 * j) * 1024 + dl * 16; float d = 0.f;
#pragma unroll
            for (int i = 0; i < 4; ++i) { const f32x4 k4 = *(const f32x4*)(kr + 4 * i); d += k4[0] * q[4 * i] + k4[1] * q[4 * i + 1] + k4[2] * q[4 * i + 2] + k4[3] * q[4 * i + 3]; }
            sc[j] = rowsum16(d);
        }
        float mx = sc[0];
#pragma unroll
        for (int j = 1; j < 8; ++j) mx = fmaxf(mx, sc[j]);
        mx = fmaxf(mx, __shfl_xor(mx, 16)); mx = fmaxf(mx, __shfl_xor(mx, 32));
        float sum = 0.f;
#pragma unroll
        for (int j = 0; j < 8; ++j) { sc[j] = __expf(sc[j] - mx); sum += sc[j]; }
        sum += __shfl_xor(sum, 16); sum += __shfl_xor(sum, 32);
        __syncthreads();
        if (dl == 0) {
#pragma unroll
            for (int j = 0; j < 8; ++j) pw[w * 32 + kgrp + 4 * j] = sc[j];
        }
        if (lane == 0) { wm[w] = mx; wm[8 + w] = sum; }
        asm volatile("s_waitcnt lgkmcnt(0)" ::: "memory"); __builtin_amdgcn_wave_barrier();
        f32x4 acc = (f32x4){0.f, 0.f, 0.f, 0.f};
#pragma unroll 16
        for (int j = 0; j < 32; ++j) { const f32x4 v4 = *(const f32x4*)(Vp + (size_t)(w * 32 + j) * 1024 + lane * 4); acc = acc + pw[w * 32 + j] * v4; }
        *(LAS f32x4*)(wacc + w * 256 + lane * 4) = acc;
        __syncthreads();
        if (tid < 256) {
            float M = wm[0];
#pragma unroll
            for (int j = 1; j < 8; ++j) M = fmaxf(M, wm[j]);
            float L = 0.f, o = 0.f;
#pragma unroll
            for (int j = 0; j < 8; ++j) { const float f = __expf(wm[j] - M); L += wm[8 + j] * f; o += wacc[j * 256 + tid] * f; }
            ob[(size_t)(NTOK + si) * 1024 + h * 256 + tid] = (bf16_t)(cvt_pk_bf16(o * __builtin_amdgcn_rcpf(L), 0.f) & 0xffffu);
        }
    }
}

DEV void phase_final(const Params& p) {
    unsigned char* ws = p.ws; const int tid = fresh_tid(), lane = tid & 63, gw = blockIdx.x * 8 + (tid >> 6), nw = gridDim.x * 8;
    const bf16_t* xb = (const bf16_t*)(ws + O_XB); const float* rs5 = (const float*)(ws + O_RS5);
    float g[16]; { float a[8], b[8]; ld8f(p.in[I_FIN] + lane * 8, a); ld8f(p.in[I_FIN] + 512 + lane * 8, b);
#pragma unroll
        for (int i = 0; i < 8; ++i) { g[i] = a[i]; g[8 + i] = b[i]; } }
#pragma unroll 2
    for (int r = gw; r < MV; r += nw) {
        const float rstd = rstd_of(rs5, r);
#pragma unroll
        for (int hf = 0; hf < 2; ++hf) { const int c = hf * 512 + lane * 8; float v[8]; ld8bf(xb + (size_t)r * 1024 + c, v);
#pragma unroll
            for (int i = 0; i < 8; ++i) v[i] = v[i] * rstd * g[hf * 8 + i];
            st8f(p.out + OUT_Y + (size_t)r * 1024 + c, v); }
    }
}

__global__ void __launch_bounds__(512, 2) mega(Params p) {
    extern __shared__ __attribute__((aligned(16))) unsigned char shm[];
    LAS unsigned char* lds = (LAS unsigned char*)shm;
    unsigned char* ws = p.ws;
    const int MT = MP / 256;
    {
        volatile LAS unsigned* st = (volatile LAS unsigned*)(lds + pg8::STAGE_BYTES);
        if (threadIdx.x < 2) st[threadIdx.x] = 0u;
        __syncthreads();
        if (threadIdx.x == 0) (void)xb_add(&((unsigned*)(ws + O_BAR))[XB_XCNT(xb_xcc_id())], 1u);
    }
#define XB_SYNC() do { XcdBarrier xb_; xb_.bar = (unsigned*)(p.ws + O_BAR); xb_.x = xb_xcc_id(); xb_.st = (volatile LAS unsigned*)(lds + pg8::STAGE_BYTES); xcd_barrier(xb_); } while (0)
    { phase_prep(p, lds); }
    XB_SYNC();
    { {
            { pg8::Gemm g{(const bf16_t*)(ws + O_XB), (const bf16_t*)(ws + O_WGU1), 1024, 1024, 1024}; pg8::GridSched S; S.init(MT, 22, 0, 1024, 1024);
              EpiSwiglu E{(const float*)(ws + O_RS1), (bf16_t*)(ws + O_H)}; pg8::gemm_phase(lds, g, S, E); }
            { pg8::Gemm g{(const bf16_t*)(ws + O_MNB), (const bf16_t*)(ws + O_WK), 1024, 1024, 1024}; pg8::GridSched S; S.init(8, 4, MT * 22, 1024, 1024);
              EpiK E{(const float*)(ws + O_RSTDM), p.out + OUT_MK, (bf16_t*)(ws + O_MKB)}; pg8::gemm_phase(lds, g, S, E); }
            { pg8::Gemm g{(const bf16_t*)(ws + O_WV), (const bf16_t*)(ws + O_MNB), 1024, 1024, 1024}; pg8::GridSched S; S.init(4, 8, MT * 22 + 32, 1024, 1024);
              EpiVT E{(const float*)(ws + O_RSTDM), p.out + OUT_MV, (bf16_t*)(ws + O_VT)}; pg8::gemm_phase(lds, g, S, E); }
        } }
    XB_SYNC();
    { { pg8::Gemm g{(const bf16_t*)(ws + O_H), (const bf16_t*)(ws + O_WD1), DFF, DFF, DFF}; pg8::GridSched S; S.init(64, 4, 0, DFF, DFF);
            EpiRes E{p.in[I_XP], (bf16_t*)(ws + O_XB), (float*)(ws + O_RS2), 0.5f}; pg8::gemm_phase(lds, g, S, E);
            SRes E2{p.in[I_XS], (bf16_t*)(ws + O_XB), (float*)(ws + O_RS2), 0.5f, NTOK};
            small_gemm<4>(lds, (const bf16_t*)(ws + O_H), DFF, (const bf16_t*)(ws + O_WD1), DFF, DFF, NTOK, 4, 16, E2); } }
    XB_SYNC();
    { { pg8::Gemm g{(const bf16_t*)(ws + O_XB), (const bf16_t*)(ws + O_WIN), 1024, 1024, 1024}; pg8::GridSched S; S.init(MT, 11, 0, 1024, 1024);
            EpiScale E{(const float*)(ws + O_RS2), (bf16_t*)(ws + O_Z), ZLD, ZLD}; pg8::gemm_phase(lds, g, S, E);
            SScale E2{(const float*)(ws + O_RS2), (bf16_t*)(ws + O_Z), ZLD, ZLD, 2816};
            small_gemm<2>(lds, (const bf16_t*)(ws + O_XB), 1024, (const bf16_t*)(ws + O_WIN) + (size_t)2816 * 1024, 1024, 1024, 0, MV / 32, 1, E2); } }
    XB_SYNC();
    { phase_mixprep(p); }
    XB_SYNC();
    { { pg8::Gemm g{(const bf16_t*)(ws + O_LIN), (const bf16_t*)(ws + O_WLORA), 384, 384, 256}; pg8::LoraSched S; S.init();
            EpiLora E{p.in[I_W0], p.in[I_A0], p.in[I_KA], (float*)(ws + O_DEC), (bf16_t*)(ws + O_H + HALFROW), (const bf16_t*)(ws + O_KK), (bf16_t*)(ws + O_KKA), (bf16_t*)(ws + O_H + 2 * HALFROW)};
            pg8::gemm_phase(lds, g, S, E); phase_chunkmix(p, lds); } }
    XB_SYNC();
    { phase_scan(p, lds); }
    XB_SYNC();
    { phase_finalize(p); }
    XB_SYNC();
    { { pg8::Gemm g{(const bf16_t*)(ws + O_YMIX), (const bf16_t*)(ws + O_WOUT), 1024, 1024, 1024}; pg8::GridSched S; S.init(64, 4, 0, 1024, 1024);
            EpiRes E{nullptr, (bf16_t*)(ws + O_XB), (float*)(ws + O_RS3), 1.f}; pg8::gemm_phase(lds, g, S, E);
            SRes E2{nullptr, (bf16_t*)(ws + O_XB), (float*)(ws + O_RS3), 1.f, 0};
            small_gemm<4>(lds, (const bf16_t*)(ws + O_YMIX), 1024, (const bf16_t*)(ws + O_WOUT), 1024, 1024, NTOK, 4, 16, E2); } }
    XB_SYNC();
    { { pg8::Gemm g{(const bf16_t*)(ws + O_XB), (const bf16_t*)(ws + O_WQ), 1024, 1024, 1024}; pg8::GridSched S; S.init(64, 4, 0, 1024, 1024);
            EpiScale E{(const float*)(ws + O_RS3), (bf16_t*)(ws + O_Z + HALFROW), 1024, 1024}; pg8::gemm_phase(lds, g, S, E);
            SScale E2{(const float*)(ws + O_RS3), (bf16_t*)(ws + O_Z + HALFROW), 1024, 1024, 0};
            small_gemm<4>(lds, (const bf16_t*)(ws + O_XB), 1024, (const bf16_t*)(ws + O_WQ), 1024, 1024, NTOK, 4, 16, E2); } }
    XB_SYNC();
    { {
            const bool sattn_first = ((blockIdx.x >> 3) & 1) != 0;
            if (sattn_first) phase_sattn(p, lds);
            { pg8::Gemm g{(const bf16_t*)(ws + O_Z + HALFROW), (const bf16_t*)(ws + O_MKB), 1024, 1024, 256}; pg8::AttnSched<0> S; S.init();
              EpiS E{(bf16_t*)(ws + O_Z), (float*)(ws + O_PSUM)}; pg8::gemm_phase(lds, g, S, E); }
            asm volatile("s_waitcnt vmcnt(0)" ::: "memory"); __syncthreads();
            if (threadIdx.x == 0) { __builtin_amdgcn_fence(__ATOMIC_ACQUIRE, "agent"); asm volatile("s_waitcnt vmcnt(0)" ::: "memory"); }
            __syncthreads();
            { pg8::Gemm g{(const bf16_t*)(ws + O_Z), (const bf16_t*)(ws + O_VT), 256, 2048, 256}; pg8::AttnSched<1> S; S.init();
              EpiO E{(const float*)(ws + O_PSUM), (bf16_t*)(ws + O_YMIX)}; pg8::gemm_phase(lds, g, S, E); }
            if (!sattn_first) phase_sattn(p, lds);
        } }
    XB_SYNC();
    { { pg8::Gemm g{(const bf16_t*)(ws + O_YMIX), (const bf16_t*)(ws + O_WO), 1024, 1024, 1024}; pg8::GridSched S; S.init(64, 4, 0, 1024, 1024);
            EpiRes E{nullptr, (bf16_t*)(ws + O_XB), (float*)(ws + O_RS4), 1.f}; pg8::gemm_phase(lds, g, S, E);
            SRes E2{nullptr, (bf16_t*)(ws + O_XB), (float*)(ws + O_RS4), 1.f, 0};
            small_gemm<4>(lds, (const bf16_t*)(ws + O_YMIX), 1024, (const bf16_t*)(ws + O_WO), 1024, 1024, NTOK, 4, 16, E2); } }
    XB_SYNC();
    { { pg8::Gemm g{(const bf16_t*)(ws + O_XB), (const bf16_t*)(ws + O_WGU2), 1024, 1024, 1024}; pg8::GridSched S; S.init(MT, 22, 0, 1024, 1024);
            EpiSwiglu E{(const float*)(ws + O_RS4), (bf16_t*)(ws + O_H)}; pg8::gemm_phase(lds, g, S, E); } }
    XB_SYNC();
    { { pg8::Gemm g{(const bf16_t*)(ws + O_H), (const bf16_t*)(ws + O_WD2), DFF, DFF, DFF}; pg8::GridSched S; S.init(64, 4, 0, DFF, DFF);
            EpiRes E{nullptr, (bf16_t*)(ws + O_XB), (float*)(ws + O_RS5), 0.5f}; pg8::gemm_phase(lds, g, S, E);
            SRes E2{nullptr, (bf16_t*)(ws + O_XB), (float*)(ws + O_RS5), 0.5f, 0};
            small_gemm<4>(lds, (const bf16_t*)(ws + O_H), DFF, (const bf16_t*)(ws + O_WD2), DFF, DFF, NTOK, 4, 16, E2); } }
    XB_SYNC();
    { phase_final(p); }
#undef XB_SYNC
}

constexpr size_t LDS_BYTES = pg8::STAGE_BYTES + 4096;

extern "C" void kernel_launch(void* const* d_in, const int* in_sizes, int n_in, void* d_out, int out_size, void* d_ws, size_t ws_size, hipStream_t stream) {
    static int grid_blocks = 0;
    if (!grid_blocks) {
        int dev = 0, cus = 0, per_cu = 0;
        hipGetDevice(&dev);
        hipDeviceGetAttribute(&cus, hipDeviceAttributeMultiprocessorCount, dev);
        hipFuncSetAttribute((const void*)mega, hipFuncAttributeMaxDynamicSharedMemorySize, (int)LDS_BYTES);
        hipOccupancyMaxActiveBlocksPerMultiprocessor(&per_cu, mega, 512, LDS_BYTES);
        if (per_cu < 1) { fprintf(stderr, "occupancy query returned %d\n", per_cu); per_cu = 1; }
        grid_blocks = cus * (per_cu > 1 ? 1 : per_cu);
        if (ws_size < WS_NEED) fprintf(stderr, "workspace too small: %zu < %zu\n", ws_size, (size_t)WS_NEED);
    }
    Params p{};
    for (int i = 0; i < 40; ++i) p.in[i] = (const float*)d_in[i];
    p.out = (float*)d_out; p.ws = (unsigned char*)d_ws;
    hipMemsetAsync((unsigned char*)d_ws + O_BAR, 0, XCD_BAR_WORDS * 4, stream);
    hipLaunchKernelGGL(mega, dim3(grid_blocks), dim3(512), LDS_BYTES, stream, p);
}
```

```cpp
#include <hip/hip_runtime.h>
#include <hip/hip_cooperative_groups.h>
#include <cstdio>
namespace cg = cooperative_groups;

#ifndef PHMASK
#define PHMASK 0xffff
#endif
#ifndef DUPMASK
#define DUPMASK 0
#endif
#ifndef ONE_LAUNCH
#define ONE_LAUNCH 1
#endif

#define LAS __attribute__((address_space(3)))
#define DEV __device__ __forceinline__
typedef unsigned short bf16_t;
typedef short bf16x8 __attribute__((ext_vector_type(8)));
typedef float f32x4 __attribute__((ext_vector_type(4)));
typedef unsigned u32x2 __attribute__((ext_vector_type(2)));
typedef unsigned u32x4 __attribute__((ext_vector_type(4)));

constexpr int DM = 1024, NTOK = 16384, NSMP = 128, MV = NTOK + NSMP, MP = 16640, SEQ = 2048;
constexpr int DFF = 2816, ZLD = 2848, BPROJ = 1824, NMEMR = 2048;
constexpr int NPH = 16;

constexpr size_t al256(size_t x) { return (x + 255) & ~(size_t)255; }
constexpr size_t O_WGU1 = 0;
constexpr size_t O_WD1 = O_WGU1 + al256((size_t)5632 * 1024 * 2);
constexpr size_t O_WIN = O_WD1 + al256((size_t)1024 * 2816 * 2);
constexpr size_t O_WOUT = O_WIN + al256((size_t)3072 * 1024 * 2);
constexpr size_t O_WQ = O_WOUT + 2097152, O_WK = O_WQ + 2097152, O_WV = O_WK + 2097152, O_WO = O_WV + 2097152;
constexpr size_t O_WGU2 = O_WO + 2097152;
constexpr size_t O_WD2 = O_WGU2 + al256((size_t)5632 * 1024 * 2);
constexpr size_t O_WLORA = O_WD2 + al256((size_t)1024 * 2816 * 2);
constexpr size_t O_MNB = O_WLORA + al256((size_t)1536 * 384 * 2);
constexpr size_t O_MKB = O_MNB + 4194304, O_VT = O_MKB + 4194304;
constexpr size_t O_RSTDM = O_VT + 4194304;
constexpr size_t RS_BYTES = (size_t)MP * 64;
constexpr size_t O_RS1 = O_RSTDM + 8192, O_RS2 = O_RS1 + RS_BYTES, O_RS3 = O_RS2 + RS_BYTES, O_RS4 = O_RS3 + RS_BYTES, O_RS5 = O_RS4 + RS_BYTES;
constexpr size_t O_PSUM = O_RS5 + RS_BYTES;
constexpr size_t HALFROW = (size_t)MP * 512 * 4;
constexpr size_t O_XB = O_PSUM + 1048576;
constexpr size_t O_XRES = O_XB + HALFROW;
constexpr size_t O_H = O_XRES + 2 * HALFROW;
constexpr size_t O_Z = O_H + al256((size_t)MP * DFF * 2);
constexpr size_t O_YMIX = O_Z + al256((size_t)MP * ZLD * 2);
constexpr size_t O_VAB = O_YMIX + HALFROW;
constexpr size_t O_LIN = O_VAB + HALFROW / 2;
constexpr size_t O_KK = O_LIN + al256((size_t)MP * 384 * 2);
constexpr size_t O_DEC = O_KK + HALFROW, O_KKA = O_DEC + HALFROW;
constexpr size_t O_BAR = O_KKA + HALFROW;
constexpr size_t WS_NEED = O_BAR + 16384;

constexpr size_t OUT_Y = 0, OUT_SP = (size_t)MV * 1024, OUT_SHP = OUT_SP + 262144, OUT_MK = OUT_SHP + 8 * 1824, OUT_MV = OUT_MK + 2097152,
                 OUT_SS = OUT_MV + 2097152, OUT_SHS = OUT_SS + 4194304, OUT_CV = OUT_SHS + 128 * 1824;

enum { I_XP = 0, I_XS, I_SRWKV, I_SSHIFT, I_CK, I_CV, I_MEM, I_LN1, I_G1, I_U1, I_D1, I_LNMIX, I_WIN, I_WOUT, I_SGUW, I_SGUB, I_SLNG, I_SLNB,
       I_MU, I_W0, I_W2, I_A0, I_A2, I_G2, I_KK, I_KA, I_RK, I_GNG, I_GNB, I_LNX, I_MEMN, I_XQ, I_XK, I_XV, I_XO, I_LN2, I_G2F, I_U2F, I_D2F, I_FIN };

struct Params { const float* in[40]; float* out; unsigned char* ws; };

DEV unsigned cvt_pk_bf16(float lo, float hi) { unsigned r; asm volatile("v_cvt_pk_bf16_f32 %0, %1, %2" : "=v"(r) : "v"(lo), "v"(hi)); return r; }
DEV float bf_lo(unsigned u) { return __uint_as_float(u << 16); }
DEV float bf_hi(unsigned u) { return __uint_as_float(u & 0xffff0000u); }
DEV f32x4 bf4(u32x2 u) { return (f32x4){__uint_as_float(u[0] << 16), __uint_as_float(u[0] & 0xffff0000u), __uint_as_float(u[1] << 16), __uint_as_float(u[1] & 0xffff0000u)}; }
DEV u32x2 pk4(f32x4 v) { u32x2 o; o[0] = cvt_pk_bf16(v[0], v[1]); o[1] = cvt_pk_bf16(v[2], v[3]); return o; }
DEV float bf2f(bf16_t b) { return __uint_as_float((unsigned)b << 16); }
DEV float sigmoidf_(float x) { return __builtin_amdgcn_rcpf(1.f + __expf(-x)); }
DEV float tanhf_(float y) { return 1.f - 2.f * __builtin_amdgcn_rcpf(1.f + __expf(2.f * y)); }
DEV float gelu_t(float x) { return 0.5f * x * (1.f + tanhf_(0.7978845608028654f * (x + 0.044715f * x * x * x))); }
DEV float wsum64(float v) {
#pragma unroll
    for (int o = 32; o >= 1; o >>= 1) v += __shfl_xor(v, o);
    return v;
}
DEV float wmax64(float v) {
#pragma unroll
    for (int o = 32; o >= 1; o >>= 1) v = fmaxf(v, __shfl_xor(v, o));
    return v;
}
template <int CTRL> DEV float dpp_f(float x) { return __builtin_bit_cast(float, __builtin_amdgcn_update_dpp(0, __builtin_bit_cast(int, x), CTRL, 0xf, 0xf, false)); }
DEV float rowsum16(float x) {
    x += dpp_f<0x128>(x); x += dpp_f<0x124>(x); x += dpp_f<0x122>(x); x += dpp_f<0x121>(x); return x;
}
DEV int fresh_tid() { int t = threadIdx.x; asm volatile("" : "+v"(t)); return t; }
DEV float rstd_of(const float* rs, int r) { const f32x4* q = (const f32x4*)(rs + (size_t)r * 16); const f32x4 p = (q[0] + q[1]) + (q[2] + q[3]); return rsqrtf(((p[0] + p[1]) + (p[2] + p[3])) * (1.f / 1024.f) + 1e-6f); }

#define XB_TMO      128
#define XB_XCNT(j)  (256  + 64 * (j))
#define XB_XSUB(j)  (1280 + 64 * (j))
#define XB_XGEN(j)  (2304 + 64 * (j))
#define XB_TOP      3328
#define XB_TOPGEN   3392
#define XCD_BAR_WORDS 3456
#define XB_SPIN_CAP (1u << 18)
DEV unsigned xb_ld(unsigned* p)              { return __hip_atomic_load(p, __ATOMIC_RELAXED, __HIP_MEMORY_SCOPE_AGENT); }
DEV unsigned xb_add(unsigned* p, unsigned v) { return __hip_atomic_fetch_add(p, v, __ATOMIC_RELAXED, __HIP_MEMORY_SCOPE_AGENT); }
DEV unsigned xb_xcc_id() { return (unsigned)__builtin_amdgcn_s_getreg((3 << 11) | 20) & 0xFu; }
#define XB_SPIN(cond, bar) do { unsigned _sp = 0; while (cond) { __builtin_amdgcn_s_sleep(1); \
    if ((++_sp & 255u) == 0u) { if (xb_ld(&(bar)[XB_TMO])) break; if (_sp > XB_SPIN_CAP) { atomicAdd(&(bar)[XB_TMO], 1u); break; } } } } while (0)
struct XcdBarrier { unsigned* bar; unsigned x; volatile LAS unsigned* st; };
DEV XcdBarrier xcd_barrier_post(unsigned* bar, volatile LAS unsigned* st) {
    XcdBarrier b; b.bar = bar; b.x = xb_xcc_id(); b.st = st;
    if (threadIdx.x == 0) (void)xb_add(&bar[XB_XCNT(b.x)], 1u);
    return b;
}
DEV void xcd_barrier_complete(unsigned* bar, unsigned x, unsigned& nloc, unsigned& nx) {
    const unsigned G = gridDim.x * gridDim.y * gridDim.z;
    unsigned sum, cnt, mine, sp = 0u;
    for (;;) {
        sum = 0u; cnt = 0u; mine = 0u;
#pragma unroll
        for (unsigned j = 0; j < 16; ++j) { const unsigned c = xb_ld(&bar[XB_XCNT(j)]); sum += c; cnt += (c > 0u) ? 1u : 0u; mine = (j == x) ? c : mine; }
        if (sum == G) break;
        __builtin_amdgcn_s_sleep(1);
        if ((++sp & 255u) == 0u) { if (xb_ld(&bar[XB_TMO])) break; if (sp > XB_SPIN_CAP) { atomicAdd(&bar[XB_TMO], 1u); break; } }
    }
    nloc = mine > 0u ? mine : 1u; nx = cnt > 0u ? cnt : 1u;
}
DEV void xcd_barrier(const XcdBarrier& b) {
    asm volatile("s_waitcnt vmcnt(0)" ::: "memory");
    __syncthreads();
    if (threadIdx.x == 0) {
        unsigned* bar = b.bar;
        __builtin_amdgcn_s_waitcnt(0);
        unsigned nloc = b.st[0], nx = b.st[1];
        if (nloc == 0u) { xcd_barrier_complete(bar, b.x, nloc, nx); b.st[0] = nloc; b.st[1] = nx; }
        const unsigned old = xb_add(&bar[XB_XSUB(b.x)], 1u);
        const unsigned gen = old / nloc;
        if (old + 1u == (gen + 1u) * nloc) {
            __builtin_amdgcn_fence(__ATOMIC_RELEASE, "agent");
            asm volatile("s_waitcnt vmcnt(0)" ::: "memory");
            const unsigned og = xb_add(&bar[XB_TOP], 1u);
            const unsigned tg = og / nx;
            if (og + 1u == (tg + 1u) * nx) xb_add(&bar[XB_TOPGEN], 1u);
            else XB_SPIN(xb_ld(&bar[XB_TOPGEN]) == tg, bar);
            __builtin_amdgcn_fence(__ATOMIC_ACQUIRE, "agent");
            xb_add(&bar[XB_XGEN(b.x)], 1u);
            asm volatile("s_waitcnt vmcnt(0)" ::: "memory");
        } else {
            XB_SPIN(xb_ld(&bar[XB_XGEN(b.x)]) == gen, bar);
            __builtin_amdgcn_fence(__ATOMIC_ACQUIRE, "agent");
            asm volatile("s_waitcnt vmcnt(0)" ::: "memory");
        }
    }
    __syncthreads();
}

namespace pg8 {
constexpr int BM = 256, BK = 64, HALF = 128, HTB = HALF * BK * 2, STAGE_BYTES = 8 * HTB, NXCD = 8, WGM = 8;
DEV int lds_byte(int r, int c) { const int st = (r >> 4) * 2 + (c >> 5), rr = r & 15, cc = c & 31, ob = rr * 64 + cc * 2; return st * 1024 + (ob ^ (((ob >> 9) & 1) << 5)); }
DEV void stage_rc(int b, int& R, int& C) { const int st = b / 1024, sb = b % 1024, swz = sb ^ (((sb >> 9) & 1) << 5); R = (st >> 1) * 16 + swz / 64; C = (st & 1) * 32 + (swz % 64) / 2; }

struct Unit { int pm, pn; long ao, bo; int x0, x1; };
struct Gemm { const bf16_t* A; const bf16_t* Bt; int lda, ldb, K; };

struct GridSched {
    int nM, nN, nwg, G, c; long ta, tb;
    DEV void init(int nM_, int nN_, int shift, int lda, int ldb) { nM = nM_; nN = nN_; nwg = nM * nN; G = (int)gridDim.x; c = ((int)blockIdx.x + G - (shift % G)) % G; ta = 256L * lda; tb = 256L * ldb; }
    DEV bool next(int i, Unit& u) const {
        const long L = (long)i * G + c; if (L >= nwg) return false;
        int wgid = (int)L; { const int q = nwg / NXCD, r = nwg % NXCD, xcd = wgid % NXCD, off = wgid / NXCD; wgid = (xcd < r ? xcd * (q + 1) : r * (q + 1) + (xcd - r) * q) + off; }
        const int nig = WGM * nN, gid = wgid / nig, fm = gid * WGM, gsz = (nM - fm) < WGM ? (nM - fm) : WGM;
        u.pm = fm + ((wgid % nig) % gsz); u.pn = (wgid % nig) / gsz; u.ao = u.pm * ta; u.bo = u.pn * tb; u.x0 = 0; u.x1 = 0; return true;
    }
};
struct LoraSched {
    int G, c;
    DEV void init() { G = (int)gridDim.x; c = (int)blockIdx.x; }
    DEV bool next(int i, Unit& u) const {
        const long L = (long)i * G + c; if (L >= 65 * 6) return false;
        const int pn = (int)L % 6, pm = (int)L / 6, off = (pn >= 4) ? 128 : 0;
        u.pm = pm; u.pn = pn; u.x0 = 0; u.x1 = 0; u.ao = (long)pm * 256 * 384 + off; u.bo = (long)pn * 256 * 384 + off; return true;
    }
};
template <int WHICH> struct AttnSched {
    int G, c;
    DEV void init() { G = (int)gridDim.x; c = (int)blockIdx.x; }
    DEV bool next(int i, Unit& u) const {
        const long L = (long)i * G + c; if (L >= 256) return false;
        const int xcd = (int)L & 7, idx = (int)L >> 3, bh = xcd * 4 + (idx >> 3), mt = idx & 7, b = bh >> 2, h = bh & 3;
        u.pm = mt; u.pn = 0; u.x0 = bh; u.x1 = mt;
        if (WHICH == 0) { u.ao = ((long)b * 2048 + mt * 256) * 1024 + h * 256; u.bo = ((long)b * 256) * 1024 + h * 256; }
        else { u.ao = ((long)bh * 2048 + mt * 256) * 256; u.bo = ((long)h * 256) * 2048 + b * 256; }
        return true;
    }
};

template <class Epi, class Sched>
DEV void gemm_phase(LAS unsigned char* lds, const Gemm g, const Sched& S, const Epi& E) {
    int tid_ = threadIdx.x; asm volatile("" : "+v"(tid_));
    const int tid = tid_, wid = __builtin_amdgcn_readfirstlane(tid >> 6), lane = tid & 63, wr = wid >> 2, wc = wid & 3, fr = lane & 15, fq = lane >> 4;
    int K = g.K, lda_ = g.lda, ldb_ = g.ldb; asm volatile("" : "+s"(K), "+s"(lda_), "+s"(ldb_)); const int nt = K / BK;
    unsigned voffA[2], voffB[2];
#pragma unroll
    for (int i = 0; i < 2; ++i) { int R, C; stage_rc(tid * 16 + i * 8192, R, C); voffA[i] = (unsigned)(R * lda_ + C) * 2u; voffB[i] = (unsigned)(R * ldb_ + C) * 2u; }
    const size_t kstep = (size_t)(BK * 2);
    const size_t hstepA = (size_t)HALF * lda_ * 2, hstepB = (size_t)HALF * ldb_ * 2;
    const unsigned ldsw = (unsigned)wid * 1024u;
    const int aoff = lds_byte(wr * 64 + fr, fq * 8), boff = lds_byte(wc * 32 + fr, fq * 8);
#define PG8_SA(b, h) (((b) * 2 + (h)) * HTB)
#define PG8_SB(b, h) ((4 + (b) * 2 + (h)) * HTB)
#define PG8_STAGE(bufoff, gbase, voff) do { _Pragma("unroll") for (int _i = 0; _i < 2; ++_i) \
        __builtin_amdgcn_global_load_lds((const unsigned*)((const char*)(gbase) + (voff)[_i]), (LAS unsigned*)(lds + (bufoff) + ldsw + _i * 8192), 16, 0, 0); } while (0)
#define PG8_LDA(dst, b, h) do { _Pragma("unroll") for (int m = 0; m < 4; ++m) _Pragma("unroll") for (int k = 0; k < 2; ++k) dst[m][k] = *(const LAS bf16x8*)(lds + PG8_SA(b, h) + aoff + m * 2048 + k * 1024); } while (0)
#define PG8_LDB(dst, b, h) do { _Pragma("unroll") for (int n = 0; n < 2; ++n) _Pragma("unroll") for (int k = 0; k < 2; ++k) dst[n][k] = *(const LAS bf16x8*)(lds + PG8_SB(b, h) + boff + n * 2048 + k * 1024); } while (0)
#define PG8_MMA(ai, bj, At, Bt) do { __builtin_amdgcn_s_setprio(1); _Pragma("unroll") for (int m = 0; m < 4; ++m) _Pragma("unroll") for (int n = 0; n < 2; ++n) _Pragma("unroll") for (int k = 0; k < 2; ++k) \
        acc[ai][bj][m][n] = __builtin_amdgcn_mfma_f32_16x16x32_bf16(Bt[n][k], At[m][k], acc[ai][bj][m][n], 0, 0, 0); __builtin_amdgcn_s_setprio(0); } while (0)
#define PG8_WAIT_V(n) asm volatile("s_waitcnt vmcnt(" #n ")" ::: "memory")
#define PG8_WAIT_L(n) asm volatile("s_waitcnt lgkmcnt(" #n ")" ::: "memory")
#define PG8_BAR __builtin_amdgcn_s_barrier()
#define PG8_SCHED __builtin_amdgcn_sched_barrier(0)
    Unit cur, nxt; int ui = 0;
    if (!S.next(0, cur)) return;
    f32x4 acc[2][2][4][2];
#pragma unroll
    for (int a = 0; a < 2; ++a)
#pragma unroll
        for (int b = 0; b < 2; ++b)
#pragma unroll
            for (int m = 0; m < 4; ++m)
#pragma unroll
                for (int n = 0; n < 2; ++n) acc[a][b][m][n] = (f32x4){0.f, 0.f, 0.f, 0.f};
    bf16x8 At[4][2], B0[2][2], B1[2][2];
    const char* cA = (const char*)g.A + (size_t)cur.ao * 2; const char* cB = (const char*)g.Bt + (size_t)cur.bo * 2;
    PG8_STAGE(PG8_SB(0, 0), cB, voffB); PG8_STAGE(PG8_SA(0, 0), cA, voffA); PG8_STAGE(PG8_SB(0, 1), cB + hstepB, voffB); PG8_STAGE(PG8_SA(0, 1), cA + hstepA, voffA);
    if (wr == 1) PG8_BAR;
    PG8_WAIT_V(4); PG8_BAR;
    PG8_STAGE(PG8_SB(1, 0), cB + kstep, voffB); PG8_STAGE(PG8_SA(1, 0), cA + kstep, voffA); PG8_STAGE(PG8_SB(1, 1), cB + hstepB + kstep, voffB);
    PG8_WAIT_V(6); PG8_BAR;
    for (;;) {
        const bool has_next = S.next(ui + 1, nxt);
        const char* nA = has_next ? (const char*)g.A + (size_t)nxt.ao * 2 : cA; const char* nB = has_next ? (const char*)g.Bt + (size_t)nxt.bo * 2 : cB;
#pragma unroll 1
        for (int t = 0; t < nt; t += 2) {
            const bool last = (t == nt - 2);
            const char* a1 = cA + (size_t)(t + 1) * kstep;
            const char* a2 = last ? nA : cA + (size_t)(t + 2) * kstep; const char* b2 = last ? nB : cB + (size_t)(t + 2) * kstep;
            const char* a3 = a2 + kstep; const char* b3 = b2 + kstep;
            PG8_LDB(B0, 0, 0); PG8_SCHED; PG8_LDA(At, 0, 0); PG8_STAGE(PG8_SA(1, 1), a1 + hstepA, voffA);
            PG8_WAIT_L(8); PG8_BAR; PG8_WAIT_L(0); PG8_MMA(0, 0, At, B0); PG8_BAR; PG8_SCHED;
            PG8_LDB(B1, 0, 1); PG8_STAGE(PG8_SB(0, 0), b2, voffB);
            PG8_BAR; PG8_WAIT_L(0); PG8_MMA(0, 1, At, B1); PG8_BAR;
            PG8_LDA(At, 0, 1); PG8_STAGE(PG8_SA(0, 0), a2, voffA);
            PG8_BAR; PG8_WAIT_L(0); PG8_MMA(1, 0, At, B0); PG8_BAR; PG8_SCHED;
            PG8_STAGE(PG8_SB(0, 1), b2 + hstepB, voffB);
            PG8_WAIT_V(6); PG8_BAR; PG8_MMA(1, 1, At, B1); PG8_BAR;
            PG8_LDB(B0, 1, 0); PG8_SCHED; PG8_LDA(At, 1, 0); PG8_STAGE(PG8_SA(0, 1), a2 + hstepA, voffA);
            PG8_WAIT_L(8); PG8_BAR; PG8_WAIT_L(0); PG8_MMA(0, 0, At, B0); PG8_BAR; PG8_SCHED;
            PG8_LDB(B1, 1, 1); PG8_STAGE(PG8_SB(1, 0), b3, voffB);
            PG8_BAR; PG8_WAIT_L(0); PG8_MMA(0, 1, At, B1); PG8_BAR;
            PG8_LDA(At, 1, 1); PG8_STAGE(PG8_SA(1, 0), a3, voffA);
            PG8_BAR; PG8_WAIT_L(0); PG8_MMA(1, 0, At, B0); PG8_BAR; PG8_SCHED;
            PG8_STAGE(PG8_SB(1, 1), b3 + hstepB, voffB);
            PG8_WAIT_V(6); PG8_BAR; PG8_MMA(1, 1, At, B1); PG8_BAR;
        }
        E(acc, cur, wr, wc, fr, fq);
        if (!has_next) break;
#pragma unroll
        for (int a = 0; a < 2; ++a)
#pragma unroll
            for (int b = 0; b < 2; ++b)
#pragma unroll
                for (int m = 0; m < 4; ++m)
#pragma unroll
                    for (int n = 0; n < 2; ++n) acc[a][b][m][n] = (f32x4){0.f, 0.f, 0.f, 0.f};
        cur = nxt; cA = nA; cB = nB; ++ui;
    }
    PG8_WAIT_V(0);
    if (wr == 0) PG8_BAR;
    PG8_BAR;
#undef PG8_SA
#undef PG8_SB
#undef PG8_STAGE
#undef PG8_LDA
#undef PG8_LDB
#undef PG8_MMA
#undef PG8_WAIT_V
#undef PG8_WAIT_L
#undef PG8_BAR
#undef PG8_SCHED
}
}
using pg8::Unit;

typedef const f32x4 (&AccRef)[2][2][4][2];

struct EpiSwiglu {
    const float* rs; bf16_t* H;
    DEV void operator()(AccRef acc, const Unit& u, int wr, int wc, int fr, int fq) const {
        const int row0 = u.pm * 256 + wr * 64 + fr, hc0 = u.pn * 128 + wc * 16 + 4 * fq;
#pragma unroll
        for (int ai = 0; ai < 2; ++ai)
#pragma unroll
            for (int m = 0; m < 4; ++m) {
                const int r = row0 + ai * 128 + m * 16; const float rstd = rstd_of(rs, r);
#pragma unroll
                for (int bj = 0; bj < 2; ++bj) {
                    float hv[4];
#pragma unroll
                    for (int i = 0; i < 4; ++i) { const float gt = acc[ai][bj][m][0][i] * rstd, up = acc[ai][bj][m][1][i] * rstd; hv[i] = gt * sigmoidf_(gt) * up; }
                    u32x2 o; o[0] = cvt_pk_bf16(hv[0], hv[1]); o[1] = cvt_pk_bf16(hv[2], hv[3]);
                    *(u32x2*)(H + (size_t)r * DFF + hc0 + bj * 64) = o;
                }
            }
    }
};

struct EpiRes {
    const float* res; bf16_t* xb; float* rs_out; float alpha;
    DEV void operator()(AccRef acc, const Unit& u, int wr, int wc, int fr, int fq) const {
        const int row0 = u.pm * 256 + wr * 64 + fr, col0 = u.pn * 256 + wc * 32 + 4 * fq;
#pragma unroll
        for (int ai = 0; ai < 2; ++ai)
#pragma unroll
            for (int mh = 0; mh < 2; ++mh) {
                f32x4 x[2][2][2];
#pragma unroll
                for (int m2 = 0; m2 < 2; ++m2)
#pragma unroll
                    for (int bj = 0; bj < 2; ++bj)
#pragma unroll
                        for (int n = 0; n < 2; ++n) { const size_t o = (size_t)(row0 + ai * 128 + (mh * 2 + m2) * 16) * 1024 + col0 + bj * 128 + n * 16;
                            x[m2][bj][n] = res ? *(const f32x4*)(res + o) : bf4(*(const u32x2*)(xb + o)); }
#pragma unroll
                for (int m2 = 0; m2 < 2; ++m2) {
                    const int m = mh * 2 + m2, r = row0 + ai * 128 + m * 16; float s = 0.f;
#pragma unroll
                    for (int bj = 0; bj < 2; ++bj)
#pragma unroll
                        for (int n = 0; n < 2; ++n) {
                            const int c = col0 + bj * 128 + n * 16; const f32x4 v = x[m2][bj][n] + alpha * acc[ai][bj][m][n];
                            *(u32x2*)(xb + (size_t)r * 1024 + c) = pk4(v);
                            s += v[0] * v[0] + v[1] * v[1] + v[2] * v[2] + v[3] * v[3];
                        }
                    s += __shfl_xor(s, 16); s += __shfl_xor(s, 32);
                    if (fq == 0) rs_out[(size_t)r * 16 + u.pn * 4 + wc] = s;
                }
            }
    }
};

struct EpiScale {
    const float* rs; bf16_t* O; int ldo, ncols;
    DEV void operator()(AccRef acc, const Unit& u, int wr, int wc, int fr, int fq) const {
        const int row0 = u.pm * 256 + wr * 64 + fr, col0 = u.pn * 256 + wc * 32 + 4 * fq;
#pragma unroll
        for (int ai = 0; ai < 2; ++ai)
#pragma unroll
            for (int m = 0; m < 4; ++m) {
                const int r = row0 + ai * 128 + m * 16; const float rstd = rstd_of(rs, r);
#pragma unroll
                for (int bj = 0; bj < 2; ++bj)
#pragma unroll
                    for (int n = 0; n < 2; ++n) {
                        const int c = col0 + bj * 128 + n * 16;
                        if (c < ncols) { const f32x4 v = acc[ai][bj][m][n] * rstd; u32x2 o; o[0] = cvt_pk_bf16(v[0], v[1]); o[1] = cvt_pk_bf16(v[2], v[3]); *(u32x2*)(O + (size_t)r * ldo + c) = o; }
                    }
            }
    }
};

struct EpiLora {
    const float* w0; const float* a0; const float* k_a; float* dec; bf16_t* kbuf; const bf16_t* kkbuf; bf16_t* kka; bf16_t* gb;
    template <int REGION> DEV void run(AccRef acc, const Unit& u, int wr, int wc, int fr, int fq) const {
        const int row0 = u.pm * 256 + wr * 64 + fr, cb = (u.pn & 1) * 256 + wc * 32 + 4 * fq;
#pragma unroll
        for (int ai = 0; ai < 2; ++ai)
#pragma unroll
            for (int m = 0; m < 4; ++m) {
                const int r = row0 + ai * 128 + m * 16;
                {
#pragma unroll
                    for (int bj = 0; bj < 2; ++bj)
#pragma unroll
                        for (int n = 0; n < 2; ++n) {
                            const int cc = cb + bj * 128 + n * 16; const f32x4 a = acc[ai][bj][m][n]; const size_t o = (size_t)r * 512 + cc;
                            if (REGION == 0) {
                                const f32x4 b0 = *(const f32x4*)(w0 + cc); f32x4 d;
#pragma unroll
                                for (int i = 0; i < 4; ++i) d[i] = __expf(-0.60653066f * sigmoidf_(b0[i] + a[i]));
                                *(f32x4*)(dec + o) = d;
                            } else if (REGION == 1) {
                                const f32x4 b0 = *(const f32x4*)(a0 + cc), ka = *(const f32x4*)(k_a + cc), kv = bf4(*(const u32x2*)(kbuf + o)), kkv = bf4(*(const u32x2*)(kkbuf + o)); f32x4 kn, kkan;
#pragma unroll
                                for (int i = 0; i < 4; ++i) { const float av = sigmoidf_(b0[i] + a[i]); kn[i] = kv[i] * (1.f + (av - 1.f) * ka[i]); kkan[i] = kkv[i] * av; }
                                *(u32x2*)(kbuf + o) = pk4(kn); *(u32x2*)(kka + o) = pk4(kkan);
                            } else {
                                u32x2 ov; ov[0] = cvt_pk_bf16(a[0], a[1]); ov[1] = cvt_pk_bf16(a[2], a[3]); *(u32x2*)(gb + o) = ov;
                            }
                        }
                }
            }
    }
    DEV void operator()(AccRef acc, const Unit& u, int wr, int wc, int fr, int fq) const {
        const int region = u.pn >> 1;
        if (region == 0) run<0>(acc, u, wr, wc, fr, fq); else if (region == 1) run<1>(acc, u, wr, wc, fr, fq); else run<2>(acc, u, wr, wc, fr, fq);
    }
};

struct EpiK {
    const float* rstdm; float* outk; bf16_t* mkb;
    DEV void operator()(AccRef acc, const Unit& u, int wr, int wc, int fr, int fq) const {
        const int row0 = u.pm * 256 + wr * 64 + fr, col0 = u.pn * 256 + wc * 32 + 4 * fq;
#pragma unroll
        for (int ai = 0; ai < 2; ++ai)
#pragma unroll
            for (int m = 0; m < 4; ++m) {
                const int r = row0 + ai * 128 + m * 16; const float rstd = rstdm[r];
#pragma unroll
                for (int bj = 0; bj < 2; ++bj)
#pragma unroll
                    for (int n = 0; n < 2; ++n) {
                        const int c = col0 + bj * 128 + n * 16; const f32x4 v = acc[ai][bj][m][n] * rstd;
                        *(f32x4*)(outk + (size_t)r * 1024 + c) = v;
                        u32x2 o; o[0] = cvt_pk_bf16(v[0], v[1]); o[1] = cvt_pk_bf16(v[2], v[3]); *(u32x2*)(mkb + (size_t)r * 1024 + c) = o;
                    }
            }
    }
};
struct EpiVT {
    const float* rstdm; float* outv; bf16_t* vt;
    DEV void operator()(AccRef acc, const Unit& u, int wr, int wc, int fr, int fq) const {
        const int row0 = u.pm * 256 + wr * 64 + fr, col0 = u.pn * 256 + wc * 32 + 4 * fq;
#pragma unroll
        for (int bj = 0; bj < 2; ++bj)
#pragma unroll
            for (int n = 0; n < 2; ++n) {
                const int c = col0 + bj * 128 + n * 16; const f32x4 rsd = *(const f32x4*)(rstdm + c);
#pragma unroll
                for (int ai = 0; ai < 2; ++ai)
#pragma unroll
                    for (int m = 0; m < 4; ++m) {
                        const int r = row0 + ai * 128 + m * 16; const f32x4 v = acc[ai][bj][m][n] * rsd;
                        u32x2 o; o[0] = cvt_pk_bf16(v[0], v[1]); o[1] = cvt_pk_bf16(v[2], v[3]); *(u32x2*)(vt + (size_t)r * 2048 + c) = o;
#pragma unroll
                        for (int i = 0; i < 4; ++i) outv[(size_t)(c + i) * 1024 + r] = v[i];
                    }
            }
    }
};
struct EpiS {
    bf16_t* P; float* psum;
    DEV void operator()(AccRef acc, const Unit& u, int wr, int wc, int fr, int fq) const {
        const size_t prow0 = (size_t)u.x0 * 2048 + u.x1 * 256;
#pragma unroll
        for (int ai = 0; ai < 2; ++ai)
#pragma unroll
            for (int m = 0; m < 4; ++m) {
                const int rl = ai * 128 + wr * 64 + m * 16 + fr; float s = 0.f;
#pragma unroll
                for (int bj = 0; bj < 2; ++bj)
#pragma unroll
                    for (int n = 0; n < 2; ++n) {
                        const f32x4 a = acc[ai][bj][m][n]; u32x2 o;
                        o[0] = cvt_pk_bf16(__expf(a[0]), __expf(a[1])); o[1] = cvt_pk_bf16(__expf(a[2]), __expf(a[3]));
                        s += bf_lo(o[0]) + bf_hi(o[0]) + bf_lo(o[1]) + bf_hi(o[1]);
                        *(u32x2*)(P + (prow0 + rl) * 256 + bj * 128 + wc * 32 + n * 16 + 4 * fq) = o;
                    }
                s += __shfl_xor(s, 16); s += __shfl_xor(s, 32);
                if (fq == 0) psum[(prow0 + rl) * 4 + wc] = s;
            }
    }
};
struct EpiO {
    const float* psum; bf16_t* O;
    DEV void operator()(AccRef acc, const Unit& u, int wr, int wc, int fr, int fq) const {
        const int bh = u.x0, b = bh >> 2, h = bh & 3; const size_t prow0 = (size_t)bh * 2048 + u.x1 * 256; const size_t m0 = (size_t)b * 2048 + u.x1 * 256;
#pragma unroll
        for (int ai = 0; ai < 2; ++ai)
#pragma unroll
            for (int m = 0; m < 4; ++m) {
                const int rl = ai * 128 + wr * 64 + m * 16 + fr; const f32x4 p = *(const f32x4*)(psum + (prow0 + rl) * 4); const float inv = __builtin_amdgcn_rcpf(p[0] + p[1] + p[2] + p[3]);
#pragma unroll
                for (int bj = 0; bj < 2; ++bj)
#pragma unroll
                    for (int n = 0; n < 2; ++n) {
                        const f32x4 v = acc[ai][bj][m][n] * inv; u32x2 o; o[0] = cvt_pk_bf16(v[0], v[1]); o[1] = cvt_pk_bf16(v[2], v[3]);
                        *(u32x2*)(O + (m0 + rl) * 1024 + h * 256 + bj * 128 + wc * 32 + n * 16 + 4 * fq) = o;
                    }
            }
    }
};

struct SRes {
    const float* res; bf16_t* xb; float* rs_out; float alpha; int res_row0;
    DEV void operator()(int r, int c, f32x4 a, int slab, int l15) const {
        const f32x4 x0 = res ? *(const f32x4*)(res + (size_t)(r - res_row0) * 1024 + c) : bf4(*(const u32x2*)(xb + (size_t)r * 1024 + c));
        const f32x4 x = x0 + alpha * a;
        *(u32x2*)(xb + (size_t)r * 1024 + c) = pk4(x);
        const float s = rowsum16(x[0] * x[0] + x[1] * x[1] + x[2] * x[2] + x[3] * x[3]);
        if (l15 == 0) rs_out[(size_t)r * 16 + slab] = s;
    }
};
struct SScale {
    const float* rs; bf16_t* O; int ldo, ncols, col_off;
    DEV void operator()(int r, int c, f32x4 a, int, int) const {
        const int cc = c + col_off;
        if (cc < ncols) { const f32x4 v = a * rstd_of(rs, r); u32x2 o; o[0] = cvt_pk_bf16(v[0], v[1]); o[1] = cvt_pk_bf16(v[2], v[3]); *(u32x2*)(O + (size_t)r * ldo + cc) = o; }
    }
};
template <int NB, class Epi>
DEV void small_gemm(LAS unsigned char* lds, const bf16_t* A, int lda, const bf16_t* Bt, int ldb, int K, int row_base, int nrg, int nslab, const Epi& E) {
    const int tid = fresh_tid(), lane = tid & 63, w = tid >> 6, l15 = lane & 15, kg = lane >> 4;
    LAS float* red = (LAS float*)lds;
    const int kw = K >> 3;
    for (int item = blockIdx.x; item < nrg * nslab; item += gridDim.x) {
        const int rgi = item % nrg, slab = item / nrg, r0 = row_base + rgi * 32, c0 = slab * 64;
        f32x4 acc[2][4];
#pragma unroll
        for (int rb = 0; rb < 2; ++rb)
#pragma unroll
            for (int n = 0; n < 4; ++n) acc[rb][n] = (f32x4){0.f, 0.f, 0.f, 0.f};
        const bf16_t* ap = A + (size_t)(r0 + l15) * lda + w * kw + kg * 8;
        const bf16_t* bp = Bt + (size_t)(c0 + l15) * ldb + w * kw + kg * 8;
#pragma unroll 4
        for (int k = 0; k < kw; k += 32) {
            const bf16x8 a0 = *(const bf16x8*)(ap + k), a1 = *(const bf16x8*)(ap + (size_t)16 * lda + k);
            bf16x8 b[NB];
#pragma unroll
            for (int n = 0; n < NB; ++n) b[n] = *(const bf16x8*)(bp + (size_t)(n * 16) * ldb + k);
#pragma unroll
            for (int n = 0; n < NB; ++n) { acc[0][n] = __builtin_amdgcn_mfma_f32_16x16x32_bf16(b[n], a0, acc[0][n], 0, 0, 0); acc[1][n] = __builtin_amdgcn_mfma_f32_16x16x32_bf16(b[n], a1, acc[1][n], 0, 0, 0); }
        }
        __syncthreads();
#pragma unroll
        for (int rb = 0; rb < 2; ++rb)
#pragma unroll
            for (int n = 0; n < 4; ++n) *(LAS f32x4*)(red + ((w * 32 + rb * 16 + l15) * 64 + n * 16 + 4 * kg)) = acc[rb][n];
        __syncthreads();
        const int row = tid >> 4, c4 = (tid & 15) * 4; f32x4 sum = (f32x4){0.f, 0.f, 0.f, 0.f};
#pragma unroll
        for (int ww = 0; ww < 8; ++ww) sum = sum + *(const LAS f32x4*)(red + ((ww * 32 + row) * 64 + c4));
        E(r0 + row, c0 + c4, sum, slab, tid & 15);
    }
}

DEV void ld8bf(const bf16_t* p, float (&v)[8]) { const u32x4 u = *(const u32x4*)p;
#pragma unroll
    for (int i = 0; i < 4; ++i) { v[2 * i] = bf_lo(u[i]); v[2 * i + 1] = bf_hi(u[i]); } }
DEV void ld8f(const float* p, float (&v)[8]) { const f32x4 a = *(const f32x4*)p, b = *(const f32x4*)(p + 4);
#pragma unroll
    for (int i = 0; i < 4; ++i) { v[i] = a[i]; v[4 + i] = b[i]; } }
DEV void st8f(float* p, const float (&v)[8]) { *(f32x4*)p = (f32x4){v[0], v[1], v[2], v[3]}; *(f32x4*)(p + 4) = (f32x4){v[4], v[5], v[6], v[7]}; }
DEV void st8bf(bf16_t* p, const float (&v)[8]) { u32x4 o; o[0] = cvt_pk_bf16(v[0], v[1]); o[1] = cvt_pk_bf16(v[2], v[3]); o[2] = cvt_pk_bf16(v[4], v[5]); o[3] = cvt_pk_bf16(v[6], v[7]); *(u32x4*)p = o; }

DEV void tr_job(const float* __restrict__ src, int Ks, int Ns, int Nd, bf16_t* __restrict__ dst, int mode, const float* __restrict__ gain, float scale, LAS float* tile) {
    const int nk = Ks / 64, nn = Nd / 64, ntile = nk * nn, ldd = Ks; const int t = fresh_tid();
    f32x4 v0, v1;
    auto gl = [&](int ti) { const int tk = ti % nk, tn = ti / nk;
        { const int id = t, k = id >> 4, gn = tn * 64 + (id & 15) * 4; v0 = (gn < Ns) ? *(const f32x4*)(src + (size_t)(tk * 64 + k) * Ns + gn) : (f32x4){0.f, 0.f, 0.f, 0.f}; if (gain) v0 = v0 * (gain[tk * 64 + k] * scale); }
        { const int id = t + 512, k = id >> 4, gn = tn * 64 + (id & 15) * 4; v1 = (gn < Ns) ? *(const f32x4*)(src + (size_t)(tk * 64 + k) * Ns + gn) : (f32x4){0.f, 0.f, 0.f, 0.f}; if (gain) v1 = v1 * (gain[tk * 64 + k] * scale); } };
    int ti = blockIdx.x;
    if (ti < ntile) gl(ti);
    for (; ti < ntile; ti += gridDim.x) {
        const int tk = ti % nk, tn = ti / nk;
        *(LAS f32x4*)(tile + (t >> 4) * 68 + (t & 15) * 4) = v0; *(LAS f32x4*)(tile + ((t + 512) >> 4) * 68 + (t & 15) * 4) = v1;
        if (ti + (int)gridDim.x < ntile) gl(ti + gridDim.x);
        __syncthreads();
        { const int n = t & 63, k8 = (t >> 6) * 8, gn = tn * 64 + n; float v[8];
#pragma unroll
          for (int j = 0; j < 8; ++j) v[j] = tile[(k8 + j) * 68 + n];
          const int drow = mode == 0 ? gn : ((gn >> 4) * 32 + (mode == 2 ? 16 : 0) + (gn & 15));
          st8bf(dst + (size_t)drow * ldd + tk * 64 + k8, v); }
        __syncthreads();
    }
}

DEV void phase_prep(const Params& p, LAS unsigned char* lds) {
    unsigned char* ws = p.ws; LAS float* tile = (LAS float*)lds;
    const int tid = fresh_tid(), lane = tid & 63, gw = blockIdx.x * 8 + (tid >> 6), nw = gridDim.x * 8;
    bf16_t* xb = (bf16_t*)(ws + O_XB); float* rs1 = (float*)(ws + O_RS1);
#pragma unroll 2
    for (int r = gw; r < MP; r += nw) {
        float ss = 0.f;
        if (r < MV) {
            const float* xr = r < NTOK ? p.in[I_XP] + (size_t)r * 1024 : p.in[I_XS] + (size_t)(r - NTOK) * 1024;
#pragma unroll
            for (int i = 0; i < 4; ++i) { const int c = lane * 4 + 256 * i; const f32x4 v = *(const f32x4*)(xr + c); ss += v[0] * v[0] + v[1] * v[1] + v[2] * v[2] + v[3] * v[3];
                u32x2 o; o[0] = cvt_pk_bf16(v[0], v[1]); o[1] = cvt_pk_bf16(v[2], v[3]); *(u32x2*)(xb + (size_t)r * 1024 + c) = o; }
            ss = wsum64(ss);
        } else {
#pragma unroll
            for (int i = 0; i < 4; ++i) { u32x2 o; o[0] = 0; o[1] = 0; *(u32x2*)(xb + (size_t)r * 1024 + lane * 4 + 256 * i) = o; }
        }
        if (lane < 16) { rs1[(size_t)r * 16 + lane] = lane == 0 ? ss : 0.f;
            if (r >= MV) { ((float*)(ws + O_RS2))[(size_t)r * 16 + lane] = 0.f; ((float*)(ws + O_RS3))[(size_t)r * 16 + lane] = 0.f; ((float*)(ws + O_RS4))[(size_t)r * 16 + lane] = 0.f; ((float*)(ws + O_RS5))[(size_t)r * 16 + lane] = 0.f; } }
    }
    bf16_t* mnb = (bf16_t*)(ws + O_MNB); float* rstdm = (float*)(ws + O_RSTDM);
    for (int r = gw; r < NMEMR; r += nw) {
        const float* xr = p.in[I_MEM] + (size_t)r * 1024; float ss = 0.f;
#pragma unroll
        for (int i = 0; i < 4; ++i) { const int c = lane * 4 + 256 * i; const f32x4 v = *(const f32x4*)(xr + c); ss += v[0] * v[0] + v[1] * v[1] + v[2] * v[2] + v[3] * v[3];
            u32x2 o; o[0] = cvt_pk_bf16(v[0], v[1]); o[1] = cvt_pk_bf16(v[2], v[3]); *(u32x2*)(mnb + (size_t)r * 1024 + c) = o; }
        ss = wsum64(ss);
        if (lane == 0) rstdm[r] = rsqrtf(ss * (1.f / 1024.f) + 1e-6f);
    }
    { bf16_t* wl = (bf16_t*)(ws + O_WLORA);
      for (int i = blockIdx.x * 512 + tid; i < 1536 * 384; i += gridDim.x * 512) {
          const int n = i / 384, k = i % 384, reg = n >> 9, c = n & 511; float v = 0.f;
          if (reg == 0 && k < 64) v = p.in[I_W2][k * 512 + c];
          else if (reg == 1 && k >= 64 && k < 128) v = p.in[I_A2][(k - 64) * 512 + c];
          else if (reg == 2 && k >= 128 && k < 288) v = p.in[I_G2][(k - 128) * 512 + c];
          wl[i] = (bf16_t)(cvt_pk_bf16(v, 0.f) & 0xffffu);
      } }
    tr_job(p.in[I_G1], 1024, 2816, 2816, (bf16_t*)(ws + O_WGU1), 1, p.in[I_LN1], 1.f, tile);
    tr_job(p.in[I_U1], 1024, 2816, 2816, (bf16_t*)(ws + O_WGU1), 2, p.in[I_LN1], 1.f, tile);
    tr_job(p.in[I_XK], 1024, 1024, 1024, (bf16_t*)(ws + O_WK), 0, p.in[I_MEMN], 1.f, tile);
    tr_job(p.in[I_XV], 1024, 1024, 1024, (bf16_t*)(ws + O_WV), 0, p.in[I_MEMN], 1.f, tile);
    tr_job(p.in[I_D1], 2816, 1024, 1024, (bf16_t*)(ws + O_WD1), 0, nullptr, 1.f, tile);
    tr_job(p.in[I_WIN], 1024, 2848, 3072, (bf16_t*)(ws + O_WIN), 0, p.in[I_LNMIX], 1.f, tile);
    tr_job(p.in[I_WOUT], 1024, 1024, 1024, (bf16_t*)(ws + O_WOUT), 0, nullptr, 1.f, tile);
    tr_job(p.in[I_XQ], 1024, 1024, 1024, (bf16_t*)(ws + O_WQ), 0, p.in[I_LNX], 0.0625f, tile);
    tr_job(p.in[I_XO], 1024, 1024, 1024, (bf16_t*)(ws + O_WO), 0, nullptr, 1.f, tile);
    tr_job(p.in[I_G2F], 1024, 2816, 2816, (bf16_t*)(ws + O_WGU2), 1, p.in[I_LN2], 1.f, tile);
    tr_job(p.in[I_U2F], 1024, 2816, 2816, (bf16_t*)(ws + O_WGU2), 2, p.in[I_LN2], 1.f, tile);
    tr_job(p.in[I_D2F], 2816, 1024, 1024, (bf16_t*)(ws + O_WD2), 0, nullptr, 1.f, tile);
}

DEV void phase_mixprep(const Params& p) {
    unsigned char* ws = p.ws; const int tid = fresh_tid(), lane = tid & 63, gw = blockIdx.x * 8 + (tid >> 6), nw = gridDim.x * 8;
    const bf16_t* z = (const bf16_t*)(ws + O_Z); bf16_t* vab = (bf16_t*)(ws + O_VAB); bf16_t* lin = (bf16_t*)(ws + O_LIN); bf16_t* ymix = (bf16_t*)(ws + O_YMIX);
    bf16_t* rbuf = (bf16_t*)(ws + O_H); bf16_t* kbuf = (bf16_t*)(ws + O_H + HALFROW); bf16_t* vbuf = (bf16_t*)(ws + O_XRES); bf16_t* kkbuf = (bf16_t*)(ws + O_KK);
#pragma unroll 2
    for (int r = gw; r < MV; r += nw) {
        const bf16_t* zr = z + (size_t)r * ZLD; const bool smp = r >= NTOK; const int t = r & (SEQ - 1), si = r - NTOK;
        {
            const int c = lane * 8; float v[8]; ld8bf(zr + 512 + c, v); float s = 0.f;
#pragma unroll
            for (int i = 0; i < 8; ++i) { v[i] = gelu_t(v[i]); s += v[i]; }
            const float mu = wsum64(s) * (1.f / 512.f); float q = 0.f;
#pragma unroll
            for (int i = 0; i < 8; ++i) { v[i] -= mu; q += v[i] * v[i]; }
            const float rstd = rsqrtf(wsum64(q) * (1.f / 512.f) + 1e-5f); float g[8], b[8]; ld8f(p.in[I_SLNG] + c, g); ld8f(p.in[I_SLNB] + c, b);
#pragma unroll
            for (int i = 0; i < 8; ++i) v[i] = v[i] * rstd * g[i] + b[i];
            st8bf(vab + (size_t)r * 512 + c, v);
            if (smp) {
                st8f(p.out + OUT_CV + (size_t)si * 512 + c, v);
                const int grp = c >> 6; const float w00 = p.in[I_SGUW][grp * 16384], b0 = p.in[I_SGUB][grp * 128]; float uu[8]; ld8bf(zr + c, uu);
#pragma unroll
                for (int i = 0; i < 8; ++i) uu[i] = gelu_t(uu[i]) * (w00 * v[i] + b0);
                st8bf(ymix + (size_t)r * 1024 + c, uu);
            }
        }
#pragma unroll
        for (int it = 0; it < 4; ++it) {
            const int ch = lane + 64 * it; if (ch >= 228) break;
            const int cb = ch * 8; float cur[8], prv[8], mu[8], zs[8]; ld8bf(zr + 1024 + cb, cur);
            if (smp) ld8f(p.in[I_SSHIFT] + (size_t)si * BPROJ + cb, prv);
            else if (t == 0) {
#pragma unroll
                for (int i = 0; i < 8; ++i) prv[i] = 0.f;
            } else ld8bf(zr - ZLD + 1024 + cb, prv);
            ld8f(p.in[I_MU] + cb, mu);
#pragma unroll
            for (int i = 0; i < 8; ++i) zs[i] = cur[i] + (prv[i] - cur[i]) * mu[i];
            if (smp) st8f(p.out + OUT_SHS + (size_t)si * BPROJ + cb, cur);
            else if (t == SEQ - 1) st8f(p.out + OUT_SHP + (size_t)(r >> 11) * BPROJ + cb, cur);
            if (it == 0) st8bf(rbuf + (size_t)r * 512 + cb, zs);
            else if (it == 1) {
                const int c = cb - 512; st8bf(kbuf + (size_t)r * 512 + c, zs); float kkw[8], kk[8]; ld8f(p.in[I_KK] + c, kkw); float ss = 0.f;
#pragma unroll
                for (int i = 0; i < 8; ++i) { kk[i] = zs[i] * kkw[i]; ss += kk[i] * kk[i]; }
                ss += __shfl_xor(ss, 1); ss += __shfl_xor(ss, 2); ss += __shfl_xor(ss, 4);
                const float rn = rsqrtf(fmaxf(ss, 1e-24f));
#pragma unroll
                for (int i = 0; i < 8; ++i) kk[i] *= rn;
                st8bf(kkbuf + (size_t)r * 512 + c, kk);
            } else if (it == 2) st8bf(vbuf + (size_t)r * 512 + (cb - 1024), zs);
            else {
                const int l = ch - 192; float o[8];
#pragma unroll
                for (int i = 0; i < 8; ++i) o[i] = l < 8 ? tanhf_(zs[i]) : (l < 16 ? zs[i] : sigmoidf_(zs[i]));
                st8bf(lin + (size_t)r * 384 + l * 8, o);
            }
        }
        if (lane >= 36 && lane < 48) { const float zero[8] = {0.f, 0.f, 0.f, 0.f, 0.f, 0.f, 0.f, 0.f}; st8bf(lin + (size_t)r * 384 + lane * 8, zero); }
    }
}

DEV void phase_chunkmix(const Params& p, LAS unsigned char* lds) {
    unsigned char* ws = p.ws; const int tid = fresh_tid(), lane = tid & 63, w = tid >> 6, l15 = lane & 15, kg = lane >> 4;
    const bf16_t* z = (const bf16_t*)(ws + O_Z); const bf16_t* vab = (const bf16_t*)(ws + O_VAB); bf16_t* ymix = (bf16_t*)(ws + O_YMIX);
    LAS bf16_t* vaT = (LAS bf16_t*)lds;
    for (int item = blockIdx.x; item < 1024; item += gridDim.x) {
        const int g = item & 7, bc = item >> 3; const size_t m0 = (size_t)bc * 128;
        __syncthreads();
#pragma unroll
        for (int i = 0; i < 2; ++i) { const int id = tid + 512 * i, s = id >> 3, d8 = (id & 7) * 8; const u32x4 u = *(const u32x4*)(vab + (m0 + s) * 512 + g * 64 + d8);
#pragma unroll
            for (int j = 0; j < 4; ++j) { vaT[(d8 + 2 * j) * 136 + s] = (bf16_t)(u[j] & 0xffffu); vaT[(d8 + 2 * j + 1) * 136 + s] = (bf16_t)(u[j] >> 16); } }
        __syncthreads();
        f32x4 acc[4];
#pragma unroll
        for (int nb = 0; nb < 4; ++nb) acc[nb] = (f32x4){0.f, 0.f, 0.f, 0.f};
        const int trow = 16 * w + l15; const float* wrow = p.in[I_SGUW] + ((size_t)g * 128 + trow) * 128;
        const int nks = (16 * w + 16 + 31) >> 5;
        for (int ks = 0; ks < nks; ++ks) {
            const int s0 = 32 * ks + kg * 8; float a[8]; ld8f(wrow + s0, a);
#pragma unroll
            for (int i = 0; i < 8; ++i) a[i] = (s0 + i <= trow) ? a[i] : 0.f;
            u32x4 au; au[0] = cvt_pk_bf16(a[0], a[1]); au[1] = cvt_pk_bf16(a[2], a[3]); au[2] = cvt_pk_bf16(a[4], a[5]); au[3] = cvt_pk_bf16(a[6], a[7]);
            const bf16x8 av = __builtin_bit_cast(bf16x8, au);
#pragma unroll
            for (int nb = 0; nb < 4; ++nb) { const bf16x8 bv = *(const LAS bf16x8*)(vaT + (nb * 16 + l15) * 136 + s0); acc[nb] = __builtin_amdgcn_mfma_f32_16x16x32_bf16(av, bv, acc[nb], 0, 0, 0); }
        }
#pragma unroll
        for (int j = 0; j < 4; ++j) { const int t = 16 * w + kg * 4 + j; const float bias = p.in[I_SGUB][g * 128 + t]; const size_t m = m0 + t;
#pragma unroll
            for (int nb = 0; nb < 4; ++nb) { const int d = g * 64 + nb * 16 + l15; const float u = gelu_t(bf2f(z[m * ZLD + d])); ymix[m * 1024 + d] = (bf16_t)(cvt_pk_bf16(u * (acc[nb][j] + bias), 0.f) & 0xffffu); } }
    }
}

DEV void phase_scan(const Params& p, LAS unsigned char* lds) {
    unsigned char* ws = p.ws; const int tid = fresh_tid(), lane = tid & 63, w = tid >> 6, rg = lane >> 4, kq = lane & 15;
    const bf16_t* rbuf = (const bf16_t*)(ws + O_H); const bf16_t* kbuf = (const bf16_t*)(ws + O_H + HALFROW); const bf16_t* vbuf = (const bf16_t*)(ws + O_XRES);
    const bf16_t* kkbuf = (const bf16_t*)(ws + O_KK); const float* dec = (const float*)(ws + O_DEC); const bf16_t* kka = (const bf16_t*)(ws + O_KKA); bf16_t* obuf = (bf16_t*)(ws + O_Z);
    constexpr int SL = 16, NCH = SEQ / SL, LB = 5 * SL * 64;
    LAS float* L = (LAS float*)lds;
    LAS float* Lv = L + 2 * LB;
    LAS float* Lp = Lv + 2 * SL * 16;
#define SCAN_BAR() do { asm volatile("s_waitcnt lgkmcnt(0)" ::: "memory"); __builtin_amdgcn_s_barrier(); asm volatile("" ::: "memory"); } while (0)
    for (int item = blockIdx.x; item < 256; item += gridDim.x) {
        const int bh = item >> 2, q = item & 3, b = bh >> 3, h = bh & 7; const size_t m0 = (size_t)b * SEQ;
        if (w >= 4) {
            const int lt = tid - 256, ls = lt >> 4, lc = (lt & 15) * 4;
            f32x4 p1; u32x2 p0, p2, p3, p4, pv; pv[0] = 0u; pv[1] = 0u;
            auto gload = [&](int ch) { const size_t o = (m0 + ch * SL + ls) * 512 + h * 64 + lc;
                p0 = *(const u32x2*)(kkbuf + o); p1 = *(const f32x4*)(dec + o); p2 = *(const u32x2*)(kbuf + o); p3 = *(const u32x2*)(kka + o); p4 = *(const u32x2*)(rbuf + o);
                if (lt < 64) pv = *(const u32x2*)(vbuf + (m0 + ch * SL + (lt >> 2)) * 512 + h * 64 + q * 16 + (lt & 3) * 4); };
            auto fill = [&](int ch) { LAS float* d = L + (ch & 1) * LB + ls * 64 + lc;
                *(LAS f32x4*)d = bf4(p0); *(LAS f32x4*)(d + SL * 64) = p1; *(LAS f32x4*)(d + 2 * SL * 64) = bf4(p2); *(LAS f32x4*)(d + 3 * SL * 64) = bf4(p3); *(LAS f32x4*)(d + 4 * SL * 64) = bf4(p4);
                if (lt < 64) *(LAS f32x4*)(Lv + (ch & 1) * SL * 16 + lt * 4) = bf4(pv); };
            auto reduce_slab = [&](int ch) { const int st = lt >> 4, row = lt & 15; const LAS float* pp = Lp + (ch & 1) * SL * 256 + st * 256 + (row >> 2) * 64 + (row & 3) * 16;
                const f32x4 a = *(const LAS f32x4*)pp, b4 = *(const LAS f32x4*)(pp + 4), c = *(const LAS f32x4*)(pp + 8), d = *(const LAS f32x4*)(pp + 12); const f32x4 t = (a + b4) + (c + d);
                obuf[(m0 + ch * SL + st) * 512 + h * 64 + q * 16 + row] = (bf16_t)(cvt_pk_bf16((t[0] + t[1]) + (t[2] + t[3]), 0.f) & 0xffffu); };
            gload(0); fill(0); gload(1);
            SCAN_BAR();
            for (int ch = 0; ch < NCH; ++ch) {
                if (ch + 1 < NCH) fill(ch + 1);
                if (ch + 2 < NCH) gload(ch + 2);
                if (ch >= 1) reduce_slab(ch - 1);
                SCAN_BAR();
            }
            reduce_slab(NCH - 1);
            {
                const int sidx = item * 4 + (w - 4), si = sidx >> 3, hh = sidx & 7; const size_t o = (size_t)(NTOK + si) * 512 + hh * 64 + kq * 4;
                const f32x4 kk4 = bf4(*(const u32x2*)(kkbuf + o)), w4 = *(const f32x4*)(dec + o), k4 = bf4(*(const u32x2*)(kbuf + o)), ka4 = bf4(*(const u32x2*)(kka + o)), r4 = bf4(*(const u32x2*)(rbuf + o));
                const float* sin = p.in[I_SRWKV] + (size_t)sidx * 4096; float* sout = p.out + OUT_SS + (size_t)sidx * 4096;
                for (int ps = 0; ps < 16; ++ps) {
                    const int v = ps * 4 + rg; f32x4 S = *(const f32x4*)(sin + v * 64 + kq * 4); const float vv = bf2f(vbuf[(size_t)(NTOK + si) * 512 + hh * 64 + v]);
                    const float sa = -rowsum16(S[0] * kk4[0] + S[1] * kk4[1] + S[2] * kk4[2] + S[3] * kk4[3]);
                    S = S * w4 + vv * k4 + sa * ka4;
                    *(f32x4*)(sout + v * 64 + kq * 4) = S;
                    const float op = rowsum16(S[0] * r4[0] + S[1] * r4[1] + S[2] * r4[2] + S[3] * r4[3]);
                    if (kq == 0) obuf[(size_t)(NTOK + si) * 512 + hh * 64 + v] = (bf16_t)(cvt_pk_bf16(op, 0.f) & 0xffffu);
                }
            }
        } else {
            float S0 = 0.f, S1 = 0.f, S2 = 0.f, S3 = 0.f; const int row = w * 4 + rg;
            SCAN_BAR();
            for (int ch = 0; ch < NCH; ++ch) {
                const LAS float* Lc = L + (ch & 1) * LB + kq * 4; const LAS float* Lvc = Lv + (ch & 1) * SL * 16 + row;
                LAS float* dst = Lp + (ch & 1) * SL * 256 + w * 64 + lane;
                f32x4 kk4 = *(const LAS f32x4*)Lc, w4 = *(const LAS f32x4*)(Lc + SL * 64), k4 = *(const LAS f32x4*)(Lc + 2 * SL * 64), ka4 = *(const LAS f32x4*)(Lc + 3 * SL * 64), r4 = *(const LAS f32x4*)(Lc + 4 * SL * 64);
                float vv = Lvc[0];
#pragma unroll 4
                for (int s = 0; s < SL; ++s) {
                    const int sn = s < SL - 1 ? s + 1 : SL - 1; const LAS float* bp = Lc + sn * 64;
                    const f32x4 nkk4 = *(const LAS f32x4*)bp, nw4 = *(const LAS f32x4*)(bp + SL * 64), nk4 = *(const LAS f32x4*)(bp + 2 * SL * 64), nka4 = *(const LAS f32x4*)(bp + 3 * SL * 64), nr4 = *(const LAS f32x4*)(bp + 4 * SL * 64);
                    const float nvv = Lvc[sn * 16];
                    const float sa = -rowsum16((S0 * kk4[0] + S1 * kk4[1]) + (S2 * kk4[2] + S3 * kk4[3]));
                    S0 = (S0 * w4[0] + vv * k4[0]) + sa * ka4[0]; S1 = (S1 * w4[1] + vv * k4[1]) + sa * ka4[1];
                    S2 = (S2 * w4[2] + vv * k4[2]) + sa * ka4[2]; S3 = (S3 * w4[3] + vv * k4[3]) + sa * ka4[3];
                    dst[s * 256] = (S0 * r4[0] + S1 * r4[1]) + (S2 * r4[2] + S3 * r4[3]);
                    kk4 = nkk4; w4 = nw4; k4 = nk4; ka4 = nka4; r4 = nr4; vv = nvv;
                }
                SCAN_BAR();
            }
            *(f32x4*)(p.out + OUT_SP + ((size_t)bh * 64 + q * 16 + row) * 64 + kq * 4) = (f32x4){S0, S1, S2, S3};
        }
        __syncthreads();
    }
#undef SCAN_BAR
}

DEV void phase_finalize(const Params& p) {
    unsigned char* ws = p.ws; const int tid = fresh_tid(), lane = tid & 63, gw = blockIdx.x * 8 + (tid >> 6), nw = gridDim.x * 8;
    const bf16_t* rbuf = (const bf16_t*)(ws + O_H); const bf16_t* kbuf = (const bf16_t*)(ws + O_H + HALFROW); const bf16_t* gb = (const bf16_t*)(ws + O_H + 2 * HALFROW);
    const bf16_t* vbuf = (const bf16_t*)(ws + O_XRES); const bf16_t* obuf = (const bf16_t*)(ws + O_Z); bf16_t* ymix = (bf16_t*)(ws + O_YMIX);
    const int c = lane * 8; float rk[8], gg[8], gbb[8]; ld8f(p.in[I_RK] + c, rk); ld8f(p.in[I_GNG] + c, gg); ld8f(p.in[I_GNB] + c, gbb);
#pragma unroll 2
    for (int r = gw; r < MV; r += nw) {
        const size_t o = (size_t)r * 512 + c; float ov[8], rv[8], kv[8], vv[8], gv[8]; ld8bf(obuf + o, ov); ld8bf(rbuf + o, rv); ld8bf(kbuf + o, kv); ld8bf(vbuf + o, vv); ld8bf(gb + o, gv);
        float s = 0.f, bs = 0.f;
#pragma unroll
        for (int i = 0; i < 8; ++i) { s += ov[i]; bs += rv[i] * kv[i] * rk[i]; }
        s += __shfl_xor(s, 1); s += __shfl_xor(s, 2); s += __shfl_xor(s, 4); bs += __shfl_xor(bs, 1); bs += __shfl_xor(bs, 2); bs += __shfl_xor(bs, 4);
        const float mu = s * (1.f / 64.f); float q = 0.f;
#pragma unroll
        for (int i = 0; i < 8; ++i) { ov[i] -= mu; q += ov[i] * ov[i]; }
        q += __shfl_xor(q, 1); q += __shfl_xor(q, 2); q += __shfl_xor(q, 4);
        const float rstd = rsqrtf(q * (1.f / 64.f) + 64e-5f); float y[8];
#pragma unroll
        for (int i = 0; i < 8; ++i) y[i] = (ov[i] * rstd * gg[i] + gbb[i] + bs * vv[i]) * gv[i];
        st8bf(ymix + (size_t)r * 1024 + 512 + c, y);
    }
}

DEV void phase_sattn(const Params& p, LAS unsigned char* lds) {
    unsigned char* ws = p.ws; const int tid = fresh_tid(), lane = tid & 63, w = tid >> 6, kgrp = lane >> 4, dl = lane & 15;
    const bf16_t* qb = (const bf16_t*)(ws + O_Z + HALFROW); bf16_t* ob = (bf16_t*)(ws + O_YMIX);
    LAS float* pw = (LAS float*)lds;
    LAS float* wm = pw + 256;
    LAS float* wacc = wm + 16;
    for (int item = blockIdx.x; item < 512; item += gridDim.x) {
        const int si = item >> 2, h = item & 3; const float* Kp = p.in[I_CK] + (size_t)si * 262144 + h * 256; const float* Vp = p.in[I_CV] + (size_t)si * 262144 + h * 256;
        float q[16]; { float a[8], b[8]; ld8bf(qb + (size_t)(NTOK + si) * 1024 + h * 256 + dl * 16, a); ld8bf(qb + (size_t)(NTOK + si) * 1024 + h * 256 + dl * 16 + 8, b);
#pragma unroll
            for (int i = 0; i < 8; ++i) { q[i] = a[i]; q[8 + i] = b[i]; } }
        float sc[8];
#pragma unroll
        for (int j = 0; j < 8; ++j) {
            const float* kr = Kp + (size_t)(w * 32 + kgrp + 4 * j) * 1024 + dl * 16; float d = 0.f;
#pragma unroll
            for (int i = 0; i < 4; ++i) { const f32x4 k4 = *(const f32x4*)(kr + 4 * i); d += k4[0] * q[4 * i] + k4[1] * q[4 * i + 1] + k4[2] * q[4 * i + 2] + k4[3] * q[4 * i + 3]; }
            sc[j] = rowsum16(d);
        }
        float mx = sc[0];
#pragma unroll
        for (int j = 1; j < 8; ++j) mx = fmaxf(mx, sc[j]);
        mx = fmaxf(mx, __shfl_xor(mx, 16)); mx = fmaxf(mx, __shfl_xor(mx, 32));
        float sum = 0.f;
#pragma unroll
        for (int j = 0; j < 8; ++j) { sc[j] = __expf(sc[j] - mx); sum += sc[j]; }
        sum += __shfl_xor(sum, 16); sum += __shfl_xor(sum, 32);
        __syncthreads();
        if (dl == 0) {
#pragma unroll
            for (int j = 0; j < 8; ++j) pw[w * 32 + kgrp + 4 * j] = sc[j];
        }
        if (lane == 0) { wm[w] = mx; wm[8 + w] = sum; }
        asm volatile("s_waitcnt lgkmcnt(0)" ::: "memory"); __builtin_amdgcn_wave_barrier();
        f32x4 acc = (f32x4){0.f, 0.f, 0.f, 0.f};
#pragma unroll 16
        for (int j = 0; j < 32; ++j) { const f32x4 v4 = *(const f32x4*)(Vp + (size_t)(w * 32 + j) * 1024 + lane * 4); acc = acc + pw[w * 32 + j] * v4; }
        *(LAS f32x4*)(wacc + w * 256 + lane * 4) = acc;
        __syncthreads();
        if (tid < 256) {
            float M = wm[0];
#pragma unroll
            for (int j = 1; j < 8; ++j) M = fmaxf(M, wm[j]);
            float L = 0.f, o = 0.f;
#pragma unroll
            for (int j = 0; j < 8; ++j) { const float f = __expf(wm[j] - M); L += wm[8 + j] * f; o += wacc[j * 256 + tid] * f; }
            ob[(size_t)(NTOK + si) * 1024 + h * 256 + tid] = (bf16_t)(cvt_pk_bf16(o * __builtin_amdgcn_rcpf(L), 0.f) & 0xffffu);
        }
    }
}

DEV void phase_final(const Params& p) {
    unsigned char* ws = p.ws; const int tid = fresh_tid(), lane = tid & 63, gw = blockIdx.x * 8 + (tid >> 6), nw = gridDim.x * 8;
    const bf16_t* xb = (const bf16_t*)(ws + O_XB); const float* rs5 = (const float*)(ws + O_RS5);
    float g[16]; { float a[8], b[8]; ld8f(p.in[I_FIN] + lane * 8, a); ld8f(p.in[I_FIN] + 512 + lane * 8, b);
#pragma unroll
        for (int i = 0; i < 8; ++i) { g[i] = a[i]; g[8 + i] = b[i]; } }
#pragma unroll 2
    for (int r = gw; r < MV; r += nw) {
        const float rstd = rstd_of(rs5, r);
#pragma unroll
        for (int hf = 0; hf < 2; ++hf) { const int c = hf * 512 + lane * 8; float v[8]; ld8bf(xb + (size_t)r * 1024 + c, v);
#pragma unroll
            for (int i = 0; i < 8; ++i) v[i] = v[i] * rstd * g[hf * 8 + i];
            st8f(p.out + OUT_Y + (size_t)r * 1024 + c, v); }
    }
}

__global__ void __launch_bounds__(512, 2) mega(Params p) {
    extern __shared__ __attribute__((aligned(16))) unsigned char shm[];
    LAS unsigned char* lds = (LAS unsigned char*)shm;
    unsigned char* ws = p.ws;
    const int MT = MP / 256;
    {
        volatile LAS unsigned* st = (volatile LAS unsigned*)(lds + pg8::STAGE_BYTES);
        if (threadIdx.x < 2) st[threadIdx.x] = 0u;
        __syncthreads();
        if (threadIdx.x == 0) (void)xb_add(&((unsigned*)(ws + O_BAR))[XB_XCNT(xb_xcc_id())], 1u);
    }
#define XB_SYNC() do { XcdBarrier xb_; xb_.bar = (unsigned*)(p.ws + O_BAR); xb_.x = xb_xcc_id(); xb_.st = (volatile LAS unsigned*)(lds + pg8::STAGE_BYTES); xcd_barrier(xb_); } while (0)
    { phase_prep(p, lds); }
    XB_SYNC();
    { {
            { pg8::Gemm g{(const bf16_t*)(ws + O_XB), (const bf16_t*)(ws + O_WGU1), 1024, 1024, 1024}; pg8::GridSched S; S.init(MT, 22, 0, 1024, 1024);
              EpiSwiglu E{(const float*)(ws + O_RS1), (bf16_t*)(ws + O_H)}; pg8::gemm_phase(lds, g, S, E); }
            { pg8::Gemm g{(const bf16_t*)(ws + O_MNB), (const bf16_t*)(ws + O_WK), 1024, 1024, 1024}; pg8::GridSched S; S.init(8, 4, MT * 22, 1024, 1024);
              EpiK E{(const float*)(ws + O_RSTDM), p.out + OUT_MK, (bf16_t*)(ws + O_MKB)}; pg8::gemm_phase(lds, g, S, E); }
            { pg8::Gemm g{(const bf16_t*)(ws + O_WV), (const bf16_t*)(ws + O_MNB), 1024, 1024, 1024}; pg8::GridSched S; S.init(4, 8, MT * 22 + 32, 1024, 1024);
              EpiVT E{(const float*)(ws + O_RSTDM), p.out + OUT_MV, (bf16_t*)(ws + O_VT)}; pg8::gemm_phase(lds, g, S, E); }
        } }
    XB_SYNC();
    { { pg8::Gemm g{(const bf16_t*)(ws + O_H), (const bf16_t*)(ws + O_WD1), DFF, DFF, DFF}; pg8::GridSched S; S.init(64, 4, 0, DFF, DFF);
            EpiRes E{p.in[I_XP], (bf16_t*)(ws + O_XB), (float*)(ws + O_RS2), 0.5f}; pg8::gemm_phase(lds, g, S, E);
            SRes E2{p.in[I_XS], (bf16_t*)(ws + O_XB), (float*)(ws + O_RS2), 0.5f, NTOK};
            small_gemm<4>(lds, (const bf16_t*)(ws + O_H), DFF, (const bf16_t*)(ws + O_WD1), DFF, DFF, NTOK, 4, 16, E2); } }
    XB_SYNC();
    { { pg8::Gemm g{(const bf16_t*)(ws + O_XB), (const bf16_t*)(ws + O_WIN), 1024, 1024, 1024}; pg8::GridSched S; S.init(MT, 11, 0, 1024, 1024);
            EpiScale E{(const float*)(ws + O_RS2), (bf16_t*)(ws + O_Z), ZLD, ZLD}; pg8::gemm_phase(lds, g, S, E);
            SScale E2{(const float*)(ws + O_RS2), (bf16_t*)(ws + O_Z), ZLD, ZLD, 2816};
            small_gemm<2>(lds, (const bf16_t*)(ws + O_XB), 1024, (const bf16_t*)(ws + O_WIN) + (size_t)2816 * 1024, 1024, 1024, 0, MV / 32, 1, E2); } }
    XB_SYNC();
    { phase_mixprep(p); }
    XB_SYNC();
    { { pg8::Gemm g{(const bf16_t*)(ws + O_LIN), (const bf16_t*)(ws + O_WLORA), 384, 384, 256}; pg8::LoraSched S; S.init();
            EpiLora E{p.in[I_W0], p.in[I_A0], p.in[I_KA], (float*)(ws + O_DEC), (bf16_t*)(ws + O_H + HALFROW), (const bf16_t*)(ws + O_KK), (bf16_t*)(ws + O_KKA), (bf16_t*)(ws + O_H + 2 * HALFROW)};
            pg8::gemm_phase(lds, g, S, E); phase_chunkmix(p, lds); } }
    XB_SYNC();
    { phase_scan(p, lds); }
    XB_SYNC();
    { phase_finalize(p); }
    XB_SYNC();
    { { pg8::Gemm g{(const bf16_t*)(ws + O_YMIX), (const bf16_t*)(ws + O_WOUT), 1024, 1024, 1024}; pg8::GridSched S; S.init(64, 4, 0, 1024, 1024);
            EpiRes E{nullptr, (bf16_t*)(ws + O_XB), (float*)(ws + O_RS3), 1.f}; pg8::gemm_phase(lds, g, S, E);
            SRes E2{nullptr, (bf16_t*)(ws + O_XB), (float*)(ws + O_RS3), 1.f, 0};
            small_gemm<4>(lds, (const bf16_t*)(ws + O_YMIX), 1024, (const bf16_t*)(ws + O_WOUT), 1024, 1024, NTOK, 4, 16, E2); } }
    XB_SYNC();
    { { pg8::Gemm g{(const bf16_t*)(ws + O_XB), (const bf16_t*)(ws + O_WQ), 1024, 1024, 1024}; pg8::GridSched S; S.init(64, 4, 0, 1024, 1024);
            EpiScale E{(const float*)(ws + O_RS3), (bf16_t*)(ws + O_Z + HALFROW), 1024, 1024}; pg8::gemm_phase(lds, g, S, E);
            SScale E2{(const float*)(ws + O_RS3), (bf16_t*)(ws + O_Z + HALFROW), 1024, 1024, 0};
            small_gemm<4>(lds, (const bf16_t*)(ws + O_XB), 1024, (const bf16_t*)(ws + O_WQ), 1024, 1024, NTOK, 4, 16, E2); } }
    XB_SYNC();
    { {
            const bool sattn_first = ((blockIdx.x >> 3) & 1) != 0;
            if (sattn_first) phase_sattn(p, lds);
            { pg8::Gemm g{(const bf16_t*)(ws + O_Z + HALFROW), (const bf16_t*)(ws + O_MKB), 1024, 1024, 256}; pg8::AttnSched<0> S; S.init();
              EpiS E{(bf16_t*)(ws + O_Z), (float*)(ws + O_PSUM)}; pg8::gemm_phase(lds, g, S, E); }
            asm volatile("s_waitcnt vmcnt(0)" ::: "memory"); __syncthreads();
            if (threadIdx.x == 0) { __builtin_amdgcn_fence(__ATOMIC_ACQUIRE, "agent"); asm volatile("s_waitcnt vmcnt(0)" ::: "memory"); }
            __syncthreads();
            { pg8::Gemm g{(const bf16_t*)(ws + O_Z), (const bf16_t*)(ws + O_VT), 256, 2048, 256}; pg8::AttnSched<1> S; S.init();
              EpiO E{(const float*)(ws + O_PSUM), (bf16_t*)(ws + O_YMIX)}; pg8::gemm_phase(lds, g, S, E); }
            if (!sattn_first) phase_sattn(p, lds);
        } }
    XB_SYNC();
    { { pg8::Gemm g{(const bf16_t*)(ws + O_YMIX), (const bf16_t*)(ws + O_WO), 1024, 1024, 1024}; pg8::GridSched S; S.init(64, 4, 0, 1024, 1024);
            EpiRes E{nullptr, (bf16_t*)(ws + O_XB), (float*)(ws + O_RS4), 1.f}; pg8::gemm_phase(lds, g, S, E);
            SRes E2{nullptr, (bf16_t*)(ws + O_XB), (float*)(ws + O_RS4), 1.f, 0};
            small_gemm<4>(lds, (const bf16_t*)(ws + O_YMIX), 1024, (const bf16_t*)(ws + O_WO), 1024, 1024, NTOK, 4, 16, E2); } }
    XB_SYNC();
    { { pg8::Gemm g{(const bf16_t*)(ws + O_XB), (const bf16_t*)(ws + O_WGU2), 1024, 1024, 1024}; pg8::GridSched S; S.init(MT, 22, 0, 1024, 1024);
            EpiSwiglu E{(const float*)(ws + O_RS4), (bf16_t*)(ws + O_H)}; pg8::gemm_phase(lds, g, S, E); } }
    XB_SYNC();
    { { pg8::Gemm g{(const bf16_t*)(ws + O_H), (const bf16_t*)(ws + O_WD2), DFF, DFF, DFF}; pg8::GridSched S; S.init(64, 4, 0, DFF, DFF);
            EpiRes E{nullptr, (bf16_t*)(ws + O_XB), (float*)(ws + O_RS5), 0.5f}; pg8::gemm_phase(lds, g, S, E);
            SRes E2{nullptr, (bf16_t*)(ws + O_XB), (float*)(ws + O_RS5), 0.5f, 0};
            small_gemm<4>(lds, (const bf16_t*)(ws + O_H), DFF, (const bf16_t*)(ws + O_WD2), DFF, DFF, NTOK, 4, 16, E2); } }
    XB_SYNC();
    { phase_final(p); }
#undef XB_SYNC
}

constexpr size_t LDS_BYTES = pg8::STAGE_BYTES + 4096;

extern "C" void kernel_launch(void* const* d_in, const int* in_sizes, int n_in, void* d_out, int out_size, void* d_ws, size_t ws_size, hipStream_t stream) {
    static int grid_blocks = 0;
    if (!grid_blocks) {
        int dev = 0, cus = 0, per_cu = 0;
        hipGetDevice(&dev);
        hipDeviceGetAttribute(&cus, hipDeviceAttributeMultiprocessorCount, dev);
        hipFuncSetAttribute((const void*)mega, hipFuncAttributeMaxDynamicSharedMemorySize, (int)LDS_BYTES);
        hipOccupancyMaxActiveBlocksPerMultiprocessor(&per_cu, mega, 512, LDS_BYTES);
        if (per_cu < 1) { fprintf(stderr, "occupancy query returned %d\n", per_cu); per_cu = 1; }
        grid_blocks = cus * (per_cu > 1 ? 1 : per_cu);
        if (ws_size < WS_NEED) fprintf(stderr, "workspace too small: %zu < %zu\n", ws_size, (size_t)WS_NEED);
    }
    Params p{};
    for (int i = 0; i < 40; ++i) p.in[i] = (const float*)d_in[i];
    p.out = (float*)d_out; p.ws = (unsigned char*)d_ws;
    hipMemsetAsync((unsigned char*)d_ws + O_BAR, 0, XCD_BAR_WORDS * 4, stream);
    hipLaunchKernelGGL(mega, dim3(grid_blocks), dim3(512), LDS_BYTES, stream, p);
}
```

```cpp
#include <hip/hip_runtime.h>
#include <hip/hip_cooperative_groups.h>
#include <cstdio>
namespace cg = cooperative_groups;

#ifndef PHMASK
#define PHMASK 0xffff
#endif
#ifndef DUPMASK
#define DUPMASK 0
#endif
#ifndef ONE_LAUNCH
#define ONE_LAUNCH 1
#endif

#define LAS __attribute__((address_space(3)))
#define DEV __device__ __forceinline__
typedef unsigned short bf16_t;
typedef short bf16x8 __attribute__((ext_vector_type(8)));
typedef float f32x4 __attribute__((ext_vector_type(4)));
typedef unsigned u32x2 __attribute__((ext_vector_type(2)));
typedef unsigned u32x4 __attribute__((ext_vector_type(4)));

constexpr int DM = 1024, NTOK = 16384, NSMP = 128, MV = NTOK + NSMP, MP = 16640, SEQ = 2048;
constexpr int DFF = 2816, ZLD = 2848, BPROJ = 1824, NMEMR = 2048;
constexpr int NPH = 16;

constexpr size_t al256(size_t x) { return (x + 255) & ~(size_t)255; }
constexpr size_t O_WGU1 = 0;
constexpr size_t O_WD1 = O_WGU1 + al256((size_t)5632 * 1024 * 2);
constexpr size_t O_WIN = O_WD1 + al256((size_t)1024 * 2816 * 2);
constexpr size_t O_WOUT = O_WIN + al256((size_t)3072 * 1024 * 2);
constexpr size_t O_WQ = O_WOUT + 2097152, O_WK = O_WQ + 2097152, O_WV = O_WK + 2097152, O_WO = O_WV + 2097152;
constexpr size_t O_WGU2 = O_WO + 2097152;
constexpr size_t O_WD2 = O_WGU2 + al256((size_t)5632 * 1024 * 2);
constexpr size_t O_WLORA = O_WD2 + al256((size_t)1024 * 2816 * 2);
constexpr size_t O_MNB = O_WLORA + al256((size_t)1536 * 384 * 2);
constexpr size_t O_MKB = O_MNB + 4194304, O_VT = O_MKB + 4194304;
constexpr size_t O_RSTDM = O_VT + 4194304;
constexpr size_t RS_BYTES = (size_t)MP * 64;
constexpr size_t O_RS1 = O_RSTDM + 8192, O_RS2 = O_RS1 + RS_BYTES, O_RS3 = O_RS2 + RS_BYTES, O_RS4 = O_RS3 + RS_BYTES, O_RS5 = O_RS4 + RS_BYTES;
constexpr size_t O_PSUM = O_RS5 + RS_BYTES;
constexpr size_t HALFROW = (size_t)MP * 512 * 4;
constexpr size_t O_XB = O_PSUM + 1048576;
constexpr size_t O_XRES = O_XB + HALFROW;
constexpr size_t O_H = O_XRES + 2 * HALFROW;
constexpr size_t O_Z = O_H + al256((size_t)MP * DFF * 2);
constexpr size_t O_YMIX = O_Z + al256((size_t)MP * ZLD * 2);
constexpr size_t O_VAB = O_YMIX + HALFROW;
constexpr size_t O_LIN = O_VAB + HALFROW / 2;
constexpr size_t O_KK = O_LIN + al256((size_t)MP * 384 * 2);
constexpr size_t O_DEC = O_KK + HALFROW, O_KKA = O_DEC + HALFROW;
constexpr size_t O_BAR = O_KKA + HALFROW;
constexpr size_t WS_NEED = O_BAR + 16384;

constexpr size_t OUT_Y = 0, OUT_SP = (size_t)MV * 1024, OUT_SHP = OUT_SP + 262144, OUT_MK = OUT_SHP + 8 * 1824, OUT_MV = OUT_MK + 2097152,
                 OUT_SS = OUT_MV + 2097152, OUT_SHS = OUT_SS + 4194304, OUT_CV = OUT_SHS + 128 * 1824;

enum { I_XP = 0, I_XS, I_SRWKV, I_SSHIFT, I_CK, I_CV, I_MEM, I_LN1, I_G1, I_U1, I_D1, I_LNMIX, I_WIN, I_WOUT, I_SGUW, I_SGUB, I_SLNG, I_SLNB,
       I_MU, I_W0, I_W2, I_A0, I_A2, I_G2, I_KK, I_KA, I_RK, I_GNG, I_GNB, I_LNX, I_MEMN, I_XQ, I_XK, I_XV, I_XO, I_LN2, I_G2F, I_U2F, I_D2F, I_FIN };

struct Params { const float* in[40]; float* out; unsigned char* ws; };

DEV unsigned cvt_pk_bf16(float lo, float hi) { unsigned r; asm volatile("v_cvt_pk_bf16_f32 %0, %1, %2" : "=v"(r) : "v"(lo), "v"(hi)); return r; }
DEV float bf_lo(unsigned u) { return __uint_as_float(u << 16); }
DEV float bf_hi(unsigned u) { return __uint_as_float(u & 0xffff0000u); }
DEV f32x4 bf4(u32x2 u) { return (f32x4){__uint_as_float(u[0] << 16), __uint_as_float(u[0] & 0xffff0000u), __uint_as_float(u[1] << 16), __uint_as_float(u[1] & 0xffff0000u)}; }
DEV u32x2 pk4(f32x4 v) { u32x2 o; o[0] = cvt_pk_bf16(v[0], v[1]); o[1] = cvt_pk_bf16(v[2], v[3]); return o; }
DEV float bf2f(bf16_t b) { return __uint_as_float((unsigned)b << 16); }
DEV float sigmoidf_(float x) { return __builtin_amdgcn_rcpf(1.f + __expf(-x)); }
DEV float tanhf_(float y) { return 1.f - 2.f * __builtin_amdgcn_rcpf(1.f + __expf(2.f * y)); }
DEV float gelu_t(float x) { return 0.5f * x * (1.f + tanhf_(0.7978845608028654f * (x + 0.044715f * x * x * x))); }
DEV float wsum64(float v) {
#pragma unroll
    for (int o = 32; o >= 1; o >>= 1) v += __shfl_xor(v, o);
    return v;
}
DEV float wmax64(float v) {
#pragma unroll
    for (int o = 32; o >= 1; o >>= 1) v = fmaxf(v, __shfl_xor(v, o));
    return v;
}
template <int CTRL> DEV float dpp_f(float x) { return __builtin_bit_cast(float, __builtin_amdgcn_update_dpp(0, __builtin_bit_cast(int, x), CTRL, 0xf, 0xf, false)); }
DEV float rowsum16(float x) {
    x += dpp_f<0x128>(x); x += dpp_f<0x124>(x); x += dpp_f<0x122>(x); x += dpp_f<0x121>(x); return x;
}
DEV int fresh_tid() { int t = threadIdx.x; asm volatile("" : "+v"(t)); return t; }
DEV float rstd_of(const float* rs, int r) { const f32x4* q = (const f32x4*)(rs + (size_t)r * 16); const f32x4 p = (q[0] + q[1]) + (q[2] + q[3]); return rsqrtf(((p[0] + p[1]) + (p[2] + p[3])) * (1.f / 1024.f) + 1e-6f); }

#define XB_TMO      128
#define XB_XCNT(j)  (256  + 64 * (j))
#define XB_XSUB(j)  (1280 + 64 * (j))
#define XB_XGEN(j)  (2304 + 64 * (j))
#define XB_TOP      3328
#define XB_TOPGEN   3392
#define XCD_BAR_WORDS 3456
#define XB_SPIN_CAP (1u << 18)
DEV unsigned xb_ld(unsigned* p)              { return __hip_atomic_load(p, __ATOMIC_RELAXED, __HIP_MEMORY_SCOPE_AGENT); }
DEV unsigned xb_add(unsigned* p, unsigned v) { return __hip_atomic_fetch_add(p, v, __ATOMIC_RELAXED, __HIP_MEMORY_SCOPE_AGENT); }
DEV unsigned xb_xcc_id() { return (unsigned)__builtin_amdgcn_s_getreg((3 << 11) | 20) & 0xFu; }
#define XB_SPIN(cond, bar) do { unsigned _sp = 0; while (cond) { __builtin_amdgcn_s_sleep(1); \
    if ((++_sp & 255u) == 0u) { if (xb_ld(&(bar)[XB_TMO])) break; if (_sp > XB_SPIN_CAP) { atomicAdd(&(bar)[XB_TMO], 1u); break; } } } } while (0)
struct XcdBarrier { unsigned* bar; unsigned x; volatile LAS unsigned* st; };
DEV XcdBarrier xcd_barrier_post(unsigned* bar, volatile LAS unsigned* st) {
    XcdBarrier b; b.bar = bar; b.x = xb_xcc_id(); b.st = st;
    if (threadIdx.x == 0) (void)xb_add(&bar[XB_XCNT(b.x)], 1u);
    return b;
}
DEV void xcd_barrier_complete(unsigned* bar, unsigned x, unsigned& nloc, unsigned& nx) {
    const unsigned G = gridDim.x * gridDim.y * gridDim.z;
    unsigned sum, cnt, mine, sp = 0u;
    for (;;) {
        sum = 0u; cnt = 0u; mine = 0u;
#pragma unroll
        for (unsigned j = 0; j < 16; ++j) { const unsigned c = xb_ld(&bar[XB_XCNT(j)]); sum += c; cnt += (c > 0u) ? 1u : 0u; mine = (j == x) ? c : mine; }
        if (sum == G) break;
        __builtin_amdgcn_s_sleep(1);
        if ((++sp & 255u) == 0u) { if (xb_ld(&bar[XB_TMO])) break; if (sp > XB_SPIN_CAP) { atomicAdd(&bar[XB_TMO], 1u); break; } }
    }
    nloc = mine > 0u ? mine : 1u; nx = cnt > 0u ? cnt : 1u;
}
DEV void xcd_barrier(const XcdBarrier& b) {
    asm volatile("s_waitcnt vmcnt(0)" ::: "memory");
    __syncthreads();
    if (threadIdx.x == 0) {
        unsigned* bar = b.bar;
        __builtin_amdgcn_s_waitcnt(0);
        unsigned nloc = b.st[0], nx = b.st[1];
        if (nloc == 0u) { xcd_barrier_complete(bar, b.x, nloc, nx); b.st[0] = nloc; b.st[1] = nx; }
        const unsigned old = xb_add(&bar[XB_XSUB(b.x)], 1u);
        const unsigned gen = old / nloc;
        if (old + 1u == (gen + 1u) * nloc) {
            __builtin_amdgcn_fence(__ATOMIC_RELEASE, "agent");
            asm volatile("s_waitcnt vmcnt(0)" ::: "memory");
            const unsigned og = xb_add(&bar[XB_TOP], 1u);
            const unsigned tg = og / nx;
            if (og + 1u == (tg + 1u) * nx) xb_add(&bar[XB_TOPGEN], 1u);
            else XB_SPIN(xb_ld(&bar[XB_TOPGEN]) == tg, bar);
            __builtin_amdgcn_fence(__ATOMIC_ACQUIRE, "agent");
            xb_add(&bar[XB_XGEN(b.x)], 1u);
            asm volatile("s_waitcnt vmcnt(0)" ::: "memory");
        } else {
            XB_SPIN(xb_ld(&bar[XB_XGEN(b.x)]) == gen, bar);
            __builtin_amdgcn_fence(__ATOMIC_ACQUIRE, "agent");
            asm volatile("s_waitcnt vmcnt(0)" ::: "memory");
        }
    }
    __syncthreads();
}

namespace pg8 {
constexpr int BM = 256, BK = 64, HALF = 128, HTB = HALF * BK * 2, STAGE_BYTES = 8 * HTB, NXCD = 8, WGM = 8;
DEV int lds_byte(int r, int c) { const int st = (r >> 4) * 2 + (c >> 5), rr = r & 15, cc = c & 31, ob = rr * 64 + cc * 2; return st * 1024 + (ob ^ (((ob >> 9) & 1) << 5)); }
DEV void stage_rc(int b, int& R, int& C) { const int st = b / 1024, sb = b % 1024, swz = sb ^ (((sb >> 9) & 1) << 5); R = (st >> 1) * 16 + swz / 64; C = (st & 1) * 32 + (swz % 64) / 2; }

struct Unit { int pm, pn; long ao, bo; int x0, x1; };
struct Gemm { const bf16_t* A; const bf16_t* Bt; int lda, ldb, K; };

struct GridSched {
    int nM, nN, nwg, G, c; long ta, tb;
    DEV void init(int nM_, int nN_, int shift, int lda, int ldb) { nM = nM_; nN = nN_; nwg = nM * nN; G = (int)gridDim.x; c = ((int)blockIdx.x + G - (shift % G)) % G; ta = 256L * lda; tb = 256L * ldb; }
    DEV bool next(int i, Unit& u) const {
        const long L = (long)i * G + c; if (L >= nwg) return false;
        int wgid = (int)L; { const int q = nwg / NXCD, r = nwg % NXCD, xcd = wgid % NXCD, off = wgid / NXCD; wgid = (xcd < r ? xcd * (q + 1) : r * (q + 1) + (xcd - r) * q) + off; }
        const int nig = WGM * nN, gid = wgid / nig, fm = gid * WGM, gsz = (nM - fm) < WGM ? (nM - fm) : WGM;
        u.pm = fm + ((wgid % nig) % gsz); u.pn = (wgid % nig) / gsz; u.ao = u.pm * ta; u.bo = u.pn * tb; u.x0 = 0; u.x1 = 0; return true;
    }
};
struct LoraSched {
    int G, c;
    DEV void init() { G = (int)gridDim.x; c = (int)blockIdx.x; }
    DEV bool next(int i, Unit& u) const {
        const long L = (long)i * G + c; if (L >= 65 * 6) return false;
        const int pn = (int)L % 6, pm = (int)L / 6, off = (pn >= 4) ? 128 : 0;
        u.pm = pm; u.pn = pn; u.x0 = 0; u.x1 = 0; u.ao = (long)pm * 256 * 384 + off; u.bo = (long)pn * 256 * 384 + off; return true;
    }
};
template <int WHICH> struct AttnSched {
    int G, c;
    DEV void init() { G = (int)gridDim.x; c = (int)blockIdx.x; }
    DEV bool next(int i, Unit& u) const {
        const long L = (long)i * G + c; if (L >= 256) return false;
        const int xcd = (int)L & 7, idx = (int)L >> 3, bh = xcd * 4 + (idx >> 3), mt = idx & 7, b = bh >> 2, h = bh & 3;
        u.pm = mt; u.pn = 0; u.x0 = bh; u.x1 = mt;
        if (WHICH == 0) { u.ao = ((long)b * 2048 + mt * 256) * 1024 + h * 256; u.bo = ((long)b * 256) * 1024 + h * 256; }
        else { u.ao = ((long)bh * 2048 + mt * 256) * 256; u.bo = ((long)h * 256) * 2048 + b * 256; }
        return true;
    }
};

template <class Epi, class Sched>
DEV void gemm_phase(LAS unsigned char* lds, const Gemm g, const Sched& S, const Epi& E) {
    int tid_ = threadIdx.x; asm volatile("" : "+v"(tid_));
    const int tid = tid_, wid = __builtin_amdgcn_readfirstlane(tid >> 6), lane = tid & 63, wr = wid >> 2, wc = wid & 3, fr = lane & 15, fq = lane >> 4;
    int K = g.K, lda_ = g.lda, ldb_ = g.ldb; asm volatile("" : "+s"(K), "+s"(lda_), "+s"(ldb_)); const int nt = K / BK;
    unsigned voffA[2], voffB[2];
#pragma unroll
    for (int i = 0; i < 2; ++i) { int R, C; stage_rc(tid * 16 + i * 8192, R, C); voffA[i] = (unsigned)(R * lda_ + C) * 2u; voffB[i] = (unsigned)(R * ldb_ + C) * 2u; }
    const size_t kstep = (size_t)(BK * 2);
    const size_t hstepA = (size_t)HALF * lda_ * 2, hstepB = (size_t)HALF * ldb_ * 2;
    const unsigned ldsw = (unsigned)wid * 1024u;
    const int aoff = lds_byte(wr * 64 + fr, fq * 8), boff = lds_byte(wc * 32 + fr, fq * 8);
#define PG8_SA(b, h) (((b) * 2 + (h)) * HTB)
#define PG8_SB(b, h) ((4 + (b) * 2 + (h)) * HTB)
#define PG8_STAGE(bufoff, gbase, voff) do { _Pragma("unroll") for (int _i = 0; _i < 2; ++_i) \
        __builtin_amdgcn_global_load_lds((const unsigned*)((const char*)(gbase) + (voff)[_i]), (LAS unsigned*)(lds + (bufoff) + ldsw + _i * 8192), 16, 0, 0); } while (0)
#define PG8_LDA(dst, b, h) do { _Pragma("unroll") for (int m = 0; m < 4; ++m) _Pragma("unroll") for (int k = 0; k < 2; ++k) dst[m][k] = *(const LAS bf16x8*)(lds + PG8_SA(b, h) + aoff + m * 2048 + k * 1024); } while (0)
#define PG8_LDB(dst, b, h) do { _Pragma("unroll") for (int n = 0; n < 2; ++n) _Pragma("unroll") for (int k = 0; k < 2; ++k) dst[n][k] = *(const LAS bf16x8*)(lds + PG8_SB(b, h) + boff + n * 2048 + k * 1024); } while (0)
#define PG8_MMA(ai, bj, At, Bt) do { __builtin_amdgcn_s_setprio(1); _Pragma("unroll") for (int m = 0; m < 4; ++m) _Pragma("unroll") for (int n = 0; n < 2; ++n) _Pragma("unroll") for (int k = 0; k < 2; ++k) \
        acc[ai][bj][m][n] = __builtin_amdgcn_mfma_f32_16x16x32_bf16(Bt[n][k], At[m][k], acc[ai][bj][m][n], 0, 0, 0); __builtin_amdgcn_s_setprio(0); } while (0)
#define PG8_WAIT_V(n) asm volatile("s_waitcnt vmcnt(" #n ")" ::: "memory")
#define PG8_WAIT_L(n) asm volatile("s_waitcnt lgkmcnt(" #n ")" ::: "memory")
#define PG8_BAR __builtin_amdgcn_s_barrier()
#define PG8_SCHED __builtin_amdgcn_sched_barrier(0)
    Unit cur, nxt; int ui = 0;
    if (!S.next(0, cur)) return;
    f32x4 acc[2][2][4][2];
#pragma unroll
    for (int a = 0; a < 2; ++a)
#pragma unroll
        for (int b = 0; b < 2; ++b)
#pragma unroll
            for (int m = 0; m < 4; ++m)
#pragma unroll
                for (int n = 0; n < 2; ++n) acc[a][b][m][n] = (f32x4){0.f, 0.f, 0.f, 0.f};
    bf16x8 At[4][2], B0[2][2], B1[2][2];
    const char* cA = (const char*)g.A + (size_t)cur.ao * 2; const char* cB = (const char*)g.Bt + (size_t)cur.bo * 2;
    PG8_STAGE(PG8_SB(0, 0), cB, voffB); PG8_STAGE(PG8_SA(0, 0), cA, voffA); PG8_STAGE(PG8_SB(0, 1), cB + hstepB, voffB); PG8_STAGE(PG8_SA(0, 1), cA + hstepA, voffA);
    if (wr == 1) PG8_BAR;
    PG8_WAIT_V(4); PG8_BAR;
    PG8_STAGE(PG8_SB(1, 0), cB + kstep, voffB); PG8_STAGE(PG8_SA(1, 0), cA + kstep, voffA); PG8_STAGE(PG8_SB(1, 1), cB + hstepB + kstep, voffB);
    PG8_WAIT_V(6); PG8_BAR;
    for (;;) {
        const bool has_next = S.next(ui + 1, nxt);
        const char* nA = has_next ? (const char*)g.A + (size_t)nxt.ao * 2 : cA; const char* nB = has_next ? (const char*)g.Bt + (size_t)nxt.bo * 2 : cB;
#pragma unroll 1
        for (int t = 0; t < nt; t += 2) {
            const bool last = (t == nt - 2);
            const char* a1 = cA + (size_t)(t + 1) * kstep;
            const char* a2 = last ? nA : cA + (size_t)(t + 2) * kstep; const char* b2 = last ? nB : cB + (size_t)(t + 2) * kstep;
            const char* a3 = a2 + kstep; const char* b3 = b2 + kstep;
            PG8_LDB(B0, 0, 0); PG8_SCHED; PG8_LDA(At, 0, 0); PG8_STAGE(PG8_SA(1, 1), a1 + hstepA, voffA);
            PG8_WAIT_L(8); PG8_BAR; PG8_WAIT_L(0); PG8_MMA(0, 0, At, B0); PG8_BAR; PG8_SCHED;
            PG8_LDB(B1, 0, 1); PG8_STAGE(PG8_SB(0, 0), b2, voffB);
            PG8_BAR; PG8_WAIT_L(0); PG8_MMA(0, 1, At, B1); PG8_BAR;
            PG8_LDA(At, 0, 1); PG8_STAGE(PG8_SA(0, 0), a2, voffA);
            PG8_BAR; PG8_WAIT_L(0); PG8_MMA(1, 0, At, B0); PG8_BAR; PG8_SCHED;
            PG8_STAGE(PG8_SB(0, 1), b2 + hstepB, voffB);
            PG8_WAIT_V(6); PG8_BAR; PG8_MMA(1, 1, At, B1); PG8_BAR;
            PG8_LDB(B0, 1, 0); PG8_SCHED; PG8_LDA(At, 1, 0); PG8_STAGE(PG8_SA(0, 1), a2 + hstepA, voffA);
            PG8_WAIT_L(8); PG8_BAR; PG8_WAIT_L(0); PG8_MMA(0, 0, At, B0); PG8_BAR; PG8_SCHED;
            PG8_LDB(B1, 1, 1); PG8_STAGE(PG8_SB(1, 0), b3, voffB);
            PG8_BAR; PG8_WAIT_L(0); PG8_MMA(0, 1, At, B1); PG8_BAR;
            PG8_LDA(At, 1, 1); PG8_STAGE(PG8_SA(1, 0), a3, voffA);
            PG8_BAR; PG8_WAIT_L(0); PG8_MMA(1, 0, At, B0); PG8_BAR; PG8_SCHED;
            PG8_STAGE(PG8_SB(1, 1), b3 + hstepB, voffB);
            PG8_WAIT_V(6); PG8_BAR; PG8_MMA(1, 1, At, B1); PG8_BAR;
        }
        E(acc, cur, wr, wc, fr, fq);
        if (!has_next) break;
#pragma unroll
        for (int a = 0; a < 2; ++a)
#pragma unroll
            for (int b = 0; b < 2; ++b)
#pragma unroll
                for (int m = 0; m < 4; ++m)
#pragma unroll
                    for (int n = 0; n < 2; ++n) acc[a][b][m][n] = (f32x4){0.f, 0.f, 0.f, 0.f};
        cur = nxt; cA = nA; cB = nB; ++ui;
    }
    PG8_WAIT_V(0);
    if (wr == 0) PG8_BAR;
    PG8_BAR;
#undef PG8_SA
#undef PG8_SB
#undef PG8_STAGE
#undef PG8_LDA
#undef PG8_LDB
#undef PG8_MMA
#undef PG8_WAIT_V
#undef PG8_WAIT_L
#undef PG8_BAR
#undef PG8_SCHED
}
}
using pg8::Unit;

typedef const f32x4 (&AccRef)[2][2][4][2];

struct EpiSwiglu {
    const float* rs; bf16_t* H;
    DEV void operator()(AccRef acc, const Unit& u, int wr, int wc, int fr, int fq) const {
        const int row0 = u.pm * 256 + wr * 64 + fr, hc0 = u.pn * 128 + wc * 16 + 4 * fq;
#pragma unroll
        for (int ai = 0; ai < 2; ++ai)
#pragma unroll
            for (int m = 0; m < 4; ++m) {
                const int r = row0 + ai * 128 + m * 16; const float rstd = rstd_of(rs, r);
#pragma unroll
                for (int bj = 0; bj < 2; ++bj) {
                    float hv[4];
#pragma unroll
                    for (int i = 0; i < 4; ++i) { const float gt = acc[ai][bj][m][0][i] * rstd, up = acc[ai][bj][m][1][i] * rstd; hv[i] = gt * sigmoidf_(gt) * up; }
                    u32x2 o; o[0] = cvt_pk_bf16(hv[0], hv[1]); o[1] = cvt_pk_bf16(hv[2], hv[3]);
                    *(u32x2*)(H + (size_t)r * DFF + hc0 + bj * 64) = o;
                }
            }
    }
};

struct EpiRes {
    const float* res; bf16_t* xb; float* rs_out; float alpha;
    DEV void operator()(AccRef acc, const Unit& u, int wr, int wc, int fr, int fq) const {
        const int row0 = u.pm * 256 + wr * 64 + fr, col0 = u.pn * 256 + wc * 32 + 4 * fq;
#pragma unroll
        for (int ai = 0; ai < 2; ++ai)
#pragma unroll
            for (int mh = 0; mh < 2; ++mh) {
                f32x4 x[2][2][2];
#pragma unroll
                for (int m2 = 0; m2 < 2; ++m2)
#pragma unroll
                    for (int bj = 0; bj < 2; ++bj)
#pragma unroll
                        for (int n = 0; n < 2; ++n) { const size_t o = (size_t)(row0 + ai * 128 + (mh * 2 + m2) * 16) * 1024 + col0 + bj * 128 + n * 16;
                            x[m2][bj][n] = res ? *(const f32x4*)(res + o) : bf4(*(const u32x2*)(xb + o)); }
#pragma unroll
                for (int m2 = 0; m2 < 2; ++m2) {
                    const int m = mh * 2 + m2, r = row0 + ai * 128 + m * 16; float s = 0.f;
#pragma unroll
                    for (int bj = 0; bj < 2; ++bj)
#pragma unroll
                        for (int n = 0; n < 2; ++n) {
                            const int c = col0 + bj * 128 + n * 16; const f32x4 v = x[m2][bj][n] + alpha * acc[ai][bj][m][n];
                            *(u32x2*)(xb + (size_t)r * 1024 + c) = pk4(v);
                            s += v[0] * v[0] + v[1] * v[1] + v[2] * v[2] + v[3] * v[3];
                        }
                    s += __shfl_xor(s, 16); s += __shfl_xor(s, 32);
                    if (fq == 0) rs_out[(size_t)r * 16 + u.pn * 4 + wc] = s;
                }
            }
    }
};

struct EpiScale {
    const float* rs; bf16_t* O; int ldo, ncols;
    DEV void operator()(AccRef acc, const Unit& u, int wr, int wc, int fr, int fq) const {
        const int row0 = u.pm * 256 + wr * 64 + fr, col0 = u.pn * 256 + wc * 32 + 4 * fq;
#pragma unroll
        for (int ai = 0; ai < 2; ++ai)
#pragma unroll
            for (int m = 0; m < 4; ++m) {
                const int r = row0 + ai * 128 + m * 16; const float rstd = rstd_of(rs, r);
#pragma unroll
                for (int bj = 0; bj < 2; ++bj)
#pragma unroll
                    for (int n = 0; n < 2; ++n) {
                        const int c = col0 + bj * 128 + n * 16;
                        if (c < ncols) { const f32x4 v = acc[ai][bj][m][n] * rstd; u32x2 o; o[0] = cvt_pk_bf16(v[0], v[1]); o[1] = cvt_pk_bf16(v[2], v[3]); *(u32x2*)(O + (size_t)r * ldo + c) = o; }
                    }
            }
    }
};

struct EpiLora {
    const float* w0; const float* a0; const float* k_a; float* dec; bf16_t* kbuf; const bf16_t* kkbuf; bf16_t* kka; bf16_t* gb;
    template <int REGION> DEV void run(AccRef acc, const Unit& u, int wr, int wc, int fr, int fq) const {
        const int row0 = u.pm * 256 + wr * 64 + fr, cb = (u.pn & 1) * 256 + wc * 32 + 4 * fq;
#pragma unroll
        for (int ai = 0; ai < 2; ++ai)
#pragma unroll
            for (int m = 0; m < 4; ++m) {
                const int r = row0 + ai * 128 + m * 16;
                {
#pragma unroll
                    for (int bj = 0; bj < 2; ++bj)
#pragma unroll
                        for (int n = 0; n < 2; ++n) {
                            const int cc = cb + bj * 128 + n * 16; const f32x4 a = acc[ai][bj][m][n]; const size_t o = (size_t)r * 512 + cc;
                            if (REGION == 0) {
                                const f32x4 b0 = *(const f32x4*)(w0 + cc); f32x4 d;
#pragma unroll
                                for (int i = 0; i < 4; ++i) d[i] = __expf(-0.60653066f * sigmoidf_(b0[i] + a[i]));
                                *(f32x4*)(dec + o) = d;
                            } else if (REGION == 1) {
                                const f32x4 b0 = *(const f32x4*)(a0 + cc), ka = *(const f32x4*)(k_a + cc), kv = bf4(*(const u32x2*)(kbuf + o)), kkv = bf4(*(const u32x2*)(kkbuf + o)); f32x4 kn, kkan;
#pragma unroll
                                for (int i = 0; i < 4; ++i) { const float av = sigmoidf_(b0[i] + a[i]); kn[i] = kv[i] * (1.f + (av - 1.f) * ka[i]); kkan[i] = kkv[i] * av; }
                                *(u32x2*)(kbuf + o) = pk4(kn); *(u32x2*)(kka + o) = pk4(kkan);
                            } else {
                                u32x2 ov; ov[0] = cvt_pk_bf16(a[0], a[1]); ov[1] = cvt_pk_bf16(a[2], a[3]); *(u32x2*)(gb + o) = ov;
                            }
                        }
                }
            }
    }
    DEV void operator()(AccRef acc, const Unit& u, int wr, int wc, int fr, int fq) const {
        const int region = u.pn >> 1;
        if (region == 0) run<0>(acc, u, wr, wc, fr, fq); else if (region == 1) run<1>(acc, u, wr, wc, fr, fq); else run<2>(acc, u, wr, wc, fr, fq);
    }
};

struct EpiK {
    const float* rstdm; float* outk; bf16_t* mkb;
    DEV void operator()(AccRef acc, const Unit& u, int wr, int wc, int fr, int fq) const {
        const int row0 = u.pm * 256 + wr * 64 + fr, col0 = u.pn * 256 + wc * 32 + 4 * fq;
#pragma unroll
        for (int ai = 0; ai < 2; ++ai)
#pragma unroll
            for (int m = 0; m < 4; ++m) {
                const int r = row0 + ai * 128 + m * 16; const float rstd = rstdm[r];
#pragma unroll
                for (int bj = 0; bj < 2; ++bj)
#pragma unroll
                    for (int n = 0; n < 2; ++n) {
                        const int c = col0 + bj * 128 + n * 16; const f32x4 v = acc[ai][bj][m][n] * rstd;
                        *(f32x4*)(outk + (size_t)r * 1024 + c) = v;
                        u32x2 o; o[0] = cvt_pk_bf16(v[0], v[1]); o[1] = cvt_pk_bf16(v[2], v[3]); *(u32x2*)(mkb + (size_t)r * 1024 + c) = o;
                    }
            }
    }
};
struct EpiVT {
    const float* rstdm; float* outv; bf16_t* vt;
    DEV void operator()(AccRef acc, const Unit& u, int wr, int wc, int fr, int fq) const {
        const int row0 = u.pm * 256 + wr * 64 + fr, col0 = u.pn * 256 + wc * 32 + 4 * fq;
#pragma unroll
        for (int bj = 0; bj < 2; ++bj)
#pragma unroll
            for (int n = 0; n < 2; ++n) {
                const int c = col0 + bj * 128 + n * 16; const f32x4 rsd = *(const f32x4*)(rstdm + c);
#pragma unroll
                for (int ai = 0; ai < 2; ++ai)
#pragma unroll
                    for (int m = 0; m < 4; ++m) {
                        const int r = row0 + ai * 128 + m * 16; const f32x4 v = acc[ai][bj][m][n] * rsd;
                        u32x2 o; o[0] = cvt_pk_bf16(v[0], v[1]); o[1] = cvt_pk_bf16(v[2], v[3]); *(u32x2*)(vt + (size_t)r * 2048 + c) = o;
#pragma unroll
                        for (int i = 0; i < 4; ++i) outv[(size_t)(c + i) * 1024 + r] = v[i];
                    }
            }
    }
};
struct EpiS {
    bf16_t* P; float* psum;
    DEV void operator()(AccRef acc, const Unit& u, int wr, int wc, int fr, int fq) const {
        const size_t prow0 = (size_t)u.x0 * 2048 + u.x1 * 256;
#pragma unroll
        for (int ai = 0; ai < 2; ++ai)
#pragma unroll
            for (int m = 0; m < 4; ++m) {
                const int rl = ai * 128 + wr * 64 + m * 16 + fr; float s = 0.f;
#pragma unroll
                for (int bj = 0; bj < 2; ++bj)
#pragma unroll
                    for (int n = 0; n < 2; ++n) {
                        const f32x4 a = acc[ai][bj][m][n]; u32x2 o;
                        o[0] = cvt_pk_bf16(__expf(a[0]), __expf(a[1])); o[1] = cvt_pk_bf16(__expf(a[2]), __expf(a[3]));
                        s += bf_lo(o[0]) + bf_hi(o[0]) + bf_lo(o[1]) + bf_hi(o[1]);
                        *(u32x2*)(P + (prow0 + rl) * 256 + bj * 128 + wc * 32 + n * 16 + 4 * fq) = o;
                    }
                s += __shfl_xor(s, 16); s += __shfl_xor(s, 32);
                if (fq == 0) psum[(prow0 + rl) * 4 + wc] = s;
            }
    }
};
struct EpiO {
    const float* psum; bf16_t* O;
    DEV void operator()(AccRef acc, const Unit& u, int wr, int wc, int fr, int fq) const {
        const int bh = u.x0, b = bh >> 2, h = bh & 3; const size_t prow0 = (size_t)bh * 2048 + u.x1 * 256; const size_t m0 = (size_t)b * 2048 + u.x1 * 256;
#pragma unroll
        for (int ai = 0; ai < 2; ++ai)
#pragma unroll
            for (int m = 0; m < 4; ++m) {
                const int rl = ai * 128 + wr * 64 + m * 16 + fr; const f32x4 p = *(const f32x4*)(psum + (prow0 + rl) * 4); const float inv = __builtin_amdgcn_rcpf(p[0] + p[1] + p[2] + p[3]);
#pragma unroll
                for (int bj = 0; bj < 2; ++bj)
#pragma unroll
                    for (int n = 0; n < 2; ++n) {
                        const f32x4 v = acc[ai][bj][m][n] * inv; u32x2 o; o[0] = cvt_pk_bf16(v[0], v[1]); o[1] = cvt_pk_bf16(v[2], v[3]);
                        *(u32x2*)(O + (m0 + rl) * 1024 + h * 256 + bj * 128 + wc * 32 + n * 16 + 4 * fq) = o;
                    }
            }
    }
};

struct SRes {
    const float* res; bf16_t* xb; float* rs_out; float alpha; int res_row0;
    DEV void operator()(int r, int c, f32x4 a, int slab, int l15) const {
        const f32x4 x0 = res ? *(const f32x4*)(res + (size_t)(r - res_row0) * 1024 + c) : bf4(*(const u32x2*)(xb + (size_t)r * 1024 + c));
        const f32x4 x = x0 + alpha * a;
        *(u32x2*)(xb + (size_t)r * 1024 + c) = pk4(x);
        const float s = rowsum16(x[0] * x[0] + x[1] * x[1] + x[2] * x[2] + x[3] * x[3]);
        if (l15 == 0) rs_out[(size_t)r * 16 + slab] = s;
    }
};
struct SScale {
    const float* rs; bf16_t* O; int ldo, ncols, col_off;
    DEV void operator()(int r, int c, f32x4 a, int, int) const {
        const int cc = c + col_off;
        if (cc < ncols) { const f32x4 v = a * rstd_of(rs, r); u32x2 o; o[0] = cvt_pk_bf16(v[0], v[1]); o[1] = cvt_pk_bf16(v[2], v[3]); *(u32x2*)(O + (size_t)r * ldo + cc) = o; }
    }
};
template <int NB, class Epi>
DEV void small_gemm(LAS unsigned char* lds, const bf16_t* A, int lda, const bf16_t* Bt, int ldb, int K, int row_base, int nrg, int nslab, const Epi& E) {
    const int tid = fresh_tid(), lane = tid & 63, w = tid >> 6, l15 = lane & 15, kg = lane >> 4;
    LAS float* red = (LAS float*)lds;
    const int kw = K >> 3;
    for (int item = blockIdx.x; item < nrg * nslab; item += gridDim.x) {
        const int rgi = item % nrg, slab = item / nrg, r0 = row_base + rgi * 32, c0 = slab * 64;
        f32x4 acc[2][4];
#pragma unroll
        for (int rb = 0; rb < 2; ++rb)
#pragma unroll
            for (int n = 0; n < 4; ++n) acc[rb][n] = (f32x4){0.f, 0.f, 0.f, 0.f};
        const bf16_t* ap = A + (size_t)(r0 + l15) * lda + w * kw + kg * 8;
        const bf16_t* bp = Bt + (size_t)(c0 + l15) * ldb + w * kw + kg * 8;
#pragma unroll 4
        for (int k = 0; k < kw; k += 32) {
            const bf16x8 a0 = *(const bf16x8*)(ap + k), a1 = *(const bf16x8*)(ap + (size_t)16 * lda + k);
            bf16x8 b[NB];
#pragma unroll
            for (int n = 0; n < NB; ++n) b[n] = *(const bf16x8*)(bp + (size_t)(n * 16) * ldb + k);
#pragma unroll
            for (int n = 0; n < NB; ++n) { acc[0][n] = __builtin_amdgcn_mfma_f32_16x16x32_bf16(b[n], a0, acc[0][n], 0, 0, 0); acc[1][n] = __builtin_amdgcn_mfma_f32_16x16x32_bf16(b[n], a1, acc[1][n], 0, 0, 0); }
        }
        __syncthreads();
#pragma unroll
        for (int rb = 0; rb < 2; ++rb)
#pragma unroll
            for (int n = 0; n < 4; ++n) *(LAS f32x4*)(red + ((w * 32 + rb * 16 + l15) * 64 + n * 16 + 4 * kg)) = acc[rb][n];
        __syncthreads();
        const int row = tid >> 4, c4 = (tid & 15) * 4; f32x4 sum = (f32x4){0.f, 0.f, 0.f, 0.f};
#pragma unroll
        for (int ww = 0; ww < 8; ++ww) sum = sum + *(const LAS f32x4*)(red + ((ww * 32 + row) * 64 + c4));
        E(r0 + row, c0 + c4, sum, slab, tid & 15);
    }
}

DEV void ld8bf(const bf16_t* p, float (&v)[8]) { const u32x4 u = *(const u32x4*)p;
#pragma unroll
    for (int i = 0; i < 4; ++i) { v[2 * i] = bf_lo(u[i]); v[2 * i + 1] = bf_hi(u[i]); } }
DEV void ld8f(const float* p, float (&v)[8]) { const f32x4 a = *(const f32x4*)p, b = *(const f32x4*)(p + 4);
#pragma unroll
    for (int i = 0; i < 4; ++i) { v[i] = a[i]; v[4 + i] = b[i]; } }
DEV void st8f(float* p, const float (&v)[8]) { *(f32x4*)p = (f32x4){v[0], v[1], v[2], v[3]}; *(f32x4*)(p + 4) = (f32x4){v[4], v[5], v[6], v[7]}; }
DEV void st8bf(bf16_t* p, const float (&v)[8]) { u32x4 o; o[0] = cvt_pk_bf16(v[0], v[1]); o[1] = cvt_pk_bf16(v[2], v[3]); o[2] = cvt_pk_bf16(v[4], v[5]); o[3] = cvt_pk_bf16(v[6], v[7]); *(u32x4*)p = o; }

DEV void tr_job(const float* __restrict__ src, int Ks, int Ns, int Nd, bf16_t* __restrict__ dst, int mode, const float* __restrict__ gain, float scale, LAS float* tile) {
    const int nk = Ks / 64, nn = Nd / 64, ntile = nk * nn, ldd = Ks; const int t = fresh_tid();
    f32x4 v0, v1;
    auto gl = [&](int ti) { const int tk = ti % nk, tn = ti / nk;
        { const int id = t, k = id >> 4, gn = tn * 64 + (id & 15) * 4; v0 = (gn < Ns) ? *(const f32x4*)(src + (size_t)(tk * 64 + k) * Ns + gn) : (f32x4){0.f, 0.f, 0.f, 0.f}; if (gain) v0 = v0 * (gain[tk * 64 + k] * scale); }
        { const int id = t + 512, k = id >> 4, gn = tn * 64 + (id & 15) * 4; v1 = (gn < Ns) ? *(const f32x4*)(src + (size_t)(tk * 64 + k) * Ns + gn) : (f32x4){0.f, 0.f, 0.f, 0.f}; if (gain) v1 = v1 * (gain[tk * 64 + k] * scale); } };
    int ti = blockIdx.x;
    if (ti < ntile) gl(ti);
    for (; ti < ntile; ti += gridDim.x) {
        const int tk = ti % nk, tn = ti / nk;
        *(LAS f32x4*)(tile + (t >> 4) * 68 + (t & 15) * 4) = v0; *(LAS f32x4*)(tile + ((t + 512) >> 4) * 68 + (t & 15) * 4) = v1;
        if (ti + (int)gridDim.x < ntile) gl(ti + gridDim.x);
        __syncthreads();
        { const int n = t & 63, k8 = (t >> 6) * 8, gn = tn * 64 + n; float v[8];
#pragma unroll
          for (int j = 0; j < 8; ++j) v[j] = tile[(k8 + j) * 68 + n];
          const int drow = mode == 0 ? gn : ((gn >> 4) * 32 + (mode == 2 ? 16 : 0) + (gn & 15));
          st8bf(dst + (size_t)drow * ldd + tk * 64 + k8, v); }
        __syncthreads();
    }
}

DEV void phase_prep(const Params& p, LAS unsigned char* lds) {
    unsigned char* ws = p.ws; LAS float* tile = (LAS float*)lds;
    const int tid = fresh_tid(), lane = tid & 63, gw = blockIdx.x * 8 + (tid >> 6), nw = gridDim.x * 8;
    bf16_t* xb = (bf16_t*)(ws + O_XB); float* rs1 = (float*)(ws + O_RS1);
#pragma unroll 2
    for (int r = gw; r < MP; r += nw) {
        float ss = 0.f;
        if (r < MV) {
            const float* xr = r < NTOK ? p.in[I_XP] + (size_t)r * 1024 : p.in[I_XS] + (size_t)(r - NTOK) * 1024;
#pragma unroll
            for (int i = 0; i < 4; ++i) { const int c = lane * 4 + 256 * i; const f32x4 v = *(const f32x4*)(xr + c); ss += v[0] * v[0] + v[1] * v[1] + v[2] * v[2] + v[3] * v[3];
                u32x2 o; o[0] = cvt_pk_bf16(v[0], v[1]); o[1] = cvt_pk_bf16(v[2], v[3]); *(u32x2*)(xb + (size_t)r * 1024 + c) = o; }
            ss = wsum64(ss);
        } else {
#pragma unroll
            for (int i = 0; i < 4; ++i) { u32x2 o; o[0] = 0; o[1] = 0; *(u32x2*)(xb + (size_t)r * 1024 + lane * 4 + 256 * i) = o; }
        }
        if (lane < 16) { rs1[(size_t)r * 16 + lane] = lane == 0 ? ss : 0.f;
            if (r >= MV) { ((float*)(ws + O_RS2))[(size_t)r * 16 + lane] = 0.f; ((float*)(ws + O_RS3))[(size_t)r * 16 + lane] = 0.f; ((float*)(ws + O_RS4))[(size_t)r * 16 + lane] = 0.f; ((float*)(ws + O_RS5))[(size_t)r * 16 + lane] = 0.f; } }
    }
    bf16_t* mnb = (bf16_t*)(ws + O_MNB); float* rstdm = (float*)(ws + O_RSTDM);
    for (int r = gw; r < NMEMR; r += nw) {
        const float* xr = p.in[I_MEM] + (size_t)r * 1024; float ss = 0.f;
#pragma unroll
        for (int i = 0; i < 4; ++i) { const int c = lane * 4 + 256 * i; const f32x4 v = *(const f32x4*)(xr + c); ss += v[0] * v[0] + v[1] * v[1] + v[2] * v[2] + v[3] * v[3];
            u32x2 o; o[0] = cvt_pk_bf16(v[0], v[1]); o[1] = cvt_pk_bf16(v[2], v[3]); *(u32x2*)(mnb + (size_t)r * 1024 + c) = o; }
        ss = wsum64(ss);
        if (lane == 0) rstdm[r] = rsqrtf(ss * (1.f / 1024.f) + 1e-6f);
    }
    { bf16_t* wl = (bf16_t*)(ws + O_WLORA);
      for (int i = blockIdx.x * 512 + tid; i < 1536 * 384; i += gridDim.x * 512) {
          const int n = i / 384, k = i % 384, reg = n >> 9, c = n & 511; float v = 0.f;
          if (reg == 0 && k < 64) v = p.in[I_W2][k * 512 + c];
          else if (reg == 1 && k >= 64 && k < 128) v = p.in[I_A2][(k - 64) * 512 + c];
          else if (reg == 2 && k >= 128 && k < 288) v = p.in[I_G2][(k - 128) * 512 + c];
          wl[i] = (bf16_t)(cvt_pk_bf16(v, 0.f) & 0xffffu);
      } }
    tr_job(p.in[I_G1], 1024, 2816, 2816, (bf16_t*)(ws + O_WGU1), 1, p.in[I_LN1], 1.f, tile);
    tr_job(p.in[I_U1], 1024, 2816, 2816, (bf16_t*)(ws + O_WGU1), 2, p.in[I_LN1], 1.f, tile);
    tr_job(p.in[I_XK], 1024, 1024, 1024, (bf16_t*)(ws + O_WK), 0, p.in[I_MEMN], 1.f, tile);
    tr_job(p.in[I_XV], 1024, 1024, 1024, (bf16_t*)(ws + O_WV), 0, p.in[I_MEMN], 1.f, tile);
    tr_job(p.in[I_D1], 2816, 1024, 1024, (bf16_t*)(ws + O_WD1), 0, nullptr, 1.f, tile);
    tr_job(p.in[I_WIN], 1024, 2848, 3072, (bf16_t*)(ws + O_WIN), 0, p.in[I_LNMIX], 1.f, tile);
    tr_job(p.in[I_WOUT], 1024, 1024, 1024, (bf16_t*)(ws + O_WOUT), 0, nullptr, 1.f, tile);
    tr_job(p.in[I_XQ], 1024, 1024, 1024, (bf16_t*)(ws + O_WQ), 0, p.in[I_LNX], 0.0625f, tile);
    tr_job(p.in[I_XO], 1024, 1024, 1024, (bf16_t*)(ws + O_WO), 0, nullptr, 1.f, tile);
    tr_job(p.in[I_G2F], 1024, 2816, 2816, (bf16_t*)(ws + O_WGU2), 1, p.in[I_LN2], 1.f, tile);
    tr_job(p.in[I_U2F], 1024, 2816, 2816, (bf16_t*)(ws + O_WGU2), 2, p.in[I_LN2], 1.f, tile);
    tr_job(p.in[I_D2F], 2816, 1024, 1024, (bf16_t*)(ws + O_WD2), 0, nullptr, 1.f, tile);
}

DEV void phase_mixprep(const Params& p) {
    unsigned char* ws = p.ws; const int tid = fresh_tid(), lane = tid & 63, gw = blockIdx.x * 8 + (tid >> 6), nw = gridDim.x * 8;
    const bf16_t* z = (const bf16_t*)(ws + O_Z); bf16_t* vab = (bf16_t*)(ws + O_VAB); bf16_t* lin = (bf16_t*)(ws + O_LIN); bf16_t* ymix = (bf16_t*)(ws + O_YMIX);
    bf16_t* rbuf = (bf16_t*)(ws + O_H); bf16_t* kbuf = (bf16_t*)(ws + O_H + HALFROW); bf16_t* vbuf = (bf16_t*)(ws + O_XRES); bf16_t* kkbuf = (bf16_t*)(ws + O_KK);
#pragma unroll 2
    for (int r = gw; r < MV; r += nw) {
        const bf16_t* zr = z + (size_t)r * ZLD; const bool smp = r >= NTOK; const int t = r & (SEQ - 1), si = r - NTOK;
        {
            const int c = lane * 8; float v[8]; ld8bf(zr + 512 + c, v); float s = 0.f;
#pragma unroll
            for (int i = 0; i < 8; ++i) { v[i] = gelu_t(v[i]); s += v[i]; }
            const float mu = wsum64(s) * (1.f / 512.f); float q = 0.f;
#pragma unroll
            for (int i = 0; i < 8; ++i) { v[i] -= mu; q += v[i] * v[i]; }
            const float rstd = rsqrtf(wsum64(q) * (1.f / 512.f) + 1e-5f); float g[8], b[8]; ld8f(p.in[I_SLNG] + c, g); ld8f(p.in[I_SLNB] + c, b);
#pragma unroll
            for (int i = 0; i < 8; ++i) v[i] = v[i] * rstd * g[i] + b[i];
            st8bf(vab + (size_t)r * 512 + c, v);
            if (smp) {
                st8f(p.out + OUT_CV + (size_t)si * 512 + c, v);
                const int grp = c >> 6; const float w00 = p.in[I_SGUW][grp * 16384], b0 = p.in[I_SGUB][grp * 128]; float uu[8]; ld8bf(zr + c, uu);
#pragma unroll
                for (int i = 0; i < 8; ++i) uu[i] = gelu_t(uu[i]) * (w00 * v[i] + b0);
                st8bf(ymix + (size_t)r * 1024 + c, uu);
            }
        }
#pragma unroll
        for (int it = 0; it < 4; ++it) {
            const int ch = lane + 64 * it; if (ch >= 228) break;
            const int cb = ch * 8; float cur[8], prv[8], mu[8], zs[8]; ld8bf(zr + 1024 + cb, cur);
            if (smp) ld8f(p.in[I_SSHIFT] + (size_t)si * BPROJ + cb, prv);
            else if (t == 0) {
#pragma unroll
                for (int i = 0; i < 8; ++i) prv[i] = 0.f;
            } else ld8bf(zr - ZLD + 1024 + cb, prv);
            ld8f(p.in[I_MU] + cb, mu);
#pragma unroll
            for (int i = 0; i < 8; ++i) zs[i] = cur[i] + (prv[i] - cur[i]) * mu[i];
            if (smp) st8f(p.out + OUT_SHS + (size_t)si * BPROJ + cb, cur);
            else if (t == SEQ - 1) st8f(p.out + OUT_SHP + (size_t)(r >> 11) * BPROJ + cb, cur);
            if (it == 0) st8bf(rbuf + (size_t)r * 512 + cb, zs);
            else if (it == 1) {
                const int c = cb - 512; st8bf(kbuf + (size_t)r * 512 + c, zs); float kkw[8], kk[8]; ld8f(p.in[I_KK] + c, kkw); float ss = 0.f;
#pragma unroll
                for (int i = 0; i < 8; ++i) { kk[i] = zs[i] * kkw[i]; ss += kk[i] * kk[i]; }
                ss += __shfl_xor(ss, 1); ss += __shfl_xor(ss, 2); ss += __shfl_xor(ss, 4);
                const float rn = rsqrtf(fmaxf(ss, 1e-24f));
#pragma unroll
                for (int i = 0; i < 8; ++i) kk[i] *= rn;
                st8bf(kkbuf + (size_t)r * 512 + c, kk);
            } else if (it == 2) st8bf(vbuf + (size_t)r * 512 + (cb - 1024), zs);
            else {
                const int l = ch - 192; float o[8];
#pragma unroll
                for (int i = 0; i < 8; ++i) o[i] = l < 8 ? tanhf_(zs[i]) : (l < 16 ? zs[i] : sigmoidf_(zs[i]));
                st8bf(lin + (size_t)r * 384 + l * 8, o);
            }
        }
        if (lane >= 36 && lane < 48) { const float zero[8] = {0.f, 0.f, 0.f, 0.f, 0.f, 0.f, 0.f, 0.f}; st8bf(lin + (size_t)r * 384 + lane * 8, zero); }
    }
}

DEV void phase_chunkmix(const Params& p, LAS unsigned char* lds) {
    unsigned char* ws = p.ws; const int tid = fresh_tid(), lane = tid & 63, w = tid >> 6, l15 = lane & 15, kg = lane >> 4;
    const bf16_t* z = (const bf16_t*)(ws + O_Z); const bf16_t* vab = (const bf16_t*)(ws + O_VAB); bf16_t* ymix = (bf16_t*)(ws + O_YMIX);
    LAS bf16_t* vaT = (LAS bf16_t*)lds;
    for (int item = blockIdx.x; item < 1024; item += gridDim.x) {
        const int g = item & 7, bc = item >> 3; const size_t m0 = (size_t)bc * 128;
        __syncthreads();
#pragma unroll
        for (int i = 0; i < 2; ++i) { const int id = tid + 512 * i, s = id >> 3, d8 = (id & 7) * 8; const u32x4 u = *(const u32x4*)(vab + (m0 + s) * 512 + g * 64 + d8);
#pragma unroll
            for (int j = 0; j < 4; ++j) { vaT[(d8 + 2 * j) * 136 + s] = (bf16_t)(u[j] & 0xffffu); vaT[(d8 + 2 * j + 1) * 136 + s] = (bf16_t)(u[j] >> 16); } }
        __syncthreads();
        f32x4 acc[4];
#pragma unroll
        for (int nb = 0; nb < 4; ++nb) acc[nb] = (f32x4){0.f, 0.f, 0.f, 0.f};
        const int trow = 16 * w + l15; const float* wrow = p.in[I_SGUW] + ((size_t)g * 128 + trow) * 128;
        const int nks = (16 * w + 16 + 31) >> 5;
        for (int ks = 0; ks < nks; ++ks) {
            const int s0 = 32 * ks + kg * 8; float a[8]; ld8f(wrow + s0, a);
#pragma unroll
            for (int i = 0; i < 8; ++i) a[i] = (s0 + i <= trow) ? a[i] : 0.f;
            u32x4 au; au[0] = cvt_pk_bf16(a[0], a[1]); au[1] = cvt_pk_bf16(a[2], a[3]); au[2] = cvt_pk_bf16(a[4], a[5]); au[3] = cvt_pk_bf16(a[6], a[7]);
            const bf16x8 av = __builtin_bit_cast(bf16x8, au);
#pragma unroll
            for (int nb = 0; nb < 4; ++nb) { const bf16x8 bv = *(const LAS bf16x8*)(vaT + (nb * 16 + l15) * 136 + s0); acc[nb] = __builtin_amdgcn_mfma_f32_16x16x32_bf16(av, bv, acc[nb], 0, 0, 0); }
        }
#pragma unroll
        for (int j = 0; j < 4; ++j) { const int t = 16 * w + kg * 4 + j; const float bias = p.in[I_SGUB][g * 128 + t]; const size_t m = m0 + t;
#pragma unroll
            for (int nb = 0; nb < 4; ++nb) { const int d = g * 64 + nb * 16 + l15; const float u = gelu_t(bf2f(z[m * ZLD + d])); ymix[m * 1024 + d] = (bf16_t)(cvt_pk_bf16(u * (acc[nb][j] + bias), 0.f) & 0xffffu); } }
    }
}

DEV void phase_scan(const Params& p, LAS unsigned char* lds) {
    unsigned char* ws = p.ws; const int tid = fresh_tid(), lane = tid & 63, w = tid >> 6, rg = lane >> 4, kq = lane & 15;
    const bf16_t* rbuf = (const bf16_t*)(ws + O_H); const bf16_t* kbuf = (const bf16_t*)(ws + O_H + HALFROW); const bf16_t* vbuf = (const bf16_t*)(ws + O_XRES);
    const bf16_t* kkbuf = (const bf16_t*)(ws + O_KK); const float* dec = (const float*)(ws + O_DEC); const bf16_t* kka = (const bf16_t*)(ws + O_KKA); bf16_t* obuf = (bf16_t*)(ws + O_Z);
    constexpr int SL = 16, NCH = SEQ / SL, LB = 5 * SL * 64;
    LAS float* L = (LAS float*)lds;
    LAS float* Lv = L + 2 * LB;
    LAS float* Lp = Lv + 2 * SL * 16;
#define SCAN_BAR() do { asm volatile("s_waitcnt lgkmcnt(0)" ::: "memory"); __builtin_amdgcn_s_barrier(); asm volatile("" ::: "memory"); } while (0)
    for (int item = blockIdx.x; item < 256; item += gridDim.x) {
        const int bh = item >> 2, q = item & 3, b = bh >> 3, h = bh & 7; const size_t m0 = (size_t)b * SEQ;
        if (w >= 4) {
            const int lt = tid - 256, ls = lt >> 4, lc = (lt & 15) * 4;
            f32x4 p1; u32x2 p0, p2, p3, p4, pv; pv[0] = 0u; pv[1] = 0u;
            auto gload = [&](int ch) { const size_t o = (m0 + ch * SL + ls) * 512 + h * 64 + lc;
                p0 = *(const u32x2*)(kkbuf + o); p1 = *(const f32x4*)(dec + o); p2 = *(const u32x2*)(kbuf + o); p3 = *(const u32x2*)(kka + o); p4 = *(const u32x2*)(rbuf + o);
                if (lt < 64) pv = *(const u32x2*)(vbuf + (m0 + ch * SL + (lt >> 2)) * 512 + h * 64 + q * 16 + (lt & 3) * 4); };
            auto fill = [&](int ch) { LAS float* d = L + (ch & 1) * LB + ls * 64 + lc;
                *(LAS f32x4*)d = bf4(p0); *(LAS f32x4*)(d + SL * 64) = p1; *(LAS f32x4*)(d + 2 * SL * 64) = bf4(p2); *(LAS f32x4*)(d + 3 * SL * 64) = bf4(p3); *(LAS f32x4*)(d + 4 * SL * 64) = bf4(p4);
                if (lt < 64) *(LAS f32x4*)(Lv + (ch & 1) * SL * 16 + lt * 4) = bf4(pv); };
            auto reduce_slab = [&](int ch) { const int st = lt >> 4, row = lt & 15; const LAS float* pp = Lp + (ch & 1) * SL * 256 + st * 256 + (row >> 2) * 64 + (row & 3) * 16;
                const f32x4 a = *(const LAS f32x4*)pp, b4 = *(const LAS f32x4*)(pp + 4), c = *(const LAS f32x4*)(pp + 8), d = *(const LAS f32x4*)(pp + 12); const f32x4 t = (a + b4) + (c + d);
                obuf[(m0 + ch * SL + st) * 512 + h * 64 + q * 16 + row] = (bf16_t)(cvt_pk_bf16((t[0] + t[1]) + (t[2] + t[3]), 0.f) & 0xffffu); };
            gload(0); fill(0); gload(1);
            SCAN_BAR();
            for (int ch = 0; ch < NCH; ++ch) {
                if (ch + 1 < NCH) fill(ch + 1);
                if (ch + 2 < NCH) gload(ch + 2);
                if (ch >= 1) reduce_slab(ch - 1);
                SCAN_BAR();
            }
            reduce_slab(NCH - 1);
            {
                const int sidx = item * 4 + (w - 4), si = sidx >> 3, hh = sidx & 7; const size_t o = (size_t)(NTOK + si) * 512 + hh * 64 + kq * 4;
                const f32x4 kk4 = bf4(*(const u32x2*)(kkbuf + o)), w4 = *(const f32x4*)(dec + o), k4 = bf4(*(const u32x2*)(kbuf + o)), ka4 = bf4(*(const u32x2*)(kka + o)), r4 = bf4(*(const u32x2*)(rbuf + o));
                const float* sin = p.in[I_SRWKV] + (size_t)sidx * 4096; float* sout = p.out + OUT_SS + (size_t)sidx * 4096;
                for (int ps = 0; ps < 16; ++ps) {
                    const int v = ps * 4 + rg; f32x4 S = *(const f32x4*)(sin + v * 64 + kq * 4); const float vv = bf2f(vbuf[(size_t)(NTOK + si) * 512 + hh * 64 + v]);
                    const float sa = -rowsum16(S[0] * kk4[0] + S[1] * kk4[1] + S[2] * kk4[2] + S[3] * kk4[3]);
                    S = S * w4 + vv * k4 + sa * ka4;
                    *(f32x4*)(sout + v * 64 + kq * 4) = S;
                    const float op = rowsum16(S[0] * r4[0] + S[1] * r4[1] + S[2] * r4[2] + S[3] * r4[3]);
                    if (kq == 0) obuf[(size_t)(NTOK + si) * 512 + hh * 64 + v] = (bf16_t)(cvt_pk_bf16(op, 0.f) & 0xffffu);
                }
            }
        } else {
            typedef float f32x2v __attribute__((ext_vector_type(2)));
            f32x2v Sa = (f32x2v){0.f, 0.f}, Sb = (f32x2v){0.f, 0.f}; const int row = w * 4 + rg;
            SCAN_BAR();
            for (int ch = 0; ch < NCH; ++ch) {
                const LAS float* Lc = L + (ch & 1) * LB + kq * 4; const LAS float* Lvc = Lv + (ch & 1) * SL * 16 + row;
                LAS float* dst = Lp + (ch & 1) * SL * 256 + w * 64 + lane;
                f32x4 kk4 = *(const LAS f32x4*)Lc, w4 = *(const LAS f32x4*)(Lc + SL * 64), k4 = *(const LAS f32x4*)(Lc + 2 * SL * 64), ka4 = *(const LAS f32x4*)(Lc + 3 * SL * 64), r4 = *(const LAS f32x4*)(Lc + 4 * SL * 64);
                float vv = Lvc[0];
#pragma unroll 4
                for (int s = 0; s < SL; ++s) {
                    const int sn = s < SL - 1 ? s + 1 : SL - 1; const LAS float* bp = Lc + sn * 64;
                    const f32x4 nkk4 = *(const LAS f32x4*)bp, nw4 = *(const LAS f32x4*)(bp + SL * 64), nk4 = *(const LAS f32x4*)(bp + 2 * SL * 64), nka4 = *(const LAS f32x4*)(bp + 3 * SL * 64), nr4 = *(const LAS f32x4*)(bp + 4 * SL * 64);
                    const float nvv = Lvc[sn * 16];
                    f32x2v t = Sa * kk4.lo; t = Sb * kk4.hi + t;
                    const float sa = -rowsum16(t[0] + t[1]);
                    Sa = (Sa * w4.lo + vv * k4.lo) + sa * ka4.lo;
                    Sb = (Sb * w4.hi + vv * k4.hi) + sa * ka4.hi;
                    f32x2v u = Sa * r4.lo; u = Sb * r4.hi + u;
                    dst[s * 256] = u[0] + u[1];
                    kk4 = nkk4; w4 = nw4; k4 = nk4; ka4 = nka4; r4 = nr4; vv = nvv;
                }
                SCAN_BAR();
            }
            const float S0 = Sa[0], S1 = Sa[1], S2 = Sb[0], S3 = Sb[1];
            *(f32x4*)(p.out + OUT_SP + ((size_t)bh * 64 + q * 16 + row) * 64 + kq * 4) = (f32x4){S0, S1, S2, S3};
        }
        __syncthreads();
    }
#undef SCAN_BAR
}

DEV void phase_finalize(const Params& p) {
    unsigned char* ws = p.ws; const int tid = fresh_tid(), lane = tid & 63, gw = blockIdx.x * 8 + (tid >> 6), nw = gridDim.x * 8;
    const bf16_t* rbuf = (const bf16_t*)(ws + O_H); const bf16_t* kbuf = (const bf16_t*)(ws + O_H + HALFROW); const bf16_t* gb = (const bf16_t*)(ws + O_H + 2 * HALFROW);
    const bf16_t* vbuf = (const bf16_t*)(ws + O_XRES); const bf16_t* obuf = (const bf16_t*)(ws + O_Z); bf16_t* ymix = (bf16_t*)(ws + O_YMIX);
    const int c = lane * 8; float rk[8], gg[8], gbb[8]; ld8f(p.in[I_RK] + c, rk); ld8f(p.in[I_GNG] + c, gg); ld8f(p.in[I_GNB] + c, gbb);
#pragma unroll 2
    for (int r = gw; r < MV; r += nw) {
        const size_t o = (size_t)r * 512 + c; float ov[8], rv[8], kv[8], vv[8], gv[8]; ld8bf(obuf + o, ov); ld8bf(rbuf + o, rv); ld8bf(kbuf + o, kv); ld8bf(vbuf + o, vv); ld8bf(gb + o, gv);
        float s = 0.f, bs = 0.f;
#pragma unroll
        for (int i = 0; i < 8; ++i) { s += ov[i]; bs += rv[i] * kv[i] * rk[i]; }
        s += __shfl_xor(s, 1); s += __shfl_xor(s, 2); s += __shfl_xor(s, 4); bs += __shfl_xor(bs, 1); bs += __shfl_xor(bs, 2); bs += __shfl_xor(bs, 4);
        const float mu = s * (1.f / 64.f); float q = 0.f;
#pragma unroll
        for (int i = 0; i < 8; ++i) { ov[i] -= mu; q += ov[i] * ov[i]; }
        q += __shfl_xor(q, 1); q += __shfl_xor(q, 2); q += __shfl_xor(q, 4);
        const float rstd = rsqrtf(q * (1.f / 64.f) + 64e-5f); float y[8];
#pragma unroll
        for (int i = 0; i < 8; ++i) y[i] = (ov[i] * rstd * gg[i] + gbb[i] + bs * vv[i]) * gv[i];
        st8bf(ymix + (size_t)r * 1024 + 512 + c, y);
    }
}

DEV void phase_sattn(const Params& p, LAS unsigned char* lds) {
    unsigned char* ws = p.ws; const int tid = fresh_tid(), lane = tid & 63, w = tid >> 6, kgrp = lane >> 4, dl = lane & 15;
    const bf16_t* qb = (const bf16_t*)(ws + O_Z + HALFROW); bf16_t* ob = (bf16_t*)(ws + O_YMIX);
    LAS float* pw = (LAS float*)lds;
    LAS float* wm = pw + 256;
    LAS float* wacc = wm + 16;
    for (int item = blockIdx.x; item < 512; item += gridDim.x) {
        const int si = item >> 2, h = item & 3; const float* Kp = p.in[I_CK] + (size_t)si * 262144 + h * 256; const float* Vp = p.in[I_CV] + (size_t)si * 262144 + h * 256;
        float q[16]; { float a[8], b[8]; ld8bf(qb + (size_t)(NTOK + si) * 1024 + h * 256 + dl * 16, a); ld8bf(qb + (size_t)(NTOK + si) * 1024 + h * 256 + dl * 16 + 8, b);
#pragma unroll
            for (int i = 0; i < 8; ++i) { q[i] = a[i]; q[8 + i] = b[i]; } }
        float sc[8];
#pragma unroll
        for (int j = 0; j < 8; ++j) {
            const float* kr = Kp + (size_t)(w * 32 + kgrp + 4 * j) * 1024 + dl * 16; float d = 0.f;
#pragma unroll
            for (int i = 0; i < 4; ++i) { const f32x4 k4 = *(const f32x4*)(kr + 4 * i); d += k4[0] * q[4 * i] + k4[1] * q[4 * i + 1] + k4[2] * q[4 * i + 2] + k4[3] * q[4 * i + 3]; }
            sc[j] = rowsum16(d);
        }
        float mx = sc[0];
#pragma unroll
        for (int j = 1; j < 8; ++j) mx = fmaxf(mx, sc[j]);
        mx = fmaxf(mx, __shfl_xor(mx, 16)); mx = fmaxf(mx, __shfl_xor(mx, 32));
        float sum = 0.f;
#pragma unroll
        for (int j = 0; j < 8; ++j) { sc[j] = __expf(sc[j] - mx); sum += sc[j]; }
        sum += __shfl_xor(sum, 16); sum += __shfl_xor(sum, 32);
        __syncthreads();
        if (dl == 0) {
#pragma unroll
            for (int j = 0; j < 8; ++j) pw[w * 32 + kgrp + 4 * j] = sc[j];
        }
        if (lane == 0) { wm[w] = mx; wm[8 + w] = sum; }
        asm volatile("s_waitcnt lgkmcnt(0)" ::: "memory"); __builtin_amdgcn_wave_barrier();
        f32x4 acc = (f32x4){0.f, 0.f, 0.f, 0.f};
#pragma unroll 16
        for (int j = 0; j < 32; ++j) { const f32x4 v4 = *(const f32x4*)(Vp + (size_t)(w * 32 + j) * 1024 + lane * 4); acc = acc + pw[w * 32 + j] * v4; }
        *(LAS f32x4*)(wacc + w * 256 + lane * 4) = acc;
        __syncthreads();
        if (tid < 256) {
            float M = wm[0];
#pragma unroll
            for (int j = 1; j < 8; ++j) M = fmaxf(M, wm[j]);
            float L = 0.f, o = 0.f;
#pragma unroll
            for (int j = 0; j < 8; ++j) { const float f = __expf(wm[j] - M); L += wm[8 + j] * f; o += wacc[j * 256 + tid] * f; }
            ob[(size_t)(NTOK + si) * 1024 + h * 256 + tid] = (bf16_t)(cvt_pk_bf16(o * __builtin_amdgcn_rcpf(L), 0.f) & 0xffffu);
        }
    }
}

DEV void phase_final(const Params& p) {
    unsigned char* ws = p.ws; const int tid = fresh_tid(), lane = tid & 63, gw = blockIdx.x * 8 + (tid >> 6), nw = gridDim.x * 8;
    const bf16_t* xb = (const bf16_t*)(ws + O_XB); const float* rs5 = (const float*)(ws + O_RS5);
    float g[16]; { float a[8], b[8]; ld8f(p.in[I_FIN] + lane * 8, a); ld8f(p.in[I_FIN] + 512 + lane * 8, b);
#pragma unroll
        for (int i = 0; i < 8; ++i) { g[i] = a[i]; g[8 + i] = b[i]; } }
#pragma unroll 2
    for (int r = gw; r < MV; r += nw) {
        const float rstd = rstd_of(rs5, r);
#pragma unroll
        for (int hf = 0; hf < 2; ++hf) { const int c = hf * 512 + lane * 8; float v[8]; ld8bf(xb + (size_t)r * 1024 + c, v);
#pragma unroll
            for (int i = 0; i < 8; ++i) v[i] = v[i] * rstd * g[hf * 8 + i];
            st8f(p.out + OUT_Y + (size_t)r * 1024 + c, v); }
    }
}

__global__ void __launch_bounds__(512, 2) mega(Params p) {
    extern __shared__ __attribute__((aligned(16))) unsigned char shm[];
    LAS unsigned char* lds = (LAS unsigned char*)shm;
    unsigned char* ws = p.ws;
    const int MT = MP / 256;
    {
        volatile LAS unsigned* st = (volatile LAS unsigned*)(lds + pg8::STAGE_BYTES);
        if (threadIdx.x < 2) st[threadIdx.x] = 0u;
        __syncthreads();
        if (threadIdx.x == 0) (void)xb_add(&((unsigned*)(ws + O_BAR))[XB_XCNT(xb_xcc_id())], 1u);
    }
#define XB_SYNC() do { XcdBarrier xb_; xb_.bar = (unsigned*)(p.ws + O_BAR); xb_.x = xb_xcc_id(); xb_.st = (volatile LAS unsigned*)(lds + pg8::STAGE_BYTES); xcd_barrier(xb_); } while (0)
    { phase_prep(p, lds); }
    XB_SYNC();
    { {
            { pg8::Gemm g{(const bf16_t*)(ws + O_XB), (const bf16_t*)(ws + O_WGU1), 1024, 1024, 1024}; pg8::GridSched S; S.init(MT, 22, 0, 1024, 1024);
              EpiSwiglu E{(const float*)(ws + O_RS1), (bf16_t*)(ws + O_H)}; pg8::gemm_phase(lds, g, S, E); }
            { pg8::Gemm g{(const bf16_t*)(ws + O_MNB), (const bf16_t*)(ws + O_WK), 1024, 1024, 1024}; pg8::GridSched S; S.init(8, 4, MT * 22, 1024, 1024);
              EpiK E{(const float*)(ws + O_RSTDM), p.out + OUT_MK, (bf16_t*)(ws + O_MKB)}; pg8::gemm_phase(lds, g, S, E); }
            { pg8::Gemm g{(const bf16_t*)(ws + O_WV), (const bf16_t*)(ws + O_MNB), 1024, 1024, 1024}; pg8::GridSched S; S.init(4, 8, MT * 22 + 32, 1024, 1024);
              EpiVT E{(const float*)(ws + O_RSTDM), p.out + OUT_MV, (bf16_t*)(ws + O_VT)}; pg8::gemm_phase(lds, g, S, E); }
        } }
    XB_SYNC();
    { { pg8::Gemm g{(const bf16_t*)(ws + O_H), (const bf16_t*)(ws + O_WD1), DFF, DFF, DFF}; pg8::GridSched S; S.init(64, 4, 0, DFF, DFF);
            EpiRes E{p.in[I_XP], (bf16_t*)(ws + O_XB), (float*)(ws + O_RS2), 0.5f}; pg8::gemm_phase(lds, g, S, E);
            SRes E2{p.in[I_XS], (bf16_t*)(ws + O_XB), (float*)(ws + O_RS2), 0.5f, NTOK};
            small_gemm<4>(lds, (const bf16_t*)(ws + O_H), DFF, (const bf16_t*)(ws + O_WD1), DFF, DFF, NTOK, 4, 16, E2); } }
    XB_SYNC();
    { { pg8::Gemm g{(const bf16_t*)(ws + O_XB), (const bf16_t*)(ws + O_WIN), 1024, 1024, 1024}; pg8::GridSched S; S.init(MT, 11, 0, 1024, 1024);
            EpiScale E{(const float*)(ws + O_RS2), (bf16_t*)(ws + O_Z), ZLD, ZLD}; pg8::gemm_phase(lds, g, S, E);
            SScale E2{(const float*)(ws + O_RS2), (bf16_t*)(ws + O_Z), ZLD, ZLD, 2816};
            small_gemm<2>(lds, (const bf16_t*)(ws + O_XB), 1024, (const bf16_t*)(ws + O_WIN) + (size_t)2816 * 1024, 1024, 1024, 0, MV / 32, 1, E2); } }
    XB_SYNC();
    { phase_mixprep(p); }
    XB_SYNC();
    { { pg8::Gemm g{(const bf16_t*)(ws + O_LIN), (const bf16_t*)(ws + O_WLORA), 384, 384, 256}; pg8::LoraSched S; S.init();
            EpiLora E{p.in[I_W0], p.in[I_A0], p.in[I_KA], (float*)(ws + O_DEC), (bf16_t*)(ws + O_H + HALFROW), (const bf16_t*)(ws + O_KK), (bf16_t*)(ws + O_KKA), (bf16_t*)(ws + O_H + 2 * HALFROW)};
            pg8::gemm_phase(lds, g, S, E); phase_chunkmix(p, lds); } }
    XB_SYNC();
    { phase_scan(p, lds); }
    XB_SYNC();
    { phase_finalize(p); }
    XB_SYNC();
    { { pg8::Gemm g{(const bf16_t*)(ws + O_YMIX), (const bf16_t*)(ws + O_WOUT), 1024, 1024, 1024}; pg8::GridSched S; S.init(64, 4, 0, 1024, 1024);
            EpiRes E{nullptr, (bf16_t*)(ws + O_XB), (float*)(ws + O_RS3), 1.f}; pg8::gemm_phase(lds, g, S, E);
            SRes E2{nullptr, (bf16_t*)(ws + O_XB), (float*)(ws + O_RS3), 1.f, 0};
            small_gemm<4>(lds, (const bf16_t*)(ws + O_YMIX), 1024, (const bf16_t*)(ws + O_WOUT), 1024, 1024, NTOK, 4, 16, E2); } }
    XB_SYNC();
    { { pg8::Gemm g{(const bf16_t*)(ws + O_XB), (const bf16_t*)(ws + O_WQ), 1024, 1024, 1024}; pg8::GridSched S; S.init(64, 4, 0, 1024, 1024);
            EpiScale E{(const float*)(ws + O_RS3), (bf16_t*)(ws + O_Z + HALFROW), 1024, 1024}; pg8::gemm_phase(lds, g, S, E);
            SScale E2{(const float*)(ws + O_RS3), (bf16_t*)(ws + O_Z + HALFROW), 1024, 1024, 0};
            small_gemm<4>(lds, (const bf16_t*)(ws + O_XB), 1024, (const bf16_t*)(ws + O_WQ), 1024, 1024, NTOK, 4, 16, E2); } }
    XB_SYNC();
    { {
            const bool sattn_first = ((blockIdx.x >> 3) & 1) != 0;
            if (sattn_first) phase_sattn(p, lds);
            { pg8::Gemm g{(const bf16_t*)(ws + O_Z + HALFROW), (const bf16_t*)(ws + O_MKB), 1024, 1024, 256}; pg8::AttnSched<0> S; S.init();
              EpiS E{(bf16_t*)(ws + O_Z), (float*)(ws + O_PSUM)}; pg8::gemm_phase(lds, g, S, E); }
            asm volatile("s_waitcnt vmcnt(0)" ::: "memory"); __syncthreads();
            if (threadIdx.x == 0) { __builtin_amdgcn_fence(__ATOMIC_ACQUIRE, "agent"); asm volatile("s_waitcnt vmcnt(0)" ::: "memory"); }
            __syncthreads();
            { pg8::Gemm g{(const bf16_t*)(ws + O_Z), (const bf16_t*)(ws + O_VT), 256, 2048, 256}; pg8::AttnSched<1> S; S.init();
              EpiO E{(const float*)(ws + O_PSUM), (bf16_t*)(ws + O_YMIX)}; pg8::gemm_phase(lds, g, S, E); }
            if (!sattn_first) phase_sattn(p, lds);
        } }
    XB_SYNC();
    { { pg8::Gemm g{(const bf16_t*)(ws + O_YMIX), (const bf16_t*)(ws + O_WO), 1024, 1024, 1024}; pg8::GridSched S; S.init(64, 4, 0, 1024, 1024);
            EpiRes E{nullptr, (bf16_t*)(ws + O_XB), (float*)(ws + O_RS4), 1.f}; pg8::gemm_phase(lds, g, S, E);
            SRes E2{nullptr, (bf16_t*)(ws + O_XB), (float*)(ws + O_RS4), 1.f, 0};
            small_gemm<4>(lds, (const bf16_t*)(ws + O_YMIX), 1024, (const bf16_t*)(ws + O_WO), 1024, 1024, NTOK, 4, 16, E2); } }
    XB_SYNC();
    { { pg8::Gemm g{(const bf16_t*)(ws + O_XB), (const bf16_t*)(ws + O_WGU2), 1024, 1024, 1024}; pg8::GridSched S; S.init(MT, 22, 0, 1024, 1024);
            EpiSwiglu E{(const float*)(ws + O_RS4), (bf16_t*)(ws + O_H)}; pg8::gemm_phase(lds, g, S, E); } }
    XB_SYNC();
    { { pg8::Gemm g{(const bf16_t*)(ws + O_H), (const bf16_t*)(ws + O_WD2), DFF, DFF, DFF}; pg8::GridSched S; S.init(64, 4, 0, DFF, DFF);
            EpiRes E{nullptr, (bf16_t*)(ws + O_XB), (float*)(ws + O_RS5), 0.5f}; pg8::gemm_phase(lds, g, S, E);
            SRes E2{nullptr, (bf16_t*)(ws + O_XB), (float*)(ws + O_RS5), 0.5f, 0};
            small_gemm<4>(lds, (const bf16_t*)(ws + O_H), DFF, (const bf16_t*)(ws + O_WD2), DFF, DFF, NTOK, 4, 16, E2); } }
    XB_SYNC();
    { phase_final(p); }
#undef XB_SYNC
}

constexpr size_t LDS_BYTES = pg8::STAGE_BYTES + 4096;

extern "C" void kernel_launch(void* const* d_in, const int* in_sizes, int n_in, void* d_out, int out_size, void* d_ws, size_t ws_size, hipStream_t stream) {
    static int grid_blocks = 0;
    if (!grid_blocks) {
        int dev = 0, cus = 0, per_cu = 0;
        hipGetDevice(&dev);
        hipDeviceGetAttribute(&cus, hipDeviceAttributeMultiprocessorCount, dev);
        hipFuncSetAttribute((const void*)mega, hipFuncAttributeMaxDynamicSharedMemorySize, (int)LDS_BYTES);
        hipOccupancyMaxActiveBlocksPerMultiprocessor(&per_cu, mega, 512, LDS_BYTES);
        if (per_cu < 1) { fprintf(stderr, "occupancy query returned %d\n", per_cu); per_cu = 1; }
        grid_blocks = cus * (per_cu > 1 ? 1 : per_cu);
        if (ws_size < WS_NEED) fprintf(stderr, "workspace too small: %zu < %zu\n", ws_size, (size_t)WS_NEED);
    }
    Params p{};
    for (int i = 0; i < 40; ++i) p.in[i] = (const float*)d_in[i];
    p.out = (float*)d_out; p.ws = (unsigned char*)d_ws;
    hipMemsetAsync((unsigned char*)d_ws + O_BAR, 0, XCD_BAR_WORDS * 4, stream);
    hipLaunchKernelGGL(mega, dim3(grid_blocks), dim3(512), LDS_BYTES, stream, p);
}
```

```cpp
#include <hip/hip_runtime.h>
#include <hip/hip_cooperative_groups.h>
#include <cstdio>
namespace cg = cooperative_groups;

#ifndef PHMASK
#define PHMASK 0xffff
#endif
#ifndef DUPMASK
#define DUPMASK 0
#endif
#ifndef ONE_LAUNCH
#define ONE_LAUNCH 1
#endif

#define LAS __attribute__((address_space(3)))
#define DEV __device__ __forceinline__
typedef unsigned short bf16_t;
typedef short bf16x8 __attribute__((ext_vector_type(8)));
typedef float f32x4 __attribute__((ext_vector_type(4)));
typedef unsigned u32x2 __attribute__((ext_vector_type(2)));
typedef unsigned u32x4 __attribute__((ext_vector_type(4)));

constexpr int DM = 1024, NTOK = 16384, NSMP = 128, MV = NTOK + NSMP, MP = 16640, SEQ = 2048;
constexpr int DFF = 2816, ZLD = 2848, BPROJ = 1824, NMEMR = 2048;
constexpr int NPH = 16;

constexpr size_t al256(size_t x) { return (x + 255) & ~(size_t)255; }
constexpr size_t O_WGU1 = 0;
constexpr size_t O_WD1 = O_WGU1 + al256((size_t)5632 * 1024 * 2);
constexpr size_t O_WIN = O_WD1 + al256((size_t)1024 * 2816 * 2);
constexpr size_t O_WOUT = O_WIN + al256((size_t)3072 * 1024 * 2);
constexpr size_t O_WQ = O_WOUT + 2097152, O_WK = O_WQ + 2097152, O_WV = O_WK + 2097152, O_WO = O_WV + 2097152;
constexpr size_t O_WGU2 = O_WO + 2097152;
constexpr size_t O_WD2 = O_WGU2 + al256((size_t)5632 * 1024 * 2);
constexpr size_t O_WLORA = O_WD2 + al256((size_t)1024 * 2816 * 2);
constexpr size_t O_MNB = O_WLORA + al256((size_t)1536 * 384 * 2);
constexpr size_t O_MKB = O_MNB + 4194304, O_VT = O_MKB + 4194304;
constexpr size_t O_RSTDM = O_VT + 4194304;
constexpr size_t RS_BYTES = (size_t)MP * 64;
constexpr size_t O_RS1 = O_RSTDM + 8192, O_RS2 = O_RS1 + RS_BYTES, O_RS3 = O_RS2 + RS_BYTES, O_RS4 = O_RS3 + RS_BYTES, O_RS5 = O_RS4 + RS_BYTES;
constexpr size_t O_PSUM = O_RS5 + RS_BYTES;
constexpr size_t HALFROW = (size_t)MP * 512 * 4;
constexpr size_t O_XB = O_PSUM + 1048576;
constexpr size_t O_XRES = O_XB + HALFROW;
constexpr size_t O_H = O_XRES + 2 * HALFROW;
constexpr size_t O_Z = O_H + al256((size_t)MP * DFF * 2);
constexpr size_t O_YMIX = O_Z + al256((size_t)MP * ZLD * 2);
constexpr size_t O_VAB = O_YMIX + HALFROW;
constexpr size_t O_LIN = O_VAB + HALFROW / 2;
constexpr size_t O_KK = O_LIN + al256((size_t)MP * 384 * 2);
constexpr size_t O_DEC = O_KK + HALFROW, O_KKA = O_DEC + HALFROW;
constexpr size_t O_BAR = O_KKA + HALFROW;
constexpr size_t WS_NEED = O_BAR + 16384;

constexpr size_t OUT_Y = 0, OUT_SP = (size_t)MV * 1024, OUT_SHP = OUT_SP + 262144, OUT_MK = OUT_SHP + 8 * 1824, OUT_MV = OUT_MK + 2097152,
                 OUT_SS = OUT_MV + 2097152, OUT_SHS = OUT_SS + 4194304, OUT_CV = OUT_SHS + 128 * 1824;

enum { I_XP = 0, I_XS, I_SRWKV, I_SSHIFT, I_CK, I_CV, I_MEM, I_LN1, I_G1, I_U1, I_D1, I_LNMIX, I_WIN, I_WOUT, I_SGUW, I_SGUB, I_SLNG, I_SLNB,
       I_MU, I_W0, I_W2, I_A0, I_A2, I_G2, I_KK, I_KA, I_RK, I_GNG, I_GNB, I_LNX, I_MEMN, I_XQ, I_XK, I_XV, I_XO, I_LN2, I_G2F, I_U2F, I_D2F, I_FIN };

struct Params { const float* in[40]; float* out; unsigned char* ws; };

DEV unsigned cvt_pk_bf16(float lo, float hi) { unsigned r; asm volatile("v_cvt_pk_bf16_f32 %0, %1, %2" : "=v"(r) : "v"(lo), "v"(hi)); return r; }
DEV float bf_lo(unsigned u) { return __uint_as_float(u << 16); }
DEV float bf_hi(unsigned u) { return __uint_as_float(u & 0xffff0000u); }
DEV f32x4 bf4(u32x2 u) { return (f32x4){__uint_as_float(u[0] << 16), __uint_as_float(u[0] & 0xffff0000u), __uint_as_float(u[1] << 16), __uint_as_float(u[1] & 0xffff0000u)}; }
DEV u32x2 pk4(f32x4 v) { u32x2 o; o[0] = cvt_pk_bf16(v[0], v[1]); o[1] = cvt_pk_bf16(v[2], v[3]); return o; }
DEV float bf2f(bf16_t b) { return __uint_as_float((unsigned)b << 16); }
DEV float sigmoidf_(float x) { return __builtin_amdgcn_rcpf(1.f + __expf(-x)); }
DEV float tanhf_(float y) { return 1.f - 2.f * __builtin_amdgcn_rcpf(1.f + __expf(2.f * y)); }
DEV float gelu_t(float x) { return 0.5f * x * (1.f + tanhf_(0.7978845608028654f * (x + 0.044715f * x * x * x))); }
DEV float wsum64(float v) {
#pragma unroll
    for (int o = 32; o >= 1; o >>= 1) v += __shfl_xor(v, o);
    return v;
}
DEV float wmax64(float v) {
#pragma unroll
    for (int o = 32; o >= 1; o >>= 1) v = fmaxf(v, __shfl_xor(v, o));
    return v;
}
template <int CTRL> DEV float dpp_f(float x) { return __builtin_bit_cast(float, __builtin_amdgcn_update_dpp(0, __builtin_bit_cast(int, x), CTRL, 0xf, 0xf, false)); }
DEV float rowsum16(float x) {
    x += dpp_f<0x128>(x); x += dpp_f<0x124>(x); x += dpp_f<0x122>(x); x += dpp_f<0x121>(x); return x;
}
DEV int fresh_tid() { int t = threadIdx.x; asm volatile("" : "+v"(t)); return t; }
DEV float rstd_of(const float* rs, int r) { const f32x4* q = (const f32x4*)(rs + (size_t)r * 16); const f32x4 p = (q[0] + q[1]) + (q[2] + q[3]); return rsqrtf(((p[0] + p[1]) + (p[2] + p[3])) * (1.f / 1024.f) + 1e-6f); }

#define XB_TMO      128
#define XB_XCNT(j)  (256  + 64 * (j))
#define XB_XSUB(j)  (1280 + 64 * (j))
#define XB_XGEN(j)  (2304 + 64 * (j))
#define XB_TOP      3328
#define XB_TOPGEN   3392
#define XCD_BAR_WORDS 3456
#define XB_SPIN_CAP (1u << 18)
DEV unsigned xb_ld(unsigned* p)              { return __hip_atomic_load(p, __ATOMIC_RELAXED, __HIP_MEMORY_SCOPE_AGENT); }
DEV unsigned xb_add(unsigned* p, unsigned v) { return __hip_atomic_fetch_add(p, v, __ATOMIC_RELAXED, __HIP_MEMORY_SCOPE_AGENT); }
DEV unsigned xb_xcc_id() { return (unsigned)__builtin_amdgcn_s_getreg((3 << 11) | 20) & 0xFu; }
#define XB_SPIN(cond, bar) do { unsigned _sp = 0; while (cond) { __builtin_amdgcn_s_sleep(1); \
    if ((++_sp & 255u) == 0u) { if (xb_ld(&(bar)[XB_TMO])) break; if (_sp > XB_SPIN_CAP) { atomicAdd(&(bar)[XB_TMO], 1u); break; } } } } while (0)
struct XcdBarrier { unsigned* bar; unsigned x; volatile LAS unsigned* st; };
DEV XcdBarrier xcd_barrier_post(unsigned* bar, volatile LAS unsigned* st) {
    XcdBarrier b; b.bar = bar; b.x = xb_xcc_id(); b.st = st;
    if (threadIdx.x == 0) (void)xb_add(&bar[XB_XCNT(b.x)], 1u);
    return b;
}
DEV void xcd_barrier_complete(unsigned* bar, unsigned x, unsigned& nloc, unsigned& nx) {
    const unsigned G = gridDim.x * gridDim.y * gridDim.z;
    unsigned sum, cnt, mine, sp = 0u;
    for (;;) {
        sum = 0u; cnt = 0u; mine = 0u;
#pragma unroll
        for (unsigned j = 0; j < 16; ++j) { const unsigned c = xb_ld(&bar[XB_XCNT(j)]); sum += c; cnt += (c > 0u) ? 1u : 0u; mine = (j == x) ? c : mine; }
        if (sum == G) break;
        __builtin_amdgcn_s_sleep(1);
        if ((++sp & 255u) == 0u) { if (xb_ld(&bar[XB_TMO])) break; if (sp > XB_SPIN_CAP) { atomicAdd(&bar[XB_TMO], 1u); break; } }
    }
    nloc = mine > 0u ? mine : 1u; nx = cnt > 0u ? cnt : 1u;
}
DEV void xcd_barrier(const XcdBarrier& b) {
    asm volatile("s_waitcnt vmcnt(0)" ::: "memory");
    __syncthreads();
    if (threadIdx.x == 0) {
        unsigned* bar = b.bar;
        __builtin_amdgcn_s_waitcnt(0);
        unsigned nloc = b.st[0], nx = b.st[1];
        if (nloc == 0u) { xcd_barrier_complete(bar, b.x, nloc, nx); b.st[0] = nloc; b.st[1] = nx; }
        const unsigned old = xb_add(&bar[XB_XSUB(b.x)], 1u);
        const unsigned gen = old / nloc;
        if (old + 1u == (gen + 1u) * nloc) {
            __builtin_amdgcn_fence(__ATOMIC_RELEASE, "agent");
            asm volatile("s_waitcnt vmcnt(0)" ::: "memory");
            const unsigned og = xb_add(&bar[XB_TOP], 1u);
            const unsigned tg = og / nx;
            if (og + 1u == (tg + 1u) * nx) xb_add(&bar[XB_TOPGEN], 1u);
            else XB_SPIN(xb_ld(&bar[XB_TOPGEN]) == tg, bar);
            __builtin_amdgcn_fence(__ATOMIC_ACQUIRE, "agent");
            xb_add(&bar[XB_XGEN(b.x)], 1u);
            asm volatile("s_waitcnt vmcnt(0)" ::: "memory");
        } else {
            XB_SPIN(xb_ld(&bar[XB_XGEN(b.x)]) == gen, bar);
            __builtin_amdgcn_fence(__ATOMIC_ACQUIRE, "agent");
            asm volatile("s_waitcnt vmcnt(0)" ::: "memory");
        }
    }
    __syncthreads();
}

namespace pg8 {
constexpr int BM = 256, BK = 64, HALF = 128, HTB = HALF * BK * 2, STAGE_BYTES = 8 * HTB, NXCD = 8, WGM = 8;
DEV int lds_byte(int r, int c) { const int st = (r >> 4) * 2 + (c >> 5), rr = r & 15, cc = c & 31, ob = rr * 64 + cc * 2; return st * 1024 + (ob ^ (((ob >> 9) & 1) << 5)); }
DEV void stage_rc(int b, int& R, int& C) { const int st = b / 1024, sb = b % 1024, swz = sb ^ (((sb >> 9) & 1) << 5); R = (st >> 1) * 16 + swz / 64; C = (st & 1) * 32 + (swz % 64) / 2; }

struct Unit { int pm, pn; long ao, bo; int x0, x1; };
struct Gemm { const bf16_t* A; const bf16_t* Bt; int lda, ldb, K; };

struct GridSched {
    int nM, nN, nwg, G, c; long ta, tb;
    DEV void init(int nM_, int nN_, int shift, int lda, int ldb) { nM = nM_; nN = nN_; nwg = nM * nN; G = (int)gridDim.x; c = ((int)blockIdx.x + G - (shift % G)) % G; ta = 256L * lda; tb = 256L * ldb; }
    DEV bool next(int i, Unit& u) const {
        const long L = (long)i * G + c; if (L >= nwg) return false;
        int wgid = (int)L; { const int q = nwg / NXCD, r = nwg % NXCD, xcd = wgid % NXCD, off = wgid / NXCD; wgid = (xcd < r ? xcd * (q + 1) : r * (q + 1) + (xcd - r) * q) + off; }
        const int nig = WGM * nN, gid = wgid / nig, fm = gid * WGM, gsz = (nM - fm) < WGM ? (nM - fm) : WGM;
        u.pm = fm + ((wgid % nig) % gsz); u.pn = (wgid % nig) / gsz; u.ao = u.pm * ta; u.bo = u.pn * tb; u.x0 = 0; u.x1 = 0; return true;
    }
};
struct LoraSched {
    int G, c;
    DEV void init() { G = (int)gridDim.x; c = (int)blockIdx.x; }
    DEV bool next(int i, Unit& u) const {
        const long L = (long)i * G + c; if (L >= 65 * 6) return false;
        const int pn = (int)L % 6, pm = (int)L / 6, off = (pn >= 4) ? 128 : 0;
        u.pm = pm; u.pn = pn; u.x0 = 0; u.x1 = 0; u.ao = (long)pm * 256 * 384 + off; u.bo = (long)pn * 256 * 384 + off; return true;
    }
};
template <int WHICH> struct AttnSched {
    int G, c;
    DEV void init() { G = (int)gridDim.x; c = (int)blockIdx.x; }
    DEV bool next(int i, Unit& u) const {
        const long L = (long)i * G + c; if (L >= 256) return false;
        const int xcd = (int)L & 7, idx = (int)L >> 3, bh = xcd * 4 + (idx >> 3), mt = idx & 7, b = bh >> 2, h = bh & 3;
        u.pm = mt; u.pn = 0; u.x0 = bh; u.x1 = mt;
        if (WHICH == 0) { u.ao = ((long)b * 2048 + mt * 256) * 1024 + h * 256; u.bo = ((long)b * 256) * 1024 + h * 256; }
        else { u.ao = ((long)bh * 2048 + mt * 256) * 256; u.bo = ((long)h * 256) * 2048 + b * 256; }
        return true;
    }
};

template <class Epi, class Sched>
DEV void gemm_phase(LAS unsigned char* lds, const Gemm g, const Sched& S, const Epi& E) {
    int tid_ = threadIdx.x; asm volatile("" : "+v"(tid_));
    const int tid = tid_, wid = __builtin_amdgcn_readfirstlane(tid >> 6), lane = tid & 63, wr = wid >> 2, wc = wid & 3, fr = lane & 15, fq = lane >> 4;
    int K = g.K, lda_ = g.lda, ldb_ = g.ldb; asm volatile("" : "+s"(K), "+s"(lda_), "+s"(ldb_)); const int nt = K / BK;
    unsigned voffA[2], voffB[2];
#pragma unroll
    for (int i = 0; i < 2; ++i) { int R, C; stage_rc(tid * 16 + i * 8192, R, C); voffA[i] = (unsigned)(R * lda_ + C) * 2u; voffB[i] = (unsigned)(R * ldb_ + C) * 2u; }
    const size_t kstep = (size_t)(BK * 2);
    const size_t hstepA = (size_t)HALF * lda_ * 2, hstepB = (size_t)HALF * ldb_ * 2;
    const unsigned ldsw = (unsigned)wid * 1024u;
    const int aoff = lds_byte(wr * 64 + fr, fq * 8), boff = lds_byte(wc * 32 + fr, fq * 8);
#define PG8_SA(b, h) (((b) * 2 + (h)) * HTB)
#define PG8_SB(b, h) ((4 + (b) * 2 + (h)) * HTB)
#define PG8_STAGE(bufoff, gbase, voff) do { _Pragma("unroll") for (int _i = 0; _i < 2; ++_i) \
        __builtin_amdgcn_global_load_lds((const unsigned*)((const char*)(gbase) + (voff)[_i]), (LAS unsigned*)(lds + (bufoff) + ldsw + _i * 8192), 16, 0, 0); } while (0)
#define PG8_LDA(dst, b, h) do { _Pragma("unroll") for (int m = 0; m < 4; ++m) _Pragma("unroll") for (int k = 0; k < 2; ++k) dst[m][k] = *(const LAS bf16x8*)(lds + PG8_SA(b, h) + aoff + m * 2048 + k * 1024); } while (0)
#define PG8_LDB(dst, b, h) do { _Pragma("unroll") for (int n = 0; n < 2; ++n) _Pragma("unroll") for (int k = 0; k < 2; ++k) dst[n][k] = *(const LAS bf16x8*)(lds + PG8_SB(b, h) + boff + n * 2048 + k * 1024); } while (0)
#define PG8_MMA(ai, bj, At, Bt) do { __builtin_amdgcn_s_setprio(1); _Pragma("unroll") for (int m = 0; m < 4; ++m) _Pragma("unroll") for (int n = 0; n < 2; ++n) _Pragma("unroll") for (int k = 0; k < 2; ++k) \
        acc[ai][bj][m][n] = __builtin_amdgcn_mfma_f32_16x16x32_bf16(Bt[n][k], At[m][k], acc[ai][bj][m][n], 0, 0, 0); __builtin_amdgcn_s_setprio(0); } while (0)
#define PG8_WAIT_V(n) asm volatile("s_waitcnt vmcnt(" #n ")" ::: "memory")
#define PG8_WAIT_L(n) asm volatile("s_waitcnt lgkmcnt(" #n ")" ::: "memory")
#define PG8_BAR __builtin_amdgcn_s_barrier()
#define PG8_SCHED __builtin_amdgcn_sched_barrier(0)
    Unit cur, nxt; int ui = 0;
    if (!S.next(0, cur)) return;
    f32x4 acc[2][2][4][2];
#pragma unroll
    for (int a = 0; a < 2; ++a)
#pragma unroll
        for (int b = 0; b < 2; ++b)
#pragma unroll
            for (int m = 0; m < 4; ++m)
#pragma unroll
                for (int n = 0; n < 2; ++n) acc[a][b][m][n] = (f32x4){0.f, 0.f, 0.f, 0.f};
    bf16x8 At[4][2], B0[2][2], B1[2][2];
    const char* cA = (const char*)g.A + (size_t)cur.ao * 2; const char* cB = (const char*)g.Bt + (size_t)cur.bo * 2;
    PG8_STAGE(PG8_SB(0, 0), cB, voffB); PG8_STAGE(PG8_SA(0, 0), cA, voffA); PG8_STAGE(PG8_SB(0, 1), cB + hstepB, voffB); PG8_STAGE(PG8_SA(0, 1), cA + hstepA, voffA);
    if (wr == 1) PG8_BAR;
    PG8_WAIT_V(4); PG8_BAR;
    PG8_STAGE(PG8_SB(1, 0), cB + kstep, voffB); PG8_STAGE(PG8_SA(1, 0), cA + kstep, voffA); PG8_STAGE(PG8_SB(1, 1), cB + hstepB + kstep, voffB);
    PG8_WAIT_V(6); PG8_BAR;
    for (;;) {
        const bool has_next = S.next(ui + 1, nxt);
        const char* nA = has_next ? (const char*)g.A + (size_t)nxt.ao * 2 : cA; const char* nB = has_next ? (const char*)g.Bt + (size_t)nxt.bo * 2 : cB;
#pragma unroll 1
        for (int t = 0; t < nt; t += 2) {
            const bool last = (t == nt - 2);
            const char* a1 = cA + (size_t)(t + 1) * kstep;
            const char* a2 = last ? nA : cA + (size_t)(t + 2) * kstep; const char* b2 = last ? nB : cB + (size_t)(t + 2) * kstep;
            const char* a3 = a2 + kstep; const char* b3 = b2 + kstep;
            PG8_LDB(B0, 0, 0); PG8_SCHED; PG8_LDA(At, 0, 0); PG8_STAGE(PG8_SA(1, 1), a1 + hstepA, voffA);
            PG8_WAIT_L(8); PG8_BAR; PG8_WAIT_L(0); PG8_MMA(0, 0, At, B0); PG8_BAR; PG8_SCHED;
            PG8_LDB(B1, 0, 1); PG8_STAGE(PG8_SB(0, 0), b2, voffB);
            PG8_BAR; PG8_WAIT_L(0); PG8_MMA(0, 1, At, B1); PG8_BAR;
            PG8_LDA(At, 0, 1); PG8_STAGE(PG8_SA(0, 0), a2, voffA);
            PG8_BAR; PG8_WAIT_L(0); PG8_MMA(1, 0, At, B0); PG8_BAR; PG8_SCHED;
            PG8_STAGE(PG8_SB(0, 1), b2 + hstepB, voffB);
            PG8_WAIT_V(6); PG8_BAR; PG8_MMA(1, 1, At, B1); PG8_BAR;
            PG8_LDB(B0, 1, 0); PG8_SCHED; PG8_LDA(At, 1, 0); PG8_STAGE(PG8_SA(0, 1), a2 + hstepA, voffA);
            PG8_WAIT_L(8); PG8_BAR; PG8_WAIT_L(0); PG8_MMA(0, 0, At, B0); PG8_BAR; PG8_SCHED;
            PG8_LDB(B1, 1, 1); PG8_STAGE(PG8_SB(1, 0), b3, voffB);
            PG8_BAR; PG8_WAIT_L(0); PG8_MMA(0, 1, At, B1); PG8_BAR;
            PG8_LDA(At, 1, 1); PG8_STAGE(PG8_SA(1, 0), a3, voffA);
            PG8_BAR; PG8_WAIT_L(0); PG8_MMA(1, 0, At, B0); PG8_BAR; PG8_SCHED;
            PG8_STAGE(PG8_SB(1, 1), b3 + hstepB, voffB);
            PG8_WAIT_V(6); PG8_BAR; PG8_MMA(1, 1, At, B1); PG8_BAR;
        }
        E(acc, cur, wr, wc, fr, fq);
        if (!has_next) break;
#pragma unroll
        for (int a = 0; a < 2; ++a)
#pragma unroll
            for (int b = 0; b < 2; ++b)
#pragma unroll
                for (int m = 0; m < 4; ++m)
#pragma unroll
                    for (int n = 0; n < 2; ++n) acc[a][b][m][n] = (f32x4){0.f, 0.f, 0.f, 0.f};
        cur = nxt; cA = nA; cB = nB; ++ui;
    }
    PG8_WAIT_V(0);
    if (wr == 0) PG8_BAR;
    PG8_BAR;
#undef PG8_SA
#undef PG8_SB
#undef PG8_STAGE
#undef PG8_LDA
#undef PG8_LDB
#undef PG8_MMA
#undef PG8_WAIT_V
#undef PG8_WAIT_L
#undef PG8_BAR
#undef PG8_SCHED
}
}
using pg8::Unit;

typedef const f32x4 (&AccRef)[2][2][4][2];

struct EpiSwiglu {
    const float* rs; bf16_t* H;
    DEV void operator()(AccRef acc, const Unit& u, int wr, int wc, int fr, int fq) const {
        const int row0 = u.pm * 256 + wr * 64 + fr, hc0 = u.pn * 128 + wc * 16 + 4 * fq;
#pragma unroll
        for (int ai = 0; ai < 2; ++ai)
#pragma unroll
            for (int m = 0; m < 4; ++m) {
                const int r = row0 + ai * 128 + m * 16; const float rstd = rstd_of(rs, r);
#pragma unroll
                for (int bj = 0; bj < 2; ++bj) {
                    float hv[4];
#pragma unroll
                    for (int i = 0; i < 4; ++i) { const float gt = acc[ai][bj][m][0][i] * rstd, up = acc[ai][bj][m][1][i] * rstd; hv[i] = gt * sigmoidf_(gt) * up; }
                    u32x2 o; o[0] = cvt_pk_bf16(hv[0], hv[1]); o[1] = cvt_pk_bf16(hv[2], hv[3]);
                    *(u32x2*)(H + (size_t)r * DFF + hc0 + bj * 64) = o;
                }
            }
    }
};

struct EpiRes {
    const float* res; bf16_t* xb; float* rs_out; float alpha;
    DEV void operator()(AccRef acc, const Unit& u, int wr, int wc, int fr, int fq) const {
        const int row0 = u.pm * 256 + wr * 64 + fr, col0 = u.pn * 256 + wc * 32 + 4 * fq;
#pragma unroll
        for (int ai = 0; ai < 2; ++ai)
#pragma unroll
            for (int mh = 0; mh < 2; ++mh) {
                f32x4 x[2][2][2];
#pragma unroll
                for (int m2 = 0; m2 < 2; ++m2)
#pragma unroll
                    for (int bj = 0; bj < 2; ++bj)
#pragma unroll
                        for (int n = 0; n < 2; ++n) { const size_t o = (size_t)(row0 + ai * 128 + (mh * 2 + m2) * 16) * 1024 + col0 + bj * 128 + n * 16;
                            x[m2][bj][n] = res ? *(const f32x4*)(res + o) : bf4(*(const u32x2*)(xb + o)); }
#pragma unroll
                for (int m2 = 0; m2 < 2; ++m2) {
                    const int m = mh * 2 + m2, r = row0 + ai * 128 + m * 16; float s = 0.f;
#pragma unroll
                    for (int bj = 0; bj < 2; ++bj)
#pragma unroll
                        for (int n = 0; n < 2; ++n) {
                            const int c = col0 + bj * 128 + n * 16; const f32x4 v = x[m2][bj][n] + alpha * acc[ai][bj][m][n];
                            *(u32x2*)(xb + (size_t)r * 1024 + c) = pk4(v);
                            s += v[0] * v[0] + v[1] * v[1] + v[2] * v[2] + v[3] * v[3];
                        }
                    s += __shfl_xor(s, 16); s += __shfl_xor(s, 32);
                    if (fq == 0) rs_out[(size_t)r * 16 + u.pn * 4 + wc] = s;
                }
            }
    }
};

struct EpiScale {
    const float* rs; bf16_t* O; int ldo, ncols;
    DEV void operator()(AccRef acc, const Unit& u, int wr, int wc, int fr, int fq) const {
        const int row0 = u.pm * 256 + wr * 64 + fr, col0 = u.pn * 256 + wc * 32 + 4 * fq;
#pragma unroll
        for (int ai = 0; ai < 2; ++ai)
#pragma unroll
            for (int m = 0; m < 4; ++m) {
                const int r = row0 + ai * 128 + m * 16; const float rstd = rstd_of(rs, r);
#pragma unroll
                for (int bj = 0; bj < 2; ++bj)
#pragma unroll
                    for (int n = 0; n < 2; ++n) {
                        const int c = col0 + bj * 128 + n * 16;
                        if (c < ncols) { const f32x4 v = acc[ai][bj][m][n] * rstd; u32x2 o; o[0] = cvt_pk_bf16(v[0], v[1]); o[1] = cvt_pk_bf16(v[2], v[3]); *(u32x2*)(O + (size_t)r * ldo + c) = o; }
                    }
            }
    }
};

struct EpiLora {
    const float* w0; const float* a0; const float* k_a; float* dec; bf16_t* kbuf; const bf16_t* kkbuf; bf16_t* kka; bf16_t* gb;
    template <int REGION> DEV void run(AccRef acc, const Unit& u, int wr, int wc, int fr, int fq) const {
        const int row0 = u.pm * 256 + wr * 64 + fr, cb = (u.pn & 1) * 256 + wc * 32 + 4 * fq;
#pragma unroll
        for (int ai = 0; ai < 2; ++ai)
#pragma unroll
            for (int m = 0; m < 4; ++m) {
                const int r = row0 + ai * 128 + m * 16;
                {
#pragma unroll
                    for (int bj = 0; bj < 2; ++bj)
#pragma unroll
                        for (int n = 0; n < 2; ++n) {
                            const int cc = cb + bj * 128 + n * 16; const f32x4 a = acc[ai][bj][m][n]; const size_t o = (size_t)r * 512 + cc;
                            if (REGION == 0) {
                                const f32x4 b0 = *(const f32x4*)(w0 + cc); f32x4 d;
#pragma unroll
                                for (int i = 0; i < 4; ++i) d[i] = __expf(-0.60653066f * sigmoidf_(b0[i] + a[i]));
                                *(f32x4*)(dec + o) = d;
                            } else if (REGION == 1) {
                                const f32x4 b0 = *(const f32x4*)(a0 + cc), ka = *(const f32x4*)(k_a + cc), kv = bf4(*(const u32x2*)(kbuf + o)), kkv = bf4(*(const u32x2*)(kkbuf + o)); f32x4 kn, kkan;
#pragma unroll
                                for (int i = 0; i < 4; ++i) { const float av = sigmoidf_(b0[i] + a[i]); kn[i] = kv[i] * (1.f + (av - 1.f) * ka[i]); kkan[i] = kkv[i] * av; }
                                *(u32x2*)(kbuf + o) = pk4(kn); *(u32x2*)(kka + o) = pk4(kkan);
                            } else {
                                u32x2 ov; ov[0] = cvt_pk_bf16(a[0], a[1]); ov[1] = cvt_pk_bf16(a[2], a[3]); *(u32x2*)(gb + o) = ov;
                            }
                        }
                }
            }
    }
    DEV void operator()(AccRef acc, const Unit& u, int wr, int wc, int fr, int fq) const {
        const int region = u.pn >> 1;
        if (region == 0) run<0>(acc, u, wr, wc, fr, fq); else if (region == 1) run<1>(acc, u, wr, wc, fr, fq); else run<2>(acc, u, wr, wc, fr, fq);
    }
};

struct EpiK {
    const float* rstdm; float* outk; bf16_t* mkb;
    DEV void operator()(AccRef acc, const Unit& u, int wr, int wc, int fr, int fq) const {
        const int row0 = u.pm * 256 + wr * 64 + fr, col0 = u.pn * 256 + wc * 32 + 4 * fq;
#pragma unroll
        for (int ai = 0; ai < 2; ++ai)
#pragma unroll
            for (int m = 0; m < 4; ++m) {
                const int r = row0 + ai * 128 + m * 16; const float rstd = rstdm[r];
#pragma unroll
                for (int bj = 0; bj < 2; ++bj)
#pragma unroll
                    for (int n = 0; n < 2; ++n) {
                        const int c = col0 + bj * 128 + n * 16; const f32x4 v = acc[ai][bj][m][n] * rstd;
                        *(f32x4*)(outk + (size_t)r * 1024 + c) = v;
                        u32x2 o; o[0] = cvt_pk_bf16(v[0], v[1]); o[1] = cvt_pk_bf16(v[2], v[3]); *(u32x2*)(mkb + (size_t)r * 1024 + c) = o;
                    }
            }
    }
};
struct EpiVT {
    const float* rstdm; float* outv; bf16_t* vt;
    DEV void operator()(AccRef acc, const Unit& u, int wr, int wc, int fr, int fq) const {
        const int row0 = u.pm * 256 + wr * 64 + fr, col0 = u.pn * 256 + wc * 32 + 4 * fq;
#pragma unroll
        for (int bj = 0; bj < 2; ++bj)
#pragma unroll
            for (int n = 0; n < 2; ++n) {
                const int c = col0 + bj * 128 + n * 16; const f32x4 rsd = *(const f32x4*)(rstdm + c);
#pragma unroll
                for (int ai = 0; ai < 2; ++ai)
#pragma unroll
                    for (int m = 0; m < 4; ++m) {
                        const int r = row0 + ai * 128 + m * 16; const f32x4 v = acc[ai][bj][m][n] * rsd;
                        u32x2 o; o[0] = cvt_pk_bf16(v[0], v[1]); o[1] = cvt_pk_bf16(v[2], v[3]); *(u32x2*)(vt + (size_t)r * 2048 + c) = o;
#pragma unroll
                        for (int i = 0; i < 4; ++i) outv[(size_t)(c + i) * 1024 + r] = v[i];
                    }
            }
    }
};
struct EpiS {
    bf16_t* P; float* psum;
    DEV void operator()(AccRef acc, const Unit& u, int wr, int wc, int fr, int fq) const {
        const size_t prow0 = (size_t)u.x0 * 2048 + u.x1 * 256;
#pragma unroll
        for (int ai = 0; ai < 2; ++ai)
#pragma unroll
            for (int m = 0; m < 4; ++m) {
                const int rl = ai * 128 + wr * 64 + m * 16 + fr; float s = 0.f;
#pragma unroll
                for (int bj = 0; bj < 2; ++bj)
#pragma unroll
                    for (int n = 0; n < 2; ++n) {
                        const f32x4 a = acc[ai][bj][m][n]; u32x2 o;
                        o[0] = cvt_pk_bf16(__expf(a[0]), __expf(a[1])); o[1] = cvt_pk_bf16(__expf(a[2]), __expf(a[3]));
                        s += bf_lo(o[0]) + bf_hi(o[0]) + bf_lo(o[1]) + bf_hi(o[1]);
                        *(u32x2*)(P + (prow0 + rl) * 256 + bj * 128 + wc * 32 + n * 16 + 4 * fq) = o;
                    }
                s += __shfl_xor(s, 16); s += __shfl_xor(s, 32);
                if (fq == 0) psum[(prow0 + rl) * 4 + wc] = s;
            }
    }
};
struct EpiO {
    const float* psum; bf16_t* O;
    DEV void operator()(AccRef acc, const Unit& u, int wr, int wc, int fr, int fq) const {
        const int bh = u.x0, b = bh >> 2, h = bh & 3; const size_t prow0 = (size_t)bh * 2048 + u.x1 * 256; const size_t m0 = (size_t)b * 2048 + u.x1 * 256;
#pragma unroll
        for (int ai = 0; ai < 2; ++ai)
#pragma unroll
            for (int m = 0; m < 4; ++m) {
                const int rl = ai * 128 + wr * 64 + m * 16 + fr; const f32x4 p = *(const f32x4*)(psum + (prow0 + rl) * 4); const float inv = __builtin_amdgcn_rcpf(p[0] + p[1] + p[2] + p[3]);
#pragma unroll
                for (int bj = 0; bj < 2; ++bj)
#pragma unroll
                    for (int n = 0; n < 2; ++n) {
                        const f32x4 v = acc[ai][bj][m][n] * inv; u32x2 o; o[0] = cvt_pk_bf16(v[0], v[1]); o[1] = cvt_pk_bf16(v[2], v[3]);
                        *(u32x2*)(O + (m0 + rl) * 1024 + h * 256 + bj * 128 + wc * 32 + n * 16 + 4 * fq) = o;
                    }
            }
    }
};

struct SRes {
    const float* res; bf16_t* xb; float* rs_out; float alpha; int res_row0;
    DEV void operator()(int r, int c, f32x4 a, int slab, int l15) const {
        const f32x4 x0 = res ? *(const f32x4*)(res + (size_t)(r - res_row0) * 1024 + c) : bf4(*(const u32x2*)(xb + (size_t)r * 1024 + c));
        const f32x4 x = x0 + alpha * a;
        *(u32x2*)(xb + (size_t)r * 1024 + c) = pk4(x);
        const float s = rowsum16(x[0] * x[0] + x[1] * x[1] + x[2] * x[2] + x[3] * x[3]);
        if (l15 == 0) rs_out[(size_t)r * 16 + slab] = s;
    }
};
struct SScale {
    const float* rs; bf16_t* O; int ldo, ncols, col_off;
    DEV void operator()(int r, int c, f32x4 a, int, int) const {
        const int cc = c + col_off;
        if (cc < ncols) { const f32x4 v = a * rstd_of(rs, r); u32x2 o; o[0] = cvt_pk_bf16(v[0], v[1]); o[1] = cvt_pk_bf16(v[2], v[3]); *(u32x2*)(O + (size_t)r * ldo + cc) = o; }
    }
};
template <int NB, class Epi>
DEV void small_gemm(LAS unsigned char* lds, const bf16_t* A, int lda, const bf16_t* Bt, int ldb, int K, int row_base, int nrg, int nslab, const Epi& E) {
    const int tid = fresh_tid(), lane = tid & 63, w = tid >> 6, l15 = lane & 15, kg = lane >> 4;
    LAS float* red = (LAS float*)lds;
    const int kw = K >> 3;
    for (int item = blockIdx.x; item < nrg * nslab; item += gridDim.x) {
        const int rgi = item % nrg, slab = item / nrg, r0 = row_base + rgi * 32, c0 = slab * 64;
        f32x4 acc[2][4];
#pragma unroll
        for (int rb = 0; rb < 2; ++rb)
#pragma unroll
            for (int n = 0; n < 4; ++n) acc[rb][n] = (f32x4){0.f, 0.f, 0.f, 0.f};
        const bf16_t* ap = A + (size_t)(r0 + l15) * lda + w * kw + kg * 8;
        const bf16_t* bp = Bt + (size_t)(c0 + l15) * ldb + w * kw + kg * 8;
#pragma unroll 4
        for (int k = 0; k < kw; k += 32) {
            const bf16x8 a0 = *(const bf16x8*)(ap + k), a1 = *(const bf16x8*)(ap + (size_t)16 * lda + k);
            bf16x8 b[NB];
#pragma unroll
            for (int n = 0; n < NB; ++n) b[n] = *(const bf16x8*)(bp + (size_t)(n * 16) * ldb + k);
#pragma unroll
            for (int n = 0; n < NB; ++n) { acc[0][n] = __builtin_amdgcn_mfma_f32_16x16x32_bf16(b[n], a0, acc[0][n], 0, 0, 0); acc[1][n] = __builtin_amdgcn_mfma_f32_16x16x32_bf16(b[n], a1, acc[1][n], 0, 0, 0); }
        }
        __syncthreads();
#pragma unroll
        for (int rb = 0; rb < 2; ++rb)
#pragma unroll
            for (int n = 0; n < 4; ++n) *(LAS f32x4*)(red + ((w * 32 + rb * 16 + l15) * 64 + n * 16 + 4 * kg)) = acc[rb][n];
        __syncthreads();
        const int row = tid >> 4, c4 = (tid & 15) * 4; f32x4 sum = (f32x4){0.f, 0.f, 0.f, 0.f};
#pragma unroll
        for (int ww = 0; ww < 8; ++ww) sum = sum + *(const LAS f32x4*)(red + ((ww * 32 + row) * 64 + c4));
        E(r0 + row, c0 + c4, sum, slab, tid & 15);
    }
}

DEV void ld8bf(const bf16_t* p, float (&v)[8]) { const u32x4 u = *(const u32x4*)p;
#pragma unroll
    for (int i = 0; i < 4; ++i) { v[2 * i] = bf_lo(u[i]); v[2 * i + 1] = bf_hi(u[i]); } }
DEV void ld8f(const float* p, float (&v)[8]) { const f32x4 a = *(const f32x4*)p, b = *(const f32x4*)(p + 4);
#pragma unroll
    for (int i = 0; i < 4; ++i) { v[i] = a[i]; v[4 + i] = b[i]; } }
DEV void st8f(float* p, const float (&v)[8]) { *(f32x4*)p = (f32x4){v[0], v[1], v[2], v[3]}; *(f32x4*)(p + 4) = (f32x4){v[4], v[5], v[6], v[7]}; }
DEV void st8bf(bf16_t* p, const float (&v)[8]) { u32x4 o; o[0] = cvt_pk_bf16(v[0], v[1]); o[1] = cvt_pk_bf16(v[2], v[3]); o[2] = cvt_pk_bf16(v[4], v[5]); o[3] = cvt_pk_bf16(v[6], v[7]); *(u32x4*)p = o; }

DEV void tr_job(const float* __restrict__ src, int Ks, int Ns, int Nd, bf16_t* __restrict__ dst, int mode, const float* __restrict__ gain, float scale, LAS float* tile) {
    const int nk = Ks / 64, nn = Nd / 64, ntile = nk * nn, ldd = Ks; const int t = fresh_tid();
    f32x4 v0, v1;
    auto gl = [&](int ti) { const int tk = ti % nk, tn = ti / nk;
        { const int id = t, k = id >> 4, gn = tn * 64 + (id & 15) * 4; v0 = (gn < Ns) ? *(const f32x4*)(src + (size_t)(tk * 64 + k) * Ns + gn) : (f32x4){0.f, 0.f, 0.f, 0.f}; if (gain) v0 = v0 * (gain[tk * 64 + k] * scale); }
        { const int id = t + 512, k = id >> 4, gn = tn * 64 + (id & 15) * 4; v1 = (gn < Ns) ? *(const f32x4*)(src + (size_t)(tk * 64 + k) * Ns + gn) : (f32x4){0.f, 0.f, 0.f, 0.f}; if (gain) v1 = v1 * (gain[tk * 64 + k] * scale); } };
    int ti = blockIdx.x;
    if (ti < ntile) gl(ti);
    for (; ti < ntile; ti += gridDim.x) {
        const int tk = ti % nk, tn = ti / nk;
        *(LAS f32x4*)(tile + (t >> 4) * 68 + (t & 15) * 4) = v0; *(LAS f32x4*)(tile + ((t + 512) >> 4) * 68 + (t & 15) * 4) = v1;
        if (ti + (int)gridDim.x < ntile) gl(ti + gridDim.x);
        __syncthreads();
        { const int n = t & 63, k8 = (t >> 6) * 8, gn = tn * 64 + n; float v[8];
#pragma unroll
          for (int j = 0; j < 8; ++j) v[j] = tile[(k8 + j) * 68 + n];
          const int drow = mode == 0 ? gn : ((gn >> 4) * 32 + (mode == 2 ? 16 : 0) + (gn & 15));
          st8bf(dst + (size_t)drow * ldd + tk * 64 + k8, v); }
        __syncthreads();
    }
}

DEV void phase_prep(const Params& p, LAS unsigned char* lds) {
    unsigned char* ws = p.ws; LAS float* tile = (LAS float*)lds;
    const int tid = fresh_tid(), lane = tid & 63, gw = blockIdx.x * 8 + (tid >> 6), nw = gridDim.x * 8;
    bf16_t* xb = (bf16_t*)(ws + O_XB); float* rs1 = (float*)(ws + O_RS1);
#pragma unroll 2
    for (int r = gw; r < MP; r += nw) {
        float ss = 0.f;
        if (r < MV) {
            const float* xr = r < NTOK ? p.in[I_XP] + (size_t)r * 1024 : p.in[I_XS] + (size_t)(r - NTOK) * 1024;
#pragma unroll
            for (int i = 0; i < 4; ++i) { const int c = lane * 4 + 256 * i; const f32x4 v = *(const f32x4*)(xr + c); ss += v[0] * v[0] + v[1] * v[1] + v[2] * v[2] + v[3] * v[3];
                u32x2 o; o[0] = cvt_pk_bf16(v[0], v[1]); o[1] = cvt_pk_bf16(v[2], v[3]); *(u32x2*)(xb + (size_t)r * 1024 + c) = o; }
            ss = wsum64(ss);
        } else {
#pragma unroll
            for (int i = 0; i < 4; ++i) { u32x2 o; o[0] = 0; o[1] = 0; *(u32x2*)(xb + (size_t)r * 1024 + lane * 4 + 256 * i) = o; }
        }
        if (lane < 16) { rs1[(size_t)r * 16 + lane] = lane == 0 ? ss : 0.f;
            if (r >= MV) { ((float*)(ws + O_RS2))[(size_t)r * 16 + lane] = 0.f; ((float*)(ws + O_RS3))[(size_t)r * 16 + lane] = 0.f; ((float*)(ws + O_RS4))[(size_t)r * 16 + lane] = 0.f; ((float*)(ws + O_RS5))[(size_t)r * 16 + lane] = 0.f; } }
    }
    bf16_t* mnb = (bf16_t*)(ws + O_MNB); float* rstdm = (float*)(ws + O_RSTDM);
    for (int r = gw; r < NMEMR; r += nw) {
        const float* xr = p.in[I_MEM] + (size_t)r * 1024; float ss = 0.f;
#pragma unroll
        for (int i = 0; i < 4; ++i) { const int c = lane * 4 + 256 * i; const f32x4 v = *(const f32x4*)(xr + c); ss += v[0] * v[0] + v[1] * v[1] + v[2] * v[2] + v[3] * v[3];
            u32x2 o; o[0] = cvt_pk_bf16(v[0], v[1]); o[1] = cvt_pk_bf16(v[2], v[3]); *(u32x2*)(mnb + (size_t)r * 1024 + c) = o; }
        ss = wsum64(ss);
        if (lane == 0) rstdm[r] = rsqrtf(ss * (1.f / 1024.f) + 1e-6f);
    }
    { bf16_t* wl = (bf16_t*)(ws + O_WLORA);
      for (int i = blockIdx.x * 512 + tid; i < 1536 * 384; i += gridDim.x * 512) {
          const int n = i / 384, k = i % 384, reg = n >> 9, c = n & 511; float v = 0.f;
          if (reg == 0 && k < 64) v = p.in[I_W2][k * 512 + c];
          else if (reg == 1 && k >= 64 && k < 128) v = p.in[I_A2][(k - 64) * 512 + c];
          else if (reg == 2 && k >= 128 && k < 288) v = p.in[I_G2][(k - 128) * 512 + c];
          wl[i] = (bf16_t)(cvt_pk_bf16(v, 0.f) & 0xffffu);
      } }
    tr_job(p.in[I_G1], 1024, 2816, 2816, (bf16_t*)(ws + O_WGU1), 1, p.in[I_LN1], 1.f, tile);
    tr_job(p.in[I_U1], 1024, 2816, 2816, (bf16_t*)(ws + O_WGU1), 2, p.in[I_LN1], 1.f, tile);
    tr_job(p.in[I_XK], 1024, 1024, 1024, (bf16_t*)(ws + O_WK), 0, p.in[I_MEMN], 1.f, tile);
    tr_job(p.in[I_XV], 1024, 1024, 1024, (bf16_t*)(ws + O_WV), 0, p.in[I_MEMN], 1.f, tile);
    tr_job(p.in[I_D1], 2816, 1024, 1024, (bf16_t*)(ws + O_WD1), 0, nullptr, 1.f, tile);
    tr_job(p.in[I_WIN], 1024, 2848, 3072, (bf16_t*)(ws + O_WIN), 0, p.in[I_LNMIX], 1.f, tile);
    tr_job(p.in[I_WOUT], 1024, 1024, 1024, (bf16_t*)(ws + O_WOUT), 0, nullptr, 1.f, tile);
    tr_job(p.in[I_XQ], 1024, 1024, 1024, (bf16_t*)(ws + O_WQ), 0, p.in[I_LNX], 0.0625f, tile);
    tr_job(p.in[I_XO], 1024, 1024, 1024, (bf16_t*)(ws + O_WO), 0, nullptr, 1.f, tile);
    tr_job(p.in[I_G2F], 1024, 2816, 2816, (bf16_t*)(ws + O_WGU2), 1, p.in[I_LN2], 1.f, tile);
    tr_job(p.in[I_U2F], 1024, 2816, 2816, (bf16_t*)(ws + O_WGU2), 2, p.in[I_LN2], 1.f, tile);
    tr_job(p.in[I_D2F], 2816, 1024, 1024, (bf16_t*)(ws + O_WD2), 0, nullptr, 1.f, tile);
}

DEV void phase_mixprep(const Params& p) {
    unsigned char* ws = p.ws; const int tid = fresh_tid(), lane = tid & 63, gw = blockIdx.x * 8 + (tid >> 6), nw = gridDim.x * 8;
    const bf16_t* z = (const bf16_t*)(ws + O_Z); bf16_t* vab = (bf16_t*)(ws + O_VAB); bf16_t* lin = (bf16_t*)(ws + O_LIN); bf16_t* ymix = (bf16_t*)(ws + O_YMIX);
    bf16_t* rbuf = (bf16_t*)(ws + O_H); bf16_t* kbuf = (bf16_t*)(ws + O_H + HALFROW); bf16_t* vbuf = (bf16_t*)(ws + O_XRES); bf16_t* kkbuf = (bf16_t*)(ws + O_KK);
#pragma unroll 2
    for (int r = gw; r < MV; r += nw) {
        const bf16_t* zr = z + (size_t)r * ZLD; const bool smp = r >= NTOK; const int t = r & (SEQ - 1), si = r - NTOK;
        {
            const int c = lane * 8; float v[8]; ld8bf(zr + 512 + c, v); float s = 0.f;
#pragma unroll
            for (int i = 0; i < 8; ++i) { v[i] = gelu_t(v[i]); s += v[i]; }
            const float mu = wsum64(s) * (1.f / 512.f); float q = 0.f;
#pragma unroll
            for (int i = 0; i < 8; ++i) { v[i] -= mu; q += v[i] * v[i]; }
            const float rstd = rsqrtf(wsum64(q) * (1.f / 512.f) + 1e-5f); float g[8], b[8]; ld8f(p.in[I_SLNG] + c, g); ld8f(p.in[I_SLNB] + c, b);
#pragma unroll
            for (int i = 0; i < 8; ++i) v[i] = v[i] * rstd * g[i] + b[i];
            st8bf(vab + (size_t)r * 512 + c, v);
            if (smp) {
                st8f(p.out + OUT_CV + (size_t)si * 512 + c, v);
                const int grp = c >> 6; const float w00 = p.in[I_SGUW][grp * 16384], b0 = p.in[I_SGUB][grp * 128]; float uu[8]; ld8bf(zr + c, uu);
#pragma unroll
                for (int i = 0; i < 8; ++i) uu[i] = gelu_t(uu[i]) * (w00 * v[i] + b0);
                st8bf(ymix + (size_t)r * 1024 + c, uu);
            }
        }
#pragma unroll
        for (int it = 0; it < 4; ++it) {
            const int ch = lane + 64 * it; if (ch >= 228) break;
            const int cb = ch * 8; float cur[8], prv[8], mu[8], zs[8]; ld8bf(zr + 1024 + cb, cur);
            if (smp) ld8f(p.in[I_SSHIFT] + (size_t)si * BPROJ + cb, prv);
            else if (t == 0) {
#pragma unroll
                for (int i = 0; i < 8; ++i) prv[i] = 0.f;
            } else ld8bf(zr - ZLD + 1024 + cb, prv);
            ld8f(p.in[I_MU] + cb, mu);
#pragma unroll
            for (int i = 0; i < 8; ++i) zs[i] = cur[i] + (prv[i] - cur[i]) * mu[i];
            if (smp) st8f(p.out + OUT_SHS + (size_t)si * BPROJ + cb, cur);
            else if (t == SEQ - 1) st8f(p.out + OUT_SHP + (size_t)(r >> 11) * BPROJ + cb, cur);
            if (it == 0) st8bf(rbuf + (size_t)r * 512 + cb, zs);
            else if (it == 1) {
                const int c = cb - 512; st8bf(kbuf + (size_t)r * 512 + c, zs); float kkw[8], kk[8]; ld8f(p.in[I_KK] + c, kkw); float ss = 0.f;
#pragma unroll
                for (int i = 0; i < 8; ++i) { kk[i] = zs[i] * kkw[i]; ss += kk[i] * kk[i]; }
                ss += __shfl_xor(ss, 1); ss += __shfl_xor(ss, 2); ss += __shfl_xor(ss, 4);
                const float rn = rsqrtf(fmaxf(ss, 1e-24f));
#pragma unroll
                for (int i = 0; i < 8; ++i) kk[i] *= rn;
                st8bf(kkbuf + (size_t)r * 512 + c, kk);
            } else if (it == 2) st8bf(vbuf + (size_t)r * 512 + (cb - 1024), zs);
            else {
                const int l = ch - 192; float o[8];
#pragma unroll
                for (int i = 0; i < 8; ++i) o[i] = l < 8 ? tanhf_(zs[i]) : (l < 16 ? zs[i] : sigmoidf_(zs[i]));
                st8bf(lin + (size_t)r * 384 + l * 8, o);
            }
        }
        if (lane >= 36 && lane < 48) { const float zero[8] = {0.f, 0.f, 0.f, 0.f, 0.f, 0.f, 0.f, 0.f}; st8bf(lin + (size_t)r * 384 + lane * 8, zero); }
    }
}

DEV void phase_chunkmix(const Params& p, LAS unsigned char* lds) {
    unsigned char* ws = p.ws; const int tid = fresh_tid(), lane = tid & 63, w = tid >> 6, l15 = lane & 15, kg = lane >> 4;
    const bf16_t* z = (const bf16_t*)(ws + O_Z); const bf16_t* vab = (const bf16_t*)(ws + O_VAB); bf16_t* ymix = (bf16_t*)(ws + O_YMIX);
    LAS bf16_t* vaT = (LAS bf16_t*)lds;
    for (int item = blockIdx.x; item < 1024; item += gridDim.x) {
        const int g = item & 7, bc = item >> 3; const size_t m0 = (size_t)bc * 128;
        __syncthreads();
#pragma unroll
        for (int i = 0; i < 2; ++i) { const int id = tid + 512 * i, s = id >> 3, d8 = (id & 7) * 8; const u32x4 u = *(const u32x4*)(vab + (m0 + s) * 512 + g * 64 + d8);
#pragma unroll
            for (int j = 0; j < 4; ++j) { vaT[(d8 + 2 * j) * 136 + s] = (bf16_t)(u[j] & 0xffffu); vaT[(d8 + 2 * j + 1) * 136 + s] = (bf16_t)(u[j] >> 16); } }
        __syncthreads();
        f32x4 acc[4];
#pragma unroll
        for (int nb = 0; nb < 4; ++nb) acc[nb] = (f32x4){0.f, 0.f, 0.f, 0.f};
        const int trow = 16 * w + l15; const float* wrow = p.in[I_SGUW] + ((size_t)g * 128 + trow) * 128;
        const int nks = (16 * w + 16 + 31) >> 5;
        for (int ks = 0; ks < nks; ++ks) {
            const int s0 = 32 * ks + kg * 8; float a[8]; ld8f(wrow + s0, a);
#pragma unroll
            for (int i = 0; i < 8; ++i) a[i] = (s0 + i <= trow) ? a[i] : 0.f;
            u32x4 au; au[0] = cvt_pk_bf16(a[0], a[1]); au[1] = cvt_pk_bf16(a[2], a[3]); au[2] = cvt_pk_bf16(a[4], a[5]); au[3] = cvt_pk_bf16(a[6], a[7]);
            const bf16x8 av = __builtin_bit_cast(bf16x8, au);
#pragma unroll
            for (int nb = 0; nb < 4; ++nb) { const bf16x8 bv = *(const LAS bf16x8*)(vaT + (nb * 16 + l15) * 136 + s0); acc[nb] = __builtin_amdgcn_mfma_f32_16x16x32_bf16(av, bv, acc[nb], 0, 0, 0); }
        }
#pragma unroll
        for (int j = 0; j < 4; ++j) { const int t = 16 * w + kg * 4 + j; const float bias = p.in[I_SGUB][g * 128 + t]; const size_t m = m0 + t;
#pragma unroll
            for (int nb = 0; nb < 4; ++nb) { const int d = g * 64 + nb * 16 + l15; const float u = gelu_t(bf2f(z[m * ZLD + d])); ymix[m * 1024 + d] = (bf16_t)(cvt_pk_bf16(u * (acc[nb][j] + bias), 0.f) & 0xffffu); } }
    }
}

DEV void phase_scan(const Params& p, LAS unsigned char* lds) {
    unsigned char* ws = p.ws; const int tid = fresh_tid(), lane = tid & 63, w = tid >> 6, rg = lane >> 4, kq = lane & 15;
    const bf16_t* rbuf = (const bf16_t*)(ws + O_H); const bf16_t* kbuf = (const bf16_t*)(ws + O_H + HALFROW); const bf16_t* vbuf = (const bf16_t*)(ws + O_XRES);
    const bf16_t* kkbuf = (const bf16_t*)(ws + O_KK); const float* dec = (const float*)(ws + O_DEC); const bf16_t* kka = (const bf16_t*)(ws + O_KKA); bf16_t* obuf = (bf16_t*)(ws + O_Z);
    constexpr int SL = 16, NCH = SEQ / SL, LB = 5 * SL * 64;
    LAS float* L = (LAS float*)lds;
    LAS float* Lv = L + 2 * LB;
    LAS float* Lp = Lv + 2 * SL * 16;
#define SCAN_BAR() do { asm volatile("s_waitcnt lgkmcnt(0)" ::: "memory"); __builtin_amdgcn_s_barrier(); asm volatile("" ::: "memory"); } while (0)
    for (int item = blockIdx.x; item < 256; item += gridDim.x) {
        const int bh = item >> 2, q = item & 3, b = bh >> 3, h = bh & 7; const size_t m0 = (size_t)b * SEQ;
        if (w >= 4) {
            const int lt = tid - 256, ls = lt >> 4, lc = (lt & 15) * 4;
            f32x4 p1; u32x2 p0, p2, p3, p4, pv; pv[0] = 0u; pv[1] = 0u;
            auto gload = [&](int ch) { const size_t o = (m0 + ch * SL + ls) * 512 + h * 64 + lc;
                p0 = *(const u32x2*)(kkbuf + o); p1 = *(const f32x4*)(dec + o); p2 = *(const u32x2*)(kbuf + o); p3 = *(const u32x2*)(kka + o); p4 = *(const u32x2*)(rbuf + o);
                if (lt < 64) pv = *(const u32x2*)(vbuf + (m0 + ch * SL + (lt >> 2)) * 512 + h * 64 + q * 16 + (lt & 3) * 4); };
            auto fill = [&](int ch) { LAS float* d = L + (ch & 1) * LB + ls * 64 + lc;
                *(LAS f32x4*)d = bf4(p0); *(LAS f32x4*)(d + SL * 64) = p1; *(LAS f32x4*)(d + 2 * SL * 64) = bf4(p2); *(LAS f32x4*)(d + 3 * SL * 64) = bf4(p3); *(LAS f32x4*)(d + 4 * SL * 64) = bf4(p4);
                if (lt < 64) *(LAS f32x4*)(Lv + (ch & 1) * SL * 16 + lt * 4) = bf4(pv); };
            auto reduce_slab = [&](int ch) { const int st = lt >> 4, row = lt & 15; const LAS float* pp = Lp + (ch & 1) * SL * 256 + st * 256 + (row >> 2) * 64 + (row & 3) * 16;
                const f32x4 a = *(const LAS f32x4*)pp, b4 = *(const LAS f32x4*)(pp + 4), c = *(const LAS f32x4*)(pp + 8), d = *(const LAS f32x4*)(pp + 12); const f32x4 t = (a + b4) + (c + d);
                obuf[(m0 + ch * SL + st) * 512 + h * 64 + q * 16 + row] = (bf16_t)(cvt_pk_bf16((t[0] + t[1]) + (t[2] + t[3]), 0.f) & 0xffffu); };
            gload(0); fill(0); gload(1);
            SCAN_BAR();
            for (int ch = 0; ch < NCH; ++ch) {
                if (ch + 1 < NCH) fill(ch + 1);
                if (ch + 2 < NCH) gload(ch + 2);
                if (ch >= 1) reduce_slab(ch - 1);
                SCAN_BAR();
            }
            reduce_slab(NCH - 1);
            {
                const int sidx = item * 4 + (w - 4), si = sidx >> 3, hh = sidx & 7; const size_t o = (size_t)(NTOK + si) * 512 + hh * 64 + kq * 4;
                const f32x4 kk4 = bf4(*(const u32x2*)(kkbuf + o)), w4 = *(const f32x4*)(dec + o), k4 = bf4(*(const u32x2*)(kbuf + o)), ka4 = bf4(*(const u32x2*)(kka + o)), r4 = bf4(*(const u32x2*)(rbuf + o));
                const float* sin = p.in[I_SRWKV] + (size_t)sidx * 4096; float* sout = p.out + OUT_SS + (size_t)sidx * 4096;
                for (int ps = 0; ps < 16; ++ps) {
                    const int v = ps * 4 + rg; f32x4 S = *(const f32x4*)(sin + v * 64 + kq * 4); const float vv = bf2f(vbuf[(size_t)(NTOK + si) * 512 + hh * 64 + v]);
                    const float sa = -rowsum16(S[0] * kk4[0] + S[1] * kk4[1] + S[2] * kk4[2] + S[3] * kk4[3]);
                    S = S * w4 + vv * k4 + sa * ka4;
                    *(f32x4*)(sout + v * 64 + kq * 4) = S;
                    const float op = rowsum16(S[0] * r4[0] + S[1] * r4[1] + S[2] * r4[2] + S[3] * r4[3]);
                    if (kq == 0) obuf[(size_t)(NTOK + si) * 512 + hh * 64 + v] = (bf16_t)(cvt_pk_bf16(op, 0.f) & 0xffffu);
                }
            }
        } else {
            typedef float f32x2v __attribute__((ext_vector_type(2)));
            f32x2v Sa = (f32x2v){0.f, 0.f}, Sb = (f32x2v){0.f, 0.f}; const int row = w * 4 + rg;
            SCAN_BAR();
            for (int ch = 0; ch < NCH; ++ch) {
                const LAS float* Lc = L + (ch & 1) * LB + kq * 4; const LAS float* Lvc = Lv + (ch & 1) * SL * 16 + row;
                LAS float* dst = Lp + (ch & 1) * SL * 256 + w * 64 + lane;
                f32x4 kk4 = *(const LAS f32x4*)Lc, w4 = *(const LAS f32x4*)(Lc + SL * 64), k4 = *(const LAS f32x4*)(Lc + 2 * SL * 64), ka4 = *(const LAS f32x4*)(Lc + 3 * SL * 64), r4 = *(const LAS f32x4*)(Lc + 4 * SL * 64);
                float vv = Lvc[0];
#pragma unroll
                for (int s = 0; s < SL; ++s) {
                    const int sn = s < SL - 1 ? s + 1 : SL - 1; const LAS float* bp = Lc + sn * 64;
                    const f32x4 nkk4 = *(const LAS f32x4*)bp, nw4 = *(const LAS f32x4*)(bp + SL * 64), nk4 = *(const LAS f32x4*)(bp + 2 * SL * 64), nka4 = *(const LAS f32x4*)(bp + 3 * SL * 64), nr4 = *(const LAS f32x4*)(bp + 4 * SL * 64);
                    const float nvv = Lvc[sn * 16];
                    f32x2v t = Sa * kk4.lo; t = Sb * kk4.hi + t;
                    const float sa = -rowsum16(t[0] + t[1]);
                    Sa = (Sa * w4.lo + vv * k4.lo) + sa * ka4.lo;
                    Sb = (Sb * w4.hi + vv * k4.hi) + sa * ka4.hi;
                    f32x2v u = Sa * r4.lo; u = Sb * r4.hi + u;
                    dst[s * 256] = u[0] + u[1];
                    kk4 = nkk4; w4 = nw4; k4 = nk4; ka4 = nka4; r4 = nr4; vv = nvv;
                }
                SCAN_BAR();
            }
            const float S0 = Sa[0], S1 = Sa[1], S2 = Sb[0], S3 = Sb[1];
            *(f32x4*)(p.out + OUT_SP + ((size_t)bh * 64 + q * 16 + row) * 64 + kq * 4) = (f32x4){S0, S1, S2, S3};
        }
        __syncthreads();
    }
#undef SCAN_BAR
}

DEV void phase_finalize(const Params& p) {
    unsigned char* ws = p.ws; const int tid = fresh_tid(), lane = tid & 63, gw = blockIdx.x * 8 + (tid >> 6), nw = gridDim.x * 8;
    const bf16_t* rbuf = (const bf16_t*)(ws + O_H); const bf16_t* kbuf = (const bf16_t*)(ws + O_H + HALFROW); const bf16_t* gb = (const bf16_t*)(ws + O_H + 2 * HALFROW);
    const bf16_t* vbuf = (const bf16_t*)(ws + O_XRES); const bf16_t* obuf = (const bf16_t*)(ws + O_Z); bf16_t* ymix = (bf16_t*)(ws + O_YMIX);
    const int c = lane * 8; float rk[8], gg[8], gbb[8]; ld8f(p.in[I_RK] + c, rk); ld8f(p.in[I_GNG] + c, gg); ld8f(p.in[I_GNB] + c, gbb);
#pragma unroll 2
    for (int r = gw; r < MV; r += nw) {
        const size_t o = (size_t)r * 512 + c; float ov[8], rv[8], kv[8], vv[8], gv[8]; ld8bf(obuf + o, ov); ld8bf(rbuf + o, rv); ld8bf(kbuf + o, kv); ld8bf(vbuf + o, vv); ld8bf(gb + o, gv);
        float s = 0.f, bs = 0.f;
#pragma unroll
        for (int i = 0; i < 8; ++i) { s += ov[i]; bs += rv[i] * kv[i] * rk[i]; }
        s += __shfl_xor(s, 1); s += __shfl_xor(s, 2); s += __shfl_xor(s, 4); bs += __shfl_xor(bs, 1); bs += __shfl_xor(bs, 2); bs += __shfl_xor(bs, 4);
        const float mu = s * (1.f / 64.f); float q = 0.f;
#pragma unroll
        for (int i = 0; i < 8; ++i) { ov[i] -= mu; q += ov[i] * ov[i]; }
        q += __shfl_xor(q, 1); q += __shfl_xor(q, 2); q += __shfl_xor(q, 4);
        const float rstd = rsqrtf(q * (1.f / 64.f) + 64e-5f); float y[8];
#pragma unroll
        for (int i = 0; i < 8; ++i) y[i] = (ov[i] * rstd * gg[i] + gbb[i] + bs * vv[i]) * gv[i];
        st8bf(ymix + (size_t)r * 1024 + 512 + c, y);
    }
}

DEV void phase_sattn(const Params& p, LAS unsigned char* lds) {
    unsigned char* ws = p.ws; const int tid = fresh_tid(), lane = tid & 63, w = tid >> 6, kgrp = lane >> 4, dl = lane & 15;
    const bf16_t* qb = (const bf16_t*)(ws + O_Z + HALFROW); bf16_t* ob = (bf16_t*)(ws + O_YMIX);
    LAS float* pw = (LAS float*)lds;
    LAS float* wm = pw + 256;
    LAS float* wacc = wm + 16;
    for (int item = blockIdx.x; item < 512; item += gridDim.x) {
        const int si = item >> 2, h = item & 3; const float* Kp = p.in[I_CK] + (size_t)si * 262144 + h * 256; const float* Vp = p.in[I_CV] + (size_t)si * 262144 + h * 256;
        float q[16]; { float a[8], b[8]; ld8bf(qb + (size_t)(NTOK + si) * 1024 + h * 256 + dl * 16, a); ld8bf(qb + (size_t)(NTOK + si) * 1024 + h * 256 + dl * 16 + 8, b);
#pragma unroll
            for (int i = 0; i < 8; ++i) { q[i] = a[i]; q[8 + i] = b[i]; } }
        float sc[8];
#pragma unroll
        for (int j = 0; j < 8; ++j) {
            const float* kr = Kp + (size_t)(w * 32 + kgrp + 4 * j) * 1024 + dl * 16; float d = 0.f;
#pragma unroll
            for (int i = 0; i < 4; ++i) { const f32x4 k4 = *(const f32x4*)(kr + 4 * i); d += k4[0] * q[4 * i] + k4[1] * q[4 * i + 1] + k4[2] * q[4 * i + 2] + k4[3] * q[4 * i + 3]; }
            sc[j] = rowsum16(d);
        }
        float mx = sc[0];
#pragma unroll
        for (int j = 1; j < 8; ++j) mx = fmaxf(mx, sc[j]);
        mx = fmaxf(mx, __shfl_xor(mx, 16)); mx = fmaxf(mx, __shfl_xor(mx, 32));
        float sum = 0.f;
#pragma unroll
        for (int j = 0; j < 8; ++j) { sc[j] = __expf(sc[j] - mx); sum += sc[j]; }
        sum += __shfl_xor(sum, 16); sum += __shfl_xor(sum, 32);
        __syncthreads();
        if (dl == 0) {
#pragma unroll
            for (int j = 0; j < 8; ++j) pw[w * 32 + kgrp + 4 * j] = sc[j];
        }
        if (lane == 0) { wm[w] = mx; wm[8 + w] = sum; }
        asm volatile("s_waitcnt lgkmcnt(0)" ::: "memory"); __builtin_amdgcn_wave_barrier();
        f32x4 acc = (f32x4){0.f, 0.f, 0.f, 0.f};
#pragma unroll 16
        for (int j = 0; j < 32; ++j) { const f32x4 v4 = *(const f32x4*)(Vp + (size_t)(w * 32 + j) * 1024 + lane * 4); acc = acc + pw[w * 32 + j] * v4; }
        *(LAS f32x4*)(wacc + w * 256 + lane * 4) = acc;
        __syncthreads();
        if (tid < 256) {
            float M = wm[0];
#pragma unroll
            for (int j = 1; j < 8; ++j) M = fmaxf(M, wm[j]);
            float L = 0.f, o = 0.f;
#pragma unroll
            for (int j = 0; j < 8; ++j) { const float f = __expf(wm[j] - M); L += wm[8 + j] * f; o += wacc[j * 256 + tid] * f; }
            ob[(size_t)(NTOK + si) * 1024 + h * 256 + tid] = (bf16_t)(cvt_pk_bf16(o * __builtin_amdgcn_rcpf(L), 0.f) & 0xffffu);
        }
    }
}

DEV void phase_final(const Params& p) {
    unsigned char* ws = p.ws; const int tid = fresh_tid(), lane = tid & 63, gw = blockIdx.x * 8 + (tid >> 6), nw = gridDim.x * 8;
    const bf16_t* xb = (const bf16_t*)(ws + O_XB); const float* rs5 = (const float*)(ws + O_RS5);
    float g[16]; { float a[8], b[8]; ld8f(p.in[I_FIN] + lane * 8, a); ld8f(p.in[I_FIN] + 512 + lane * 8, b);
#pragma unroll
        for (int i = 0; i < 8; ++i) { g[i] = a[i]; g[8 + i] = b[i]; } }
#pragma unroll 2
    for (int r = gw; r < MV; r += nw) {
        const float rstd = rstd_of(rs5, r);
#pragma unroll
        for (int hf = 0; hf < 2; ++hf) { const int c = hf * 512 + lane * 8; float v[8]; ld8bf(xb + (size_t)r * 1024 + c, v);
#pragma unroll
            for (int i = 0; i < 8; ++i) v[i] = v[i] * rstd * g[hf * 8 + i];
            st8f(p.out + OUT_Y + (size_t)r * 1024 + c, v); }
    }
}

__global__ void __launch_bounds__(512, 2) mega(Params p) {
    extern __shared__ __attribute__((aligned(16))) unsigned char shm[];
    LAS unsigned char* lds = (LAS unsigned char*)shm;
    unsigned char* ws = p.ws;
    const int MT = MP / 256;
    {
        volatile LAS unsigned* st = (volatile LAS unsigned*)(lds + pg8::STAGE_BYTES);
        if (threadIdx.x < 2) st[threadIdx.x] = 0u;
        __syncthreads();
        if (threadIdx.x == 0) (void)xb_add(&((unsigned*)(ws + O_BAR))[XB_XCNT(xb_xcc_id())], 1u);
    }
#define XB_SYNC() do { XcdBarrier xb_; xb_.bar = (unsigned*)(p.ws + O_BAR); xb_.x = xb_xcc_id(); xb_.st = (volatile LAS unsigned*)(lds + pg8::STAGE_BYTES); xcd_barrier(xb_); } while (0)
    { phase_prep(p, lds); }
    XB_SYNC();
    { {
            { pg8::Gemm g{(const bf16_t*)(ws + O_XB), (const bf16_t*)(ws + O_WGU1), 1024, 1024, 1024}; pg8::GridSched S; S.init(MT, 22, 0, 1024, 1024);
              EpiSwiglu E{(const float*)(ws + O_RS1), (bf16_t*)(ws + O_H)}; pg8::gemm_phase(lds, g, S, E); }
            { pg8::Gemm g{(const bf16_t*)(ws + O_MNB), (const bf16_t*)(ws + O_WK), 1024, 1024, 1024}; pg8::GridSched S; S.init(8, 4, MT * 22, 1024, 1024);
              EpiK E{(const float*)(ws + O_RSTDM), p.out + OUT_MK, (bf16_t*)(ws + O_MKB)}; pg8::gemm_phase(lds, g, S, E); }
            { pg8::Gemm g{(const bf16_t*)(ws + O_WV), (const bf16_t*)(ws + O_MNB), 1024, 1024, 1024}; pg8::GridSched S; S.init(4, 8, MT * 22 + 32, 1024, 1024);
              EpiVT E{(const float*)(ws + O_RSTDM), p.out + OUT_MV, (bf16_t*)(ws + O_VT)}; pg8::gemm_phase(lds, g, S, E); }
        } }
    XB_SYNC();
    { { pg8::Gemm g{(const bf16_t*)(ws + O_H), (const bf16_t*)(ws + O_WD1), DFF, DFF, DFF}; pg8::GridSched S; S.init(64, 4, 0, DFF, DFF);
            EpiRes E{p.in[I_XP], (bf16_t*)(ws + O_XB), (float*)(ws + O_RS2), 0.5f}; pg8::gemm_phase(lds, g, S, E);
            SRes E2{p.in[I_XS], (bf16_t*)(ws + O_XB), (float*)(ws + O_RS2), 0.5f, NTOK};
            small_gemm<4>(lds, (const bf16_t*)(ws + O_H), DFF, (const bf16_t*)(ws + O_WD1), DFF, DFF, NTOK, 4, 16, E2); } }
    XB_SYNC();
    { { pg8::Gemm g{(const bf16_t*)(ws + O_XB), (const bf16_t*)(ws + O_WIN), 1024, 1024, 1024}; pg8::GridSched S; S.init(MT, 11, 0, 1024, 1024);
            EpiScale E{(const float*)(ws + O_RS2), (bf16_t*)(ws + O_Z), ZLD, ZLD}; pg8::gemm_phase(lds, g, S, E);
            SScale E2{(const float*)(ws + O_RS2), (bf16_t*)(ws + O_Z), ZLD, ZLD, 2816};
            small_gemm<2>(lds, (const bf16_t*)(ws + O_XB), 1024, (const bf16_t*)(ws + O_WIN) + (size_t)2816 * 1024, 1024, 1024, 0, MV / 32, 1, E2); } }
    XB_SYNC();
    { phase_mixprep(p); }
    XB_SYNC();
    { { pg8::Gemm g{(const bf16_t*)(ws + O_LIN), (const bf16_t*)(ws + O_WLORA), 384, 384, 256}; pg8::LoraSched S; S.init();
            EpiLora E{p.in[I_W0], p.in[I_A0], p.in[I_KA], (float*)(ws + O_DEC), (bf16_t*)(ws + O_H + HALFROW), (const bf16_t*)(ws + O_KK), (bf16_t*)(ws + O_KKA), (bf16_t*)(ws + O_H + 2 * HALFROW)};
            pg8::gemm_phase(lds, g, S, E); phase_chunkmix(p, lds); } }
    XB_SYNC();
    { phase_scan(p, lds); }
    XB_SYNC();
    { phase_finalize(p); }
    XB_SYNC();
    { { pg8::Gemm g{(const bf16_t*)(ws + O_YMIX), (const bf16_t*)(ws + O_WOUT), 1024, 1024, 1024}; pg8::GridSched S; S.init(64, 4, 0, 1024, 1024);
            EpiRes E{nullptr, (bf16_t*)(ws + O_XB), (float*)(ws + O_RS3), 1.f}; pg8::gemm_phase(lds, g, S, E);
            SRes E2{nullptr, (bf16_t*)(ws + O_XB), (float*)(ws + O_RS3), 1.f, 0};
            small_gemm<4>(lds, (const bf16_t*)(ws + O_YMIX), 1024, (const bf16_t*)(ws + O_WOUT), 1024, 1024, NTOK, 4, 16, E2); } }
    XB_SYNC();
    { { pg8::Gemm g{(const bf16_t*)(ws + O_XB), (const bf16_t*)(ws + O_WQ), 1024, 1024, 1024}; pg8::GridSched S; S.init(64, 4, 0, 1024, 1024);
            EpiScale E{(const float*)(ws + O_RS3), (bf16_t*)(ws + O_Z + HALFROW), 1024, 1024}; pg8::gemm_phase(lds, g, S, E);
            SScale E2{(const float*)(ws + O_RS3), (bf16_t*)(ws + O_Z + HALFROW), 1024, 1024, 0};
            small_gemm<4>(lds, (const bf16_t*)(ws + O_XB), 1024, (const bf16_t*)(ws + O_WQ), 1024, 1024, NTOK, 4, 16, E2); } }
    XB_SYNC();
    { {
            const bool sattn_first = ((blockIdx.x >> 3) & 1) != 0;
            if (sattn_first) phase_sattn(p, lds);
            { pg8::Gemm g{(const bf16_t*)(ws + O_Z + HALFROW), (const bf16_t*)(ws + O_MKB), 1024, 1024, 256}; pg8::AttnSched<0> S; S.init();
              EpiS E{(bf16_t*)(ws + O_Z), (float*)(ws + O_PSUM)}; pg8::gemm_phase(lds, g, S, E); }
            asm volatile("s_waitcnt vmcnt(0)" ::: "memory"); __syncthreads();
            if (threadIdx.x == 0) { __builtin_amdgcn_fence(__ATOMIC_ACQUIRE, "agent"); asm volatile("s_waitcnt vmcnt(0)" ::: "memory"); }
            __syncthreads();
            { pg8::Gemm g{(const bf16_t*)(ws + O_Z), (const bf16_t*)(ws + O_VT), 256, 2048, 256}; pg8::AttnSched<1> S; S.init();
              EpiO E{(const float*)(ws + O_PSUM), (bf16_t*)(ws + O_YMIX)}; pg8::gemm_phase(lds, g, S, E); }
            if (!sattn_first) phase_sattn(p, lds);
        } }
    XB_SYNC();
    { { pg8::Gemm g{(const bf16_t*)(ws + O_YMIX), (const bf16_t*)(ws + O_WO), 1024, 1024, 1024}; pg8::GridSched S; S.init(64, 4, 0, 1024, 1024);
            EpiRes E{nullptr, (bf16_t*)(ws + O_XB), (float*)(ws + O_RS4), 1.f}; pg8::gemm_phase(lds, g, S, E);
            SRes E2{nullptr, (bf16_t*)(ws + O_XB), (float*)(ws + O_RS4), 1.f, 0};
            small_gemm<4>(lds, (const bf16_t*)(ws + O_YMIX), 1024, (const bf16_t*)(ws + O_WO), 1024, 1024, NTOK, 4, 16, E2); } }
    XB_SYNC();
    { { pg8::Gemm g{(const bf16_t*)(ws + O_XB), (const bf16_t*)(ws + O_WGU2), 1024, 1024, 1024}; pg8::GridSched S; S.init(MT, 22, 0, 1024, 1024);
            EpiSwiglu E{(const float*)(ws + O_RS4), (bf16_t*)(ws + O_H)}; pg8::gemm_phase(lds, g, S, E); } }
    XB_SYNC();
    { { pg8::Gemm g{(const bf16_t*)(ws + O_H), (const bf16_t*)(ws + O_WD2), DFF, DFF, DFF}; pg8::GridSched S; S.init(64, 4, 0, DFF, DFF);
            EpiRes E{nullptr, (bf16_t*)(ws + O_XB), (float*)(ws + O_RS5), 0.5f}; pg8::gemm_phase(lds, g, S, E);
            SRes E2{nullptr, (bf16_t*)(ws + O_XB), (float*)(ws + O_RS5), 0.5f, 0};
            small_gemm<4>(lds, (const bf16_t*)(ws + O_H), DFF, (const bf16_t*)(ws + O_WD2), DFF, DFF, NTOK, 4, 16, E2); } }
    XB_SYNC();
    { phase_final(p); }
#undef XB_SYNC
}

constexpr size_t LDS_BYTES = pg8::STAGE_BYTES + 4096;

extern "C" void kernel_launch(void* const* d_in, const int* in_sizes, int n_in, void* d_out, int out_size, void* d_ws, size_t ws_size, hipStream_t stream) {
    static int grid_blocks = 0;
    if (!grid_blocks) {
        int dev = 0, cus = 0, per_cu = 0;
        hipGetDevice(&dev);
        hipDeviceGetAttribute(&cus, hipDeviceAttributeMultiprocessorCount, dev);
        hipFuncSetAttribute((const void*)mega, hipFuncAttributeMaxDynamicSharedMemorySize, (int)LDS_BYTES);
        hipOccupancyMaxActiveBlocksPerMultiprocessor(&per_cu, mega, 512, LDS_BYTES);
        if (per_cu < 1) { fprintf(stderr, "occupancy query returned %d\n", per_cu); per_cu = 1; }
        grid_blocks = cus * (per_cu > 1 ? 1 : per_cu);
        if (ws_size < WS_NEED) fprintf(stderr, "workspace too small: %zu < %zu\n", ws_size, (size_t)WS_NEED);
    }
    Params p{};
    for (int i = 0; i < 40; ++i) p.in[i] = (const float*)d_in[i];
    p.out = (float*)d_out; p.ws = (unsigned char*)d_ws;
    hipMemsetAsync((unsigned char*)d_ws + O_BAR, 0, XCD_BAR_WORDS * 4, stream);
    hipLaunchKernelGGL(mega, dim3(grid_blocks), dim3(512), LDS_BYTES, stream, p);
}
```

```cpp
#include <hip/hip_runtime.h>
#include <hip/hip_cooperative_groups.h>
#include <cstdio>
namespace cg = cooperative_groups;

#ifndef PHMASK
#define PHMASK 0xffff
#endif
#ifndef DUPMASK
#define DUPMASK 0
#endif
#ifndef ONE_LAUNCH
#define ONE_LAUNCH 1
#endif

#define LAS __attribute__((address_space(3)))
#define DEV __device__ __forceinline__
typedef unsigned short bf16_t;
typedef short bf16x8 __attribute__((ext_vector_type(8)));
typedef float f32x4 __attribute__((ext_vector_type(4)));
typedef unsigned u32x2 __attribute__((ext_vector_type(2)));
typedef unsigned u32x4 __attribute__((ext_vector_type(4)));

constexpr int DM = 1024, NTOK = 16384, NSMP = 128, MV = NTOK + NSMP, MP = 16640, SEQ = 2048;
constexpr int DFF = 2816, ZLD = 2848, BPROJ = 1824, NMEMR = 2048;
constexpr int NPH = 16;

constexpr size_t al256(size_t x) { return (x + 255) & ~(size_t)255; }
constexpr size_t O_WGU1 = 0;
constexpr size_t O_WD1 = O_WGU1 + al256((size_t)5632 * 1024 * 2);
constexpr size_t O_WIN = O_WD1 + al256((size_t)1024 * 2816 * 2);
constexpr size_t O_WOUT = O_WIN + al256((size_t)3072 * 1024 * 2);
constexpr size_t O_WQ = O_WOUT + 2097152, O_WK = O_WQ + 2097152, O_WV = O_WK + 2097152, O_WO = O_WV + 2097152;
constexpr size_t O_WGU2 = O_WO + 2097152;
constexpr size_t O_WD2 = O_WGU2 + al256((size_t)5632 * 1024 * 2);
constexpr size_t O_WLORA = O_WD2 + al256((size_t)1024 * 2816 * 2);
constexpr size_t O_MNB = O_WLORA + al256((size_t)1536 * 384 * 2);
constexpr size_t O_MKB = O_MNB + 4194304, O_VT = O_MKB + 4194304;
constexpr size_t O_RSTDM = O_VT + 4194304;
constexpr size_t RS_BYTES = (size_t)MP * 64;
constexpr size_t O_RS1 = O_RSTDM + 8192, O_RS2 = O_RS1 + RS_BYTES, O_RS3 = O_RS2 + RS_BYTES, O_RS4 = O_RS3 + RS_BYTES, O_RS5 = O_RS4 + RS_BYTES;
constexpr size_t O_PSUM = O_RS5 + RS_BYTES;
constexpr size_t HALFROW = (size_t)MP * 512 * 4;
constexpr size_t O_XB = O_PSUM + 1048576;
constexpr size_t O_XRES = O_XB + HALFROW;
constexpr size_t O_H = O_XRES + 2 * HALFROW;
constexpr size_t O_Z = O_H + al256((size_t)MP * DFF * 2);
constexpr size_t O_YMIX = O_Z + al256((size_t)MP * ZLD * 2);
constexpr size_t O_VAB = O_YMIX + HALFROW;
constexpr size_t O_LIN = O_VAB + HALFROW / 2;
constexpr size_t O_KK = O_LIN + al256((size_t)MP * 384 * 2);
constexpr size_t O_DEC = O_KK + HALFROW, O_KKA = O_DEC + HALFROW;
constexpr size_t O_BAR = O_KKA + HALFROW;
constexpr size_t WS_NEED = O_BAR + 16384;

constexpr size_t OUT_Y = 0, OUT_SP = (size_t)MV * 1024, OUT_SHP = OUT_SP + 262144, OUT_MK = OUT_SHP + 8 * 1824, OUT_MV = OUT_MK + 2097152,
                 OUT_SS = OUT_MV + 2097152, OUT_SHS = OUT_SS + 4194304, OUT_CV = OUT_SHS + 128 * 1824;

enum { I_XP = 0, I_XS, I_SRWKV, I_SSHIFT, I_CK, I_CV, I_MEM, I_LN1, I_G1, I_U1, I_D1, I_LNMIX, I_WIN, I_WOUT, I_SGUW, I_SGUB, I_SLNG, I_SLNB,
       I_MU, I_W0, I_W2, I_A0, I_A2, I_G2, I_KK, I_KA, I_RK, I_GNG, I_GNB, I_LNX, I_MEMN, I_XQ, I_XK, I_XV, I_XO, I_LN2, I_G2F, I_U2F, I_D2F, I_FIN };

struct Params { const float* in[40]; float* out; unsigned char* ws; };

DEV unsigned cvt_pk_bf16(float lo, float hi) { unsigned r; asm volatile("v_cvt_pk_bf16_f32 %0, %1, %2" : "=v"(r) : "v"(lo), "v"(hi)); return r; }
DEV float bf_lo(unsigned u) { return __uint_as_float(u << 16); }
DEV float bf_hi(unsigned u) { return __uint_as_float(u & 0xffff0000u); }
DEV f32x4 bf4(u32x2 u) { return (f32x4){__uint_as_float(u[0] << 16), __uint_as_float(u[0] & 0xffff0000u), __uint_as_float(u[1] << 16), __uint_as_float(u[1] & 0xffff0000u)}; }
DEV u32x2 pk4(f32x4 v) { u32x2 o; o[0] = cvt_pk_bf16(v[0], v[1]); o[1] = cvt_pk_bf16(v[2], v[3]); return o; }
DEV float bf2f(bf16_t b) { return __uint_as_float((unsigned)b << 16); }
DEV float sigmoidf_(float x) { return __builtin_amdgcn_rcpf(1.f + __expf(-x)); }
DEV float tanhf_(float y) { return 1.f - 2.f * __builtin_amdgcn_rcpf(1.f + __expf(2.f * y)); }
DEV float gelu_t(float x) { return 0.5f * x * (1.f + tanhf_(0.7978845608028654f * (x + 0.044715f * x * x * x))); }
DEV float wsum64(float v) {
#pragma unroll
    for (int o = 32; o >= 1; o >>= 1) v += __shfl_xor(v, o);
    return v;
}
DEV float wmax64(float v) {
#pragma unroll
    for (int o = 32; o >= 1; o >>= 1) v = fmaxf(v, __shfl_xor(v, o));
    return v;
}
template <int CTRL> DEV float dpp_f(float x) { return __builtin_bit_cast(float, __builtin_amdgcn_update_dpp(0, __builtin_bit_cast(int, x), CTRL, 0xf, 0xf, false)); }
DEV float rowsum16(float x) {
    x += dpp_f<0x128>(x); x += dpp_f<0x124>(x); x += dpp_f<0x122>(x); x += dpp_f<0x121>(x); return x;
}
DEV int fresh_tid() { int t = threadIdx.x; asm volatile("" : "+v"(t)); return t; }
DEV float rstd_of(const float* rs, int r) { const f32x4* q = (const f32x4*)(rs + (size_t)r * 16); const f32x4 p = (q[0] + q[1]) + (q[2] + q[3]); return rsqrtf(((p[0] + p[1]) + (p[2] + p[3])) * (1.f / 1024.f) + 1e-6f); }

#define XB_TMO      128
#define XB_XCNT(j)  (256  + 64 * (j))
#define XB_XSUB(j)  (1280 + 64 * (j))
#define XB_XGEN(j)  (2304 + 64 * (j))
#define XB_TOP      3328
#define XB_TOPGEN   3392
#define XCD_BAR_WORDS 3456
#define XB_SPIN_CAP (1u << 18)
DEV unsigned xb_ld(unsigned* p)              { return __hip_atomic_load(p, __ATOMIC_RELAXED, __HIP_MEMORY_SCOPE_AGENT); }
DEV unsigned xb_add(unsigned* p, unsigned v) { return __hip_atomic_fetch_add(p, v, __ATOMIC_RELAXED, __HIP_MEMORY_SCOPE_AGENT); }
DEV unsigned xb_xcc_id() { return (unsigned)__builtin_amdgcn_s_getreg((3 << 11) | 20) & 0xFu; }
#define XB_SPIN(cond, bar) do { unsigned _sp = 0; while (cond) { __builtin_amdgcn_s_sleep(1); \
    if ((++_sp & 255u) == 0u) { if (xb_ld(&(bar)[XB_TMO])) break; if (_sp > XB_SPIN_CAP) { atomicAdd(&(bar)[XB_TMO], 1u); break; } } } } while (0)
struct XcdBarrier { unsigned* bar; unsigned x; volatile LAS unsigned* st; };
DEV XcdBarrier xcd_barrier_post(unsigned* bar, volatile LAS unsigned* st) {
    XcdBarrier b; b.bar = bar; b.x = xb_xcc_id(); b.st = st;
    if (threadIdx.x == 0) (void)xb_add(&bar[XB_XCNT(b.x)], 1u);
    return b;
}
DEV void xcd_barrier_complete(unsigned* bar, unsigned x, unsigned& nloc, unsigned& nx) {
    const unsigned G = gridDim.x * gridDim.y * gridDim.z;
    unsigned sum, cnt, mine, sp = 0u;
    for (;;) {
        sum = 0u; cnt = 0u; mine = 0u;
#pragma unroll
        for (unsigned j = 0; j < 16; ++j) { const unsigned c = xb_ld(&bar[XB_XCNT(j)]); sum += c; cnt += (c > 0u) ? 1u : 0u; mine = (j == x) ? c : mine; }
        if (sum == G) break;
        __builtin_amdgcn_s_sleep(1);
        if ((++sp & 255u) == 0u) { if (xb_ld(&bar[XB_TMO])) break; if (sp > XB_SPIN_CAP) { atomicAdd(&bar[XB_TMO], 1u); break; } }
    }
    nloc = mine > 0u ? mine : 1u; nx = cnt > 0u ? cnt : 1u;
}
DEV void xcd_barrier(const XcdBarrier& b) {
    asm volatile("s_waitcnt vmcnt(0)" ::: "memory");
    __syncthreads();
    if (threadIdx.x == 0) {
        unsigned* bar = b.bar;
        __builtin_amdgcn_s_waitcnt(0);
        unsigned nloc = b.st[0], nx = b.st[1];
        if (nloc == 0u) { xcd_barrier_complete(bar, b.x, nloc, nx); b.st[0] = nloc; b.st[1] = nx; }
        const unsigned old = xb_add(&bar[XB_XSUB(b.x)], 1u);
        const unsigned gen = old / nloc;
        if (old + 1u == (gen + 1u) * nloc) {
            __builtin_amdgcn_fence(__ATOMIC_RELEASE, "agent");
            asm volatile("s_waitcnt vmcnt(0)" ::: "memory");
            const unsigned og = xb_add(&bar[XB_TOP], 1u);
            const unsigned tg = og / nx;
            if (og + 1u == (tg + 1u) * nx) xb_add(&bar[XB_TOPGEN], 1u);
            else XB_SPIN(xb_ld(&bar[XB_TOPGEN]) == tg, bar);
            __builtin_amdgcn_fence(__ATOMIC_ACQUIRE, "agent");
            xb_add(&bar[XB_XGEN(b.x)], 1u);
            asm volatile("s_waitcnt vmcnt(0)" ::: "memory");
        } else {
            XB_SPIN(xb_ld(&bar[XB_XGEN(b.x)]) == gen, bar);
            __builtin_amdgcn_fence(__ATOMIC_ACQUIRE, "agent");
            asm volatile("s_waitcnt vmcnt(0)" ::: "memory");
        }
    }
    __syncthreads();
}

namespace pg8 {
constexpr int BM = 256, BK = 64, HALF = 128, HTB = HALF * BK * 2, STAGE_BYTES = 8 * HTB, NXCD = 8, WGM = 8;
DEV int lds_byte(int r, int c) { const int st = (r >> 4) * 2 + (c >> 5), rr = r & 15, cc = c & 31, ob = rr * 64 + cc * 2; return st * 1024 + (ob ^ (((ob >> 9) & 1) << 5)); }
DEV void stage_rc(int b, int& R, int& C) { const int st = b / 1024, sb = b % 1024, swz = sb ^ (((sb >> 9) & 1) << 5); R = (st >> 1) * 16 + swz / 64; C = (st & 1) * 32 + (swz % 64) / 2; }

struct Unit { int pm, pn; long ao, bo; int x0, x1; };
struct Gemm { const bf16_t* A; const bf16_t* Bt; int lda, ldb, K; };

struct GridSched {
    int nM, nN, nwg, G, c; long ta, tb;
    DEV void init(int nM_, int nN_, int shift, int lda, int ldb) { nM = nM_; nN = nN_; nwg = nM * nN; G = (int)gridDim.x; c = ((int)blockIdx.x + G - (shift % G)) % G; ta = 256L * lda; tb = 256L * ldb; }
    DEV bool next(int i, Unit& u) const {
        const long L = (long)i * G + c; if (L >= nwg) return false;
        int wgid = (int)L; { const int q = nwg / NXCD, r = nwg % NXCD, xcd = wgid % NXCD, off = wgid / NXCD; wgid = (xcd < r ? xcd * (q + 1) : r * (q + 1) + (xcd - r) * q) + off; }
        const int nig = WGM * nN, gid = wgid / nig, fm = gid * WGM, gsz = (nM - fm) < WGM ? (nM - fm) : WGM;
        u.pm = fm + ((wgid % nig) % gsz); u.pn = (wgid % nig) / gsz; u.ao = u.pm * ta; u.bo = u.pn * tb; u.x0 = 0; u.x1 = 0; return true;
    }
};
struct LoraSched {
    int G, c;
    DEV void init() { G = (int)gridDim.x; c = (int)blockIdx.x; }
    DEV bool next(int i, Unit& u) const {
        const long L = (long)i * G + c; if (L >= 65 * 6) return false;
        const int pn = (int)L % 6, pm = (int)L / 6, off = (pn >= 4) ? 128 : 0;
        u.pm = pm; u.pn = pn; u.x0 = 0; u.x1 = 0; u.ao = (long)pm * 256 * 384 + off; u.bo = (long)pn * 256 * 384 + off; return true;
    }
};
template <int WHICH> struct AttnSched {
    int G, c;
    DEV void init() { G = (int)gridDim.x; c = (int)blockIdx.x; }
    DEV bool next(int i, Unit& u) const {
        const long L = (long)i * G + c; if (L >= 256) return false;
        const int xcd = (int)L & 7, idx = (int)L >> 3, bh = xcd * 4 + (idx >> 3), mt = idx & 7, b = bh >> 2, h = bh & 3;
        u.pm = mt; u.pn = 0; u.x0 = bh; u.x1 = mt;
        if (WHICH == 0) { u.ao = ((long)b * 2048 + mt * 256) * 1024 + h * 256; u.bo = ((long)b * 256) * 1024 + h * 256; }
        else { u.ao = ((long)bh * 2048 + mt * 256) * 256; u.bo = ((long)h * 256) * 2048 + b * 256; }
        return true;
    }
};

template <class Epi, class Sched>
DEV void gemm_phase(LAS unsigned char* lds, const Gemm g, const Sched& S, const Epi& E) {
    int tid_ = threadIdx.x; asm volatile("" : "+v"(tid_));
    const int tid = tid_, wid = __builtin_amdgcn_readfirstlane(tid >> 6), lane = tid & 63, wr = wid >> 2, wc = wid & 3, fr = lane & 15, fq = lane >> 4;
    int K = g.K, lda_ = g.lda, ldb_ = g.ldb; asm volatile("" : "+s"(K), "+s"(lda_), "+s"(ldb_)); const int nt = K / BK;
    unsigned voffA[2], voffB[2];
#pragma unroll
    for (int i = 0; i < 2; ++i) { int R, C; stage_rc(tid * 16 + i * 8192, R, C); voffA[i] = (unsigned)(R * lda_ + C) * 2u; voffB[i] = (unsigned)(R * ldb_ + C) * 2u; }
    const size_t kstep = (size_t)(BK * 2);
    const size_t hstepA = (size_t)HALF * lda_ * 2, hstepB = (size_t)HALF * ldb_ * 2;
    const unsigned ldsw = (unsigned)wid * 1024u;
    const int aoff = lds_byte(wr * 64 + fr, fq * 8), boff = lds_byte(wc * 32 + fr, fq * 8);
#define PG8_SA(b, h) (((b) * 2 + (h)) * HTB)
#define PG8_SB(b, h) ((4 + (b) * 2 + (h)) * HTB)
#define PG8_STAGE(bufoff, gbase, voff) do { _Pragma("unroll") for (int _i = 0; _i < 2; ++_i) \
        __builtin_amdgcn_global_load_lds((const unsigned*)((const char*)(gbase) + (voff)[_i]), (LAS unsigned*)(lds + (bufoff) + ldsw + _i * 8192), 16, 0, 0); } while (0)
#define PG8_LDA(dst, b, h) do { _Pragma("unroll") for (int m = 0; m < 4; ++m) _Pragma("unroll") for (int k = 0; k < 2; ++k) dst[m][k] = *(const LAS bf16x8*)(lds + PG8_SA(b, h) + aoff + m * 2048 + k * 1024); } while (0)
#define PG8_LDB(dst, b, h) do { _Pragma("unroll") for (int n = 0; n < 2; ++n) _Pragma("unroll") for (int k = 0; k < 2; ++k) dst[n][k] = *(const LAS bf16x8*)(lds + PG8_SB(b, h) + boff + n * 2048 + k * 1024); } while (0)
#define PG8_MMA(ai, bj, At, Bt) do { __builtin_amdgcn_s_setprio(1); _Pragma("unroll") for (int m = 0; m < 4; ++m) _Pragma("unroll") for (int n = 0; n < 2; ++n) _Pragma("unroll") for (int k = 0; k < 2; ++k) \
        acc[ai][bj][m][n] = __builtin_amdgcn_mfma_f32_16x16x32_bf16(Bt[n][k], At[m][k], acc[ai][bj][m][n], 0, 0, 0); __builtin_amdgcn_s_setprio(0); } while (0)
#define PG8_WAIT_V(n) asm volatile("s_waitcnt vmcnt(" #n ")" ::: "memory")
#define PG8_WAIT_L(n) asm volatile("s_waitcnt lgkmcnt(" #n ")" ::: "memory")
#define PG8_BAR __builtin_amdgcn_s_barrier()
#define PG8_SCHED __builtin_amdgcn_sched_barrier(0)
    Unit cur, nxt; int ui = 0;
    if (!S.next(0, cur)) return;
    f32x4 acc[2][2][4][2];
#pragma unroll
    for (int a = 0; a < 2; ++a)
#pragma unroll
        for (int b = 0; b < 2; ++b)
#pragma unroll
            for (int m = 0; m < 4; ++m)
#pragma unroll
                for (int n = 0; n < 2; ++n) acc[a][b][m][n] = (f32x4){0.f, 0.f, 0.f, 0.f};
    bf16x8 At[4][2], B0[2][2], B1[2][2];
    const char* cA = (const char*)g.A + (size_t)cur.ao * 2; const char* cB = (const char*)g.Bt + (size_t)cur.bo * 2;
    PG8_STAGE(PG8_SB(0, 0), cB, voffB); PG8_STAGE(PG8_SA(0, 0), cA, voffA); PG8_STAGE(PG8_SB(0, 1), cB + hstepB, voffB); PG8_STAGE(PG8_SA(0, 1), cA + hstepA, voffA);
    if (wr == 1) PG8_BAR;
    PG8_WAIT_V(4); PG8_BAR;
    PG8_STAGE(PG8_SB(1, 0), cB + kstep, voffB); PG8_STAGE(PG8_SA(1, 0), cA + kstep, voffA); PG8_STAGE(PG8_SB(1, 1), cB + hstepB + kstep, voffB);
    PG8_WAIT_V(6); PG8_BAR;
    for (;;) {
        const bool has_next = S.next(ui + 1, nxt);
        const char* nA = has_next ? (const char*)g.A + (size_t)nxt.ao * 2 : cA; const char* nB = has_next ? (const char*)g.Bt + (size_t)nxt.bo * 2 : cB;
#pragma unroll 1
        for (int t = 0; t < nt; t += 2) {
            const bool last = (t == nt - 2);
            const char* a1 = cA + (size_t)(t + 1) * kstep;
            const char* a2 = last ? nA : cA + (size_t)(t + 2) * kstep; const char* b2 = last ? nB : cB + (size_t)(t + 2) * kstep;
            const char* a3 = a2 + kstep; const char* b3 = b2 + kstep;
            PG8_LDB(B0, 0, 0); PG8_SCHED; PG8_LDA(At, 0, 0); PG8_STAGE(PG8_SA(1, 1), a1 + hstepA, voffA);
            PG8_WAIT_L(8); PG8_BAR; PG8_WAIT_L(0); PG8_MMA(0, 0, At, B0); PG8_BAR; PG8_SCHED;
            PG8_LDB(B1, 0, 1); PG8_STAGE(PG8_SB(0, 0), b2, voffB);
            PG8_BAR; PG8_WAIT_L(0); PG8_MMA(0, 1, At, B1); PG8_BAR;
            PG8_LDA(At, 0, 1); PG8_STAGE(PG8_SA(0, 0), a2, voffA);
            PG8_BAR; PG8_WAIT_L(0); PG8_MMA(1, 0, At, B0); PG8_BAR; PG8_SCHED;
            PG8_STAGE(PG8_SB(0, 1), b2 + hstepB, voffB);
            PG8_WAIT_V(6); PG8_BAR; PG8_MMA(1, 1, At, B1); PG8_BAR;
            PG8_LDB(B0, 1, 0); PG8_SCHED; PG8_LDA(At, 1, 0); PG8_STAGE(PG8_SA(0, 1), a2 + hstepA, voffA);
            PG8_WAIT_L(8); PG8_BAR; PG8_WAIT_L(0); PG8_MMA(0, 0, At, B0); PG8_BAR; PG8_SCHED;
            PG8_LDB(B1, 1, 1); PG8_STAGE(PG8_SB(1, 0), b3, voffB);
            PG8_BAR; PG8_WAIT_L(0); PG8_MMA(0, 1, At, B1); PG8_BAR;
            PG8_LDA(At, 1, 1); PG8_STAGE(PG8_SA(1, 0), a3, voffA);
            PG8_BAR; PG8_WAIT_L(0); PG8_MMA(1, 0, At, B0); PG8_BAR; PG8_SCHED;
            PG8_STAGE(PG8_SB(1, 1), b3 + hstepB, voffB);
            PG8_WAIT_V(6); PG8_BAR; PG8_MMA(1, 1, At, B1); PG8_BAR;
        }
        E(acc, cur, wr, wc, fr, fq);
        if (!has_next) break;
#pragma unroll
        for (int a = 0; a < 2; ++a)
#pragma unroll
            for (int b = 0; b < 2; ++b)
#pragma unroll
                for (int m = 0; m < 4; ++m)
#pragma unroll
                    for (int n = 0; n < 2; ++n) acc[a][b][m][n] = (f32x4){0.f, 0.f, 0.f, 0.f};
        cur = nxt; cA = nA; cB = nB; ++ui;
    }
    PG8_WAIT_V(0);
    if (wr == 0) PG8_BAR;
    PG8_BAR;
#undef PG8_SA
#undef PG8_SB
#undef PG8_STAGE
#undef PG8_LDA
#undef PG8_LDB
#undef PG8_MMA
#undef PG8_WAIT_V
#undef PG8_WAIT_L
#undef PG8_BAR
#undef PG8_SCHED
}
}
using pg8::Unit;

typedef const f32x4 (&AccRef)[2][2][4][2];

struct EpiSwiglu {
    const float* rs; bf16_t* H;
    DEV void operator()(AccRef acc, const Unit& u, int wr, int wc, int fr, int fq) const {
        const int row0 = u.pm * 256 + wr * 64 + fr, hc0 = u.pn * 128 + wc * 16 + 4 * fq;
#pragma unroll
        for (int ai = 0; ai < 2; ++ai)
#pragma unroll
            for (int m = 0; m < 4; ++m) {
                const int r = row0 + ai * 128 + m * 16; const float rstd = rstd_of(rs, r);
#pragma unroll
                for (int bj = 0; bj < 2; ++bj) {
                    float hv[4];
#pragma unroll
                    for (int i = 0; i < 4; ++i) { const float gt = acc[ai][bj][m][0][i] * rstd, up = acc[ai][bj][m][1][i] * rstd; hv[i] = gt * sigmoidf_(gt) * up; }
                    u32x2 o; o[0] = cvt_pk_bf16(hv[0], hv[1]); o[1] = cvt_pk_bf16(hv[2], hv[3]);
                    *(u32x2*)(H + (size_t)r * DFF + hc0 + bj * 64) = o;
                }
            }
    }
};

struct EpiRes {
    const float* res; bf16_t* xb; float* rs_out; float alpha;
    DEV void operator()(AccRef acc, const Unit& u, int wr, int wc, int fr, int fq) const {
        const int row0 = u.pm * 256 + wr * 64 + fr, col0 = u.pn * 256 + wc * 32 + 4 * fq;
#pragma unroll
        for (int ai = 0; ai < 2; ++ai)
#pragma unroll
            for (int mh = 0; mh < 2; ++mh) {
                f32x4 x[2][2][2];
#pragma unroll
                for (int m2 = 0; m2 < 2; ++m2)
#pragma unroll
                    for (int bj = 0; bj < 2; ++bj)
#pragma unroll
                        for (int n = 0; n < 2; ++n) { const size_t o = (size_t)(row0 + ai * 128 + (mh * 2 + m2) * 16) * 1024 + col0 + bj * 128 + n * 16;
                            x[m2][bj][n] = res ? *(const f32x4*)(res + o) : bf4(*(const u32x2*)(xb + o)); }
#pragma unroll
                for (int m2 = 0; m2 < 2; ++m2) {
                    const int m = mh * 2 + m2, r = row0 + ai * 128 + m * 16; float s = 0.f;
#pragma unroll
                    for (int bj = 0; bj < 2; ++bj)
#pragma unroll
                        for (int n = 0; n < 2; ++n) {
                            const int c = col0 + bj * 128 + n * 16; const f32x4 v = x[m2][bj][n] + alpha * acc[ai][bj][m][n];
                            *(u32x2*)(xb + (size_t)r * 1024 + c) = pk4(v);
                            s += v[0] * v[0] + v[1] * v[1] + v[2] * v[2] + v[3] * v[3];
                        }
                    s += __shfl_xor(s, 16); s += __shfl_xor(s, 32);
                    if (fq == 0) rs_out[(size_t)r * 16 + u.pn * 4 + wc] = s;
                }
            }
    }
};

struct EpiScale {
    const float* rs; bf16_t* O; int ldo, ncols;
    DEV void operator()(AccRef acc, const Unit& u, int wr, int wc, int fr, int fq) const {
        const int row0 = u.pm * 256 + wr * 64 + fr, col0 = u.pn * 256 + wc * 32 + 4 * fq;
#pragma unroll
        for (int ai = 0; ai < 2; ++ai)
#pragma unroll
            for (int m = 0; m < 4; ++m) {
                const int r = row0 + ai * 128 + m * 16; const float rstd = rstd_of(rs, r);
#pragma unroll
                for (int bj = 0; bj < 2; ++bj)
#pragma unroll
                    for (int n = 0; n < 2; ++n) {
                        const int c = col0 + bj * 128 + n * 16;
                        if (c < ncols) { const f32x4 v = acc[ai][bj][m][n] * rstd; u32x2 o; o[0] = cvt_pk_bf16(v[0], v[1]); o[1] = cvt_pk_bf16(v[2], v[3]); *(u32x2*)(O + (size_t)r * ldo + c) = o; }
                    }
            }
    }
};

struct EpiLora {
    const float* w0; const float* a0; const float* k_a; float* dec; bf16_t* kbuf; const bf16_t* kkbuf; bf16_t* kka; bf16_t* gb;
    template <int REGION> DEV void run(AccRef acc, const Unit& u, int wr, int wc, int fr, int fq) const {
        const int row0 = u.pm * 256 + wr * 64 + fr, cb = (u.pn & 1) * 256 + wc * 32 + 4 * fq;
#pragma unroll
        for (int ai = 0; ai < 2; ++ai)
#pragma unroll
            for (int m = 0; m < 4; ++m) {
                const int r = row0 + ai * 128 + m * 16;
                {
#pragma unroll
                    for (int bj = 0; bj < 2; ++bj)
#pragma unroll
                        for (int n = 0; n < 2; ++n) {
                            const int cc = cb + bj * 128 + n * 16; const f32x4 a = acc[ai][bj][m][n]; const size_t o = (size_t)r * 512 + cc;
                            if (REGION == 0) {
                                const f32x4 b0 = *(const f32x4*)(w0 + cc); f32x4 d;
#pragma unroll
                                for (int i = 0; i < 4; ++i) d[i] = __expf(-0.60653066f * sigmoidf_(b0[i] + a[i]));
                                *(f32x4*)(dec + o) = d;
                            } else if (REGION == 1) {
                                const f32x4 b0 = *(const f32x4*)(a0 + cc), ka = *(const f32x4*)(k_a + cc), kv = bf4(*(const u32x2*)(kbuf + o)), kkv = bf4(*(const u32x2*)(kkbuf + o)); f32x4 kn, kkan;
#pragma unroll
                                for (int i = 0; i < 4; ++i) { const float av = sigmoidf_(b0[i] + a[i]); kn[i] = kv[i] * (1.f + (av - 1.f) * ka[i]); kkan[i] = kkv[i] * av; }
                                *(u32x2*)(kbuf + o) = pk4(kn); *(u32x2*)(kka + o) = pk4(kkan);
                            } else {
                                u32x2 ov; ov[0] = cvt_pk_bf16(a[0], a[1]); ov[1] = cvt_pk_bf16(a[2], a[3]); *(u32x2*)(gb + o) = ov;
                            }
                        }
                }
            }
    }
    DEV void operator()(AccRef acc, const Unit& u, int wr, int wc, int fr, int fq) const {
        const int region = u.pn >> 1;
        if (region == 0) run<0>(acc, u, wr, wc, fr, fq); else if (region == 1) run<1>(acc, u, wr, wc, fr, fq); else run<2>(acc, u, wr, wc, fr, fq);
    }
};

struct EpiK {
    const float* rstdm; float* outk; bf16_t* mkb;
    DEV void operator()(AccRef acc, const Unit& u, int wr, int wc, int fr, int fq) const {
        const int row0 = u.pm * 256 + wr * 64 + fr, col0 = u.pn * 256 + wc * 32 + 4 * fq;
#pragma unroll
        for (int ai = 0; ai < 2; ++ai)
#pragma unroll
            for (int m = 0; m < 4; ++m) {
                const int r = row0 + ai * 128 + m * 16; const float rstd = rstdm[r];
#pragma unroll
                for (int bj = 0; bj < 2; ++bj)
#pragma unroll
                    for (int n = 0; n < 2; ++n) {
                        const int c = col0 + bj * 128 + n * 16; const f32x4 v = acc[ai][bj][m][n] * rstd;
                        *(f32x4*)(outk + (size_t)r * 1024 + c) = v;
                        u32x2 o; o[0] = cvt_pk_bf16(v[0], v[1]); o[1] = cvt_pk_bf16(v[2], v[3]); *(u32x2*)(mkb + (size_t)r * 1024 + c) = o;
                    }
            }
    }
};
struct EpiVT {
    const float* rstdm; float* outv; bf16_t* vt;
    DEV void operator()(AccRef acc, const Unit& u, int wr, int wc, int fr, int fq) const {
        const int row0 = u.pm * 256 + wr * 64 + fr, col0 = u.pn * 256 + wc * 32 + 4 * fq;
#pragma unroll
        for (int bj = 0; bj < 2; ++bj)
#pragma unroll
            for (int n = 0; n < 2; ++n) {
                const int c = col0 + bj * 128 + n * 16; const f32x4 rsd = *(const f32x4*)(rstdm + c);
#pragma unroll
                for (int ai = 0; ai < 2; ++ai)
#pragma unroll
                    for (int m = 0; m < 4; ++m) {
                        const int r = row0 + ai * 128 + m * 16; const f32x4 v = acc[ai][bj][m][n] * rsd;
                        u32x2 o; o[0] = cvt_pk_bf16(v[0], v[1]); o[1] = cvt_pk_bf16(v[2], v[3]); *(u32x2*)(vt + (size_t)r * 2048 + c) = o;
#pragma unroll
                        for (int i = 0; i < 4; ++i) outv[(size_t)(c + i) * 1024 + r] = v[i];
                    }
            }
    }
};
struct EpiS {
    bf16_t* P; float* psum;
    DEV void operator()(AccRef acc, const Unit& u, int wr, int wc, int fr, int fq) const {
        const size_t prow0 = (size_t)u.x0 * 2048 + u.x1 * 256;
#pragma unroll
        for (int ai = 0; ai < 2; ++ai)
#pragma unroll
            for (int m = 0; m < 4; ++m) {
                const int rl = ai * 128 + wr * 64 + m * 16 + fr; float s = 0.f;
#pragma unroll
                for (int bj = 0; bj < 2; ++bj)
#pragma unroll
                    for (int n = 0; n < 2; ++n) {
                        const f32x4 a = acc[ai][bj][m][n]; u32x2 o;
                        o[0] = cvt_pk_bf16(__expf(a[0]), __expf(a[1])); o[1] = cvt_pk_bf16(__expf(a[2]), __expf(a[3]));
                        s += bf_lo(o[0]) + bf_hi(o[0]) + bf_lo(o[1]) + bf_hi(o[1]);
                        *(u32x2*)(P + (prow0 + rl) * 256 + bj * 128 + wc * 32 + n * 16 + 4 * fq) = o;
                    }
                s += __shfl_xor(s, 16); s += __shfl_xor(s, 32);
                if (fq == 0) psum[(prow0 + rl) * 4 + wc] = s;
            }
    }
};
struct EpiO {
    const float* psum; bf16_t* O;
    DEV void operator()(AccRef acc, const Unit& u, int wr, int wc, int fr, int fq) const {
        const int bh = u.x0, b = bh >> 2, h = bh & 3; const size_t prow0 = (size_t)bh * 2048 + u.x1 * 256; const size_t m0 = (size_t)b * 2048 + u.x1 * 256;
#pragma unroll
        for (int ai = 0; ai < 2; ++ai)
#pragma unroll
            for (int m = 0; m < 4; ++m) {
                const int rl = ai * 128 + wr * 64 + m * 16 + fr; const f32x4 p = *(const f32x4*)(psum + (prow0 + rl) * 4); const float inv = __builtin_amdgcn_rcpf(p[0] + p[1] + p[2] + p[3]);
#pragma unroll
                for (int bj = 0; bj < 2; ++bj)
#pragma unroll
                    for (int n = 0; n < 2; ++n) {
                        const f32x4 v = acc[ai][bj][m][n] * inv; u32x2 o; o[0] = cvt_pk_bf16(v[0], v[1]); o[1] = cvt_pk_bf16(v[2], v[3]);
                        *(u32x2*)(O + (m0 + rl) * 1024 + h * 256 + bj * 128 + wc * 32 + n * 16 + 4 * fq) = o;
                    }
            }
    }
};

struct SRes {
    const float* res; bf16_t* xb; float* rs_out; float alpha; int res_row0;
    DEV void operator()(int r, int c, f32x4 a, int slab, int l15) const {
        const f32x4 x0 = res ? *(const f32x4*)(res + (size_t)(r - res_row0) * 1024 + c) : bf4(*(const u32x2*)(xb + (size_t)r * 1024 + c));
        const f32x4 x = x0 + alpha * a;
        *(u32x2*)(xb + (size_t)r * 1024 + c) = pk4(x);
        const float s = rowsum16(x[0] * x[0] + x[1] * x[1] + x[2] * x[2] + x[3] * x[3]);
        if (l15 == 0) rs_out[(size_t)r * 16 + slab] = s;
    }
};
struct SScale {
    const float* rs; bf16_t* O; int ldo, ncols, col_off;
    DEV void operator()(int r, int c, f32x4 a, int, int) const {
        const int cc = c + col_off;
        if (cc < ncols) { const f32x4 v = a * rstd_of(rs, r); u32x2 o; o[0] = cvt_pk_bf16(v[0], v[1]); o[1] = cvt_pk_bf16(v[2], v[3]); *(u32x2*)(O + (size_t)r * ldo + cc) = o; }
    }
};
template <int NB, class Epi>
DEV void small_gemm(LAS unsigned char* lds, const bf16_t* A, int lda, const bf16_t* Bt, int ldb, int K, int row_base, int nrg, int nslab, const Epi& E) {
    const int tid = fresh_tid(), lane = tid & 63, w = tid >> 6, l15 = lane & 15, kg = lane >> 4;
    LAS float* red = (LAS float*)lds;
    const int kw = K >> 3;
    for (int item = blockIdx.x; item < nrg * nslab; item += gridDim.x) {
        const int rgi = item % nrg, slab = item / nrg, r0 = row_base + rgi * 32, c0 = slab * 64;
        f32x4 acc[2][4];
#pragma unroll
        for (int rb = 0; rb < 2; ++rb)
#pragma unroll
            for (int n = 0; n < 4; ++n) acc[rb][n] = (f32x4){0.f, 0.f, 0.f, 0.f};
        const bf16_t* ap = A + (size_t)(r0 + l15) * lda + w * kw + kg * 8;
        const bf16_t* bp = Bt + (size_t)(c0 + l15) * ldb + w * kw + kg * 8;
#pragma unroll 4
        for (int k = 0; k < kw; k += 32) {
            const bf16x8 a0 = *(const bf16x8*)(ap + k), a1 = *(const bf16x8*)(ap + (size_t)16 * lda + k);
            bf16x8 b[NB];
#pragma unroll
            for (int n = 0; n < NB; ++n) b[n] = *(const bf16x8*)(bp + (size_t)(n * 16) * ldb + k);
#pragma unroll
            for (int n = 0; n < NB; ++n) { acc[0][n] = __builtin_amdgcn_mfma_f32_16x16x32_bf16(b[n], a0, acc[0][n], 0, 0, 0); acc[1][n] = __builtin_amdgcn_mfma_f32_16x16x32_bf16(b[n], a1, acc[1][n], 0, 0, 0); }
        }
        __syncthreads();
#pragma unroll
        for (int rb = 0; rb < 2; ++rb)
#pragma unroll
            for (int n = 0; n < 4; ++n) *(LAS f32x4*)(red + ((w * 32 + rb * 16 + l15) * 64 + n * 16 + 4 * kg)) = acc[rb][n];
        __syncthreads();
        const int row = tid >> 4, c4 = (tid & 15) * 4; f32x4 sum = (f32x4){0.f, 0.f, 0.f, 0.f};
#pragma unroll
        for (int ww = 0; ww < 8; ++ww) sum = sum + *(const LAS f32x4*)(red + ((ww * 32 + row) * 64 + c4));
        E(r0 + row, c0 + c4, sum, slab, tid & 15);
    }
}

DEV void ld8bf(const bf16_t* p, float (&v)[8]) { const u32x4 u = *(const u32x4*)p;
#pragma unroll
    for (int i = 0; i < 4; ++i) { v[2 * i] = bf_lo(u[i]); v[2 * i + 1] = bf_hi(u[i]); } }
DEV void ld8f(const float* p, float (&v)[8]) { const f32x4 a = *(const f32x4*)p, b = *(const f32x4*)(p + 4);
#pragma unroll
    for (int i = 0; i < 4; ++i) { v[i] = a[i]; v[4 + i] = b[i]; } }
DEV void st8f(float* p, const float (&v)[8]) { *(f32x4*)p = (f32x4){v[0], v[1], v[2], v[3]}; *(f32x4*)(p + 4) = (f32x4){v[4], v[5], v[6], v[7]}; }
DEV void st8bf(bf16_t* p, const float (&v)[8]) { u32x4 o; o[0] = cvt_pk_bf16(v[0], v[1]); o[1] = cvt_pk_bf16(v[2], v[3]); o[2] = cvt_pk_bf16(v[4], v[5]); o[3] = cvt_pk_bf16(v[6], v[7]); *(u32x4*)p = o; }

DEV void tr_job(const float* __restrict__ src, int Ks, int Ns, int Nd, bf16_t* __restrict__ dst, int mode, const float* __restrict__ gain, float scale, LAS float* tile) {
    const int nk = Ks / 64, nn = Nd / 64, ntile = nk * nn, ldd = Ks; const int t = fresh_tid();
    f32x4 v0, v1;
    auto gl = [&](int ti) { const int tk = ti % nk, tn = ti / nk;
        { const int id = t, k = id >> 4, gn = tn * 64 + (id & 15) * 4; v0 = (gn < Ns) ? *(const f32x4*)(src + (size_t)(tk * 64 + k) * Ns + gn) : (f32x4){0.f, 0.f, 0.f, 0.f}; if (gain) v0 = v0 * (gain[tk * 64 + k] * scale); }
        { const int id = t + 512, k = id >> 4, gn = tn * 64 + (id & 15) * 4; v1 = (gn < Ns) ? *(const f32x4*)(src + (size_t)(tk * 64 + k) * Ns + gn) : (f32x4){0.f, 0.f, 0.f, 0.f}; if (gain) v1 = v1 * (gain[tk * 64 + k] * scale); } };
    int ti = blockIdx.x;
    if (ti < ntile) gl(ti);
    for (; ti < ntile; ti += gridDim.x) {
        const int tk = ti % nk, tn = ti / nk;
        *(LAS f32x4*)(tile + (t >> 4) * 68 + (t & 15) * 4) = v0; *(LAS f32x4*)(tile + ((t + 512) >> 4) * 68 + (t & 15) * 4) = v1;
        if (ti + (int)gridDim.x < ntile) gl(ti + gridDim.x);
        __syncthreads();
        { const int n = t & 63, k8 = (t >> 6) * 8, gn = tn * 64 + n; float v[8];
#pragma unroll
          for (int j = 0; j < 8; ++j) v[j] = tile[(k8 + j) * 68 + n];
          const int drow = mode == 0 ? gn : ((gn >> 4) * 32 + (mode == 2 ? 16 : 0) + (gn & 15));
          st8bf(dst + (size_t)drow * ldd + tk * 64 + k8, v); }
        __syncthreads();
    }
}

DEV void phase_prep(const Params& p, LAS unsigned char* lds) {
    unsigned char* ws = p.ws; LAS float* tile = (LAS float*)lds;
    const int tid = fresh_tid(), lane = tid & 63, gw = blockIdx.x * 8 + (tid >> 6), nw = gridDim.x * 8;
    bf16_t* xb = (bf16_t*)(ws + O_XB); float* rs1 = (float*)(ws + O_RS1);
#pragma unroll 2
    for (int r = gw; r < MP; r += nw) {
        float ss = 0.f;
        if (r < MV) {
            const float* xr = r < NTOK ? p.in[I_XP] + (size_t)r * 1024 : p.in[I_XS] + (size_t)(r - NTOK) * 1024;
#pragma unroll
            for (int i = 0; i < 4; ++i) { const int c = lane * 4 + 256 * i; const f32x4 v = *(const f32x4*)(xr + c); ss += v[0] * v[0] + v[1] * v[1] + v[2] * v[2] + v[3] * v[3];
                u32x2 o; o[0] = cvt_pk_bf16(v[0], v[1]); o[1] = cvt_pk_bf16(v[2], v[3]); *(u32x2*)(xb + (size_t)r * 1024 + c) = o; }
            ss = wsum64(ss);
        } else {
#pragma unroll
            for (int i = 0; i < 4; ++i) { u32x2 o; o[0] = 0; o[1] = 0; *(u32x2*)(xb + (size_t)r * 1024 + lane * 4 + 256 * i) = o; }
        }
        if (lane < 16) { rs1[(size_t)r * 16 + lane] = lane == 0 ? ss : 0.f;
            if (r >= MV) { ((float*)(ws + O_RS2))[(size_t)r * 16 + lane] = 0.f; ((float*)(ws + O_RS3))[(size_t)r * 16 + lane] = 0.f; ((float*)(ws + O_RS4))[(size_t)r * 16 + lane] = 0.f; ((float*)(ws + O_RS5))[(size_t)r * 16 + lane] = 0.f; } }
    }
    bf16_t* mnb = (bf16_t*)(ws + O_MNB); float* rstdm = (float*)(ws + O_RSTDM);
    for (int r = gw; r < NMEMR; r += nw) {
        const float* xr = p.in[I_MEM] + (size_t)r * 1024; float ss = 0.f;
#pragma unroll
        for (int i = 0; i < 4; ++i) { const int c = lane * 4 + 256 * i; const f32x4 v = *(const f32x4*)(xr + c); ss += v[0] * v[0] + v[1] * v[1] + v[2] * v[2] + v[3] * v[3];
            u32x2 o; o[0] = cvt_pk_bf16(v[0], v[1]); o[1] = cvt_pk_bf16(v[2], v[3]); *(u32x2*)(mnb + (size_t)r * 1024 + c) = o; }
        ss = wsum64(ss);
        if (lane == 0) rstdm[r] = rsqrtf(ss * (1.f / 1024.f) + 1e-6f);
    }
    { bf16_t* wl = (bf16_t*)(ws + O_WLORA);
      for (int i = blockIdx.x * 512 + tid; i < 1536 * 384; i += gridDim.x * 512) {
          const int n = i / 384, k = i % 384, reg = n >> 9, c = n & 511; float v = 0.f;
          if (reg == 0 && k < 64) v = p.in[I_W2][k * 512 + c];
          else if (reg == 1 && k >= 64 && k < 128) v = p.in[I_A2][(k - 64) * 512 + c];
          else if (reg == 2 && k >= 128 && k < 288) v = p.in[I_G2][(k - 128) * 512 + c];
          wl[i] = (bf16_t)(cvt_pk_bf16(v, 0.f) & 0xffffu);
      } }
    tr_job(p.in[I_G1], 1024, 2816, 2816, (bf16_t*)(ws + O_WGU1), 1, p.in[I_LN1], 1.f, tile);
    tr_job(p.in[I_U1], 1024, 2816, 2816, (bf16_t*)(ws + O_WGU1), 2, p.in[I_LN1], 1.f, tile);
    tr_job(p.in[I_XK], 1024, 1024, 1024, (bf16_t*)(ws + O_WK), 0, p.in[I_MEMN], 1.f, tile);
    tr_job(p.in[I_XV], 1024, 1024, 1024, (bf16_t*)(ws + O_WV), 0, p.in[I_MEMN], 1.f, tile);
    tr_job(p.in[I_D1], 2816, 1024, 1024, (bf16_t*)(ws + O_WD1), 0, nullptr, 1.f, tile);
    tr_job(p.in[I_WIN], 1024, 2848, 3072, (bf16_t*)(ws + O_WIN), 0, p.in[I_LNMIX], 1.f, tile);
    tr_job(p.in[I_WOUT], 1024, 1024, 1024, (bf16_t*)(ws + O_WOUT), 0, nullptr, 1.f, tile);
    tr_job(p.in[I_XQ], 1024, 1024, 1024, (bf16_t*)(ws + O_WQ), 0, p.in[I_LNX], 0.0625f, tile);
    tr_job(p.in[I_XO], 1024, 1024, 1024, (bf16_t*)(ws + O_WO), 0, nullptr, 1.f, tile);
    tr_job(p.in[I_G2F], 1024, 2816, 2816, (bf16_t*)(ws + O_WGU2), 1, p.in[I_LN2], 1.f, tile);
    tr_job(p.in[I_U2F], 1024, 2816, 2816, (bf16_t*)(ws + O_WGU2), 2, p.in[I_LN2], 1.f, tile);
    tr_job(p.in[I_D2F], 2816, 1024, 1024, (bf16_t*)(ws + O_WD2), 0, nullptr, 1.f, tile);
}

DEV void phase_mixprep(const Params& p) {
    unsigned char* ws = p.ws; const int tid = fresh_tid(), lane = tid & 63, gw = blockIdx.x * 8 + (tid >> 6), nw = gridDim.x * 8;
    const bf16_t* z = (const bf16_t*)(ws + O_Z); bf16_t* vab = (bf16_t*)(ws + O_VAB); bf16_t* lin = (bf16_t*)(ws + O_LIN); bf16_t* ymix = (bf16_t*)(ws + O_YMIX);
    bf16_t* rbuf = (bf16_t*)(ws + O_H); bf16_t* kbuf = (bf16_t*)(ws + O_H + HALFROW); bf16_t* vbuf = (bf16_t*)(ws + O_XRES); bf16_t* kkbuf = (bf16_t*)(ws + O_KK);
#pragma unroll 2
    for (int r = gw; r < MV; r += nw) {
        const bf16_t* zr = z + (size_t)r * ZLD; const bool smp = r >= NTOK; const int t = r & (SEQ - 1), si = r - NTOK;
        {
            const int c = lane * 8; float v[8]; ld8bf(zr + 512 + c, v); float s = 0.f;
#pragma unroll
            for (int i = 0; i < 8; ++i) { v[i] = gelu_t(v[i]); s += v[i]; }
            const float mu = wsum64(s) * (1.f / 512.f); float q = 0.f;
#pragma unroll
            for (int i = 0; i < 8; ++i) { v[i] -= mu; q += v[i] * v[i]; }
            const float rstd = rsqrtf(wsum64(q) * (1.f / 512.f) + 1e-5f); float g[8], b[8]; ld8f(p.in[I_SLNG] + c, g); ld8f(p.in[I_SLNB] + c, b);
#pragma unroll
            for (int i = 0; i < 8; ++i) v[i] = v[i] * rstd * g[i] + b[i];
            st8bf(vab + (size_t)r * 512 + c, v);
            if (smp) {
                st8f(p.out + OUT_CV + (size_t)si * 512 + c, v);
                const int grp = c >> 6; const float w00 = p.in[I_SGUW][grp * 16384], b0 = p.in[I_SGUB][grp * 128]; float uu[8]; ld8bf(zr + c, uu);
#pragma unroll
                for (int i = 0; i < 8; ++i) uu[i] = gelu_t(uu[i]) * (w00 * v[i] + b0);
                st8bf(ymix + (size_t)r * 1024 + c, uu);
            }
        }
#pragma unroll
        for (int it = 0; it < 4; ++it) {
            const int ch = lane + 64 * it; if (ch >= 228) break;
            const int cb = ch * 8; float cur[8], prv[8], mu[8], zs[8]; ld8bf(zr + 1024 + cb, cur);
            if (smp) ld8f(p.in[I_SSHIFT] + (size_t)si * BPROJ + cb, prv);
            else if (t == 0) {
#pragma unroll
                for (int i = 0; i < 8; ++i) prv[i] = 0.f;
            } else ld8bf(zr - ZLD + 1024 + cb, prv);
            ld8f(p.in[I_MU] + cb, mu);
#pragma unroll
            for (int i = 0; i < 8; ++i) zs[i] = cur[i] + (prv[i] - cur[i]) * mu[i];
            if (smp) st8f(p.out + OUT_SHS + (size_t)si * BPROJ + cb, cur);
            else if (t == SEQ - 1) st8f(p.out + OUT_SHP + (size_t)(r >> 11) * BPROJ + cb, cur);
            if (it == 0) st8bf(rbuf + (size_t)r * 512 + cb, zs);
            else if (it == 1) {
                const int c = cb - 512; st8bf(kbuf + (size_t)r * 512 + c, zs); float kkw[8], kk[8]; ld8f(p.in[I_KK] + c, kkw); float ss = 0.f;
#pragma unroll
                for (int i = 0; i < 8; ++i) { kk[i] = zs[i] * kkw[i]; ss += kk[i] * kk[i]; }
                ss += __shfl_xor(ss, 1); ss += __shfl_xor(ss, 2); ss += __shfl_xor(ss, 4);
                const float rn = rsqrtf(fmaxf(ss, 1e-24f));
#pragma unroll
                for (int i = 0; i < 8; ++i) kk[i] *= rn;
                st8bf(kkbuf + (size_t)r * 512 + c, kk);
            } else if (it == 2) st8bf(vbuf + (size_t)r * 512 + (cb - 1024), zs);
            else {
                const int l = ch - 192; float o[8];
#pragma unroll
                for (int i = 0; i < 8; ++i) o[i] = l < 8 ? tanhf_(zs[i]) : (l < 16 ? zs[i] : sigmoidf_(zs[i]));
                st8bf(lin + (size_t)r * 384 + l * 8, o);
            }
        }
        if (lane >= 36 && lane < 48) { const float zero[8] = {0.f, 0.f, 0.f, 0.f, 0.f, 0.f, 0.f, 0.f}; st8bf(lin + (size_t)r * 384 + lane * 8, zero); }
    }
}

DEV void phase_chunkmix(const Params& p, LAS unsigned char* lds) {
    unsigned char* ws = p.ws; const int tid = fresh_tid(), lane = tid & 63, w = tid >> 6, l15 = lane & 15, kg = lane >> 4;
    const bf16_t* z = (const bf16_t*)(ws + O_Z); const bf16_t* vab = (const bf16_t*)(ws + O_VAB); bf16_t* ymix = (bf16_t*)(ws + O_YMIX);
    LAS bf16_t* vaT = (LAS bf16_t*)lds;
    for (int item = blockIdx.x; item < 1024; item += gridDim.x) {
        const int g = item & 7, bc = item >> 3; const size_t m0 = (size_t)bc * 128;
        const int trow = 16 * w + l15; const float* wrow = p.in[I_SGUW] + ((size_t)g * 128 + trow) * 128;
        const int nks = (16 * w + 16 + 31) >> 5;
        f32x4 ar[4][2];
#pragma unroll
        for (int ks = 0; ks < 4; ++ks) if (ks < nks) { ar[ks][0] = *(const f32x4*)(wrow + 32 * ks + kg * 8); ar[ks][1] = *(const f32x4*)(wrow + 32 * ks + kg * 8 + 4); }
        __syncthreads();
#pragma unroll
        for (int i = 0; i < 2; ++i) { const int id = tid + 512 * i, s = id >> 3, d8 = (id & 7) * 8; const u32x4 u = *(const u32x4*)(vab + (m0 + s) * 512 + g * 64 + d8);
#pragma unroll
            for (int j = 0; j < 4; ++j) { vaT[(d8 + 2 * j) * 136 + s] = (bf16_t)(u[j] & 0xffffu); vaT[(d8 + 2 * j + 1) * 136 + s] = (bf16_t)(u[j] >> 16); } }
        __syncthreads();
        f32x4 acc[4];
#pragma unroll
        for (int nb = 0; nb < 4; ++nb) acc[nb] = (f32x4){0.f, 0.f, 0.f, 0.f};
#pragma unroll
        for (int ks = 0; ks < 4; ++ks) if (ks < nks) {
            const int s0 = 32 * ks + kg * 8; float a[8];
#pragma unroll
            for (int i = 0; i < 4; ++i) { a[i] = ar[ks][0][i]; a[4 + i] = ar[ks][1][i]; }
#pragma unroll
            for (int i = 0; i < 8; ++i) a[i] = (s0 + i <= trow) ? a[i] : 0.f;
            u32x4 au; au[0] = cvt_pk_bf16(a[0], a[1]); au[1] = cvt_pk_bf16(a[2], a[3]); au[2] = cvt_pk_bf16(a[4], a[5]); au[3] = cvt_pk_bf16(a[6], a[7]);
            const bf16x8 av = __builtin_bit_cast(bf16x8, au);
#pragma unroll
            for (int nb = 0; nb < 4; ++nb) { const bf16x8 bv = *(const LAS bf16x8*)(vaT + (nb * 16 + l15) * 136 + s0); acc[nb] = __builtin_amdgcn_mfma_f32_16x16x32_bf16(av, bv, acc[nb], 0, 0, 0); }
        }
#pragma unroll
        for (int j = 0; j < 4; ++j) { const int t = 16 * w + kg * 4 + j; const float bias = p.in[I_SGUB][g * 128 + t]; const size_t m = m0 + t;
#pragma unroll
            for (int nb = 0; nb < 4; ++nb) { const int d = g * 64 + nb * 16 + l15; const float u = gelu_t(bf2f(z[m * ZLD + d])); ymix[m * 1024 + d] = (bf16_t)(cvt_pk_bf16(u * (acc[nb][j] + bias), 0.f) & 0xffffu); } }
    }
}

DEV void phase_scan(const Params& p, LAS unsigned char* lds) {
    unsigned char* ws = p.ws; const int tid = fresh_tid(), lane = tid & 63, w = tid >> 6, rg = lane >> 4, kq = lane & 15;
    const bf16_t* rbuf = (const bf16_t*)(ws + O_H); const bf16_t* kbuf = (const bf16_t*)(ws + O_H + HALFROW); const bf16_t* vbuf = (const bf16_t*)(ws + O_XRES);
    const bf16_t* kkbuf = (const bf16_t*)(ws + O_KK); const float* dec = (const float*)(ws + O_DEC); const bf16_t* kka = (const bf16_t*)(ws + O_KKA); bf16_t* obuf = (bf16_t*)(ws + O_Z);
    constexpr int SL = 16, NCH = SEQ / SL, LB = 5 * SL * 64;
    LAS float* L = (LAS float*)lds;
    LAS float* Lv = L + 2 * LB;
    LAS float* Lp = Lv + 2 * SL * 16;
#define SCAN_BAR() do { asm volatile("s_waitcnt lgkmcnt(0)" ::: "memory"); __builtin_amdgcn_s_barrier(); asm volatile("" ::: "memory"); } while (0)
    for (int item = blockIdx.x; item < 256; item += gridDim.x) {
        const int bh = item >> 2, q = item & 3, b = bh >> 3, h = bh & 7; const size_t m0 = (size_t)b * SEQ;
        if (w >= 4) {
            const int lt = tid - 256, ls = lt >> 4, lc = (lt & 15) * 4;
            f32x4 p1; u32x2 p0, p2, p3, p4, pv; pv[0] = 0u; pv[1] = 0u;
            auto gload = [&](int ch) { const size_t o = (m0 + ch * SL + ls) * 512 + h * 64 + lc;
                p0 = *(const u32x2*)(kkbuf + o); p1 = *(const f32x4*)(dec + o); p2 = *(const u32x2*)(kbuf + o); p3 = *(const u32x2*)(kka + o); p4 = *(const u32x2*)(rbuf + o);
                if (lt < 64) pv = *(const u32x2*)(vbuf + (m0 + ch * SL + (lt >> 2)) * 512 + h * 64 + q * 16 + (lt & 3) * 4); };
            auto fill = [&](int ch) { LAS float* d = L + (ch & 1) * LB + ls * 64 + lc;
                *(LAS f32x4*)d = bf4(p0); *(LAS f32x4*)(d + SL * 64) = p1; *(LAS f32x4*)(d + 2 * SL * 64) = bf4(p2); *(LAS f32x4*)(d + 3 * SL * 64) = bf4(p3); *(LAS f32x4*)(d + 4 * SL * 64) = bf4(p4);
                if (lt < 64) *(LAS f32x4*)(Lv + (ch & 1) * SL * 16 + lt * 4) = bf4(pv); };
            auto reduce_slab = [&](int ch) { const int st = lt >> 4, row = lt & 15; const LAS float* pp = Lp + (ch & 1) * SL * 256 + st * 256 + (row >> 2) * 64 + (row & 3) * 16;
                const f32x4 a = *(const LAS f32x4*)pp, b4 = *(const LAS f32x4*)(pp + 4), c = *(const LAS f32x4*)(pp + 8), d = *(const LAS f32x4*)(pp + 12); const f32x4 t = (a + b4) + (c + d);
                obuf[(m0 + ch * SL + st) * 512 + h * 64 + q * 16 + row] = (bf16_t)(cvt_pk_bf16((t[0] + t[1]) + (t[2] + t[3]), 0.f) & 0xffffu); };
            gload(0); fill(0); gload(1);
            SCAN_BAR();
            for (int ch = 0; ch < NCH; ++ch) {
                if (ch + 1 < NCH) fill(ch + 1);
                if (ch + 2 < NCH) gload(ch + 2);
                if (ch >= 1) reduce_slab(ch - 1);
                SCAN_BAR();
            }
            reduce_slab(NCH - 1);
            {
                const int sidx = item * 4 + (w - 4), si = sidx >> 3, hh = sidx & 7; const size_t o = (size_t)(NTOK + si) * 512 + hh * 64 + kq * 4;
                const f32x4 kk4 = bf4(*(const u32x2*)(kkbuf + o)), w4 = *(const f32x4*)(dec + o), k4 = bf4(*(const u32x2*)(kbuf + o)), ka4 = bf4(*(const u32x2*)(kka + o)), r4 = bf4(*(const u32x2*)(rbuf + o));
                const float* sin = p.in[I_SRWKV] + (size_t)sidx * 4096; float* sout = p.out + OUT_SS + (size_t)sidx * 4096;
                for (int ps = 0; ps < 16; ++ps) {
                    const int v = ps * 4 + rg; f32x4 S = *(const f32x4*)(sin + v * 64 + kq * 4); const float vv = bf2f(vbuf[(size_t)(NTOK + si) * 512 + hh * 64 + v]);
                    const float sa = -rowsum16(S[0] * kk4[0] + S[1] * kk4[1] + S[2] * kk4[2] + S[3] * kk4[3]);
                    S = S * w4 + vv * k4 + sa * ka4;
                    *(f32x4*)(sout + v * 64 + kq * 4) = S;
                    const float op = rowsum16(S[0] * r4[0] + S[1] * r4[1] + S[2] * r4[2] + S[3] * r4[3]);
                    if (kq == 0) obuf[(size_t)(NTOK + si) * 512 + hh * 64 + v] = (bf16_t)(cvt_pk_bf16(op, 0.f) & 0xffffu);
                }
            }
        } else {
            typedef float f32x2v __attribute__((ext_vector_type(2)));
            f32x2v Sa = (f32x2v){0.f, 0.f}, Sb = (f32x2v){0.f, 0.f}; const int row = w * 4 + rg;
            SCAN_BAR();
            for (int ch = 0; ch < NCH; ++ch) {
                const LAS float* Lc = L + (ch & 1) * LB + kq * 4; const LAS float* Lvc = Lv + (ch & 1) * SL * 16 + row;
                LAS float* dst = Lp + (ch & 1) * SL * 256 + w * 64 + lane;
                f32x4 kk4 = *(const LAS f32x4*)Lc, w4 = *(const LAS f32x4*)(Lc + SL * 64), k4 = *(const LAS f32x4*)(Lc + 2 * SL * 64), ka4 = *(const LAS f32x4*)(Lc + 3 * SL * 64), r4 = *(const LAS f32x4*)(Lc + 4 * SL * 64);
                float vv = Lvc[0];
#pragma unroll
                for (int s = 0; s < SL; ++s) {
                    const int sn = s < SL - 1 ? s + 1 : SL - 1; const LAS float* bp = Lc + sn * 64;
                    const f32x4 nkk4 = *(const LAS f32x4*)bp, nw4 = *(const LAS f32x4*)(bp + SL * 64), nk4 = *(const LAS f32x4*)(bp + 2 * SL * 64), nka4 = *(const LAS f32x4*)(bp + 3 * SL * 64), nr4 = *(const LAS f32x4*)(bp + 4 * SL * 64);
                    const float nvv = Lvc[sn * 16];
                    f32x2v t = Sa * kk4.lo; t = Sb * kk4.hi + t;
                    const float sa = -rowsum16(t[0] + t[1]);
                    Sa = (Sa * w4.lo + vv * k4.lo) + sa * ka4.lo;
                    Sb = (Sb * w4.hi + vv * k4.hi) + sa * ka4.hi;
                    f32x2v u = Sa * r4.lo; u = Sb * r4.hi + u;
                    dst[s * 256] = u[0] + u[1];
                    kk4 = nkk4; w4 = nw4; k4 = nk4; ka4 = nka4; r4 = nr4; vv = nvv;
                }
                SCAN_BAR();
            }
            const float S0 = Sa[0], S1 = Sa[1], S2 = Sb[0], S3 = Sb[1];
            *(f32x4*)(p.out + OUT_SP + ((size_t)bh * 64 + q * 16 + row) * 64 + kq * 4) = (f32x4){S0, S1, S2, S3};
        }
        __syncthreads();
    }
#undef SCAN_BAR
}

DEV void phase_finalize(const Params& p) {
    unsigned char* ws = p.ws; const int tid = fresh_tid(), lane = tid & 63, gw = blockIdx.x * 8 + (tid >> 6), nw = gridDim.x * 8;
    const bf16_t* rbuf = (const bf16_t*)(ws + O_H); const bf16_t* kbuf = (const bf16_t*)(ws + O_H + HALFROW); const bf16_t* gb = (const bf16_t*)(ws + O_H + 2 * HALFROW);
    const bf16_t* vbuf = (const bf16_t*)(ws + O_XRES); const bf16_t* obuf = (const bf16_t*)(ws + O_Z); bf16_t* ymix = (bf16_t*)(ws + O_YMIX);
    const int c = lane * 8; float rk[8], gg[8], gbb[8]; ld8f(p.in[I_RK] + c, rk); ld8f(p.in[I_GNG] + c, gg); ld8f(p.in[I_GNB] + c, gbb);
#pragma unroll 2
    for (int r = gw; r < MV; r += nw) {
        const size_t o = (size_t)r * 512 + c; float ov[8], rv[8], kv[8], vv[8], gv[8]; ld8bf(obuf + o, ov); ld8bf(rbuf + o, rv); ld8bf(kbuf + o, kv); ld8bf(vbuf + o, vv); ld8bf(gb + o, gv);
        float s = 0.f, bs = 0.f;
#pragma unroll
        for (int i = 0; i < 8; ++i) { s += ov[i]; bs += rv[i] * kv[i] * rk[i]; }
        s += __shfl_xor(s, 1); s += __shfl_xor(s, 2); s += __shfl_xor(s, 4); bs += __shfl_xor(bs, 1); bs += __shfl_xor(bs, 2); bs += __shfl_xor(bs, 4);
        const float mu = s * (1.f / 64.f); float q = 0.f;
#pragma unroll
        for (int i = 0; i < 8; ++i) { ov[i] -= mu; q += ov[i] * ov[i]; }
        q += __shfl_xor(q, 1); q += __shfl_xor(q, 2); q += __shfl_xor(q, 4);
        const float rstd = rsqrtf(q * (1.f / 64.f) + 64e-5f); float y[8];
#pragma unroll
        for (int i = 0; i < 8; ++i) y[i] = (ov[i] * rstd * gg[i] + gbb[i] + bs * vv[i]) * gv[i];
        st8bf(ymix + (size_t)r * 1024 + 512 + c, y);
    }
}

DEV void phase_sattn(const Params& p, LAS unsigned char* lds) {
    unsigned char* ws = p.ws; const int tid = fresh_tid(), lane = tid & 63, w = tid >> 6, kgrp = lane >> 4, dl = lane & 15;
    const bf16_t* qb = (const bf16_t*)(ws + O_Z + HALFROW); bf16_t* ob = (bf16_t*)(ws + O_YMIX);
    LAS float* pw = (LAS float*)lds;
    LAS float* wm = pw + 256;
    LAS float* wacc = wm + 16;
    for (int item = blockIdx.x; item < 512; item += gridDim.x) {
        const int si = item >> 2, h = item & 3; const float* Kp = p.in[I_CK] + (size_t)si * 262144 + h * 256; const float* Vp = p.in[I_CV] + (size_t)si * 262144 + h * 256;
        float q[16]; { float a[8], b[8]; ld8bf(qb + (size_t)(NTOK + si) * 1024 + h * 256 + dl * 16, a); ld8bf(qb + (size_t)(NTOK + si) * 1024 + h * 256 + dl * 16 + 8, b);
#pragma unroll
            for (int i = 0; i < 8; ++i) { q[i] = a[i]; q[8 + i] = b[i]; } }
        float sc[8];
#pragma unroll
        for (int j = 0; j < 8; ++j) {
            const float* kr = Kp + (size_t)(w * 32 + kgrp + 4 * j) * 1024 + dl * 16; float d = 0.f;
#pragma unroll
            for (int i = 0; i < 4; ++i) { const f32x4 k4 = *(const f32x4*)(kr + 4 * i); d += k4[0] * q[4 * i] + k4[1] * q[4 * i + 1] + k4[2] * q[4 * i + 2] + k4[3] * q[4 * i + 3]; }
            sc[j] = rowsum16(d);
        }
        float mx = sc[0];
#pragma unroll
        for (int j = 1; j < 8; ++j) mx = fmaxf(mx, sc[j]);
        mx = fmaxf(mx, __shfl_xor(mx, 16)); mx = fmaxf(mx, __shfl_xor(mx, 32));
        float sum = 0.f;
#pragma unroll
        for (int j = 0; j < 8; ++j) { sc[j] = __expf(sc[j] - mx); sum += sc[j]; }
        sum += __shfl_xor(sum, 16); sum += __shfl_xor(sum, 32);
        __syncthreads();
        if (dl == 0) {
#pragma unroll
            for (int j = 0; j < 8; ++j) pw[w * 32 + kgrp + 4 * j] = sc[j];
        }
        if (lane == 0) { wm[w] = mx; wm[8 + w] = sum; }
        asm volatile("s_waitcnt lgkmcnt(0)" ::: "memory"); __builtin_amdgcn_wave_barrier();
        f32x4 acc = (f32x4){0.f, 0.f, 0.f, 0.f};
#pragma unroll 16
        for (int j = 0; j < 32; ++j) { const f32x4 v4 = *(const f32x4*)(Vp + (size_t)(w * 32 + j) * 1024 + lane * 4); acc = acc + pw[w * 32 + j] * v4; }
        *(LAS f32x4*)(wacc + w * 256 + lane * 4) = acc;
        __syncthreads();
        if (tid < 256) {
            float M = wm[0];
#pragma unroll
            for (int j = 1; j < 8; ++j) M = fmaxf(M, wm[j]);
            float L = 0.f, o = 0.f;
#pragma unroll
            for (int j = 0; j < 8; ++j) { const float f = __expf(wm[j] - M); L += wm[8 + j] * f; o += wacc[j * 256 + tid] * f; }
            ob[(size_t)(NTOK + si) * 1024 + h * 256 + tid] = (bf16_t)(cvt_pk_bf16(o * __builtin_amdgcn_rcpf(L), 0.f) & 0xffffu);
        }
    }
}

DEV void phase_final(const Params& p) {
    unsigned char* ws = p.ws; const int tid = fresh_tid(), lane = tid & 63, gw = blockIdx.x * 8 + (tid >> 6), nw = gridDim.x * 8;
    const bf16_t* xb = (const bf16_t*)(ws + O_XB); const float* rs5 = (const float*)(ws + O_RS5);
    float g[16]; { float a[8], b[8]; ld8f(p.in[I_FIN] + lane * 8, a); ld8f(p.in[I_FIN] + 512 + lane * 8, b);
#pragma unroll
        for (int i = 0; i < 8; ++i) { g[i] = a[i]; g[8 + i] = b[i]; } }
#pragma unroll 2
    for (int r = gw; r < MV; r += nw) {
        const float rstd = rstd_of(rs5, r);
#pragma unroll
        for (int hf = 0; hf < 2; ++hf) { const int c = hf * 512 + lane * 8; float v[8]; ld8bf(xb + (size_t)r * 1024 + c, v);
#pragma unroll
            for (int i = 0; i < 8; ++i) v[i] = v[i] * rstd * g[hf * 8 + i];
            st8f(p.out + OUT_Y + (size_t)r * 1024 + c, v); }
    }
}

__global__ void __launch_bounds__(512, 2) mega(Params p) {
    extern __shared__ __attribute__((aligned(16))) unsigned char shm[];
    LAS unsigned char* lds = (LAS unsigned char*)shm;
    unsigned char* ws = p.ws;
    const int MT = MP / 256;
    {
        volatile LAS unsigned* st = (volatile LAS unsigned*)(lds + pg8::STAGE_BYTES);
        if (threadIdx.x < 2) st[threadIdx.x] = 0u;
        __syncthreads();
        if (threadIdx.x == 0) (void)xb_add(&((unsigned*)(ws + O_BAR))[XB_XCNT(xb_xcc_id())], 1u);
    }
#define XB_SYNC() do { XcdBarrier xb_; xb_.bar = (unsigned*)(p.ws + O_BAR); xb_.x = xb_xcc_id(); xb_.st = (volatile LAS unsigned*)(lds + pg8::STAGE_BYTES); xcd_barrier(xb_); } while (0)
    { phase_prep(p, lds); }
    XB_SYNC();
    { {
            { pg8::Gemm g{(const bf16_t*)(ws + O_XB), (const bf16_t*)(ws + O_WGU1), 1024, 1024, 1024}; pg8::GridSched S; S.init(MT, 22, 0, 1024, 1024);
              EpiSwiglu E{(const float*)(ws + O_RS1), (bf16_t*)(ws + O_H)}; pg8::gemm_phase(lds, g, S, E); }
            { pg8::Gemm g{(const bf16_t*)(ws + O_MNB), (const bf16_t*)(ws + O_WK), 1024, 1024, 1024}; pg8::GridSched S; S.init(8, 4, MT * 22, 1024, 1024);
              EpiK E{(const float*)(ws + O_RSTDM), p.out + OUT_MK, (bf16_t*)(ws + O_MKB)}; pg8::gemm_phase(lds, g, S, E); }
            { pg8::Gemm g{(const bf16_t*)(ws + O_WV), (const bf16_t*)(ws + O_MNB), 1024, 1024, 1024}; pg8::GridSched S; S.init(4, 8, MT * 22 + 32, 1024, 1024);
              EpiVT E{(const float*)(ws + O_RSTDM), p.out + OUT_MV, (bf16_t*)(ws + O_VT)}; pg8::gemm_phase(lds, g, S, E); }
        } }
    XB_SYNC();
    { { pg8::Gemm g{(const bf16_t*)(ws + O_H), (const bf16_t*)(ws + O_WD1), DFF, DFF, DFF}; pg8::GridSched S; S.init(64, 4, 0, DFF, DFF);
            EpiRes E{p.in[I_XP], (bf16_t*)(ws + O_XB), (float*)(ws + O_RS2), 0.5f}; pg8::gemm_phase(lds, g, S, E);
            SRes E2{p.in[I_XS], (bf16_t*)(ws + O_XB), (float*)(ws + O_RS2), 0.5f, NTOK};
            small_gemm<4>(lds, (const bf16_t*)(ws + O_H), DFF, (const bf16_t*)(ws + O_WD1), DFF, DFF, NTOK, 4, 16, E2); } }
    XB_SYNC();
    { { pg8::Gemm g{(const bf16_t*)(ws + O_XB), (const bf16_t*)(ws + O_WIN), 1024, 1024, 1024}; pg8::GridSched S; S.init(MT, 11, 0, 1024, 1024);
            EpiScale E{(const float*)(ws + O_RS2), (bf16_t*)(ws + O_Z), ZLD, ZLD}; pg8::gemm_phase(lds, g, S, E);
            SScale E2{(const float*)(ws + O_RS2), (bf16_t*)(ws + O_Z), ZLD, ZLD, 2816};
            small_gemm<2>(lds, (const bf16_t*)(ws + O_XB), 1024, (const bf16_t*)(ws + O_WIN) + (size_t)2816 * 1024, 1024, 1024, 0, MV / 32, 1, E2); } }
    XB_SYNC();
    { phase_mixprep(p); }
    XB_SYNC();
    { { pg8::Gemm g{(const bf16_t*)(ws + O_LIN), (const bf16_t*)(ws + O_WLORA), 384, 384, 256}; pg8::LoraSched S; S.init();
            EpiLora E{p.in[I_W0], p.in[I_A0], p.in[I_KA], (float*)(ws + O_DEC), (bf16_t*)(ws + O_H + HALFROW), (const bf16_t*)(ws + O_KK), (bf16_t*)(ws + O_KKA), (bf16_t*)(ws + O_H + 2 * HALFROW)};
            pg8::gemm_phase(lds, g, S, E); phase_chunkmix(p, lds); } }
    XB_SYNC();
    { phase_scan(p, lds); }
    XB_SYNC();
    { phase_finalize(p); }
    XB_SYNC();
    { { pg8::Gemm g{(const bf16_t*)(ws + O_YMIX), (const bf16_t*)(ws + O_WOUT), 1024, 1024, 1024}; pg8::GridSched S; S.init(64, 4, 0, 1024, 1024);
            EpiRes E{nullptr, (bf16_t*)(ws + O_XB), (float*)(ws + O_RS3), 1.f}; pg8::gemm_phase(lds, g, S, E);
            SRes E2{nullptr, (bf16_t*)(ws + O_XB), (float*)(ws + O_RS3), 1.f, 0};
            small_gemm<4>(lds, (const bf16_t*)(ws + O_YMIX), 1024, (const bf16_t*)(ws + O_WOUT), 1024, 1024, NTOK, 4, 16, E2); } }
    XB_SYNC();
    { { pg8::Gemm g{(const bf16_t*)(ws + O_XB), (const bf16_t*)(ws + O_WQ), 1024, 1024, 1024}; pg8::GridSched S; S.init(64, 4, 0, 1024, 1024);
            EpiScale E{(const float*)(ws + O_RS3), (bf16_t*)(ws + O_Z + HALFROW), 1024, 1024}; pg8::gemm_phase(lds, g, S, E);
            SScale E2{(const float*)(ws + O_RS3), (bf16_t*)(ws + O_Z + HALFROW), 1024, 1024, 0};
            small_gemm<4>(lds, (const bf16_t*)(ws + O_XB), 1024, (const bf16_t*)(ws + O_WQ), 1024, 1024, NTOK, 4, 16, E2); } }
    XB_SYNC();
    { {
            const bool sattn_first = ((blockIdx.x >> 3) & 1) != 0;
            if (sattn_first) phase_sattn(p, lds);
            { pg8::Gemm g{(const bf16_t*)(ws + O_Z + HALFROW), (const bf16_t*)(ws + O_MKB), 1024, 1024, 256}; pg8::AttnSched<0> S; S.init();
              EpiS E{(bf16_t*)(ws + O_Z), (float*)(ws + O_PSUM)}; pg8::gemm_phase(lds, g, S, E); }
            asm volatile("s_waitcnt vmcnt(0)" ::: "memory"); __syncthreads();
            if (threadIdx.x == 0) { __builtin_amdgcn_fence(__ATOMIC_ACQUIRE, "agent"); asm volatile("s_waitcnt vmcnt(0)" ::: "memory"); }
            __syncthreads();
            { pg8::Gemm g{(const bf16_t*)(ws + O_Z), (const bf16_t*)(ws + O_VT), 256, 2048, 256}; pg8::AttnSched<1> S; S.init();
              EpiO E{(const float*)(ws + O_PSUM), (bf16_t*)(ws + O_YMIX)}; pg8::gemm_phase(lds, g, S, E); }
            if (!sattn_first) phase_sattn(p, lds);
        } }
    XB_SYNC();
    { { pg8::Gemm g{(const bf16_t*)(ws + O_YMIX), (const bf16_t*)(ws + O_WO), 1024, 1024, 1024}; pg8::GridSched S; S.init(64, 4, 0, 1024, 1024);
            EpiRes E{nullptr, (bf16_t*)(ws + O_XB), (float*)(ws + O_RS4), 1.f}; pg8::gemm_phase(lds, g, S, E);
            SRes E2{nullptr, (bf16_t*)(ws + O_XB), (float*)(ws + O_RS4), 1.f, 0};
            small_gemm<4>(lds, (const bf16_t*)(ws + O_YMIX), 1024, (const bf16_t*)(ws + O_WO), 1024, 1024, NTOK, 4, 16, E2); } }
    XB_SYNC();
    { { pg8::Gemm g{(const bf16_t*)(ws + O_XB), (const bf16_t*)(ws + O_WGU2), 1024, 1024, 1024}; pg8::GridSched S; S.init(MT, 22, 0, 1024, 1024);
            EpiSwiglu E{(const float*)(ws + O_RS4), (bf16_t*)(ws + O_H)}; pg8::gemm_phase(lds, g, S, E); } }
    XB_SYNC();
    { { pg8::Gemm g{(const bf16_t*)(ws + O_H), (const bf16_t*)(ws + O_WD2), DFF, DFF, DFF}; pg8::GridSched S; S.init(64, 4, 0, DFF, DFF);
            EpiRes E{nullptr, (bf16_t*)(ws + O_XB), (float*)(ws + O_RS5), 0.5f}; pg8::gemm_phase(lds, g, S, E);
            SRes E2{nullptr, (bf16_t*)(ws + O_XB), (float*)(ws + O_RS5), 0.5f, 0};
            small_gemm<4>(lds, (const bf16_t*)(ws + O_H), DFF, (const bf16_t*)(ws + O_WD2), DFF, DFF, NTOK, 4, 16, E2); } }
    XB_SYNC();
    { phase_final(p); }
#undef XB_SYNC
}

constexpr size_t LDS_BYTES = pg8::STAGE_BYTES + 4096;

extern "C" void kernel_launch(void* const* d_in, const int* in_sizes, int n_in, void* d_out, int out_size, void* d_ws, size_t ws_size, hipStream_t stream) {
    static int grid_blocks = 0;
    if (!grid_blocks) {
        int dev = 0, cus = 0, per_cu = 0;
        hipGetDevice(&dev);
        hipDeviceGetAttribute(&cus, hipDeviceAttributeMultiprocessorCount, dev);
        hipFuncSetAttribute((const void*)mega, hipFuncAttributeMaxDynamicSharedMemorySize, (int)LDS_BYTES);
        hipOccupancyMaxActiveBlocksPerMultiprocessor(&per_cu, mega, 512, LDS_BYTES);
        if (per_cu < 1) { fprintf(stderr, "occupancy query returned %d\n", per_cu); per_cu = 1; }
        grid_blocks = cus * (per_cu > 1 ? 1 : per_cu);
        if (ws_size < WS_NEED) fprintf(stderr, "workspace too small: %zu < %zu\n", ws_size, (size_t)WS_NEED);
    }
    Params p{};
    for (int i = 0; i < 40; ++i) p.in[i] = (const float*)d_in[i];
    p.out = (float*)d_out; p.ws = (unsigned char*)d_ws;
    hipMemsetAsync((unsigned char*)d_ws + O_BAR, 0, XCD_BAR_WORDS * 4, stream);
    hipLaunchKernelGGL(mega, dim3(grid_blocks), dim3(512), LDS_BYTES, stream, p);
}
```

```cpp
#include <hip/hip_runtime.h>
#include <hip/hip_cooperative_groups.h>
#include <cstdio>
namespace cg = cooperative_groups;

#ifndef PHMASK
#define PHMASK 0xffff
#endif
#ifndef DUPMASK
#define DUPMASK 0
#endif
#ifndef ONE_LAUNCH
#define ONE_LAUNCH 1
#endif

#define LAS __attribute__((address_space(3)))
#define DEV __device__ __forceinline__
typedef unsigned short bf16_t;
typedef short bf16x8 __attribute__((ext_vector_type(8)));
typedef float f32x4 __attribute__((ext_vector_type(4)));
typedef unsigned u32x2 __attribute__((ext_vector_type(2)));
typedef unsigned u32x4 __attribute__((ext_vector_type(4)));

constexpr int DM = 1024, NTOK = 16384, NSMP = 128, MV = NTOK + NSMP, MP = 16640, SEQ = 2048;
constexpr int DFF = 2816, ZLD = 2848, BPROJ = 1824, NMEMR = 2048;
constexpr int NPH = 16;

constexpr size_t al256(size_t x) { return (x + 255) & ~(size_t)255; }
constexpr size_t O_WGU1 = 0;
constexpr size_t O_WD1 = O_WGU1 + al256((size_t)5632 * 1024 * 2);
constexpr size_t O_WIN = O_WD1 + al256((size_t)1024 * 2816 * 2);
constexpr size_t O_WOUT = O_WIN + al256((size_t)3072 * 1024 * 2);
constexpr size_t O_WQ = O_WOUT + 2097152, O_WK = O_WQ + 2097152, O_WV = O_WK + 2097152, O_WO = O_WV + 2097152;
constexpr size_t O_WGU2 = O_WO + 2097152;
constexpr size_t O_WD2 = O_WGU2 + al256((size_t)5632 * 1024 * 2);
constexpr size_t O_WLORA = O_WD2 + al256((size_t)1024 * 2816 * 2);
constexpr size_t O_MNB = O_WLORA + al256((size_t)1536 * 384 * 2);
constexpr size_t O_MKB = O_MNB + 4194304, O_VT = O_MKB + 4194304;
constexpr size_t O_RSTDM = O_VT + 4194304;
constexpr size_t RS_BYTES = (size_t)MP * 64;
constexpr size_t O_RS1 = O_RSTDM + 8192, O_RS2 = O_RS1 + RS_BYTES, O_RS3 = O_RS2 + RS_BYTES, O_RS4 = O_RS3 + RS_BYTES, O_RS5 = O_RS4 + RS_BYTES;
constexpr size_t O_PSUM = O_RS5 + RS_BYTES;
constexpr size_t HALFROW = (size_t)MP * 512 * 4;
constexpr size_t O_XB = O_PSUM + 1048576;
constexpr size_t O_XRES = O_XB + HALFROW;
constexpr size_t O_H = O_XRES + 2 * HALFROW;
constexpr size_t O_Z = O_H + al256((size_t)MP * DFF * 2);
constexpr size_t O_YMIX = O_Z + al256((size_t)MP * ZLD * 2);
constexpr size_t O_VAB = O_YMIX + HALFROW;
constexpr size_t O_LIN = O_VAB + HALFROW / 2;
constexpr size_t O_KK = O_LIN + al256((size_t)MP * 384 * 2);
constexpr size_t O_DEC = O_KK + HALFROW, O_KKA = O_DEC + HALFROW;
constexpr size_t O_BAR = O_KKA + HALFROW;
constexpr size_t WS_NEED = O_BAR + 16384;

constexpr size_t OUT_Y = 0, OUT_SP = (size_t)MV * 1024, OUT_SHP = OUT_SP + 262144, OUT_MK = OUT_SHP + 8 * 1824, OUT_MV = OUT_MK + 2097152,
                 OUT_SS = OUT_MV + 2097152, OUT_SHS = OUT_SS + 4194304, OUT_CV = OUT_SHS + 128 * 1824;

enum { I_XP = 0, I_XS, I_SRWKV, I_SSHIFT, I_CK, I_CV, I_MEM, I_LN1, I_G1, I_U1, I_D1, I_LNMIX, I_WIN, I_WOUT, I_SGUW, I_SGUB, I_SLNG, I_SLNB,
       I_MU, I_W0, I_W2, I_A0, I_A2, I_G2, I_KK, I_KA, I_RK, I_GNG, I_GNB, I_LNX, I_MEMN, I_XQ, I_XK, I_XV, I_XO, I_LN2, I_G2F, I_U2F, I_D2F, I_FIN };

struct Params { const float* in[40]; float* out; unsigned char* ws; };

DEV unsigned cvt_pk_bf16(float lo, float hi) { unsigned r; asm volatile("v_cvt_pk_bf16_f32 %0, %1, %2" : "=v"(r) : "v"(lo), "v"(hi)); return r; }
DEV float bf_lo(unsigned u) { return __uint_as_float(u << 16); }
DEV float bf_hi(unsigned u) { return __uint_as_float(u & 0xffff0000u); }
DEV f32x4 bf4(u32x2 u) { return (f32x4){__uint_as_float(u[0] << 16), __uint_as_float(u[0] & 0xffff0000u), __uint_as_float(u[1] << 16), __uint_as_float(u[1] & 0xffff0000u)}; }
DEV u32x2 pk4(f32x4 v) { u32x2 o; o[0] = cvt_pk_bf16(v[0], v[1]); o[1] = cvt_pk_bf16(v[2], v[3]); return o; }
DEV float bf2f(bf16_t b) { return __uint_as_float((unsigned)b << 16); }
DEV float sigmoidf_(float x) { return __builtin_amdgcn_rcpf(1.f + __expf(-x)); }
DEV float tanhf_(float y) { return 1.f - 2.f * __builtin_amdgcn_rcpf(1.f + __expf(2.f * y)); }
DEV float gelu_t(float x) { return 0.5f * x * (1.f + tanhf_(0.7978845608028654f * (x + 0.044715f * x * x * x))); }
DEV float wsum64(float v) {
#pragma unroll
    for (int o = 32; o >= 1; o >>= 1) v += __shfl_xor(v, o);
    return v;
}
DEV float wmax64(float v) {
#pragma unroll
    for (int o = 32; o >= 1; o >>= 1) v = fmaxf(v, __shfl_xor(v, o));
    return v;
}
template <int CTRL> DEV float dpp_f(float x) { return __builtin_bit_cast(float, __builtin_amdgcn_update_dpp(0, __builtin_bit_cast(int, x), CTRL, 0xf, 0xf, false)); }
DEV float rowsum16(float x) {
    x += dpp_f<0x128>(x); x += dpp_f<0x124>(x); x += dpp_f<0x122>(x); x += dpp_f<0x121>(x); return x;
}
DEV int fresh_tid() { int t = threadIdx.x; asm volatile("" : "+v"(t)); return t; }
DEV float rstd_of(const float* rs, int r) { const f32x4* q = (const f32x4*)(rs + (size_t)r * 16); const f32x4 p = (q[0] + q[1]) + (q[2] + q[3]); return rsqrtf(((p[0] + p[1]) + (p[2] + p[3])) * (1.f / 1024.f) + 1e-6f); }

#define XB_TMO      128
#define XB_XCNT(j)  (256  + 64 * (j))
#define XB_XSUB(j)  (1280 + 64 * (j))
#define XB_XGEN(j)  (2304 + 64 * (j))
#define XB_TOP      3328
#define XB_TOPGEN   3392
#define XCD_BAR_WORDS 3456
#define XB_SPIN_CAP (1u << 18)
DEV unsigned xb_ld(unsigned* p)              { return __hip_atomic_load(p, __ATOMIC_RELAXED, __HIP_MEMORY_SCOPE_AGENT); }
DEV unsigned xb_add(unsigned* p, unsigned v) { return __hip_atomic_fetch_add(p, v, __ATOMIC_RELAXED, __HIP_MEMORY_SCOPE_AGENT); }
DEV unsigned xb_xcc_id() { return (unsigned)__builtin_amdgcn_s_getreg((3 << 11) | 20) & 0xFu; }
#define XB_SPIN(cond, bar) do { unsigned _sp = 0; while (cond) { __builtin_amdgcn_s_sleep(1); \
    if ((++_sp & 255u) == 0u) { if (xb_ld(&(bar)[XB_TMO])) break; if (_sp > XB_SPIN_CAP) { atomicAdd(&(bar)[XB_TMO], 1u); break; } } } } while (0)
struct XcdBarrier { unsigned* bar; unsigned x; volatile LAS unsigned* st; };
DEV XcdBarrier xcd_barrier_post(unsigned* bar, volatile LAS unsigned* st) {
    XcdBarrier b; b.bar = bar; b.x = xb_xcc_id(); b.st = st;
    if (threadIdx.x == 0) (void)xb_add(&bar[XB_XCNT(b.x)], 1u);
    return b;
}
DEV void xcd_barrier_complete(unsigned* bar, unsigned x, unsigned& nloc, unsigned& nx) {
    const unsigned G = gridDim.x * gridDim.y * gridDim.z;
    unsigned sum, cnt, mine, sp = 0u;
    for (;;) {
        sum = 0u; cnt = 0u; mine = 0u;
#pragma unroll
        for (unsigned j = 0; j < 16; ++j) { const unsigned c = xb_ld(&bar[XB_XCNT(j)]); sum += c; cnt += (c > 0u) ? 1u : 0u; mine = (j == x) ? c : mine; }
        if (sum == G) break;
        __builtin_amdgcn_s_sleep(1);
        if ((++sp & 255u) == 0u) { if (xb_ld(&bar[XB_TMO])) break; if (sp > XB_SPIN_CAP) { atomicAdd(&bar[XB_TMO], 1u); break; } }
    }
    nloc = mine > 0u ? mine : 1u; nx = cnt > 0u ? cnt : 1u;
}
DEV void xcd_barrier(const XcdBarrier& b) {
    asm volatile("s_waitcnt vmcnt(0)" ::: "memory");
    __syncthreads();
    if (threadIdx.x == 0) {
        unsigned* bar = b.bar;
        __builtin_amdgcn_s_waitcnt(0);
        unsigned nloc = b.st[0], nx = b.st[1];
        if (nloc == 0u) { xcd_barrier_complete(bar, b.x, nloc, nx); b.st[0] = nloc; b.st[1] = nx; }
        const unsigned old = xb_add(&bar[XB_XSUB(b.x)], 1u);
        const unsigned gen = old / nloc;
        if (old + 1u == (gen + 1u) * nloc) {
            __builtin_amdgcn_fence(__ATOMIC_RELEASE, "agent");
            asm volatile("s_waitcnt vmcnt(0)" ::: "memory");
            const unsigned og = xb_add(&bar[XB_TOP], 1u);
            const unsigned tg = og / nx;
            if (og + 1u == (tg + 1u) * nx) xb_add(&bar[XB_TOPGEN], 1u);
            else XB_SPIN(xb_ld(&bar[XB_TOPGEN]) == tg, bar);
            __builtin_amdgcn_fence(__ATOMIC_ACQUIRE, "agent");
            xb_add(&bar[XB_XGEN(b.x)], 1u);
            asm volatile("s_waitcnt vmcnt(0)" ::: "memory");
        } else {
            XB_SPIN(xb_ld(&bar[XB_XGEN(b.x)]) == gen, bar);
            __builtin_amdgcn_fence(__ATOMIC_ACQUIRE, "agent");
            asm volatile("s_waitcnt vmcnt(0)" ::: "memory");
        }
    }
    __syncthreads();
}

namespace pg8 {
constexpr int BM = 256, BK = 64, HALF = 128, HTB = HALF * BK * 2, STAGE_BYTES = 8 * HTB, NXCD = 8, WGM = 8;
DEV int lds_byte(int r, int c) { const int st = (r >> 4) * 2 + (c >> 5), rr = r & 15, cc = c & 31, ob = rr * 64 + cc * 2; return st * 1024 + (ob ^ (((ob >> 9) & 1) << 5)); }
DEV void stage_rc(int b, int& R, int& C) { const int st = b / 1024, sb = b % 1024, swz = sb ^ (((sb >> 9) & 1) << 5); R = (st >> 1) * 16 + swz / 64; C = (st & 1) * 32 + (swz % 64) / 2; }

struct Unit { int pm, pn; long ao, bo; int x0, x1; };
struct Gemm { const bf16_t* A; const bf16_t* Bt; int lda, ldb, K; };

struct GridSched {
    int nM, nN, nwg, G, c; long ta, tb;
    DEV void init(int nM_, int nN_, int shift, int lda, int ldb) { nM = nM_; nN = nN_; nwg = nM * nN; G = (int)gridDim.x; c = ((int)blockIdx.x + G - (shift % G)) % G; ta = 256L * lda; tb = 256L * ldb; }
    DEV bool next(int i, Unit& u) const {
        const long L = (long)i * G + c; if (L >= nwg) return false;
        int wgid = (int)L; { const int q = nwg / NXCD, r = nwg % NXCD, xcd = wgid % NXCD, off = wgid / NXCD; wgid = (xcd < r ? xcd * (q + 1) : r * (q + 1) + (xcd - r) * q) + off; }
        const int nig = WGM * nN, gid = wgid / nig, fm = gid * WGM, gsz = (nM - fm) < WGM ? (nM - fm) : WGM;
        u.pm = fm + ((wgid % nig) % gsz); u.pn = (wgid % nig) / gsz; u.ao = u.pm * ta; u.bo = u.pn * tb; u.x0 = 0; u.x1 = 0; return true;
    }
};
struct LoraSched {
    int G, c;
    DEV void init() { G = (int)gridDim.x; c = (int)blockIdx.x; }
    DEV bool next(int i, Unit& u) const {
        const long L = (long)i * G + c; if (L >= 65 * 6) return false;
        const int pn = (int)L % 6, pm = (int)L / 6, off = (pn >= 4) ? 128 : 0;
        u.pm = pm; u.pn = pn; u.x0 = 0; u.x1 = 0; u.ao = (long)pm * 256 * 384 + off; u.bo = (long)pn * 256 * 384 + off; return true;
    }
};
template <int WHICH> struct AttnSched {
    int G, c;
    DEV void init() { G = (int)gridDim.x; c = (int)blockIdx.x; }
    DEV bool next(int i, Unit& u) const {
        const long L = (long)i * G + c; if (L >= 256) return false;
        const int xcd = (int)L & 7, idx = (int)L >> 3, bh = xcd * 4 + (idx >> 3), mt = idx & 7, b = bh >> 2, h = bh & 3;
        u.pm = mt; u.pn = 0; u.x0 = bh; u.x1 = mt;
        if (WHICH == 0) { u.ao = ((long)b * 2048 + mt * 256) * 1024 + h * 256; u.bo = ((long)b * 256) * 1024 + h * 256; }
        else { u.ao = ((long)bh * 2048 + mt * 256) * 256; u.bo = ((long)h * 256) * 2048 + b * 256; }
        return true;
    }
};

template <class Epi, class Sched>
DEV void gemm_phase(LAS unsigned char* lds, const Gemm g, const Sched& S, const Epi& E) {
    int tid_ = threadIdx.x; asm volatile("" : "+v"(tid_));
    const int tid = tid_, wid = __builtin_amdgcn_readfirstlane(tid >> 6), lane = tid & 63, wr = wid >> 2, wc = wid & 3, fr = lane & 15, fq = lane >> 4;
    int K = g.K, lda_ = g.lda, ldb_ = g.ldb; asm volatile("" : "+s"(K), "+s"(lda_), "+s"(ldb_)); const int nt = K / BK;
    unsigned voffA[2], voffB[2];
#pragma unroll
    for (int i = 0; i < 2; ++i) { int R, C; stage_rc(tid * 16 + i * 8192, R, C); voffA[i] = (unsigned)(R * lda_ + C) * 2u; voffB[i] = (unsigned)(R * ldb_ + C) * 2u; }
    const size_t kstep = (size_t)(BK * 2);
    const size_t hstepA = (size_t)HALF * lda_ * 2, hstepB = (size_t)HALF * ldb_ * 2;
    const unsigned ldsw = (unsigned)wid * 1024u;
    const int aoff = lds_byte(wr * 64 + fr, fq * 8), boff = lds_byte(wc * 32 + fr, fq * 8);
#define PG8_SA(b, h) (((b) * 2 + (h)) * HTB)
#define PG8_SB(b, h) ((4 + (b) * 2 + (h)) * HTB)
#define PG8_STAGE(bufoff, gbase, voff) do { _Pragma("unroll") for (int _i = 0; _i < 2; ++_i) \
        __builtin_amdgcn_global_load_lds((const unsigned*)((const char*)(gbase) + (voff)[_i]), (LAS unsigned*)(lds + (bufoff) + ldsw + _i * 8192), 16, 0, 0); } while (0)
#define PG8_LDA(dst, b, h) do { _Pragma("unroll") for (int m = 0; m < 4; ++m) _Pragma("unroll") for (int k = 0; k < 2; ++k) dst[m][k] = *(const LAS bf16x8*)(lds + PG8_SA(b, h) + aoff + m * 2048 + k * 1024); } while (0)
#define PG8_LDB(dst, b, h) do { _Pragma("unroll") for (int n = 0; n < 2; ++n) _Pragma("unroll") for (int k = 0; k < 2; ++k) dst[n][k] = *(const LAS bf16x8*)(lds + PG8_SB(b, h) + boff + n * 2048 + k * 1024); } while (0)
#define PG8_MMA(ai, bj, At, Bt) do { __builtin_amdgcn_s_setprio(1); _Pragma("unroll") for (int m = 0; m < 4; ++m) _Pragma("unroll") for (int n = 0; n < 2; ++n) _Pragma("unroll") for (int k = 0; k < 2; ++k) \
        acc[ai][bj][m][n] = __builtin_amdgcn_mfma_f32_16x16x32_bf16(Bt[n][k], At[m][k], acc[ai][bj][m][n], 0, 0, 0); __builtin_amdgcn_s_setprio(0); } while (0)
#define PG8_WAIT_V(n) asm volatile("s_waitcnt vmcnt(" #n ")" ::: "memory")
#define PG8_WAIT_L(n) asm volatile("s_waitcnt lgkmcnt(" #n ")" ::: "memory")
#define PG8_BAR __builtin_amdgcn_s_barrier()
#define PG8_SCHED __builtin_amdgcn_sched_barrier(0)
    Unit cur, nxt; int ui = 0;
    if (!S.next(0, cur)) return;
    f32x4 acc[2][2][4][2];
#pragma unroll
    for (int a = 0; a < 2; ++a)
#pragma unroll
        for (int b = 0; b < 2; ++b)
#pragma unroll
            for (int m = 0; m < 4; ++m)
#pragma unroll
                for (int n = 0; n < 2; ++n) acc[a][b][m][n] = (f32x4){0.f, 0.f, 0.f, 0.f};
    bf16x8 At[4][2], B0[2][2], B1[2][2];
    const char* cA = (const char*)g.A + (size_t)cur.ao * 2; const char* cB = (const char*)g.Bt + (size_t)cur.bo * 2;
    PG8_STAGE(PG8_SB(0, 0), cB, voffB); PG8_STAGE(PG8_SA(0, 0), cA, voffA); PG8_STAGE(PG8_SB(0, 1), cB + hstepB, voffB); PG8_STAGE(PG8_SA(0, 1), cA + hstepA, voffA);
    if (wr == 1) PG8_BAR;
    PG8_WAIT_V(4); PG8_BAR;
    PG8_STAGE(PG8_SB(1, 0), cB + kstep, voffB); PG8_STAGE(PG8_SA(1, 0), cA + kstep, voffA); PG8_STAGE(PG8_SB(1, 1), cB + hstepB + kstep, voffB);
    PG8_WAIT_V(6); PG8_BAR;
    for (;;) {
        const bool has_next = S.next(ui + 1, nxt);
        const char* nA = has_next ? (const char*)g.A + (size_t)nxt.ao * 2 : cA; const char* nB = has_next ? (const char*)g.Bt + (size_t)nxt.bo * 2 : cB;
#pragma unroll 1
        for (int t = 0; t < nt; t += 2) {
            const bool last = (t == nt - 2);
            const char* a1 = cA + (size_t)(t + 1) * kstep;
            const char* a2 = last ? nA : cA + (size_t)(t + 2) * kstep; const char* b2 = last ? nB : cB + (size_t)(t + 2) * kstep;
            const char* a3 = a2 + kstep; const char* b3 = b2 + kstep;
            PG8_LDB(B0, 0, 0); PG8_SCHED; PG8_LDA(At, 0, 0); PG8_STAGE(PG8_SA(1, 1), a1 + hstepA, voffA);
            PG8_WAIT_L(8); PG8_BAR; PG8_WAIT_L(0); PG8_MMA(0, 0, At, B0); PG8_BAR; PG8_SCHED;
            PG8_LDB(B1, 0, 1); PG8_STAGE(PG8_SB(0, 0), b2, voffB);
            PG8_BAR; PG8_WAIT_L(0); PG8_MMA(0, 1, At, B1); PG8_BAR;
            PG8_LDA(At, 0, 1); PG8_STAGE(PG8_SA(0, 0), a2, voffA);
            PG8_BAR; PG8_WAIT_L(0); PG8_MMA(1, 0, At, B0); PG8_BAR; PG8_SCHED;
            PG8_STAGE(PG8_SB(0, 1), b2 + hstepB, voffB);
            PG8_WAIT_V(6); PG8_BAR; PG8_MMA(1, 1, At, B1); PG8_BAR;
            PG8_LDB(B0, 1, 0); PG8_SCHED; PG8_LDA(At, 1, 0); PG8_STAGE(PG8_SA(0, 1), a2 + hstepA, voffA);
            PG8_WAIT_L(8); PG8_BAR; PG8_WAIT_L(0); PG8_MMA(0, 0, At, B0); PG8_BAR; PG8_SCHED;
            PG8_LDB(B1, 1, 1); PG8_STAGE(PG8_SB(1, 0), b3, voffB);
            PG8_BAR; PG8_WAIT_L(0); PG8_MMA(0, 1, At, B1); PG8_BAR;
            PG8_LDA(At, 1, 1); PG8_STAGE(PG8_SA(1, 0), a3, voffA);
            PG8_BAR; PG8_WAIT_L(0); PG8_MMA(1, 0, At, B0); PG8_BAR; PG8_SCHED;
            PG8_STAGE(PG8_SB(1, 1), b3 + hstepB, voffB);
            PG8_WAIT_V(6); PG8_BAR; PG8_MMA(1, 1, At, B1); PG8_BAR;
        }
        E(acc, cur, wr, wc, fr, fq);
        if (!has_next) break;
#pragma unroll
        for (int a = 0; a < 2; ++a)
#pragma unroll
            for (int b = 0; b < 2; ++b)
#pragma unroll
                for (int m = 0; m < 4; ++m)
#pragma unroll
                    for (int n = 0; n < 2; ++n) acc[a][b][m][n] = (f32x4){0.f, 0.f, 0.f, 0.f};
        cur = nxt; cA = nA; cB = nB; ++ui;
    }
    PG8_WAIT_V(0);
    if (wr == 0) PG8_BAR;
    PG8_BAR;
#undef PG8_SA
#undef PG8_SB
#undef PG8_STAGE
#undef PG8_LDA
#undef PG8_LDB
#undef PG8_MMA
#undef PG8_WAIT_V
#undef PG8_WAIT_L
#undef PG8_BAR
#undef PG8_SCHED
}
}
using pg8::Unit;

typedef const f32x4 (&AccRef)[2][2][4][2];

struct EpiSwiglu {
    const float* rs; bf16_t* H;
    DEV void operator()(AccRef acc, const Unit& u, int wr, int wc, int fr, int fq) const {
        const int row0 = u.pm * 256 + wr * 64 + fr, hc0 = u.pn * 128 + wc * 16 + 4 * fq;
#pragma unroll
        for (int ai = 0; ai < 2; ++ai)
#pragma unroll
            for (int m = 0; m < 4; ++m) {
                const int r = row0 + ai * 128 + m * 16; const float rstd = rstd_of(rs, r);
#pragma unroll
                for (int bj = 0; bj < 2; ++bj) {
                    float hv[4];
#pragma unroll
                    for (int i = 0; i < 4; ++i) { const float gt = acc[ai][bj][m][0][i] * rstd, up = acc[ai][bj][m][1][i] * rstd; hv[i] = gt * sigmoidf_(gt) * up; }
                    u32x2 o; o[0] = cvt_pk_bf16(hv[0], hv[1]); o[1] = cvt_pk_bf16(hv[2], hv[3]);
                    *(u32x2*)(H + (size_t)r * DFF + hc0 + bj * 64) = o;
                }
            }
    }
};

struct EpiRes {
    const float* res; bf16_t* xb; float* rs_out; float alpha;
    DEV void operator()(AccRef acc, const Unit& u, int wr, int wc, int fr, int fq) const {
        const int row0 = u.pm * 256 + wr * 64 + fr, col0 = u.pn * 256 + wc * 32 + 4 * fq;
#pragma unroll
        for (int ai = 0; ai < 2; ++ai)
#pragma unroll
            for (int mh = 0; mh < 2; ++mh) {
                f32x4 x[2][2][2];
#pragma unroll
                for (int m2 = 0; m2 < 2; ++m2)
#pragma unroll
                    for (int bj = 0; bj < 2; ++bj)
#pragma unroll
                        for (int n = 0; n < 2; ++n) { const size_t o = (size_t)(row0 + ai * 128 + (mh * 2 + m2) * 16) * 1024 + col0 + bj * 128 + n * 16;
                            x[m2][bj][n] = res ? *(const f32x4*)(res + o) : bf4(*(const u32x2*)(xb + o)); }
#pragma unroll
                for (int m2 = 0; m2 < 2; ++m2) {
                    const int m = mh * 2 + m2, r = row0 + ai * 128 + m * 16; float s = 0.f;
#pragma unroll
                    for (int bj = 0; bj < 2; ++bj)
#pragma unroll
                        for (int n = 0; n < 2; ++n) {
                            const int c = col0 + bj * 128 + n * 16; const f32x4 v = x[m2][bj][n] + alpha * acc[ai][bj][m][n];
                            *(u32x2*)(xb + (size_t)r * 1024 + c) = pk4(v);
                            s += v[0] * v[0] + v[1] * v[1] + v[2] * v[2] + v[3] * v[3];
                        }
                    s += __shfl_xor(s, 16); s += __shfl_xor(s, 32);
                    if (fq == 0) rs_out[(size_t)r * 16 + u.pn * 4 + wc] = s;
                }
            }
    }
};

struct EpiScale {
    const float* rs; bf16_t* O; int ldo, ncols;
    DEV void operator()(AccRef acc, const Unit& u, int wr, int wc, int fr, int fq) const {
        const int row0 = u.pm * 256 + wr * 64 + fr, col0 = u.pn * 256 + wc * 32 + 4 * fq;
#pragma unroll
        for (int ai = 0; ai < 2; ++ai)
#pragma unroll
            for (int m = 0; m < 4; ++m) {
                const int r = row0 + ai * 128 + m * 16; const float rstd = rstd_of(rs, r);
#pragma unroll
                for (int bj = 0; bj < 2; ++bj)
#pragma unroll
                    for (int n = 0; n < 2; ++n) {
                        const int c = col0 + bj * 128 + n * 16;
                        if (c < ncols) { const f32x4 v = acc[ai][bj][m][n] * rstd; u32x2 o; o[0] = cvt_pk_bf16(v[0], v[1]); o[1] = cvt_pk_bf16(v[2], v[3]); *(u32x2*)(O + (size_t)r * ldo + c) = o; }
                    }
            }
    }
};

struct EpiLora {
    const float* w0; const float* a0; const float* k_a; float* dec; bf16_t* kbuf; const bf16_t* kkbuf; bf16_t* kka; bf16_t* gb;
    template <int REGION> DEV void run(AccRef acc, const Unit& u, int wr, int wc, int fr, int fq) const {
        const int row0 = u.pm * 256 + wr * 64 + fr, cb = (u.pn & 1) * 256 + wc * 32 + 4 * fq;
#pragma unroll
        for (int ai = 0; ai < 2; ++ai)
#pragma unroll
            for (int m = 0; m < 4; ++m) {
                const int r = row0 + ai * 128 + m * 16;
                {
#pragma unroll
                    for (int bj = 0; bj < 2; ++bj)
#pragma unroll
                        for (int n = 0; n < 2; ++n) {
                            const int cc = cb + bj * 128 + n * 16; const f32x4 a = acc[ai][bj][m][n]; const size_t o = (size_t)r * 512 + cc;
                            if (REGION == 0) {
                                const f32x4 b0 = *(const f32x4*)(w0 + cc); f32x4 d;
#pragma unroll
                                for (int i = 0; i < 4; ++i) d[i] = __expf(-0.60653066f * sigmoidf_(b0[i] + a[i]));
                                *(f32x4*)(dec + o) = d;
                            } else if (REGION == 1) {
                                const f32x4 b0 = *(const f32x4*)(a0 + cc), ka = *(const f32x4*)(k_a + cc), kv = bf4(*(const u32x2*)(kbuf + o)), kkv = bf4(*(const u32x2*)(kkbuf + o)); f32x4 kn, kkan;
#pragma unroll
                                for (int i = 0; i < 4; ++i) { const float av = sigmoidf_(b0[i] + a[i]); kn[i] = kv[i] * (1.f + (av - 1.f) * ka[i]); kkan[i] = kkv[i] * av; }
                                *(u32x2*)(kbuf + o) = pk4(kn); *(u32x2*)(kka + o) = pk4(kkan);
                            } else {
                                u32x2 ov; ov[0] = cvt_pk_bf16(a[0], a[1]); ov[1] = cvt_pk_bf16(a[2], a[3]); *(u32x2*)(gb + o) = ov;
                            }
                        }
                }
            }
    }
    DEV void operator()(AccRef acc, const Unit& u, int wr, int wc, int fr, int fq) const {
        const int region = u.pn >> 1;
        if (region == 0) run<0>(acc, u, wr, wc, fr, fq); else if (region == 1) run<1>(acc, u, wr, wc, fr, fq); else run<2>(acc, u, wr, wc, fr, fq);
    }
};

struct EpiK {
    const float* rstdm; float* outk; bf16_t* mkb;
    DEV void operator()(AccRef acc, const Unit& u, int wr, int wc, int fr, int fq) const {
        const int row0 = u.pm * 256 + wr * 64 + fr, col0 = u.pn * 256 + wc * 32 + 4 * fq;
#pragma unroll
        for (int ai = 0; ai < 2; ++ai)
#pragma unroll
            for (int m = 0; m < 4; ++m) {
                const int r = row0 + ai * 128 + m * 16; const float rstd = rstdm[r];
#pragma unroll
                for (int bj = 0; bj < 2; ++bj)
#pragma unroll
                    for (int n = 0; n < 2; ++n) {
                        const int c = col0 + bj * 128 + n * 16; const f32x4 v = acc[ai][bj][m][n] * rstd;
                        *(f32x4*)(outk + (size_t)r * 1024 + c) = v;
                        u32x2 o; o[0] = cvt_pk_bf16(v[0], v[1]); o[1] = cvt_pk_bf16(v[2], v[3]); *(u32x2*)(mkb + (size_t)r * 1024 + c) = o;
                    }
            }
    }
};
struct EpiVT {
    const float* rstdm; float* outv; bf16_t* vt;
    DEV void operator()(AccRef acc, const Unit& u, int wr, int wc, int fr, int fq) const {
        const int row0 = u.pm * 256 + wr * 64 + fr, col0 = u.pn * 256 + wc * 32 + 4 * fq;
#pragma unroll
        for (int bj = 0; bj < 2; ++bj)
#pragma unroll
            for (int n = 0; n < 2; ++n) {
                const int c = col0 + bj * 128 + n * 16; const f32x4 rsd = *(const f32x4*)(rstdm + c);
#pragma unroll
                for (int ai = 0; ai < 2; ++ai)
#pragma unroll
                    for (int m = 0; m < 4; ++m) {
                        const int r = row0 + ai * 128 + m * 16; const f32x4 v = acc[ai][bj][m][n] * rsd;
                        u32x2 o; o[0] = cvt_pk_bf16(v[0], v[1]); o[1] = cvt_pk_bf16(v[2], v[3]); *(u32x2*)(vt + (size_t)r * 2048 + c) = o;
#pragma unroll
                        for (int i = 0; i < 4; ++i) outv[(size_t)(c + i) * 1024 + r] = v[i];
                    }
            }
    }
};
struct EpiS {
    bf16_t* P; float* psum;
    DEV void operator()(AccRef acc, const Unit& u, int wr, int wc, int fr, int fq) const {
        const size_t prow0 = (size_t)u.x0 * 2048 + u.x1 * 256;
#pragma unroll
        for (int ai = 0; ai < 2; ++ai)
#pragma unroll
            for (int m = 0; m < 4; ++m) {
                const int rl = ai * 128 + wr * 64 + m * 16 + fr; float s = 0.f;
#pragma unroll
                for (int bj = 0; bj < 2; ++bj)
#pragma unroll
                    for (int n = 0; n < 2; ++n) {
                        const f32x4 a = acc[ai][bj][m][n]; u32x2 o;
                        o[0] = cvt_pk_bf16(__expf(a[0]), __expf(a[1])); o[1] = cvt_pk_bf16(__expf(a[2]), __expf(a[3]));
                        s += bf_lo(o[0]) + bf_hi(o[0]) + bf_lo(o[1]) + bf_hi(o[1]);
                        *(u32x2*)(P + (prow0 + rl) * 256 + bj * 128 + wc * 32 + n * 16 + 4 * fq) = o;
                    }
                s += __shfl_xor(s, 16); s += __shfl_xor(s, 32);
                if (fq == 0) psum[(prow0 + rl) * 4 + wc] = s;
            }
    }
};
struct EpiO {
    const float* psum; bf16_t* O;
    DEV void operator()(AccRef acc, const Unit& u, int wr, int wc, int fr, int fq) const {
        const int bh = u.x0, b = bh >> 2, h = bh & 3; const size_t prow0 = (size_t)bh * 2048 + u.x1 * 256; const size_t m0 = (size_t)b * 2048 + u.x1 * 256;
#pragma unroll
        for (int ai = 0; ai < 2; ++ai)
#pragma unroll
            for (int m = 0; m < 4; ++m) {
                const int rl = ai * 128 + wr * 64 + m * 16 + fr; const f32x4 p = *(const f32x4*)(psum + (prow0 + rl) * 4); const float inv = __builtin_amdgcn_rcpf(p[0] + p[1] + p[2] + p[3]);
#pragma unroll
                for (int bj = 0; bj < 2; ++bj)
#pragma unroll
                    for (int n = 0; n < 2; ++n) {
                        const f32x4 v = acc[ai][bj][m][n] * inv; u32x2 o; o[0] = cvt_pk_bf16(v[0], v[1]); o[1] = cvt_pk_bf16(v[2], v[3]);
                        *(u32x2*)(O + (m0 + rl) * 1024 + h * 256 + bj * 128 + wc * 32 + n * 16 + 4 * fq) = o;
                    }
            }
    }
};

struct SRes {
    const float* res; bf16_t* xb; float* rs_out; float alpha; int res_row0;
    DEV void operator()(int r, int c, f32x4 a, int slab, int l15) const {
        const f32x4 x0 = res ? *(const f32x4*)(res + (size_t)(r - res_row0) * 1024 + c) : bf4(*(const u32x2*)(xb + (size_t)r * 1024 + c));
        const f32x4 x = x0 + alpha * a;
        *(u32x2*)(xb + (size_t)r * 1024 + c) = pk4(x);
        const float s = rowsum16(x[0] * x[0] + x[1] * x[1] + x[2] * x[2] + x[3] * x[3]);
        if (l15 == 0) rs_out[(size_t)r * 16 + slab] = s;
    }
};
struct SScale {
    const float* rs; bf16_t* O; int ldo, ncols, col_off;
    DEV void operator()(int r, int c, f32x4 a, int, int) const {
        const int cc = c + col_off;
        if (cc < ncols) { const f32x4 v = a * rstd_of(rs, r); u32x2 o; o[0] = cvt_pk_bf16(v[0], v[1]); o[1] = cvt_pk_bf16(v[2], v[3]); *(u32x2*)(O + (size_t)r * ldo + cc) = o; }
    }
};
template <int NB, class Epi>
DEV void small_gemm(LAS unsigned char* lds, const bf16_t* A, int lda, const bf16_t* Bt, int ldb, int K, int row_base, int nrg, int nslab, const Epi& E) {
    const int tid = fresh_tid(), lane = tid & 63, w = tid >> 6, l15 = lane & 15, kg = lane >> 4;
    LAS float* red = (LAS float*)lds;
    const int kw = K >> 3;
    for (int item = blockIdx.x; item < nrg * nslab; item += gridDim.x) {
        const int rgi = item % nrg, slab = item / nrg, r0 = row_base + rgi * 32, c0 = slab * 64;
        f32x4 acc[2][4];
#pragma unroll
        for (int rb = 0; rb < 2; ++rb)
#pragma unroll
            for (int n = 0; n < 4; ++n) acc[rb][n] = (f32x4){0.f, 0.f, 0.f, 0.f};
        const bf16_t* ap = A + (size_t)(r0 + l15) * lda + w * kw + kg * 8;
        const bf16_t* bp = Bt + (size_t)(c0 + l15) * ldb + w * kw + kg * 8;
#pragma unroll 4
        for (int k = 0; k < kw; k += 32) {
            const bf16x8 a0 = *(const bf16x8*)(ap + k), a1 = *(const bf16x8*)(ap + (size_t)16 * lda + k);
            bf16x8 b[NB];
#pragma unroll
            for (int n = 0; n < NB; ++n) b[n] = *(const bf16x8*)(bp + (size_t)(n * 16) * ldb + k);
#pragma unroll
            for (int n = 0; n < NB; ++n) { acc[0][n] = __builtin_amdgcn_mfma_f32_16x16x32_bf16(b[n], a0, acc[0][n], 0, 0, 0); acc[1][n] = __builtin_amdgcn_mfma_f32_16x16x32_bf16(b[n], a1, acc[1][n], 0, 0, 0); }
        }
        __syncthreads();
#pragma unroll
        for (int rb = 0; rb < 2; ++rb)
#pragma unroll
            for (int n = 0; n < 4; ++n) *(LAS f32x4*)(red + ((w * 32 + rb * 16 + l15) * 64 + n * 16 + 4 * kg)) = acc[rb][n];
        __syncthreads();
        const int row = tid >> 4, c4 = (tid & 15) * 4; f32x4 sum = (f32x4){0.f, 0.f, 0.f, 0.f};
#pragma unroll
        for (int ww = 0; ww < 8; ++ww) sum = sum + *(const LAS f32x4*)(red + ((ww * 32 + row) * 64 + c4));
        E(r0 + row, c0 + c4, sum, slab, tid & 15);
    }
}

DEV void ld8bf(const bf16_t* p, float (&v)[8]) { const u32x4 u = *(const u32x4*)p;
#pragma unroll
    for (int i = 0; i < 4; ++i) { v[2 * i] = bf_lo(u[i]); v[2 * i + 1] = bf_hi(u[i]); } }
DEV void ld8f(const float* p, float (&v)[8]) { const f32x4 a = *(const f32x4*)p, b = *(const f32x4*)(p + 4);
#pragma unroll
    for (int i = 0; i < 4; ++i) { v[i] = a[i]; v[4 + i] = b[i]; } }
DEV void st8f(float* p, const float (&v)[8]) { *(f32x4*)p = (f32x4){v[0], v[1], v[2], v[3]}; *(f32x4*)(p + 4) = (f32x4){v[4], v[5], v[6], v[7]}; }
DEV void st8bf(bf16_t* p, const float (&v)[8]) { u32x4 o; o[0] = cvt_pk_bf16(v[0], v[1]); o[1] = cvt_pk_bf16(v[2], v[3]); o[2] = cvt_pk_bf16(v[4], v[5]); o[3] = cvt_pk_bf16(v[6], v[7]); *(u32x4*)p = o; }

DEV void tr_job(const float* __restrict__ src, int Ks, int Ns, int Nd, bf16_t* __restrict__ dst, int mode, const float* __restrict__ gain, float scale, LAS float* tile) {
    const int nk = Ks / 64, nn = Nd / 64, ntile = nk * nn, ldd = Ks; const int t = fresh_tid();
    f32x4 v0, v1;
    auto gl = [&](int ti) { const int tk = ti % nk, tn = ti / nk;
        { const int id = t, k = id >> 4, gn = tn * 64 + (id & 15) * 4; v0 = (gn < Ns) ? *(const f32x4*)(src + (size_t)(tk * 64 + k) * Ns + gn) : (f32x4){0.f, 0.f, 0.f, 0.f}; if (gain) v0 = v0 * (gain[tk * 64 + k] * scale); }
        { const int id = t + 512, k = id >> 4, gn = tn * 64 + (id & 15) * 4; v1 = (gn < Ns) ? *(const f32x4*)(src + (size_t)(tk * 64 + k) * Ns + gn) : (f32x4){0.f, 0.f, 0.f, 0.f}; if (gain) v1 = v1 * (gain[tk * 64 + k] * scale); } };
    int ti = blockIdx.x;
    if (ti < ntile) gl(ti);
    for (; ti < ntile; ti += gridDim.x) {
        const int tk = ti % nk, tn = ti / nk;
        *(LAS f32x4*)(tile + (t >> 4) * 68 + (t & 15) * 4) = v0; *(LAS f32x4*)(tile + ((t + 512) >> 4) * 68 + (t & 15) * 4) = v1;
        if (ti + (int)gridDim.x < ntile) gl(ti + gridDim.x);
        __syncthreads();
        { const int n = t & 63, k8 = (t >> 6) * 8, gn = tn * 64 + n; float v[8];
#pragma unroll
          for (int j = 0; j < 8; ++j) v[j] = tile[(k8 + j) * 68 + n];
          const int drow = mode == 0 ? gn : ((gn >> 4) * 32 + (mode == 2 ? 16 : 0) + (gn & 15));
          st8bf(dst + (size_t)drow * ldd + tk * 64 + k8, v); }
        __syncthreads();
    }
}

DEV void phase_prep(const Params& p, LAS unsigned char* lds) {
    unsigned char* ws = p.ws; LAS float* tile = (LAS float*)lds;
    const int tid = fresh_tid(), lane = tid & 63, gw = blockIdx.x * 8 + (tid >> 6), nw = gridDim.x * 8;
    bf16_t* xb = (bf16_t*)(ws + O_XB); float* rs1 = (float*)(ws + O_RS1);
#pragma unroll 2
    for (int r = gw; r < MP; r += nw) {
        float ss = 0.f;
        if (r < MV) {
            const float* xr = r < NTOK ? p.in[I_XP] + (size_t)r * 1024 : p.in[I_XS] + (size_t)(r - NTOK) * 1024;
#pragma unroll
            for (int i = 0; i < 4; ++i) { const int c = lane * 4 + 256 * i; const f32x4 v = *(const f32x4*)(xr + c); ss += v[0] * v[0] + v[1] * v[1] + v[2] * v[2] + v[3] * v[3];
                u32x2 o; o[0] = cvt_pk_bf16(v[0], v[1]); o[1] = cvt_pk_bf16(v[2], v[3]); *(u32x2*)(xb + (size_t)r * 1024 + c) = o; }
            ss = wsum64(ss);
        } else {
#pragma unroll
            for (int i = 0; i < 4; ++i) { u32x2 o; o[0] = 0; o[1] = 0; *(u32x2*)(xb + (size_t)r * 1024 + lane * 4 + 256 * i) = o; }
        }
        if (lane < 16) { rs1[(size_t)r * 16 + lane] = lane == 0 ? ss : 0.f;
            if (r >= MV) { ((float*)(ws + O_RS2))[(size_t)r * 16 + lane] = 0.f; ((float*)(ws + O_RS3))[(size_t)r * 16 + lane] = 0.f; ((float*)(ws + O_RS4))[(size_t)r * 16 + lane] = 0.f; ((float*)(ws + O_RS5))[(size_t)r * 16 + lane] = 0.f; } }
    }
    bf16_t* mnb = (bf16_t*)(ws + O_MNB); float* rstdm = (float*)(ws + O_RSTDM);
    for (int r = gw; r < NMEMR; r += nw) {
        const float* xr = p.in[I_MEM] + (size_t)r * 1024; float ss = 0.f;
#pragma unroll
        for (int i = 0; i < 4; ++i) { const int c = lane * 4 + 256 * i; const f32x4 v = *(const f32x4*)(xr + c); ss += v[0] * v[0] + v[1] * v[1] + v[2] * v[2] + v[3] * v[3];
            u32x2 o; o[0] = cvt_pk_bf16(v[0], v[1]); o[1] = cvt_pk_bf16(v[2], v[3]); *(u32x2*)(mnb + (size_t)r * 1024 + c) = o; }
        ss = wsum64(ss);
        if (lane == 0) rstdm[r] = rsqrtf(ss * (1.f / 1024.f) + 1e-6f);
    }
    { bf16_t* wl = (bf16_t*)(ws + O_WLORA);
      for (int i = blockIdx.x * 512 + tid; i < 1536 * 384; i += gridDim.x * 512) {
          const int n = i / 384, k = i % 384, reg = n >> 9, c = n & 511; float v = 0.f;
          if (reg == 0 && k < 64) v = p.in[I_W2][k * 512 + c];
          else if (reg == 1 && k >= 64 && k < 128) v = p.in[I_A2][(k - 64) * 512 + c];
          else if (reg == 2 && k >= 128 && k < 288) v = p.in[I_G2][(k - 128) * 512 + c];
          wl[i] = (bf16_t)(cvt_pk_bf16(v, 0.f) & 0xffffu);
      } }
    tr_job(p.in[I_G1], 1024, 2816, 2816, (bf16_t*)(ws + O_WGU1), 1, p.in[I_LN1], 1.f, tile);
    tr_job(p.in[I_U1], 1024, 2816, 2816, (bf16_t*)(ws + O_WGU1), 2, p.in[I_LN1], 1.f, tile);
    tr_job(p.in[I_XK], 1024, 1024, 1024, (bf16_t*)(ws + O_WK), 0, p.in[I_MEMN], 1.f, tile);
    tr_job(p.in[I_XV], 1024, 1024, 1024, (bf16_t*)(ws + O_WV), 0, p.in[I_MEMN], 1.f, tile);
    tr_job(p.in[I_D1], 2816, 1024, 1024, (bf16_t*)(ws + O_WD1), 0, nullptr, 1.f, tile);
    tr_job(p.in[I_WIN], 1024, 2848, 3072, (bf16_t*)(ws + O_WIN), 0, p.in[I_LNMIX], 1.f, tile);
    tr_job(p.in[I_WOUT], 1024, 1024, 1024, (bf16_t*)(ws + O_WOUT), 0, nullptr, 1.f, tile);
    tr_job(p.in[I_XQ], 1024, 1024, 1024, (bf16_t*)(ws + O_WQ), 0, p.in[I_LNX], 0.0625f, tile);
    tr_job(p.in[I_XO], 1024, 1024, 1024, (bf16_t*)(ws + O_WO), 0, nullptr, 1.f, tile);
    tr_job(p.in[I_G2F], 1024, 2816, 2816, (bf16_t*)(ws + O_WGU2), 1, p.in[I_LN2], 1.f, tile);
    tr_job(p.in[I_U2F], 1024, 2816, 2816, (bf16_t*)(ws + O_WGU2), 2, p.in[I_LN2], 1.f, tile);
    tr_job(p.in[I_D2F], 2816, 1024, 1024, (bf16_t*)(ws + O_WD2), 0, nullptr, 1.f, tile);
}

DEV void phase_mixprep(const Params& p) {
    unsigned char* ws = p.ws; const int tid = fresh_tid(), lane = tid & 63, gw = blockIdx.x * 8 + (tid >> 6), nw = gridDim.x * 8;
    const bf16_t* z = (const bf16_t*)(ws + O_Z); bf16_t* vab = (bf16_t*)(ws + O_VAB); bf16_t* lin = (bf16_t*)(ws + O_LIN); bf16_t* ymix = (bf16_t*)(ws + O_YMIX);
    bf16_t* rbuf = (bf16_t*)(ws + O_H); bf16_t* kbuf = (bf16_t*)(ws + O_H + HALFROW); bf16_t* vbuf = (bf16_t*)(ws + O_XRES); bf16_t* kkbuf = (bf16_t*)(ws + O_KK);
#pragma unroll 2
    for (int r = gw; r < MV; r += nw) {
        const bf16_t* zr = z + (size_t)r * ZLD; const bool smp = r >= NTOK; const int t = r & (SEQ - 1), si = r - NTOK;
        {
            const int c = lane * 8; float v[8]; ld8bf(zr + 512 + c, v); float s = 0.f;
#pragma unroll
            for (int i = 0; i < 8; ++i) { v[i] = gelu_t(v[i]); s += v[i]; }
            const float mu = wsum64(s) * (1.f / 512.f); float q = 0.f;
#pragma unroll
            for (int i = 0; i < 8; ++i) { v[i] -= mu; q += v[i] * v[i]; }
            const float rstd = rsqrtf(wsum64(q) * (1.f / 512.f) + 1e-5f); float g[8], b[8]; ld8f(p.in[I_SLNG] + c, g); ld8f(p.in[I_SLNB] + c, b);
#pragma unroll
            for (int i = 0; i < 8; ++i) v[i] = v[i] * rstd * g[i] + b[i];
            st8bf(vab + (size_t)r * 512 + c, v);
            if (smp) {
                st8f(p.out + OUT_CV + (size_t)si * 512 + c, v);
                const int grp = c >> 6; const float w00 = p.in[I_SGUW][grp * 16384], b0 = p.in[I_SGUB][grp * 128]; float uu[8]; ld8bf(zr + c, uu);
#pragma unroll
                for (int i = 0; i < 8; ++i) uu[i] = gelu_t(uu[i]) * (w00 * v[i] + b0);
                st8bf(ymix + (size_t)r * 1024 + c, uu);
            }
        }
#pragma unroll
        for (int it = 0; it < 4; ++it) {
            const int ch = lane + 64 * it; if (ch >= 228) break;
            const int cb = ch * 8; float cur[8], prv[8], mu[8], zs[8]; ld8bf(zr + 1024 + cb, cur);
            if (smp) ld8f(p.in[I_SSHIFT] + (size_t)si * BPROJ + cb, prv);
            else if (t == 0) {
#pragma unroll
                for (int i = 0; i < 8; ++i) prv[i] = 0.f;
            } else ld8bf(zr - ZLD + 1024 + cb, prv);
            ld8f(p.in[I_MU] + cb, mu);
#pragma unroll
            for (int i = 0; i < 8; ++i) zs[i] = cur[i] + (prv[i] - cur[i]) * mu[i];
            if (smp) st8f(p.out + OUT_SHS + (size_t)si * BPROJ + cb, cur);
            else if (t == SEQ - 1) st8f(p.out + OUT_SHP + (size_t)(r >> 11) * BPROJ + cb, cur);
            if (it == 0) st8bf(rbuf + (size_t)r * 512 + cb, zs);
            else if (it == 1) {
                const int c = cb - 512; st8bf(kbuf + (size_t)r * 512 + c, zs); float kkw[8], kk[8]; ld8f(p.in[I_KK] + c, kkw); float ss = 0.f;
#pragma unroll
                for (int i = 0; i < 8; ++i) { kk[i] = zs[i] * kkw[i]; ss += kk[i] * kk[i]; }
                ss += __shfl_xor(ss, 1); ss += __shfl_xor(ss, 2); ss += __shfl_xor(ss, 4);
                const float rn = rsqrtf(fmaxf(ss, 1e-24f));
#pragma unroll
                for (int i = 0; i < 8; ++i) kk[i] *= rn;
                st8bf(kkbuf + (size_t)r * 512 + c, kk);
            } else if (it == 2) st8bf(vbuf + (size_t)r * 512 + (cb - 1024), zs);
            else {
                const int l = ch - 192; float o[8];
#pragma unroll
                for (int i = 0; i < 8; ++i) o[i] = l < 8 ? tanhf_(zs[i]) : (l < 16 ? zs[i] : sigmoidf_(zs[i]));
                st8bf(lin + (size_t)r * 384 + l * 8, o);
            }
        }
        if (lane >= 36 && lane < 48) { const float zero[8] = {0.f, 0.f, 0.f, 0.f, 0.f, 0.f, 0.f, 0.f}; st8bf(lin + (size_t)r * 384 + lane * 8, zero); }
    }
}

DEV void phase_chunkmix(const Params& p, LAS unsigned char* lds) {
    unsigned char* ws = p.ws; const int tid = fresh_tid(), lane = tid & 63, w = tid >> 6, l15 = lane & 15, kg = lane >> 4;
    const bf16_t* z = (const bf16_t*)(ws + O_Z); const bf16_t* vab = (const bf16_t*)(ws + O_VAB); bf16_t* ymix = (bf16_t*)(ws + O_YMIX);
    LAS bf16_t* vaT = (LAS bf16_t*)lds;
    for (int item = blockIdx.x; item < 1024; item += gridDim.x) {
        const int g = item & 7, bc = item >> 3; const size_t m0 = (size_t)bc * 128;
        const int trow = 16 * w + l15; const float* wrow = p.in[I_SGUW] + ((size_t)g * 128 + trow) * 128;
        const int nks = (16 * w + 16 + 31) >> 5;
        f32x4 ar[4][2];
#pragma unroll
        for (int ks = 0; ks < 4; ++ks) if (ks < nks) { ar[ks][0] = *(const f32x4*)(wrow + 32 * ks + kg * 8); ar[ks][1] = *(const f32x4*)(wrow + 32 * ks + kg * 8 + 4); }
        bf16_t zu[4][4]; float bs[4];
#pragma unroll
        for (int j = 0; j < 4; ++j) { const int t = 16 * w + kg * 4 + j; bs[j] = p.in[I_SGUB][g * 128 + t];
#pragma unroll
            for (int nb = 0; nb < 4; ++nb) zu[j][nb] = z[(m0 + t) * ZLD + g * 64 + nb * 16 + l15]; }
        __syncthreads();
#pragma unroll
        for (int i = 0; i < 2; ++i) { const int id = tid + 512 * i, s = id >> 3, d8 = (id & 7) * 8; const u32x4 u = *(const u32x4*)(vab + (m0 + s) * 512 + g * 64 + d8);
#pragma unroll
            for (int j = 0; j < 4; ++j) { vaT[(d8 + 2 * j) * 136 + s] = (bf16_t)(u[j] & 0xffffu); vaT[(d8 + 2 * j + 1) * 136 + s] = (bf16_t)(u[j] >> 16); } }
        __syncthreads();
        f32x4 acc[4];
#pragma unroll
        for (int nb = 0; nb < 4; ++nb) acc[nb] = (f32x4){0.f, 0.f, 0.f, 0.f};
#pragma unroll
        for (int ks = 0; ks < 4; ++ks) if (ks < nks) {
            const int s0 = 32 * ks + kg * 8; float a[8];
#pragma unroll
            for (int i = 0; i < 4; ++i) { a[i] = ar[ks][0][i]; a[4 + i] = ar[ks][1][i]; }
#pragma unroll
            for (int i = 0; i < 8; ++i) a[i] = (s0 + i <= trow) ? a[i] : 0.f;
            u32x4 au; au[0] = cvt_pk_bf16(a[0], a[1]); au[1] = cvt_pk_bf16(a[2], a[3]); au[2] = cvt_pk_bf16(a[4], a[5]); au[3] = cvt_pk_bf16(a[6], a[7]);
            const bf16x8 av = __builtin_bit_cast(bf16x8, au);
#pragma unroll
            for (int nb = 0; nb < 4; ++nb) { const bf16x8 bv = *(const LAS bf16x8*)(vaT + (nb * 16 + l15) * 136 + s0); acc[nb] = __builtin_amdgcn_mfma_f32_16x16x32_bf16(av, bv, acc[nb], 0, 0, 0); }
        }
#pragma unroll
        for (int j = 0; j < 4; ++j) { const int t = 16 * w + kg * 4 + j; const float bias = bs[j]; const size_t m = m0 + t;
#pragma unroll
            for (int nb = 0; nb < 4; ++nb) { const int d = g * 64 + nb * 16 + l15; const float u = gelu_t(bf2f(zu[j][nb])); ymix[m * 1024 + d] = (bf16_t)(cvt_pk_bf16(u * (acc[nb][j] + bias), 0.f) & 0xffffu); } }
    }
}

DEV void phase_scan(const Params& p, LAS unsigned char* lds) {
    unsigned char* ws = p.ws; const int tid = fresh_tid(), lane = tid & 63, w = tid >> 6, rg = lane >> 4, kq = lane & 15;
    const bf16_t* rbuf = (const bf16_t*)(ws + O_H); const bf16_t* kbuf = (const bf16_t*)(ws + O_H + HALFROW); const bf16_t* vbuf = (const bf16_t*)(ws + O_XRES);
    const bf16_t* kkbuf = (const bf16_t*)(ws + O_KK); const float* dec = (const float*)(ws + O_DEC); const bf16_t* kka = (const bf16_t*)(ws + O_KKA); bf16_t* obuf = (bf16_t*)(ws + O_Z);
    constexpr int SL = 16, NCH = SEQ / SL, LB = 5 * SL * 64;
    LAS float* L = (LAS float*)lds;
    LAS float* Lv = L + 2 * LB;
    LAS float* Lp = Lv + 2 * SL * 16;
#define SCAN_BAR() do { asm volatile("s_waitcnt lgkmcnt(0)" ::: "memory"); __builtin_amdgcn_s_barrier(); asm volatile("" ::: "memory"); } while (0)
    for (int item = blockIdx.x; item < 256; item += gridDim.x) {
        const int bh = item >> 2, q = item & 3, b = bh >> 3, h = bh & 7; const size_t m0 = (size_t)b * SEQ;
        if (w >= 4) {
            const int lt = tid - 256, ls = lt >> 4, lc = (lt & 15) * 4;
            f32x4 p1; u32x2 p0, p2, p3, p4, pv; pv[0] = 0u; pv[1] = 0u;
            auto gload = [&](int ch) { const size_t o = (m0 + ch * SL + ls) * 512 + h * 64 + lc;
                p0 = *(const u32x2*)(kkbuf + o); p1 = *(const f32x4*)(dec + o); p2 = *(const u32x2*)(kbuf + o); p3 = *(const u32x2*)(kka + o); p4 = *(const u32x2*)(rbuf + o);
                if (lt < 64) pv = *(const u32x2*)(vbuf + (m0 + ch * SL + (lt >> 2)) * 512 + h * 64 + q * 16 + (lt & 3) * 4); };
            auto fill = [&](int ch) { LAS float* d = L + (ch & 1) * LB + ls * 64 + lc;
                *(LAS f32x4*)d = bf4(p0); *(LAS f32x4*)(d + SL * 64) = p1; *(LAS f32x4*)(d + 2 * SL * 64) = bf4(p2); *(LAS f32x4*)(d + 3 * SL * 64) = bf4(p3); *(LAS f32x4*)(d + 4 * SL * 64) = bf4(p4);
                if (lt < 64) *(LAS f32x4*)(Lv + (ch & 1) * SL * 16 + lt * 4) = bf4(pv); };
            auto reduce_slab = [&](int ch) { const int st = lt >> 4, row = lt & 15; const LAS float* pp = Lp + (ch & 1) * SL * 256 + st * 256 + (row >> 2) * 64 + (row & 3) * 16;
                const f32x4 a = *(const LAS f32x4*)pp, b4 = *(const LAS f32x4*)(pp + 4), c = *(const LAS f32x4*)(pp + 8), d = *(const LAS f32x4*)(pp + 12); const f32x4 t = (a + b4) + (c + d);
                obuf[(m0 + ch * SL + st) * 512 + h * 64 + q * 16 + row] = (bf16_t)(cvt_pk_bf16((t[0] + t[1]) + (t[2] + t[3]), 0.f) & 0xffffu); };
            gload(0); fill(0); gload(1);
            SCAN_BAR();
            for (int ch = 0; ch < NCH; ++ch) {
                if (ch + 1 < NCH) fill(ch + 1);
                if (ch + 2 < NCH) gload(ch + 2);
                if (ch >= 1) reduce_slab(ch - 1);
                SCAN_BAR();
            }
            reduce_slab(NCH - 1);
            {
                const int sidx = item * 4 + (w - 4), si = sidx >> 3, hh = sidx & 7; const size_t o = (size_t)(NTOK + si) * 512 + hh * 64 + kq * 4;
                const f32x4 kk4 = bf4(*(const u32x2*)(kkbuf + o)), w4 = *(const f32x4*)(dec + o), k4 = bf4(*(const u32x2*)(kbuf + o)), ka4 = bf4(*(const u32x2*)(kka + o)), r4 = bf4(*(const u32x2*)(rbuf + o));
                const float* sin = p.in[I_SRWKV] + (size_t)sidx * 4096; float* sout = p.out + OUT_SS + (size_t)sidx * 4096;
                for (int ps = 0; ps < 16; ++ps) {
                    const int v = ps * 4 + rg; f32x4 S = *(const f32x4*)(sin + v * 64 + kq * 4); const float vv = bf2f(vbuf[(size_t)(NTOK + si) * 512 + hh * 64 + v]);
                    const float sa = -rowsum16(S[0] * kk4[0] + S[1] * kk4[1] + S[2] * kk4[2] + S[3] * kk4[3]);
                    S = S * w4 + vv * k4 + sa * ka4;
                    *(f32x4*)(sout + v * 64 + kq * 4) = S;
                    const float op = rowsum16(S[0] * r4[0] + S[1] * r4[1] + S[2] * r4[2] + S[3] * r4[3]);
                    if (kq == 0) obuf[(size_t)(NTOK + si) * 512 + hh * 64 + v] = (bf16_t)(cvt_pk_bf16(op, 0.f) & 0xffffu);
                }
            }
        } else {
            typedef float f32x2v __attribute__((ext_vector_type(2)));
            f32x2v Sa = (f32x2v){0.f, 0.f}, Sb = (f32x2v){0.f, 0.f}; const int row = w * 4 + rg;
            SCAN_BAR();
            for (int ch = 0; ch < NCH; ++ch) {
                const LAS float* Lc = L + (ch & 1) * LB + kq * 4; const LAS float* Lvc = Lv + (ch & 1) * SL * 16 + row;
                LAS float* dst = Lp + (ch & 1) * SL * 256 + w * 64 + lane;
                f32x4 kk4 = *(const LAS f32x4*)Lc, w4 = *(const LAS f32x4*)(Lc + SL * 64), k4 = *(const LAS f32x4*)(Lc + 2 * SL * 64), ka4 = *(const LAS f32x4*)(Lc + 3 * SL * 64), r4 = *(const LAS f32x4*)(Lc + 4 * SL * 64);
                float vv = Lvc[0];
#pragma unroll
                for (int s = 0; s < SL; ++s) {
                    const int sn = s < SL - 1 ? s + 1 : SL - 1; const LAS float* bp = Lc + sn * 64;
                    const f32x4 nkk4 = *(const LAS f32x4*)bp, nw4 = *(const LAS f32x4*)(bp + SL * 64), nk4 = *(const LAS f32x4*)(bp + 2 * SL * 64), nka4 = *(const LAS f32x4*)(bp + 3 * SL * 64), nr4 = *(const LAS f32x4*)(bp + 4 * SL * 64);
                    const float nvv = Lvc[sn * 16];
                    f32x2v t = Sa * kk4.lo; t = Sb * kk4.hi + t;
                    const float sa = -rowsum16(t[0] + t[1]);
                    Sa = (Sa * w4.lo + vv * k4.lo) + sa * ka4.lo;
                    Sb = (Sb * w4.hi + vv * k4.hi) + sa * ka4.hi;
                    f32x2v u = Sa * r4.lo; u = Sb * r4.hi + u;
                    dst[s * 256] = u[0] + u[1];
                    kk4 = nkk4; w4 = nw4; k4 = nk4; ka4 = nka4; r4 = nr4; vv = nvv;
                }
                SCAN_BAR();
            }
            const float S0 = Sa[0], S1 = Sa[1], S2 = Sb[0], S3 = Sb[1];
            *(f32x4*)(p.out + OUT_SP + ((size_t)bh * 64 + q * 16 + row) * 64 + kq * 4) = (f32x4){S0, S1, S2, S3};
        }
        __syncthreads();
    }
#undef SCAN_BAR
}

DEV void phase_finalize(const Params& p) {
    unsigned char* ws = p.ws; const int tid = fresh_tid(), lane = tid & 63, gw = blockIdx.x * 8 + (tid >> 6), nw = gridDim.x * 8;
    const bf16_t* rbuf = (const bf16_t*)(ws + O_H); const bf16_t* kbuf = (const bf16_t*)(ws + O_H + HALFROW); const bf16_t* gb = (const bf16_t*)(ws + O_H + 2 * HALFROW);
    const bf16_t* vbuf = (const bf16_t*)(ws + O_XRES); const bf16_t* obuf = (const bf16_t*)(ws + O_Z); bf16_t* ymix = (bf16_t*)(ws + O_YMIX);
    const int c = lane * 8; float rk[8], gg[8], gbb[8]; ld8f(p.in[I_RK] + c, rk); ld8f(p.in[I_GNG] + c, gg); ld8f(p.in[I_GNB] + c, gbb);
#pragma unroll 2
    for (int r = gw; r < MV; r += nw) {
        const size_t o = (size_t)r * 512 + c; float ov[8], rv[8], kv[8], vv[8], gv[8]; ld8bf(obuf + o, ov); ld8bf(rbuf + o, rv); ld8bf(kbuf + o, kv); ld8bf(vbuf + o, vv); ld8bf(gb + o, gv);
        float s = 0.f, bs = 0.f;
#pragma unroll
        for (int i = 0; i < 8; ++i) { s += ov[i]; bs += rv[i] * kv[i] * rk[i]; }
        s += __shfl_xor(s, 1); s += __shfl_xor(s, 2); s += __shfl_xor(s, 4); bs += __shfl_xor(bs, 1); bs += __shfl_xor(bs, 2); bs += __shfl_xor(bs, 4);
        const float mu = s * (1.f / 64.f); float q = 0.f;
#pragma unroll
        for (int i = 0; i < 8; ++i) { ov[i] -= mu; q += ov[i] * ov[i]; }
        q += __shfl_xor(q, 1); q += __shfl_xor(q, 2); q += __shfl_xor(q, 4);
        const float rstd = rsqrtf(q * (1.f / 64.f) + 64e-5f); float y[8];
#pragma unroll
        for (int i = 0; i < 8; ++i) y[i] = (ov[i] * rstd * gg[i] + gbb[i] + bs * vv[i]) * gv[i];
        st8bf(ymix + (size_t)r * 1024 + 512 + c, y);
    }
}

DEV void phase_sattn(const Params& p, LAS unsigned char* lds) {
    unsigned char* ws = p.ws; const int tid = fresh_tid(), lane = tid & 63, w = tid >> 6, kgrp = lane >> 4, dl = lane & 15;
    const bf16_t* qb = (const bf16_t*)(ws + O_Z + HALFROW); bf16_t* ob = (bf16_t*)(ws + O_YMIX);
    LAS float* pw = (LAS float*)lds;
    LAS float* wm = pw + 256;
    LAS float* wacc = wm + 16;
    for (int item = blockIdx.x; item < 512; item += gridDim.x) {
        const int si = item >> 2, h = item & 3; const float* Kp = p.in[I_CK] + (size_t)si * 262144 + h * 256; const float* Vp = p.in[I_CV] + (size_t)si * 262144 + h * 256;
        float q[16]; { float a[8], b[8]; ld8bf(qb + (size_t)(NTOK + si) * 1024 + h * 256 + dl * 16, a); ld8bf(qb + (size_t)(NTOK + si) * 1024 + h * 256 + dl * 16 + 8, b);
#pragma unroll
            for (int i = 0; i < 8; ++i) { q[i] = a[i]; q[8 + i] = b[i]; } }
        float sc[8];
#pragma unroll
        for (int j = 0; j < 8; ++j) {
            const float* kr = Kp + (size_t)(w * 32 + kgrp + 4 * j) * 1024 + dl * 16; float d = 0.f;
#pragma unroll
            for (int i = 0; i < 4; ++i) { const f32x4 k4 = *(const f32x4*)(kr + 4 * i); d += k4[0] * q[4 * i] + k4[1] * q[4 * i + 1] + k4[2] * q[4 * i + 2] + k4[3] * q[4 * i + 3]; }
            sc[j] = rowsum16(d);
        }
        float mx = sc[0];
#pragma unroll
        for (int j = 1; j < 8; ++j) mx = fmaxf(mx, sc[j]);
        mx = fmaxf(mx, __shfl_xor(mx, 16)); mx = fmaxf(mx, __shfl_xor(mx, 32));
        float sum = 0.f;
#pragma unroll
        for (int j = 0; j < 8; ++j) { sc[j] = __expf(sc[j] - mx); sum += sc[j]; }
        sum += __shfl_xor(sum, 16); sum += __shfl_xor(sum, 32);
        __syncthreads();
        if (dl == 0) {
#pragma unroll
            for (int j = 0; j < 8; ++j) pw[w * 32 + kgrp + 4 * j] = sc[j];
        }
        if (lane == 0) { wm[w] = mx; wm[8 + w] = sum; }
        asm volatile("s_waitcnt lgkmcnt(0)" ::: "memory"); __builtin_amdgcn_wave_barrier();
        f32x4 acc = (f32x4){0.f, 0.f, 0.f, 0.f};
#pragma unroll 16
        for (int j = 0; j < 32; ++j) { const f32x4 v4 = *(const f32x4*)(Vp + (size_t)(w * 32 + j) * 1024 + lane * 4); acc = acc + pw[w * 32 + j] * v4; }
        *(LAS f32x4*)(wacc + w * 256 + lane * 4) = acc;
        __syncthreads();
        if (tid < 256) {
            float M = wm[0];
#pragma unroll
            for (int j = 1; j < 8; ++j) M = fmaxf(M, wm[j]);
            float L = 0.f, o = 0.f;
#pragma unroll
            for (int j = 0; j < 8; ++j) { const float f = __expf(wm[j] - M); L += wm[8 + j] * f; o += wacc[j * 256 + tid] * f; }
            ob[(size_t)(NTOK + si) * 1024 + h * 256 + tid] = (bf16_t)(cvt_pk_bf16(o * __builtin_amdgcn_rcpf(L), 0.f) & 0xffffu);
        }
    }
}

DEV void phase_final(const Params& p) {
    unsigned char* ws = p.ws; const int tid = fresh_tid(), lane = tid & 63, gw = blockIdx.x * 8 + (tid >> 6), nw = gridDim.x * 8;
    const bf16_t* xb = (const bf16_t*)(ws + O_XB); const float* rs5 = (const float*)(ws + O_RS5);
    float g[16]; { float a[8], b[8]; ld8f(p.in[I_FIN] + lane * 8, a); ld8f(p.in[I_FIN] + 512 + lane * 8, b);
#pragma unroll
        for (int i = 0; i < 8; ++i) { g[i] = a[i]; g[8 + i] = b[i]; } }
#pragma unroll 2
    for (int r = gw; r < MV; r += nw) {
        const float rstd = rstd_of(rs5, r);
#pragma unroll
        for (int hf = 0; hf < 2; ++hf) { const int c = hf * 512 + lane * 8; float v[8]; ld8bf(xb + (size_t)r * 1024 + c, v);
#pragma unroll
            for (int i = 0; i < 8; ++i) v[i] = v[i] * rstd * g[hf * 8 + i];
            st8f(p.out + OUT_Y + (size_t)r * 1024 + c, v); }
    }
}

__global__ void __launch_bounds__(512, 2) mega(Params p) {
    extern __shared__ __attribute__((aligned(16))) unsigned char shm[];
    LAS unsigned char* lds = (LAS unsigned char*)shm;
    unsigned char* ws = p.ws;
    const int MT = MP / 256;
    {
        volatile LAS unsigned* st = (volatile LAS unsigned*)(lds + pg8::STAGE_BYTES);
        if (threadIdx.x < 2) st[threadIdx.x] = 0u;
        __syncthreads();
        if (threadIdx.x == 0) (void)xb_add(&((unsigned*)(ws + O_BAR))[XB_XCNT(xb_xcc_id())], 1u);
    }
#define XB_SYNC() do { XcdBarrier xb_; xb_.bar = (unsigned*)(p.ws + O_BAR); xb_.x = xb_xcc_id(); xb_.st = (volatile LAS unsigned*)(lds + pg8::STAGE_BYTES); xcd_barrier(xb_); } while (0)
    { phase_prep(p, lds); }
    XB_SYNC();
    { {
            { pg8::Gemm g{(const bf16_t*)(ws + O_XB), (const bf16_t*)(ws + O_WGU1), 1024, 1024, 1024}; pg8::GridSched S; S.init(MT, 22, 0, 1024, 1024);
              EpiSwiglu E{(const float*)(ws + O_RS1), (bf16_t*)(ws + O_H)}; pg8::gemm_phase(lds, g, S, E); }
            { pg8::Gemm g{(const bf16_t*)(ws + O_MNB), (const bf16_t*)(ws + O_WK), 1024, 1024, 1024}; pg8::GridSched S; S.init(8, 4, MT * 22, 1024, 1024);
              EpiK E{(const float*)(ws + O_RSTDM), p.out + OUT_MK, (bf16_t*)(ws + O_MKB)}; pg8::gemm_phase(lds, g, S, E); }
            { pg8::Gemm g{(const bf16_t*)(ws + O_WV), (const bf16_t*)(ws + O_MNB), 1024, 1024, 1024}; pg8::GridSched S; S.init(4, 8, MT * 22 + 32, 1024, 1024);
              EpiVT E{(const float*)(ws + O_RSTDM), p.out + OUT_MV, (bf16_t*)(ws + O_VT)}; pg8::gemm_phase(lds, g, S, E); }
        } }
    XB_SYNC();
    { { pg8::Gemm g{(const bf16_t*)(ws + O_H), (const bf16_t*)(ws + O_WD1), DFF, DFF, DFF}; pg8::GridSched S; S.init(64, 4, 0, DFF, DFF);
            EpiRes E{p.in[I_XP], (bf16_t*)(ws + O_XB), (float*)(ws + O_RS2), 0.5f}; pg8::gemm_phase(lds, g, S, E);
            SRes E2{p.in[I_XS], (bf16_t*)(ws + O_XB), (float*)(ws + O_RS2), 0.5f, NTOK};
            small_gemm<4>(lds, (const bf16_t*)(ws + O_H), DFF, (const bf16_t*)(ws + O_WD1), DFF, DFF, NTOK, 4, 16, E2); } }
    XB_SYNC();
    { { pg8::Gemm g{(const bf16_t*)(ws + O_XB), (const bf16_t*)(ws + O_WIN), 1024, 1024, 1024}; pg8::GridSched S; S.init(MT, 11, 0, 1024, 1024);
            EpiScale E{(const float*)(ws + O_RS2), (bf16_t*)(ws + O_Z), ZLD, ZLD}; pg8::gemm_phase(lds, g, S, E);
            SScale E2{(const float*)(ws + O_RS2), (bf16_t*)(ws + O_Z), ZLD, ZLD, 2816};
            small_gemm<2>(lds, (const bf16_t*)(ws + O_XB), 1024, (const bf16_t*)(ws + O_WIN) + (size_t)2816 * 1024, 1024, 1024, 0, MV / 32, 1, E2); } }
    XB_SYNC();
    { phase_mixprep(p); }
    XB_SYNC();
    { { pg8::Gemm g{(const bf16_t*)(ws + O_LIN), (const bf16_t*)(ws + O_WLORA), 384, 384, 256}; pg8::LoraSched S; S.init();
            EpiLora E{p.in[I_W0], p.in[I_A0], p.in[I_KA], (float*)(ws + O_DEC), (bf16_t*)(ws + O_H + HALFROW), (const bf16_t*)(ws + O_KK), (bf16_t*)(ws + O_KKA), (bf16_t*)(ws + O_H + 2 * HALFROW)};
            pg8::gemm_phase(lds, g, S, E); phase_chunkmix(p, lds); } }
    XB_SYNC();
    { phase_scan(p, lds); }
    XB_SYNC();
    { phase_finalize(p); }
    XB_SYNC();
    { { pg8::Gemm g{(const bf16_t*)(ws + O_YMIX), (const bf16_t*)(ws + O_WOUT), 1024, 1024, 1024}; pg8::GridSched S; S.init(64, 4, 0, 1024, 1024);
            EpiRes E{nullptr, (bf16_t*)(ws + O_XB), (float*)(ws + O_RS3), 1.f}; pg8::gemm_phase(lds, g, S, E);
            SRes E2{nullptr, (bf16_t*)(ws + O_XB), (float*)(ws + O_RS3), 1.f, 0};
            small_gemm<4>(lds, (const bf16_t*)(ws + O_YMIX), 1024, (const bf16_t*)(ws + O_WOUT), 1024, 1024, NTOK, 4, 16, E2); } }
    XB_SYNC();
    { { pg8::Gemm g{(const bf16_t*)(ws + O_XB), (const bf16_t*)(ws + O_WQ), 1024, 1024, 1024}; pg8::GridSched S; S.init(64, 4, 0, 1024, 1024);
            EpiScale E{(const float*)(ws + O_RS3), (bf16_t*)(ws + O_Z + HALFROW), 1024, 1024}; pg8::gemm_phase(lds, g, S, E);
            SScale E2{(const float*)(ws + O_RS3), (bf16_t*)(ws + O_Z + HALFROW), 1024, 1024, 0};
            small_gemm<4>(lds, (const bf16_t*)(ws + O_XB), 1024, (const bf16_t*)(ws + O_WQ), 1024, 1024, NTOK, 4, 16, E2); } }
    XB_SYNC();
    { {
            const bool sattn_first = ((blockIdx.x >> 3) & 1) != 0;
            if (sattn_first) phase_sattn(p, lds);
            { pg8::Gemm g{(const bf16_t*)(ws + O_Z + HALFROW), (const bf16_t*)(ws + O_MKB), 1024, 1024, 256}; pg8::AttnSched<0> S; S.init();
              EpiS E{(bf16_t*)(ws + O_Z), (float*)(ws + O_PSUM)}; pg8::gemm_phase(lds, g, S, E); }
            asm volatile("s_waitcnt vmcnt(0)" ::: "memory"); __syncthreads();
            if (threadIdx.x == 0) { __builtin_amdgcn_fence(__ATOMIC_ACQUIRE, "agent"); asm volatile("s_waitcnt vmcnt(0)" ::: "memory"); }
            __syncthreads();
            { pg8::Gemm g{(const bf16_t*)(ws + O_Z), (const bf16_t*)(ws + O_VT), 256, 2048, 256}; pg8::AttnSched<1> S; S.init();
              EpiO E{(const float*)(ws + O_PSUM), (bf16_t*)(ws + O_YMIX)}; pg8::gemm_phase(lds, g, S, E); }
            if (!sattn_first) phase_sattn(p, lds);
        } }
    XB_SYNC();
    { { pg8::Gemm g{(const bf16_t*)(ws + O_YMIX), (const bf16_t*)(ws + O_WO), 1024, 1024, 1024}; pg8::GridSched S; S.init(64, 4, 0, 1024, 1024);
            EpiRes E{nullptr, (bf16_t*)(ws + O_XB), (float*)(ws + O_RS4), 1.f}; pg8::gemm_phase(lds, g, S, E);
            SRes E2{nullptr, (bf16_t*)(ws + O_XB), (float*)(ws + O_RS4), 1.f, 0};
            small_gemm<4>(lds, (const bf16_t*)(ws + O_YMIX), 1024, (const bf16_t*)(ws + O_WO), 1024, 1024, NTOK, 4, 16, E2); } }
    XB_SYNC();
    { { pg8::Gemm g{(const bf16_t*)(ws + O_XB), (const bf16_t*)(ws + O_WGU2), 1024, 1024, 1024}; pg8::GridSched S; S.init(MT, 22, 0, 1024, 1024);
            EpiSwiglu E{(const float*)(ws + O_RS4), (bf16_t*)(ws + O_H)}; pg8::gemm_phase(lds, g, S, E); } }
    XB_SYNC();
    { { pg8::Gemm g{(const bf16_t*)(ws + O_H), (const bf16_t*)(ws + O_WD2), DFF, DFF, DFF}; pg8::GridSched S; S.init(64, 4, 0, DFF, DFF);
            EpiRes E{nullptr, (bf16_t*)(ws + O_XB), (float*)(ws + O_RS5), 0.5f}; pg8::gemm_phase(lds, g, S, E);
            SRes E2{nullptr, (bf16_t*)(ws + O_XB), (float*)(ws + O_RS5), 0.5f, 0};
            small_gemm<4>(lds, (const bf16_t*)(ws + O_H), DFF, (const bf16_t*)(ws + O_WD2), DFF, DFF, NTOK, 4, 16, E2); } }
    XB_SYNC();
    { phase_final(p); }
#undef XB_SYNC
}

constexpr size_t LDS_BYTES = pg8::STAGE_BYTES + 4096;

extern "C" void kernel_launch(void* const* d_in, const int* in_sizes, int n_in, void* d_out, int out_size, void* d_ws, size_t ws_size, hipStream_t stream) {
    static int grid_blocks = 0;
    if (!grid_blocks) {
        int dev = 0, cus = 0, per_cu = 0;
        hipGetDevice(&dev);
        hipDeviceGetAttribute(&cus, hipDeviceAttributeMultiprocessorCount, dev);
        hipFuncSetAttribute((const void*)mega, hipFuncAttributeMaxDynamicSharedMemorySize, (int)LDS_BYTES);
        hipOccupancyMaxActiveBlocksPerMultiprocessor(&per_cu, mega, 512, LDS_BYTES);
        if (per_cu < 1) { fprintf(stderr, "occupancy query returned %d\n", per_cu); per_cu = 1; }
        grid_blocks = cus * (per_cu > 1 ? 1 : per_cu);
        if (ws_size < WS_NEED) fprintf(stderr, "workspace too small: %zu < %zu\n", ws_size, (size_t)WS_NEED);
    }
    Params p{};
    for (int i = 0; i < 40; ++i) p.in[i] = (const float*)d_in[i];
    p.out = (float*)d_out; p.ws = (unsigned char*)d_ws;
    hipMemsetAsync((unsigned char*)d_ws + O_BAR, 0, XCD_BAR_WORDS * 4, stream);
    hipLaunchKernelGGL(mega, dim3(grid_blocks), dim3(512), LDS_BYTES, stream, p);
}
```

```cpp
#include <hip/hip_runtime.h>
#include <hip/hip_cooperative_groups.h>
#include <cstdio>
namespace cg = cooperative_groups;

#ifndef PHMASK
#define PHMASK 0xffff
#endif
#ifndef DUPMASK
#define DUPMASK 0
#endif
#ifndef ONE_LAUNCH
#define ONE_LAUNCH 1
#endif

#define LAS __attribute__((address_space(3)))
#define DEV __device__ __forceinline__
typedef unsigned short bf16_t;
typedef short bf16x8 __attribute__((ext_vector_type(8)));
typedef float f32x4 __attribute__((ext_vector_type(4)));
typedef unsigned u32x2 __attribute__((ext_vector_type(2)));
typedef unsigned u32x4 __attribute__((ext_vector_type(4)));

constexpr int DM = 1024, NTOK = 16384, NSMP = 128, MV = NTOK + NSMP, MP = 16640, SEQ = 2048;
constexpr int DFF = 2816, ZLD = 2848, BPROJ = 1824, NMEMR = 2048;
constexpr int NPH = 16;

constexpr size_t al256(size_t x) { return (x + 255) & ~(size_t)255; }
constexpr size_t O_WGU1 = 0;
constexpr size_t O_WD1 = O_WGU1 + al256((size_t)5632 * 1024 * 2);
constexpr size_t O_WIN = O_WD1 + al256((size_t)1024 * 2816 * 2);
constexpr size_t O_WOUT = O_WIN + al256((size_t)3072 * 1024 * 2);
constexpr size_t O_WQ = O_WOUT + 2097152, O_WK = O_WQ + 2097152, O_WV = O_WK + 2097152, O_WO = O_WV + 2097152;
constexpr size_t O_WGU2 = O_WO + 2097152;
constexpr size_t O_WD2 = O_WGU2 + al256((size_t)5632 * 1024 * 2);
constexpr size_t O_WLORA = O_WD2 + al256((size_t)1024 * 2816 * 2);
constexpr size_t O_MNB = O_WLORA + al256((size_t)1536 * 384 * 2);
constexpr size_t O_MKB = O_MNB + 4194304, O_VT = O_MKB + 4194304;
constexpr size_t O_RSTDM = O_VT + 4194304;
constexpr size_t RS_BYTES = (size_t)MP * 64;
constexpr size_t O_RS1 = O_RSTDM + 8192, O_RS2 = O_RS1 + RS_BYTES, O_RS3 = O_RS2 + RS_BYTES, O_RS4 = O_RS3 + RS_BYTES, O_RS5 = O_RS4 + RS_BYTES;
constexpr size_t O_PSUM = O_RS5 + RS_BYTES;
constexpr size_t HALFROW = (size_t)MP * 512 * 4;
constexpr size_t O_XB = O_PSUM + 1048576;
constexpr size_t O_XRES = O_XB + HALFROW;
constexpr size_t O_H = O_XRES + 2 * HALFROW;
constexpr size_t O_Z = O_H + al256((size_t)MP * DFF * 2);
constexpr size_t O_YMIX = O_Z + al256((size_t)MP * ZLD * 2);
constexpr size_t O_VAB = O_YMIX + HALFROW;
constexpr size_t O_LIN = O_VAB + HALFROW / 2;
constexpr size_t O_KK = O_LIN + al256((size_t)MP * 384 * 2);
constexpr size_t O_DEC = O_KK + HALFROW, O_KKA = O_DEC + HALFROW;
constexpr size_t O_BAR = O_KKA + HALFROW;
constexpr size_t WS_NEED = O_BAR + 16384;

constexpr size_t OUT_Y = 0, OUT_SP = (size_t)MV * 1024, OUT_SHP = OUT_SP + 262144, OUT_MK = OUT_SHP + 8 * 1824, OUT_MV = OUT_MK + 2097152,
                 OUT_SS = OUT_MV + 2097152, OUT_SHS = OUT_SS + 4194304, OUT_CV = OUT_SHS + 128 * 1824;

enum { I_XP = 0, I_XS, I_SRWKV, I_SSHIFT, I_CK, I_CV, I_MEM, I_LN1, I_G1, I_U1, I_D1, I_LNMIX, I_WIN, I_WOUT, I_SGUW, I_SGUB, I_SLNG, I_SLNB,
       I_MU, I_W0, I_W2, I_A0, I_A2, I_G2, I_KK, I_KA, I_RK, I_GNG, I_GNB, I_LNX, I_MEMN, I_XQ, I_XK, I_XV, I_XO, I_LN2, I_G2F, I_U2F, I_D2F, I_FIN };

struct Params { const float* in[40]; float* out; unsigned char* ws; };

DEV unsigned cvt_pk_bf16(float lo, float hi) { unsigned r; asm volatile("v_cvt_pk_bf16_f32 %0, %1, %2" : "=v"(r) : "v"(lo), "v"(hi)); return r; }
DEV float bf_lo(unsigned u) { return __uint_as_float(u << 16); }
DEV float bf_hi(unsigned u) { return __uint_as_float(u & 0xffff0000u); }
DEV f32x4 bf4(u32x2 u) { return (f32x4){__uint_as_float(u[0] << 16), __uint_as_float(u[0] & 0xffff0000u), __uint_as_float(u[1] << 16), __uint_as_float(u[1] & 0xffff0000u)}; }
DEV u32x2 pk4(f32x4 v) { u32x2 o; o[0] = cvt_pk_bf16(v[0], v[1]); o[1] = cvt_pk_bf16(v[2], v[3]); return o; }
DEV float bf2f(bf16_t b) { return __uint_as_float((unsigned)b << 16); }
DEV float sigmoidf_(float x) { return __builtin_amdgcn_rcpf(1.f + __expf(-x)); }
DEV float tanhf_(float y) { return 1.f - 2.f * __builtin_amdgcn_rcpf(1.f + __expf(2.f * y)); }
DEV float gelu_t(float x) { return 0.5f * x * (1.f + tanhf_(0.7978845608028654f * (x + 0.044715f * x * x * x))); }
DEV float wsum64(float v) {
#pragma unroll
    for (int o = 32; o >= 1; o >>= 1) v += __shfl_xor(v, o);
    return v;
}
DEV float wmax64(float v) {
#pragma unroll
    for (int o = 32; o >= 1; o >>= 1) v = fmaxf(v, __shfl_xor(v, o));
    return v;
}
template <int CTRL> DEV float dpp_f(float x) { return __builtin_bit_cast(float, __builtin_amdgcn_update_dpp(0, __builtin_bit_cast(int, x), CTRL, 0xf, 0xf, false)); }
DEV float rowsum16(float x) {
    x += dpp_f<0x128>(x); x += dpp_f<0x124>(x); x += dpp_f<0x122>(x); x += dpp_f<0x121>(x); return x;
}
DEV int fresh_tid() { int t = threadIdx.x; asm volatile("" : "+v"(t)); return t; }
DEV float rstd_of(const float* rs, int r) { const f32x4* q = (const f32x4*)(rs + (size_t)r * 16); const f32x4 p = (q[0] + q[1]) + (q[2] + q[3]); return rsqrtf(((p[0] + p[1]) + (p[2] + p[3])) * (1.f / 1024.f) + 1e-6f); }

#define XB_TMO      128
#define XB_XCNT(j)  (256  + 64 * (j))
#define XB_XSUB(j)  (1280 + 64 * (j))
#define XB_XGEN(j)  (2304 + 64 * (j))
#define XB_TOP      3328
#define XB_TOPGEN   3392
#define XCD_BAR_WORDS 3456
#define XB_SPIN_CAP (1u << 18)
DEV unsigned xb_ld(unsigned* p)              { return __hip_atomic_load(p, __ATOMIC_RELAXED, __HIP_MEMORY_SCOPE_AGENT); }
DEV unsigned xb_add(unsigned* p, unsigned v) { return __hip_atomic_fetch_add(p, v, __ATOMIC_RELAXED, __HIP_MEMORY_SCOPE_AGENT); }
DEV unsigned xb_xcc_id() { return (unsigned)__builtin_amdgcn_s_getreg((3 << 11) | 20) & 0xFu; }
#define XB_SPIN(cond, bar) do { unsigned _sp = 0; while (cond) { __builtin_amdgcn_s_sleep(1); \
    if ((++_sp & 255u) == 0u) { if (xb_ld(&(bar)[XB_TMO])) break; if (_sp > XB_SPIN_CAP) { atomicAdd(&(bar)[XB_TMO], 1u); break; } } } } while (0)
struct XcdBarrier { unsigned* bar; unsigned x; volatile LAS unsigned* st; };
DEV XcdBarrier xcd_barrier_post(unsigned* bar, volatile LAS unsigned* st) {
    XcdBarrier b; b.bar = bar; b.x = xb_xcc_id(); b.st = st;
    if (threadIdx.x == 0) (void)xb_add(&bar[XB_XCNT(b.x)], 1u);
    return b;
}
DEV void xcd_barrier_complete(unsigned* bar, unsigned x, unsigned& nloc, unsigned& nx) {
    const unsigned G = gridDim.x * gridDim.y * gridDim.z;
    unsigned sum, cnt, mine, sp = 0u;
    for (;;) {
        sum = 0u; cnt = 0u; mine = 0u;
#pragma unroll
        for (unsigned j = 0; j < 16; ++j) { const unsigned c = xb_ld(&bar[XB_XCNT(j)]); sum += c; cnt += (c > 0u) ? 1u : 0u; mine = (j == x) ? c : mine; }
        if (sum == G) break;
        __builtin_amdgcn_s_sleep(1);
        if ((++sp & 255u) == 0u) { if (xb_ld(&bar[XB_TMO])) break; if (sp > XB_SPIN_CAP) { atomicAdd(&bar[XB_TMO], 1u); break; } }
    }
    nloc = mine > 0u ? mine : 1u; nx = cnt > 0u ? cnt : 1u;
}
DEV void xcd_barrier(const XcdBarrier& b) {
    asm volatile("s_waitcnt vmcnt(0)" ::: "memory");
    __syncthreads();
    if (threadIdx.x == 0) {
        unsigned* bar = b.bar;
        __builtin_amdgcn_s_waitcnt(0);
        unsigned nloc = b.st[0], nx = b.st[1];
        if (nloc == 0u) { xcd_barrier_complete(bar, b.x, nloc, nx); b.st[0] = nloc; b.st[1] = nx; }
        const unsigned old = xb_add(&bar[XB_XSUB(b.x)], 1u);
        const unsigned gen = old / nloc;
        if (old + 1u == (gen + 1u) * nloc) {
            __builtin_amdgcn_fence(__ATOMIC_RELEASE, "agent");
            asm volatile("s_waitcnt vmcnt(0)" ::: "memory");
            const unsigned og = xb_add(&bar[XB_TOP], 1u);
            const unsigned tg = og / nx;
            if (og + 1u == (tg + 1u) * nx) xb_add(&bar[XB_TOPGEN], 1u);
            else XB_SPIN(xb_ld(&bar[XB_TOPGEN]) == tg, bar);
            __builtin_amdgcn_fence(__ATOMIC_ACQUIRE, "agent");
            xb_add(&bar[XB_XGEN(b.x)], 1u);
            asm volatile("s_waitcnt vmcnt(0)" ::: "memory");
        } else {
            XB_SPIN(xb_ld(&bar[XB_XGEN(b.x)]) == gen, bar);
            __builtin_amdgcn_fence(__ATOMIC_ACQUIRE, "agent");
            asm volatile("s_waitcnt vmcnt(0)" ::: "memory");
        }
    }
    __syncthreads();
}

namespace pg8 {
constexpr int BM = 256, BK = 64, HALF = 128, HTB = HALF * BK * 2, STAGE_BYTES = 8 * HTB, NXCD = 8, WGM = 8;
DEV int lds_byte(int r, int c) { const int st = (r >> 4) * 2 + (c >> 5), rr = r & 15, cc = c & 31, ob = rr * 64 + cc * 2; return st * 1024 + (ob ^ (((ob >> 9) & 1) << 5)); }
DEV void stage_rc(int b, int& R, int& C) { const int st = b / 1024, sb = b % 1024, swz = sb ^ (((sb >> 9) & 1) << 5); R = (st >> 1) * 16 + swz / 64; C = (st & 1) * 32 + (swz % 64) / 2; }

struct Unit { int pm, pn; long ao, bo; int x0, x1; };
struct Gemm { const bf16_t* A; const bf16_t* Bt; int lda, ldb, K; };

struct GridSched {
    int nM, nN, nwg, G, c; long ta, tb;
    DEV void init(int nM_, int nN_, int shift, int lda, int ldb) { nM = nM_; nN = nN_; nwg = nM * nN; G = (int)gridDim.x; c = ((int)blockIdx.x + G - (shift % G)) % G; ta = 256L * lda; tb = 256L * ldb; }
    DEV bool next(int i, Unit& u) const {
        const long L = (long)i * G + c; if (L >= nwg) return false;
        int wgid = (int)L; { const int q = nwg / NXCD, r = nwg % NXCD, xcd = wgid % NXCD, off = wgid / NXCD; wgid = (xcd < r ? xcd * (q + 1) : r * (q + 1) + (xcd - r) * q) + off; }
        const int nig = WGM * nN, gid = wgid / nig, fm = gid * WGM, gsz = (nM - fm) < WGM ? (nM - fm) : WGM;
        u.pm = fm + ((wgid % nig) % gsz); u.pn = (wgid % nig) / gsz; u.ao = u.pm * ta; u.bo = u.pn * tb; u.x0 = 0; u.x1 = 0; return true;
    }
};
struct LoraSched {
    int G, c;
    DEV void init() { G = (int)gridDim.x; c = (int)blockIdx.x; }
    DEV bool next(int i, Unit& u) const {
        const long L = (long)i * G + c; if (L >= 65 * 6) return false;
        const int pn = (int)L % 6, pm = (int)L / 6, off = (pn >= 4) ? 128 : 0;
        u.pm = pm; u.pn = pn; u.x0 = 0; u.x1 = 0; u.ao = (long)pm * 256 * 384 + off; u.bo = (long)pn * 256 * 384 + off; return true;
    }
};
template <int WHICH> struct AttnSched {
    int G, c;
    DEV void init() { G = (int)gridDim.x; c = (int)blockIdx.x; }
    DEV bool next(int i, Unit& u) const {
        const long L = (long)i * G + c; if (L >= 256) return false;
        const int xcd = (int)L & 7, idx = (int)L >> 3, bh = xcd * 4 + (idx >> 3), mt = idx & 7, b = bh >> 2, h = bh & 3;
        u.pm = mt; u.pn = 0; u.x0 = bh; u.x1 = mt;
        if (WHICH == 0) { u.ao = ((long)b * 2048 + mt * 256) * 1024 + h * 256; u.bo = ((long)b * 256) * 1024 + h * 256; }
        else { u.ao = ((long)bh * 2048 + mt * 256) * 256; u.bo = ((long)h * 256) * 2048 + b * 256; }
        return true;
    }
};

template <class Epi, class Sched>
DEV void gemm_phase(LAS unsigned char* lds, const Gemm g, const Sched& S, const Epi& E) {
    int tid_ = threadIdx.x; asm volatile("" : "+v"(tid_));
    const int tid = tid_, wid = __builtin_amdgcn_readfirstlane(tid >> 6), lane = tid & 63, wr = wid >> 2, wc = wid & 3, fr = lane & 15, fq = lane >> 4;
    int K = g.K, lda_ = g.lda, ldb_ = g.ldb; asm volatile("" : "+s"(K), "+s"(lda_), "+s"(ldb_)); const int nt = K / BK;
    unsigned voffA[2], voffB[2];
#pragma unroll
    for (int i = 0; i < 2; ++i) { int R, C; stage_rc(tid * 16 + i * 8192, R, C); voffA[i] = (unsigned)(R * lda_ + C) * 2u; voffB[i] = (unsigned)(R * ldb_ + C) * 2u; }
    const size_t kstep = (size_t)(BK * 2);
    const size_t hstepA = (size_t)HALF * lda_ * 2, hstepB = (size_t)HALF * ldb_ * 2;
    const unsigned ldsw = (unsigned)wid * 1024u;
    const int aoff = lds_byte(wr * 64 + fr, fq * 8), boff = lds_byte(wc * 32 + fr, fq * 8);
#define PG8_SA(b, h) (((b) * 2 + (h)) * HTB)
#define PG8_SB(b, h) ((4 + (b) * 2 + (h)) * HTB)
#define PG8_STAGE(bufoff, gbase, voff) do { _Pragma("unroll") for (int _i = 0; _i < 2; ++_i) \
        __builtin_amdgcn_global_load_lds((const unsigned*)((const char*)(gbase) + (voff)[_i]), (LAS unsigned*)(lds + (bufoff) + ldsw + _i * 8192), 16, 0, 0); } while (0)
#define PG8_LDA(dst, b, h) do { _Pragma("unroll") for (int m = 0; m < 4; ++m) _Pragma("unroll") for (int k = 0; k < 2; ++k) dst[m][k] = *(const LAS bf16x8*)(lds + PG8_SA(b, h) + aoff + m * 2048 + k * 1024); } while (0)
#define PG8_LDB(dst, b, h) do { _Pragma("unroll") for (int n = 0; n < 2; ++n) _Pragma("unroll") for (int k = 0; k < 2; ++k) dst[n][k] = *(const LAS bf16x8*)(lds + PG8_SB(b, h) + boff + n * 2048 + k * 1024); } while (0)
#define PG8_MMA(ai, bj, At, Bt) do { __builtin_amdgcn_s_setprio(1); _Pragma("unroll") for (int m = 0; m < 4; ++m) _Pragma("unroll") for (int n = 0; n < 2; ++n) _Pragma("unroll") for (int k = 0; k < 2; ++k) \
        acc[ai][bj][m][n] = __builtin_amdgcn_mfma_f32_16x16x32_bf16(Bt[n][k], At[m][k], acc[ai][bj][m][n], 0, 0, 0); __builtin_amdgcn_s_setprio(0); } while (0)
#define PG8_WAIT_V(n) asm volatile("s_waitcnt vmcnt(" #n ")" ::: "memory")
#define PG8_WAIT_L(n) asm volatile("s_waitcnt lgkmcnt(" #n ")" ::: "memory")
#define PG8_BAR __builtin_amdgcn_s_barrier()
#define PG8_SCHED __builtin_amdgcn_sched_barrier(0)
    Unit cur, nxt; int ui = 0;
    if (!S.next(0, cur)) return;
    f32x4 acc[2][2][4][2];
#pragma unroll
    for (int a = 0; a < 2; ++a)
#pragma unroll
        for (int b = 0; b < 2; ++b)
#pragma unroll
            for (int m = 0; m < 4; ++m)
#pragma unroll
                for (int n = 0; n < 2; ++n) acc[a][b][m][n] = (f32x4){0.f, 0.f, 0.f, 0.f};
    bf16x8 At[4][2], B0[2][2], B1[2][2];
    const char* cA = (const char*)g.A + (size_t)cur.ao * 2; const char* cB = (const char*)g.Bt + (size_t)cur.bo * 2;
    PG8_STAGE(PG8_SB(0, 0), cB, voffB); PG8_STAGE(PG8_SA(0, 0), cA, voffA); PG8_STAGE(PG8_SB(0, 1), cB + hstepB, voffB); PG8_STAGE(PG8_SA(0, 1), cA + hstepA, voffA);
    if (wr == 1) PG8_BAR;
    PG8_WAIT_V(4); PG8_BAR;
    PG8_STAGE(PG8_SB(1, 0), cB + kstep, voffB); PG8_STAGE(PG8_SA(1, 0), cA + kstep, voffA); PG8_STAGE(PG8_SB(1, 1), cB + hstepB + kstep, voffB);
    PG8_WAIT_V(6); PG8_BAR;
    for (;;) {
        const bool has_next = S.next(ui + 1, nxt);
        const char* nA = has_next ? (const char*)g.A + (size_t)nxt.ao * 2 : cA; const char* nB = has_next ? (const char*)g.Bt + (size_t)nxt.bo * 2 : cB;
#pragma unroll 1
        for (int t = 0; t < nt; t += 2) {
            const bool last = (t == nt - 2);
            const char* a1 = cA + (size_t)(t + 1) * kstep;
            const char* a2 = last ? nA : cA + (size_t)(t + 2) * kstep; const char* b2 = last ? nB : cB + (size_t)(t + 2) * kstep;
            const char* a3 = a2 + kstep; const char* b3 = b2 + kstep;
            PG8_LDB(B0, 0, 0); PG8_SCHED; PG8_LDA(At, 0, 0); PG8_STAGE(PG8_SA(1, 1), a1 + hstepA, voffA);
            PG8_WAIT_L(8); PG8_BAR; PG8_WAIT_L(0); PG8_MMA(0, 0, At, B0); PG8_BAR; PG8_SCHED;
            PG8_LDB(B1, 0, 1); PG8_STAGE(PG8_SB(0, 0), b2, voffB);
            PG8_BAR; PG8_WAIT_L(0); PG8_MMA(0, 1, At, B1); PG8_BAR;
            PG8_LDA(At, 0, 1); PG8_STAGE(PG8_SA(0, 0), a2, voffA);
            PG8_BAR; PG8_WAIT_L(0); PG8_MMA(1, 0, At, B0); PG8_BAR; PG8_SCHED;
            PG8_STAGE(PG8_SB(0, 1), b2 + hstepB, voffB);
            PG8_WAIT_V(6); PG8_BAR; PG8_MMA(1, 1, At, B1); PG8_BAR;
            PG8_LDB(B0, 1, 0); PG8_SCHED; PG8_LDA(At, 1, 0); PG8_STAGE(PG8_SA(0, 1), a2 + hstepA, voffA);
            PG8_WAIT_L(8); PG8_BAR; PG8_WAIT_L(0); PG8_MMA(0, 0, At, B0); PG8_BAR; PG8_SCHED;
            PG8_LDB(B1, 1, 1); PG8_STAGE(PG8_SB(1, 0), b3, voffB);
            PG8_BAR; PG8_WAIT_L(0); PG8_MMA(0, 1, At, B1); PG8_BAR;
            PG8_LDA(At, 1, 1); PG8_STAGE(PG8_SA(1, 0), a3, voffA);
            PG8_BAR; PG8_WAIT_L(0); PG8_MMA(1, 0, At, B0); PG8_BAR; PG8_SCHED;
            PG8_STAGE(PG8_SB(1, 1), b3 + hstepB, voffB);
            PG8_WAIT_V(6); PG8_BAR; PG8_MMA(1, 1, At, B1); PG8_BAR;
        }
        E(acc, cur, wr, wc, fr, fq);
        if (!has_next) break;
#pragma unroll
        for (int a = 0; a < 2; ++a)
#pragma unroll
            for (int b = 0; b < 2; ++b)
#pragma unroll
                for (int m = 0; m < 4; ++m)
#pragma unroll
                    for (int n = 0; n < 2; ++n) acc[a][b][m][n] = (f32x4){0.f, 0.f, 0.f, 0.f};
        cur = nxt; cA = nA; cB = nB; ++ui;
    }
    PG8_WAIT_V(0);
    if (wr == 0) PG8_BAR;
    PG8_BAR;
#undef PG8_SA
#undef PG8_SB
#undef PG8_STAGE
#undef PG8_LDA
#undef PG8_LDB
#undef PG8_MMA
#undef PG8_WAIT_V
#undef PG8_WAIT_L
#undef PG8_BAR
#undef PG8_SCHED
}
}
using pg8::Unit;

typedef const f32x4 (&AccRef)[2][2][4][2];

struct EpiSwiglu {
    const float* rs; bf16_t* H;
    DEV void operator()(AccRef acc, const Unit& u, int wr, int wc, int fr, int fq) const {
        const int row0 = u.pm * 256 + wr * 64 + fr, hc0 = u.pn * 128 + wc * 16 + 4 * fq;
#pragma unroll
        for (int ai = 0; ai < 2; ++ai)
#pragma unroll
            for (int m = 0; m < 4; ++m) {
                const int r = row0 + ai * 128 + m * 16; const float rstd = rstd_of(rs, r);
#pragma unroll
                for (int bj = 0; bj < 2; ++bj) {
                    float hv[4];
#pragma unroll
                    for (int i = 0; i < 4; ++i) { const float gt = acc[ai][bj][m][0][i] * rstd, up = acc[ai][bj][m][1][i] * rstd; hv[i] = gt * sigmoidf_(gt) * up; }
                    u32x2 o; o[0] = cvt_pk_bf16(hv[0], hv[1]); o[1] = cvt_pk_bf16(hv[2], hv[3]);
                    *(u32x2*)(H + (size_t)r * DFF + hc0 + bj * 64) = o;
                }
            }
    }
};

struct EpiRes {
    const float* res; bf16_t* xb; float* rs_out; float alpha;
    DEV void operator()(AccRef acc, const Unit& u, int wr, int wc, int fr, int fq) const {
        const int row0 = u.pm * 256 + wr * 64 + fr, col0 = u.pn * 256 + wc * 32 + 4 * fq;
#pragma unroll
        for (int ai = 0; ai < 2; ++ai)
#pragma unroll
            for (int mh = 0; mh < 2; ++mh) {
                f32x4 x[2][2][2];
#pragma unroll
                for (int m2 = 0; m2 < 2; ++m2)
#pragma unroll
                    for (int bj = 0; bj < 2; ++bj)
#pragma unroll
                        for (int n = 0; n < 2; ++n) { const size_t o = (size_t)(row0 + ai * 128 + (mh * 2 + m2) * 16) * 1024 + col0 + bj * 128 + n * 16;
                            x[m2][bj][n] = res ? *(const f32x4*)(res + o) : bf4(*(const u32x2*)(xb + o)); }
#pragma unroll
                for (int m2 = 0; m2 < 2; ++m2) {
                    const int m = mh * 2 + m2, r = row0 + ai * 128 + m * 16; float s = 0.f;
#pragma unroll
                    for (int bj = 0; bj < 2; ++bj)
#pragma unroll
                        for (int n = 0; n < 2; ++n) {
                            const int c = col0 + bj * 128 + n * 16; const f32x4 v = x[m2][bj][n] + alpha * acc[ai][bj][m][n];
                            *(u32x2*)(xb + (size_t)r * 1024 + c) = pk4(v);
                            s += v[0] * v[0] + v[1] * v[1] + v[2] * v[2] + v[3] * v[3];
                        }
                    s += __shfl_xor(s, 16); s += __shfl_xor(s, 32);
                    if (fq == 0) rs_out[(size_t)r * 16 + u.pn * 4 + wc] = s;
                }
            }
    }
};

struct EpiScale {
    const float* rs; bf16_t* O; int ldo, ncols;
    DEV void operator()(AccRef acc, const Unit& u, int wr, int wc, int fr, int fq) const {
        const int row0 = u.pm * 256 + wr * 64 + fr, col0 = u.pn * 256 + wc * 32 + 4 * fq;
#pragma unroll
        for (int ai = 0; ai < 2; ++ai)
#pragma unroll
            for (int m = 0; m < 4; ++m) {
                const int r = row0 + ai * 128 + m * 16; const float rstd = rstd_of(rs, r);
#pragma unroll
                for (int bj = 0; bj < 2; ++bj)
#pragma unroll
                    for (int n = 0; n < 2; ++n) {
                        const int c = col0 + bj * 128 + n * 16;
                        if (c < ncols) { const f32x4 v = acc[ai][bj][m][n] * rstd; u32x2 o; o[0] = cvt_pk_bf16(v[0], v[1]); o[1] = cvt_pk_bf16(v[2], v[3]); *(u32x2*)(O + (size_t)r * ldo + c) = o; }
                    }
            }
    }
};

struct EpiLora {
    const float* w0; const float* a0; const float* k_a; float* dec; bf16_t* kbuf; const bf16_t* kkbuf; bf16_t* kka; bf16_t* gb;
    template <int REGION> DEV void run(AccRef acc, const Unit& u, int wr, int wc, int fr, int fq) const {
        const int row0 = u.pm * 256 + wr * 64 + fr, cb = (u.pn & 1) * 256 + wc * 32 + 4 * fq;
#pragma unroll
        for (int ai = 0; ai < 2; ++ai)
#pragma unroll
            for (int m = 0; m < 4; ++m) {
                const int r = row0 + ai * 128 + m * 16;
                {
#pragma unroll
                    for (int bj = 0; bj < 2; ++bj)
#pragma unroll
                        for (int n = 0; n < 2; ++n) {
                            const int cc = cb + bj * 128 + n * 16; const f32x4 a = acc[ai][bj][m][n]; const size_t o = (size_t)r * 512 + cc;
                            if (REGION == 0) {
                                const f32x4 b0 = *(const f32x4*)(w0 + cc); f32x4 d;
#pragma unroll
                                for (int i = 0; i < 4; ++i) d[i] = __expf(-0.60653066f * sigmoidf_(b0[i] + a[i]));
                                *(f32x4*)(dec + o) = d;
                            } else if (REGION == 1) {
                                const f32x4 b0 = *(const f32x4*)(a0 + cc), ka = *(const f32x4*)(k_a + cc), kv = bf4(*(const u32x2*)(kbuf + o)), kkv = bf4(*(const u32x2*)(kkbuf + o)); f32x4 kn, kkan;
#pragma unroll
                                for (int i = 0; i < 4; ++i) { const float av = sigmoidf_(b0[i] + a[i]); kn[i] = kv[i] * (1.f + (av - 1.f) * ka[i]); kkan[i] = kkv[i] * av; }
                                *(u32x2*)(kbuf + o) = pk4(kn); *(u32x2*)(kka + o) = pk4(kkan);
                            } else {
                                u32x2 ov; ov[0] = cvt_pk_bf16(a[0], a[1]); ov[1] = cvt_pk_bf16(a[2], a[3]); *(u32x2*)(gb + o) = ov;
                            }
                        }
                }
            }
    }
    DEV void operator()(AccRef acc, const Unit& u, int wr, int wc, int fr, int fq) const {
        const int region = u.pn >> 1;
        if (region == 0) run<0>(acc, u, wr, wc, fr, fq); else if (region == 1) run<1>(acc, u, wr, wc, fr, fq); else run<2>(acc, u, wr, wc, fr, fq);
    }
};

struct EpiK {
    const float* rstdm; float* outk; bf16_t* mkb;
    DEV void operator()(AccRef acc, const Unit& u, int wr, int wc, int fr, int fq) const {
        const int row0 = u.pm * 256 + wr * 64 + fr, col0 = u.pn * 256 + wc * 32 + 4 * fq;
#pragma unroll
        for (int ai = 0; ai < 2; ++ai)
#pragma unroll
            for (int m = 0; m < 4; ++m) {
                const int r = row0 + ai * 128 + m * 16; const float rstd = rstdm[r];
#pragma unroll
                for (int bj = 0; bj < 2; ++bj)
#pragma unroll
                    for (int n = 0; n < 2; ++n) {
                        const int c = col0 + bj * 128 + n * 16; const f32x4 v = acc[ai][bj][m][n] * rstd;
                        *(f32x4*)(outk + (size_t)r * 1024 + c) = v;
                        u32x2 o; o[0] = cvt_pk_bf16(v[0], v[1]); o[1] = cvt_pk_bf16(v[2], v[3]); *(u32x2*)(mkb + (size_t)r * 1024 + c) = o;
                    }
            }
    }
};
struct EpiVT {
    const float* rstdm; float* outv; bf16_t* vt;
    DEV void operator()(AccRef acc, const Unit& u, int wr, int wc, int fr, int fq) const {
        const int row0 = u.pm * 256 + wr * 64 + fr, col0 = u.pn * 256 + wc * 32 + 4 * fq;
#pragma unroll
        for (int bj = 0; bj < 2; ++bj)
#pragma unroll
            for (int n = 0; n < 2; ++n) {
                const int c = col0 + bj * 128 + n * 16; const f32x4 rsd = *(const f32x4*)(rstdm + c);
#pragma unroll
                for (int ai = 0; ai < 2; ++ai)
#pragma unroll
                    for (int m = 0; m < 4; ++m) {
                        const int r = row0 + ai * 128 + m * 16; const f32x4 v = acc[ai][bj][m][n] * rsd;
                        u32x2 o; o[0] = cvt_pk_bf16(v[0], v[1]); o[1] = cvt_pk_bf16(v[2], v[3]); *(u32x2*)(vt + (size_t)r * 2048 + c) = o;
#pragma unroll
                        for (int i = 0; i < 4; ++i) outv[(size_t)(c + i) * 1024 + r] = v[i];
                    }
            }
    }
};
struct EpiS {
    bf16_t* P; float* psum;
    DEV void operator()(AccRef acc, const Unit& u, int wr, int wc, int fr, int fq) const {
        const size_t prow0 = (size_t)u.x0 * 2048 + u.x1 * 256;
#pragma unroll
        for (int ai = 0; ai < 2; ++ai)
#pragma unroll
            for (int m = 0; m < 4; ++m) {
                const int rl = ai * 128 + wr * 64 + m * 16 + fr; float s = 0.f;
#pragma unroll
                for (int bj = 0; bj < 2; ++bj)
#pragma unroll
                    for (int n = 0; n < 2; ++n) {
                        const f32x4 a = acc[ai][bj][m][n]; u32x2 o;
                        o[0] = cvt_pk_bf16(__expf(a[0]), __expf(a[1])); o[1] = cvt_pk_bf16(__expf(a[2]), __expf(a[3]));
                        s += bf_lo(o[0]) + bf_hi(o[0]) + bf_lo(o[1]) + bf_hi(o[1]);
                        *(u32x2*)(P + (prow0 + rl) * 256 + bj * 128 + wc * 32 + n * 16 + 4 * fq) = o;
                    }
                s += __shfl_xor(s, 16); s += __shfl_xor(s, 32);
                if (fq == 0) psum[(prow0 + rl) * 4 + wc] = s;
            }
    }
};
struct EpiO {
    const float* psum; bf16_t* O;
    DEV void operator()(AccRef acc, const Unit& u, int wr, int wc, int fr, int fq) const {
        const int bh = u.x0, b = bh >> 2, h = bh & 3; const size_t prow0 = (size_t)bh * 2048 + u.x1 * 256; const size_t m0 = (size_t)b * 2048 + u.x1 * 256;
#pragma unroll
        for (int ai = 0; ai < 2; ++ai)
#pragma unroll
            for (int m = 0; m < 4; ++m) {
                const int rl = ai * 128 + wr * 64 + m * 16 + fr; const f32x4 p = *(const f32x4*)(psum + (prow0 + rl) * 4); const float inv = __builtin_amdgcn_rcpf(p[0] + p[1] + p[2] + p[3]);
#pragma unroll
                for (int bj = 0; bj < 2; ++bj)
#pragma unroll
                    for (int n = 0; n < 2; ++n) {
                        const f32x4 v = acc[ai][bj][m][n] * inv; u32x2 o; o[0] = cvt_pk_bf16(v[0], v[1]); o[1] = cvt_pk_bf16(v[2], v[3]);
                        *(u32x2*)(O + (m0 + rl) * 1024 + h * 256 + bj * 128 + wc * 32 + n * 16 + 4 * fq) = o;
                    }
            }
    }
};

struct SRes {
    const float* res; bf16_t* xb; float* rs_out; float alpha; int res_row0;
    DEV void operator()(int r, int c, f32x4 a, int slab, int l15) const {
        const f32x4 x0 = res ? *(const f32x4*)(res + (size_t)(r - res_row0) * 1024 + c) : bf4(*(const u32x2*)(xb + (size_t)r * 1024 + c));
        const f32x4 x = x0 + alpha * a;
        *(u32x2*)(xb + (size_t)r * 1024 + c) = pk4(x);
        const float s = rowsum16(x[0] * x[0] + x[1] * x[1] + x[2] * x[2] + x[3] * x[3]);
        if (l15 == 0) rs_out[(size_t)r * 16 + slab] = s;
    }
};
struct SScale {
    const float* rs; bf16_t* O; int ldo, ncols, col_off;
    DEV void operator()(int r, int c, f32x4 a, int, int) const {
        const int cc = c + col_off;
        if (cc < ncols) { const f32x4 v = a * rstd_of(rs, r); u32x2 o; o[0] = cvt_pk_bf16(v[0], v[1]); o[1] = cvt_pk_bf16(v[2], v[3]); *(u32x2*)(O + (size_t)r * ldo + cc) = o; }
    }
};
template <int NB, class Epi>
DEV void small_gemm(LAS unsigned char* lds, const bf16_t* A, int lda, const bf16_t* Bt, int ldb, int K, int row_base, int nrg, int nslab, const Epi& E) {
    const int tid = fresh_tid(), lane = tid & 63, w = tid >> 6, l15 = lane & 15, kg = lane >> 4;
    LAS float* red = (LAS float*)lds;
    const int kw = K >> 3;
    for (int item = blockIdx.x; item < nrg * nslab; item += gridDim.x) {
        const int rgi = item % nrg, slab = item / nrg, r0 = row_base + rgi * 32, c0 = slab * 64;
        f32x4 acc[2][4];
#pragma unroll
        for (int rb = 0; rb < 2; ++rb)
#pragma unroll
            for (int n = 0; n < 4; ++n) acc[rb][n] = (f32x4){0.f, 0.f, 0.f, 0.f};
        const bf16_t* ap = A + (size_t)(r0 + l15) * lda + w * kw + kg * 8;
        const bf16_t* bp = Bt + (size_t)(c0 + l15) * ldb + w * kw + kg * 8;
#pragma unroll 4
        for (int k = 0; k < kw; k += 32) {
            const bf16x8 a0 = *(const bf16x8*)(ap + k), a1 = *(const bf16x8*)(ap + (size_t)16 * lda + k);
            bf16x8 b[NB];
#pragma unroll
            for (int n = 0; n < NB; ++n) b[n] = *(const bf16x8*)(bp + (size_t)(n * 16) * ldb + k);
#pragma unroll
            for (int n = 0; n < NB; ++n) { acc[0][n] = __builtin_amdgcn_mfma_f32_16x16x32_bf16(b[n], a0, acc[0][n], 0, 0, 0); acc[1][n] = __builtin_amdgcn_mfma_f32_16x16x32_bf16(b[n], a1, acc[1][n], 0, 0, 0); }
        }
        __syncthreads();
#pragma unroll
        for (int rb = 0; rb < 2; ++rb)
#pragma unroll
            for (int n = 0; n < 4; ++n) *(LAS f32x4*)(red + ((w * 32 + rb * 16 + l15) * 64 + n * 16 + 4 * kg)) = acc[rb][n];
        __syncthreads();
        const int row = tid >> 4, c4 = (tid & 15) * 4; f32x4 sum = (f32x4){0.f, 0.f, 0.f, 0.f};
#pragma unroll
        for (int ww = 0; ww < 8; ++ww) sum = sum + *(const LAS f32x4*)(red + ((ww * 32 + row) * 64 + c4));
        E(r0 + row, c0 + c4, sum, slab, tid & 15);
    }
}

DEV void ld8bf(const bf16_t* p, float (&v)[8]) { const u32x4 u = *(const u32x4*)p;
#pragma unroll
    for (int i = 0; i < 4; ++i) { v[2 * i] = bf_lo(u[i]); v[2 * i + 1] = bf_hi(u[i]); } }
DEV void ld8f(const float* p, float (&v)[8]) { const f32x4 a = *(const f32x4*)p, b = *(const f32x4*)(p + 4);
#pragma unroll
    for (int i = 0; i < 4; ++i) { v[i] = a[i]; v[4 + i] = b[i]; } }
DEV void st8f(float* p, const float (&v)[8]) { *(f32x4*)p = (f32x4){v[0], v[1], v[2], v[3]}; *(f32x4*)(p + 4) = (f32x4){v[4], v[5], v[6], v[7]}; }
DEV void st8bf(bf16_t* p, const float (&v)[8]) { u32x4 o; o[0] = cvt_pk_bf16(v[0], v[1]); o[1] = cvt_pk_bf16(v[2], v[3]); o[2] = cvt_pk_bf16(v[4], v[5]); o[3] = cvt_pk_bf16(v[6], v[7]); *(u32x4*)p = o; }

DEV void tr_job(const float* __restrict__ src, int Ks, int Ns, int Nd, bf16_t* __restrict__ dst, int mode, const float* __restrict__ gain, float scale, LAS float* tile) {
    const int nk = Ks / 64, nn = Nd / 64, ntile = nk * nn, ldd = Ks; const int t = fresh_tid();
    f32x4 v0, v1;
    auto gl = [&](int ti) { const int tk = ti % nk, tn = ti / nk;
        { const int id = t, k = id >> 4, gn = tn * 64 + (id & 15) * 4; v0 = (gn < Ns) ? *(const f32x4*)(src + (size_t)(tk * 64 + k) * Ns + gn) : (f32x4){0.f, 0.f, 0.f, 0.f}; if (gain) v0 = v0 * (gain[tk * 64 + k] * scale); }
        { const int id = t + 512, k = id >> 4, gn = tn * 64 + (id & 15) * 4; v1 = (gn < Ns) ? *(const f32x4*)(src + (size_t)(tk * 64 + k) * Ns + gn) : (f32x4){0.f, 0.f, 0.f, 0.f}; if (gain) v1 = v1 * (gain[tk * 64 + k] * scale); } };
    int ti = blockIdx.x;
    if (ti < ntile) gl(ti);
    for (; ti < ntile; ti += gridDim.x) {
        const int tk = ti % nk, tn = ti / nk;
        *(LAS f32x4*)(tile + (t >> 4) * 68 + (t & 15) * 4) = v0; *(LAS f32x4*)(tile + ((t + 512) >> 4) * 68 + (t & 15) * 4) = v1;
        if (ti + (int)gridDim.x < ntile) gl(ti + gridDim.x);
        __syncthreads();
        { const int n = t & 63, k8 = (t >> 6) * 8, gn = tn * 64 + n; float v[8];
#pragma unroll
          for (int j = 0; j < 8; ++j) v[j] = tile[(k8 + j) * 68 + n];
          const int drow = mode == 0 ? gn : ((gn >> 4) * 32 + (mode == 2 ? 16 : 0) + (gn & 15));
          st8bf(dst + (size_t)drow * ldd + tk * 64 + k8, v); }
        __syncthreads();
    }
}

DEV void phase_prep(const Params& p, LAS unsigned char* lds) {
    unsigned char* ws = p.ws; LAS float* tile = (LAS float*)lds;
    const int tid = fresh_tid(), lane = tid & 63, gw = blockIdx.x * 8 + (tid >> 6), nw = gridDim.x * 8;
    bf16_t* xb = (bf16_t*)(ws + O_XB); float* rs1 = (float*)(ws + O_RS1);
#pragma unroll 2
    for (int r = gw; r < MP; r += nw) {
        float ss = 0.f;
        if (r < MV) {
            const float* xr = r < NTOK ? p.in[I_XP] + (size_t)r * 1024 : p.in[I_XS] + (size_t)(r - NTOK) * 1024;
#pragma unroll
            for (int i = 0; i < 4; ++i) { const int c = lane * 4 + 256 * i; const f32x4 v = *(const f32x4*)(xr + c); ss += v[0] * v[0] + v[1] * v[1] + v[2] * v[2] + v[3] * v[3];
                u32x2 o; o[0] = cvt_pk_bf16(v[0], v[1]); o[1] = cvt_pk_bf16(v[2], v[3]); *(u32x2*)(xb + (size_t)r * 1024 + c) = o; }
            ss = wsum64(ss);
        } else {
#pragma unroll
            for (int i = 0; i < 4; ++i) { u32x2 o; o[0] = 0; o[1] = 0; *(u32x2*)(xb + (size_t)r * 1024 + lane * 4 + 256 * i) = o; }
        }
        if (lane < 16) { rs1[(size_t)r * 16 + lane] = lane == 0 ? ss : 0.f;
            if (r >= MV) { ((float*)(ws + O_RS2))[(size_t)r * 16 + lane] = 0.f; ((float*)(ws + O_RS3))[(size_t)r * 16 + lane] = 0.f; ((float*)(ws + O_RS4))[(size_t)r * 16 + lane] = 0.f; ((float*)(ws + O_RS5))[(size_t)r * 16 + lane] = 0.f; } }
    }
    bf16_t* mnb = (bf16_t*)(ws + O_MNB); float* rstdm = (float*)(ws + O_RSTDM);
    for (int r = gw; r < NMEMR; r += nw) {
        const float* xr = p.in[I_MEM] + (size_t)r * 1024; float ss = 0.f;
#pragma unroll
        for (int i = 0; i < 4; ++i) { const int c = lane * 4 + 256 * i; const f32x4 v = *(const f32x4*)(xr + c); ss += v[0] * v[0] + v[1] * v[1] + v[2] * v[2] + v[3] * v[3];
            u32x2 o; o[0] = cvt_pk_bf16(v[0], v[1]); o[1] = cvt_pk_bf16(v[2], v[3]); *(u32x2*)(mnb + (size_t)r * 1024 + c) = o; }
        ss = wsum64(ss);
        if (lane == 0) rstdm[r] = rsqrtf(ss * (1.f / 1024.f) + 1e-6f);
    }
    { bf16_t* wl = (bf16_t*)(ws + O_WLORA);
      for (int i = blockIdx.x * 512 + tid; i < 1536 * 384; i += gridDim.x * 512) {
          const int n = i / 384, k = i % 384, reg = n >> 9, c = n & 511; float v = 0.f;
          if (reg == 0 && k < 64) v = p.in[I_W2][k * 512 + c];
          else if (reg == 1 && k >= 64 && k < 128) v = p.in[I_A2][(k - 64) * 512 + c];
          else if (reg == 2 && k >= 128 && k < 288) v = p.in[I_G2][(k - 128) * 512 + c];
          wl[i] = (bf16_t)(cvt_pk_bf16(v, 0.f) & 0xffffu);
      } }
    tr_job(p.in[I_G1], 1024, 2816, 2816, (bf16_t*)(ws + O_WGU1), 1, p.in[I_LN1], 1.f, tile);
    tr_job(p.in[I_U1], 1024, 2816, 2816, (bf16_t*)(ws + O_WGU1), 2, p.in[I_LN1], 1.f, tile);
    tr_job(p.in[I_XK], 1024, 1024, 1024, (bf16_t*)(ws + O_WK), 0, p.in[I_MEMN], 1.f, tile);
    tr_job(p.in[I_XV], 1024, 1024, 1024, (bf16_t*)(ws + O_WV), 0, p.in[I_MEMN], 1.f, tile);
    tr_job(p.in[I_D1], 2816, 1024, 1024, (bf16_t*)(ws + O_WD1), 0, nullptr, 1.f, tile);
    tr_job(p.in[I_WIN], 1024, 2848, 3072, (bf16_t*)(ws + O_WIN), 0, p.in[I_LNMIX], 1.f, tile);
    tr_job(p.in[I_WOUT], 1024, 1024, 1024, (bf16_t*)(ws + O_WOUT), 0, nullptr, 1.f, tile);
    tr_job(p.in[I_XQ], 1024, 1024, 1024, (bf16_t*)(ws + O_WQ), 0, p.in[I_LNX], 0.0625f, tile);
    tr_job(p.in[I_XO], 1024, 1024, 1024, (bf16_t*)(ws + O_WO), 0, nullptr, 1.f, tile);
    tr_job(p.in[I_G2F], 1024, 2816, 2816, (bf16_t*)(ws + O_WGU2), 1, p.in[I_LN2], 1.f, tile);
    tr_job(p.in[I_U2F], 1024, 2816, 2816, (bf16_t*)(ws + O_WGU2), 2, p.in[I_LN2], 1.f, tile);
    tr_job(p.in[I_D2F], 2816, 1024, 1024, (bf16_t*)(ws + O_WD2), 0, nullptr, 1.f, tile);
}

DEV void phase_mixprep(const Params& p) {
    unsigned char* ws = p.ws; const int tid = fresh_tid(), lane = tid & 63, gw = blockIdx.x * 8 + (tid >> 6), nw = gridDim.x * 8;
    const bf16_t* z = (const bf16_t*)(ws + O_Z); bf16_t* vab = (bf16_t*)(ws + O_VAB); bf16_t* lin = (bf16_t*)(ws + O_LIN); bf16_t* ymix = (bf16_t*)(ws + O_YMIX);
    bf16_t* rbuf = (bf16_t*)(ws + O_H); bf16_t* kbuf = (bf16_t*)(ws + O_H + HALFROW); bf16_t* vbuf = (bf16_t*)(ws + O_XRES); bf16_t* kkbuf = (bf16_t*)(ws + O_KK);
    float lng[8], lnb[8], mu4[4][8], kkw[8];
    ld8f(p.in[I_SLNG] + lane * 8, lng); ld8f(p.in[I_SLNB] + lane * 8, lnb); ld8f(p.in[I_KK] + lane * 8, kkw);
#pragma unroll
    for (int it = 0; it < 4; ++it) { const int ch = lane + 64 * it; if (ch < 228) ld8f(p.in[I_MU] + ch * 8, mu4[it]); else {
#pragma unroll
        for (int i = 0; i < 8; ++i) mu4[it][i] = 0.f; } }
#pragma unroll 2
    for (int r = gw; r < MV; r += nw) {
        const bf16_t* zr = z + (size_t)r * ZLD; const bool smp = r >= NTOK; const int t = r & (SEQ - 1), si = r - NTOK;
        {
            const int c = lane * 8; float v[8]; ld8bf(zr + 512 + c, v); float s = 0.f;
#pragma unroll
            for (int i = 0; i < 8; ++i) { v[i] = gelu_t(v[i]); s += v[i]; }
            const float mu = wsum64(s) * (1.f / 512.f); float q = 0.f;
#pragma unroll
            for (int i = 0; i < 8; ++i) { v[i] -= mu; q += v[i] * v[i]; }
            const float rstd = rsqrtf(wsum64(q) * (1.f / 512.f) + 1e-5f);
#pragma unroll
            for (int i = 0; i < 8; ++i) v[i] = v[i] * rstd * lng[i] + lnb[i];
            st8bf(vab + (size_t)r * 512 + c, v);
            if (smp) {
                st8f(p.out + OUT_CV + (size_t)si * 512 + c, v);
                const int grp = c >> 6; const float w00 = p.in[I_SGUW][grp * 16384], b0 = p.in[I_SGUB][grp * 128]; float uu[8]; ld8bf(zr + c, uu);
#pragma unroll
                for (int i = 0; i < 8; ++i) uu[i] = gelu_t(uu[i]) * (w00 * v[i] + b0);
                st8bf(ymix + (size_t)r * 1024 + c, uu);
            }
        }
#pragma unroll
        for (int it = 0; it < 4; ++it) {
            const int ch = lane + 64 * it; if (ch >= 228) break;
            const int cb = ch * 8; float cur[8], prv[8], mu[8], zs[8]; ld8bf(zr + 1024 + cb, cur);
            if (smp) ld8f(p.in[I_SSHIFT] + (size_t)si * BPROJ + cb, prv);
            else if (t == 0) {
#pragma unroll
                for (int i = 0; i < 8; ++i) prv[i] = 0.f;
            } else ld8bf(zr - ZLD + 1024 + cb, prv);
#pragma unroll
            for (int i = 0; i < 8; ++i) { mu[i] = mu4[it][i]; zs[i] = cur[i] + (prv[i] - cur[i]) * mu[i]; }
            if (smp) st8f(p.out + OUT_SHS + (size_t)si * BPROJ + cb, cur);
            else if (t == SEQ - 1) st8f(p.out + OUT_SHP + (size_t)(r >> 11) * BPROJ + cb, cur);
            if (it == 0) st8bf(rbuf + (size_t)r * 512 + cb, zs);
            else if (it == 1) {
                const int c = cb - 512; st8bf(kbuf + (size_t)r * 512 + c, zs); float kk[8]; float ss = 0.f;
#pragma unroll
                for (int i = 0; i < 8; ++i) { kk[i] = zs[i] * kkw[i]; ss += kk[i] * kk[i]; }
                ss += __shfl_xor(ss, 1); ss += __shfl_xor(ss, 2); ss += __shfl_xor(ss, 4);
                const float rn = rsqrtf(fmaxf(ss, 1e-24f));
#pragma unroll
                for (int i = 0; i < 8; ++i) kk[i] *= rn;
                st8bf(kkbuf + (size_t)r * 512 + c, kk);
            } else if (it == 2) st8bf(vbuf + (size_t)r * 512 + (cb - 1024), zs);
            else {
                const int l = ch - 192; float o[8];
#pragma unroll
                for (int i = 0; i < 8; ++i) o[i] = l < 8 ? tanhf_(zs[i]) : (l < 16 ? zs[i] : sigmoidf_(zs[i]));
                st8bf(lin + (size_t)r * 384 + l * 8, o);
            }
        }
        if (lane >= 36 && lane < 48) { const float zero[8] = {0.f, 0.f, 0.f, 0.f, 0.f, 0.f, 0.f, 0.f}; st8bf(lin + (size_t)r * 384 + lane * 8, zero); }
    }
}

DEV void phase_chunkmix(const Params& p, LAS unsigned char* lds) {
    unsigned char* ws = p.ws; const int tid = fresh_tid(), lane = tid & 63, w = tid >> 6, l15 = lane & 15, kg = lane >> 4;
    const bf16_t* z = (const bf16_t*)(ws + O_Z); const bf16_t* vab = (const bf16_t*)(ws + O_VAB); bf16_t* ymix = (bf16_t*)(ws + O_YMIX);
    LAS bf16_t* vaT = (LAS bf16_t*)lds;
    for (int item = blockIdx.x; item < 1024; item += gridDim.x) {
        const int g = item & 7, bc = item >> 3; const size_t m0 = (size_t)bc * 128;
        const int trow = 16 * w + l15; const float* wrow = p.in[I_SGUW] + ((size_t)g * 128 + trow) * 128;
        const int nks = (16 * w + 16 + 31) >> 5;
        f32x4 ar[4][2];
#pragma unroll
        for (int ks = 0; ks < 4; ++ks) if (ks < nks) { ar[ks][0] = *(const f32x4*)(wrow + 32 * ks + kg * 8); ar[ks][1] = *(const f32x4*)(wrow + 32 * ks + kg * 8 + 4); }
        bf16_t zu[4][4]; float bs[4];
#pragma unroll
        for (int j = 0; j < 4; ++j) { const int t = 16 * w + kg * 4 + j; bs[j] = p.in[I_SGUB][g * 128 + t];
#pragma unroll
            for (int nb = 0; nb < 4; ++nb) zu[j][nb] = z[(m0 + t) * ZLD + g * 64 + nb * 16 + l15]; }
        __syncthreads();
#pragma unroll
        for (int i = 0; i < 2; ++i) { const int id = tid + 512 * i, s = id >> 3, d8 = (id & 7) * 8; const u32x4 u = *(const u32x4*)(vab + (m0 + s) * 512 + g * 64 + d8);
#pragma unroll
            for (int j = 0; j < 4; ++j) { vaT[(d8 + 2 * j) * 136 + s] = (bf16_t)(u[j] & 0xffffu); vaT[(d8 + 2 * j + 1) * 136 + s] = (bf16_t)(u[j] >> 16); } }
        __syncthreads();
        f32x4 acc[4];
#pragma unroll
        for (int nb = 0; nb < 4; ++nb) acc[nb] = (f32x4){0.f, 0.f, 0.f, 0.f};
#pragma unroll
        for (int ks = 0; ks < 4; ++ks) if (ks < nks) {
            const int s0 = 32 * ks + kg * 8; float a[8];
#pragma unroll
            for (int i = 0; i < 4; ++i) { a[i] = ar[ks][0][i]; a[4 + i] = ar[ks][1][i]; }
#pragma unroll
            for (int i = 0; i < 8; ++i) a[i] = (s0 + i <= trow) ? a[i] : 0.f;
            u32x4 au; au[0] = cvt_pk_bf16(a[0], a[1]); au[1] = cvt_pk_bf16(a[2], a[3]); au[2] = cvt_pk_bf16(a[4], a[5]); au[3] = cvt_pk_bf16(a[6], a[7]);
            const bf16x8 av = __builtin_bit_cast(bf16x8, au);
#pragma unroll
            for (int nb = 0; nb < 4; ++nb) { const bf16x8 bv = *(const LAS bf16x8*)(vaT + (nb * 16 + l15) * 136 + s0); acc[nb] = __builtin_amdgcn_mfma_f32_16x16x32_bf16(av, bv, acc[nb], 0, 0, 0); }
        }
#pragma unroll
        for (int j = 0; j < 4; ++j) { const int t = 16 * w + kg * 4 + j; const float bias = bs[j]; const size_t m = m0 + t;
#pragma unroll
            for (int nb = 0; nb < 4; ++nb) { const int d = g * 64 + nb * 16 + l15; const float u = gelu_t(bf2f(zu[j][nb])); ymix[m * 1024 + d] = (bf16_t)(cvt_pk_bf16(u * (acc[nb][j] + bias), 0.f) & 0xffffu); } }
    }
}

DEV void phase_scan(const Params& p, LAS unsigned char* lds) {
    unsigned char* ws = p.ws; const int tid = fresh_tid(), lane = tid & 63, w = tid >> 6, rg = lane >> 4, kq = lane & 15;
    const bf16_t* rbuf = (const bf16_t*)(ws + O_H); const bf16_t* kbuf = (const bf16_t*)(ws + O_H + HALFROW); const bf16_t* vbuf = (const bf16_t*)(ws + O_XRES);
    const bf16_t* kkbuf = (const bf16_t*)(ws + O_KK); const float* dec = (const float*)(ws + O_DEC); const bf16_t* kka = (const bf16_t*)(ws + O_KKA); bf16_t* obuf = (bf16_t*)(ws + O_Z);
    constexpr int SL = 16, NCH = SEQ / SL, LB = 5 * SL * 64;
    LAS float* L = (LAS float*)lds;
    LAS float* Lv = L + 2 * LB;
    LAS float* Lp = Lv + 2 * SL * 16;
#define SCAN_BAR() do { asm volatile("s_waitcnt lgkmcnt(0)" ::: "memory"); __builtin_amdgcn_s_barrier(); asm volatile("" ::: "memory"); } while (0)
    for (int item = blockIdx.x; item < 256; item += gridDim.x) {
        const int bh = item >> 2, q = item & 3, b = bh >> 3, h = bh & 7; const size_t m0 = (size_t)b * SEQ;
        if (w >= 4) {
            const int lt = tid - 256, ls = lt >> 4, lc = (lt & 15) * 4;
            f32x4 p1; u32x2 p0, p2, p3, p4, pv; pv[0] = 0u; pv[1] = 0u;
            auto gload = [&](int ch) { const size_t o = (m0 + ch * SL + ls) * 512 + h * 64 + lc;
                p0 = *(const u32x2*)(kkbuf + o); p1 = *(const f32x4*)(dec + o); p2 = *(const u32x2*)(kbuf + o); p3 = *(const u32x2*)(kka + o); p4 = *(const u32x2*)(rbuf + o);
                if (lt < 64) pv = *(const u32x2*)(vbuf + (m0 + ch * SL + (lt >> 2)) * 512 + h * 64 + q * 16 + (lt & 3) * 4); };
            auto fill = [&](int ch) { LAS float* d = L + (ch & 1) * LB + ls * 64 + lc;
                *(LAS f32x4*)d = bf4(p0); *(LAS f32x4*)(d + SL * 64) = p1; *(LAS f32x4*)(d + 2 * SL * 64) = bf4(p2); *(LAS f32x4*)(d + 3 * SL * 64) = bf4(p3); *(LAS f32x4*)(d + 4 * SL * 64) = bf4(p4);
                if (lt < 64) *(LAS f32x4*)(Lv + (ch & 1) * SL * 16 + lt * 4) = bf4(pv); };
            auto reduce_slab = [&](int ch) { const int st = lt >> 4, row = lt & 15; const LAS float* pp = Lp + (ch & 1) * SL * 256 + st * 256 + (row >> 2) * 64 + (row & 3) * 16;
                const f32x4 a = *(const LAS f32x4*)pp, b4 = *(const LAS f32x4*)(pp + 4), c = *(const LAS f32x4*)(pp + 8), d = *(const LAS f32x4*)(pp + 12); const f32x4 t = (a + b4) + (c + d);
                obuf[(m0 + ch * SL + st) * 512 + h * 64 + q * 16 + row] = (bf16_t)(cvt_pk_bf16((t[0] + t[1]) + (t[2] + t[3]), 0.f) & 0xffffu); };
            gload(0); fill(0); gload(1);
            SCAN_BAR();
            for (int ch = 0; ch < NCH; ++ch) {
                if (ch + 1 < NCH) fill(ch + 1);
                if (ch + 2 < NCH) gload(ch + 2);
                if (ch >= 1) reduce_slab(ch - 1);
                SCAN_BAR();
            }
            reduce_slab(NCH - 1);
            {
                const int sidx = item * 4 + (w - 4), si = sidx >> 3, hh = sidx & 7; const size_t o = (size_t)(NTOK + si) * 512 + hh * 64 + kq * 4;
                const f32x4 kk4 = bf4(*(const u32x2*)(kkbuf + o)), w4 = *(const f32x4*)(dec + o), k4 = bf4(*(const u32x2*)(kbuf + o)), ka4 = bf4(*(const u32x2*)(kka + o)), r4 = bf4(*(const u32x2*)(rbuf + o));
                const float* sin = p.in[I_SRWKV] + (size_t)sidx * 4096; float* sout = p.out + OUT_SS + (size_t)sidx * 4096;
                for (int ps = 0; ps < 16; ++ps) {
                    const int v = ps * 4 + rg; f32x4 S = *(const f32x4*)(sin + v * 64 + kq * 4); const float vv = bf2f(vbuf[(size_t)(NTOK + si) * 512 + hh * 64 + v]);
                    const float sa = -rowsum16(S[0] * kk4[0] + S[1] * kk4[1] + S[2] * kk4[2] + S[3] * kk4[3]);
                    S = S * w4 + vv * k4 + sa * ka4;
                    *(f32x4*)(sout + v * 64 + kq * 4) = S;
                    const float op = rowsum16(S[0] * r4[0] + S[1] * r4[1] + S[2] * r4[2] + S[3] * r4[3]);
                    if (kq == 0) obuf[(size_t)(NTOK + si) * 512 + hh * 64 + v] = (bf16_t)(cvt_pk_bf16(op, 0.f) & 0xffffu);
                }
            }
        } else {
            typedef float f32x2v __attribute__((ext_vector_type(2)));
            f32x2v Sa = (f32x2v){0.f, 0.f}, Sb = (f32x2v){0.f, 0.f}; const int row = w * 4 + rg;
            SCAN_BAR();
            for (int ch = 0; ch < NCH; ++ch) {
                const LAS float* Lc = L + (ch & 1) * LB + kq * 4; const LAS float* Lvc = Lv + (ch & 1) * SL * 16 + row;
                LAS float* dst = Lp + (ch & 1) * SL * 256 + w * 64 + lane;
                f32x4 kk4 = *(const LAS f32x4*)Lc, w4 = *(const LAS f32x4*)(Lc + SL * 64), k4 = *(const LAS f32x4*)(Lc + 2 * SL * 64), ka4 = *(const LAS f32x4*)(Lc + 3 * SL * 64), r4 = *(const LAS f32x4*)(Lc + 4 * SL * 64);
                float vv = Lvc[0];
#pragma unroll
                for (int s = 0; s < SL; ++s) {
                    const int sn = s < SL - 1 ? s + 1 : SL - 1; const LAS float* bp = Lc + sn * 64;
                    const f32x4 nkk4 = *(const LAS f32x4*)bp, nw4 = *(const LAS f32x4*)(bp + SL * 64), nk4 = *(const LAS f32x4*)(bp + 2 * SL * 64), nka4 = *(const LAS f32x4*)(bp + 3 * SL * 64), nr4 = *(const LAS f32x4*)(bp + 4 * SL * 64);
                    const float nvv = Lvc[sn * 16];
                    f32x2v t = Sa * kk4.lo; t = Sb * kk4.hi + t;
                    const float sa = -rowsum16(t[0] + t[1]);
                    Sa = (Sa * w4.lo + vv * k4.lo) + sa * ka4.lo;
                    Sb = (Sb * w4.hi + vv * k4.hi) + sa * ka4.hi;
                    f32x2v u = Sa * r4.lo; u = Sb * r4.hi + u;
                    dst[s * 256] = u[0] + u[1];
                    kk4 = nkk4; w4 = nw4; k4 = nk4; ka4 = nka4; r4 = nr4; vv = nvv;
                }
                SCAN_BAR();
            }
            const float S0 = Sa[0], S1 = Sa[1], S2 = Sb[0], S3 = Sb[1];
            *(f32x4*)(p.out + OUT_SP + ((size_t)bh * 64 + q * 16 + row) * 64 + kq * 4) = (f32x4){S0, S1, S2, S3};
        }
        __syncthreads();
    }
#undef SCAN_BAR
}

DEV void phase_finalize(const Params& p) {
    unsigned char* ws = p.ws; const int tid = fresh_tid(), lane = tid & 63, gw = blockIdx.x * 8 + (tid >> 6), nw = gridDim.x * 8;
    const bf16_t* rbuf = (const bf16_t*)(ws + O_H); const bf16_t* kbuf = (const bf16_t*)(ws + O_H + HALFROW); const bf16_t* gb = (const bf16_t*)(ws + O_H + 2 * HALFROW);
    const bf16_t* vbuf = (const bf16_t*)(ws + O_XRES); const bf16_t* obuf = (const bf16_t*)(ws + O_Z); bf16_t* ymix = (bf16_t*)(ws + O_YMIX);
    const int c = lane * 8; float rk[8], gg[8], gbb[8]; ld8f(p.in[I_RK] + c, rk); ld8f(p.in[I_GNG] + c, gg); ld8f(p.in[I_GNB] + c, gbb);
#pragma unroll 2
    for (int r = gw; r < MV; r += nw) {
        const size_t o = (size_t)r * 512 + c; float ov[8], rv[8], kv[8], vv[8], gv[8]; ld8bf(obuf + o, ov); ld8bf(rbuf + o, rv); ld8bf(kbuf + o, kv); ld8bf(vbuf + o, vv); ld8bf(gb + o, gv);
        float s = 0.f, bs = 0.f;
#pragma unroll
        for (int i = 0; i < 8; ++i) { s += ov[i]; bs += rv[i] * kv[i] * rk[i]; }
        s += __shfl_xor(s, 1); s += __shfl_xor(s, 2); s += __shfl_xor(s, 4); bs += __shfl_xor(bs, 1); bs += __shfl_xor(bs, 2); bs += __shfl_xor(bs, 4);
        const float mu = s * (1.f / 64.f); float q = 0.f;
#pragma unroll
        for (int i = 0; i < 8; ++i) { ov[i] -= mu; q += ov[i] * ov[i]; }
        q += __shfl_xor(q, 1); q += __shfl_xor(q, 2); q += __shfl_xor(q, 4);
        const float rstd = rsqrtf(q * (1.f / 64.f) + 64e-5f); float y[8];
#pragma unroll
        for (int i = 0; i < 8; ++i) y[i] = (ov[i] * rstd * gg[i] + gbb[i] + bs * vv[i]) * gv[i];
        st8bf(ymix + (size_t)r * 1024 + 512 + c, y);
    }
}

DEV void phase_sattn(const Params& p, LAS unsigned char* lds) {
    unsigned char* ws = p.ws; const int tid = fresh_tid(), lane = tid & 63, w = tid >> 6, kgrp = lane >> 4, dl = lane & 15;
    const bf16_t* qb = (const bf16_t*)(ws + O_Z + HALFROW); bf16_t* ob = (bf16_t*)(ws + O_YMIX);
    LAS float* pw = (LAS float*)lds;
    LAS float* wm = pw + 256;
    LAS float* wacc = wm + 16;
    for (int item = blockIdx.x; item < 512; item += gridDim.x) {
        const int si = item >> 2, h = item & 3; const float* Kp = p.in[I_CK] + (size_t)si * 262144 + h * 256; const float* Vp = p.in[I_CV] + (size_t)si * 262144 + h * 256;
        float q[16]; { float a[8], b[8]; ld8bf(qb + (size_t)(NTOK + si) * 1024 + h * 256 + dl * 16, a); ld8bf(qb + (size_t)(NTOK + si) * 1024 + h * 256 + dl * 16 + 8, b);
#pragma unroll
            for (int i = 0; i < 8; ++i) { q[i] = a[i]; q[8 + i] = b[i]; } }
        float sc[8];
#pragma unroll
        for (int j = 0; j < 8; ++j) {
            const float* kr = Kp + (size_t)(w * 32 + kgrp + 4 * j) * 1024 + dl * 16; float d = 0.f;
#pragma unroll
            for (int i = 0; i < 4; ++i) { const f32x4 k4 = *(const f32x4*)(kr + 4 * i); d += k4[0] * q[4 * i] + k4[1] * q[4 * i + 1] + k4[2] * q[4 * i + 2] + k4[3] * q[4 * i + 3]; }
            sc[j] = rowsum16(d);
        }
        float mx = sc[0];
#pragma unroll
        for (int j = 1; j < 8; ++j) mx = fmaxf(mx, sc[j]);
        mx = fmaxf(mx, __shfl_xor(mx, 16)); mx = fmaxf(mx, __shfl_xor(mx, 32));
        float sum = 0.f;
#pragma unroll
        for (int j = 0; j < 8; ++j) { sc[j] = __expf(sc[j] - mx); sum += sc[j]; }
        sum += __shfl_xor(sum, 16); sum += __shfl_xor(sum, 32);
        __syncthreads();
        if (dl == 0) {
#pragma unroll
            for (int j = 0; j < 8; ++j) pw[w * 32 + kgrp + 4 * j] = sc[j];
        }
        if (lane == 0) { wm[w] = mx; wm[8 + w] = sum; }
        asm volatile("s_waitcnt lgkmcnt(0)" ::: "memory"); __builtin_amdgcn_wave_barrier();
        f32x4 acc = (f32x4){0.f, 0.f, 0.f, 0.f};
#pragma unroll 16
        for (int j = 0; j < 32; ++j) { const f32x4 v4 = *(const f32x4*)(Vp + (size_t)(w * 32 + j) * 1024 + lane * 4); acc = acc + pw[w * 32 + j] * v4; }
        *(LAS f32x4*)(wacc + w * 256 + lane * 4) = acc;
        __syncthreads();
        if (tid < 256) {
            float M = wm[0];
#pragma unroll
            for (int j = 1; j < 8; ++j) M = fmaxf(M, wm[j]);
            float L = 0.f, o = 0.f;
#pragma unroll
            for (int j = 0; j < 8; ++j) { const float f = __expf(wm[j] - M); L += wm[8 + j] * f; o += wacc[j * 256 + tid] * f; }
            ob[(size_t)(NTOK + si) * 1024 + h * 256 + tid] = (bf16_t)(cvt_pk_bf16(o * __builtin_amdgcn_rcpf(L), 0.f) & 0xffffu);
        }
    }
}

DEV void phase_final(const Params& p) {
    unsigned char* ws = p.ws; const int tid = fresh_tid(), lane = tid & 63, gw = blockIdx.x * 8 + (tid >> 6), nw = gridDim.x * 8;
    const bf16_t* xb = (const bf16_t*)(ws + O_XB); const float* rs5 = (const float*)(ws + O_RS5);
    float g[16]; { float a[8], b[8]; ld8f(p.in[I_FIN] + lane * 8, a); ld8f(p.in[I_FIN] + 512 + lane * 8, b);
#pragma unroll
        for (int i = 0; i < 8; ++i) { g[i] = a[i]; g[8 + i] = b[i]; } }
#pragma unroll 2
    for (int r = gw; r < MV; r += nw) {
        const float rstd = rstd_of(rs5, r);
#pragma unroll
        for (int hf = 0; hf < 2; ++hf) { const int c = hf * 512 + lane * 8; float v[8]; ld8bf(xb + (size_t)r * 1024 + c, v);
#pragma unroll
            for (int i = 0; i < 8; ++i) v[i] = v[i] * rstd * g[hf * 8 + i];
            st8f(p.out + OUT_Y + (size_t)r * 1024 + c, v); }
    }
}

__global__ void __launch_bounds__(512, 2) mega(Params p) {
    extern __shared__ __attribute__((aligned(16))) unsigned char shm[];
    LAS unsigned char* lds = (LAS unsigned char*)shm;
    unsigned char* ws = p.ws;
    const int MT = MP / 256;
    {
        volatile LAS unsigned* st = (volatile LAS unsigned*)(lds + pg8::STAGE_BYTES);
        if (threadIdx.x < 2) st[threadIdx.x] = 0u;
        __syncthreads();
        if (threadIdx.x == 0) (void)xb_add(&((unsigned*)(ws + O_BAR))[XB_XCNT(xb_xcc_id())], 1u);
    }
#define XB_SYNC() do { XcdBarrier xb_; xb_.bar = (unsigned*)(p.ws + O_BAR); xb_.x = xb_xcc_id(); xb_.st = (volatile LAS unsigned*)(lds + pg8::STAGE_BYTES); xcd_barrier(xb_); } while (0)
    { phase_prep(p, lds); }
    XB_SYNC();
    { {
            { pg8::Gemm g{(const bf16_t*)(ws + O_XB), (const bf16_t*)(ws + O_WGU1), 1024, 1024, 1024}; pg8::GridSched S; S.init(MT, 22, 0, 1024, 1024);
              EpiSwiglu E{(const float*)(ws + O_RS1), (bf16_t*)(ws + O_H)}; pg8::gemm_phase(lds, g, S, E); }
            { pg8::Gemm g{(const bf16_t*)(ws + O_MNB), (const bf16_t*)(ws + O_WK), 1024, 1024, 1024}; pg8::GridSched S; S.init(8, 4, MT * 22, 1024, 1024);
              EpiK E{(const float*)(ws + O_RSTDM), p.out + OUT_MK, (bf16_t*)(ws + O_MKB)}; pg8::gemm_phase(lds, g, S, E); }
            { pg8::Gemm g{(const bf16_t*)(ws + O_WV), (const bf16_t*)(ws + O_MNB), 1024, 1024, 1024}; pg8::GridSched S; S.init(4, 8, MT * 22 + 32, 1024, 1024);
              EpiVT E{(const float*)(ws + O_RSTDM), p.out + OUT_MV, (bf16_t*)(ws + O_VT)}; pg8::gemm_phase(lds, g, S, E); }
        } }
    XB_SYNC();
    { { pg8::Gemm g{(const bf16_t*)(ws + O_H), (const bf16_t*)(ws + O_WD1), DFF, DFF, DFF}; pg8::GridSched S; S.init(64, 4, 0, DFF, DFF);
            EpiRes E{p.in[I_XP], (bf16_t*)(ws + O_XB), (float*)(ws + O_RS2), 0.5f}; pg8::gemm_phase(lds, g, S, E);
            SRes E2{p.in[I_XS], (bf16_t*)(ws + O_XB), (float*)(ws + O_RS2), 0.5f, NTOK};
            small_gemm<4>(lds, (const bf16_t*)(ws + O_H), DFF, (const bf16_t*)(ws + O_WD1), DFF, DFF, NTOK, 4, 16, E2); } }
    XB_SYNC();
    { { pg8::Gemm g{(const bf16_t*)(ws + O_XB), (const bf16_t*)(ws + O_WIN), 1024, 1024, 1024}; pg8::GridSched S; S.init(MT, 11, 0, 1024, 1024);
            EpiScale E{(const float*)(ws + O_RS2), (bf16_t*)(ws + O_Z), ZLD, ZLD}; pg8::gemm_phase(lds, g, S, E);
            SScale E2{(const float*)(ws + O_RS2), (bf16_t*)(ws + O_Z), ZLD, ZLD, 2816};
            small_gemm<2>(lds, (const bf16_t*)(ws + O_XB), 1024, (const bf16_t*)(ws + O_WIN) + (size_t)2816 * 1024, 1024, 1024, 0, MV / 32, 1, E2); } }
    XB_SYNC();
    { phase_mixprep(p); }
    XB_SYNC();
    { { pg8::Gemm g{(const bf16_t*)(ws + O_LIN), (const bf16_t*)(ws + O_WLORA), 384, 384, 256}; pg8::LoraSched S; S.init();
            EpiLora E{p.in[I_W0], p.in[I_A0], p.in[I_KA], (float*)(ws + O_DEC), (bf16_t*)(ws + O_H + HALFROW), (const bf16_t*)(ws + O_KK), (bf16_t*)(ws + O_KKA), (bf16_t*)(ws + O_H + 2 * HALFROW)};
            pg8::gemm_phase(lds, g, S, E); phase_chunkmix(p, lds); } }
    XB_SYNC();
    { phase_scan(p, lds); }
    XB_SYNC();
    { phase_finalize(p); }
    XB_SYNC();
    { { pg8::Gemm g{(const bf16_t*)(ws + O_YMIX), (const bf16_t*)(ws + O_WOUT), 1024, 1024, 1024}; pg8::GridSched S; S.init(64, 4, 0, 1024, 1024);
            EpiRes E{nullptr, (bf16_t*)(ws + O_XB), (float*)(ws + O_RS3), 1.f}; pg8::gemm_phase(lds, g, S, E);
            SRes E2{nullptr, (bf16_t*)(ws + O_XB), (float*)(ws + O_RS3), 1.f, 0};
            small_gemm<4>(lds, (const bf16_t*)(ws + O_YMIX), 1024, (const bf16_t*)(ws + O_WOUT), 1024, 1024, NTOK, 4, 16, E2); } }
    XB_SYNC();
    { { pg8::Gemm g{(const bf16_t*)(ws + O_XB), (const bf16_t*)(ws + O_WQ), 1024, 1024, 1024}; pg8::GridSched S; S.init(64, 4, 0, 1024, 1024);
            EpiScale E{(const float*)(ws + O_RS3), (bf16_t*)(ws + O_Z + HALFROW), 1024, 1024}; pg8::gemm_phase(lds, g, S, E);
            SScale E2{(const float*)(ws + O_RS3), (bf16_t*)(ws + O_Z + HALFROW), 1024, 1024, 0};
            small_gemm<4>(lds, (const bf16_t*)(ws + O_XB), 1024, (const bf16_t*)(ws + O_WQ), 1024, 1024, NTOK, 4, 16, E2); } }
    XB_SYNC();
    { {
            const bool sattn_first = ((blockIdx.x >> 3) & 1) != 0;
            if (sattn_first) phase_sattn(p, lds);
            { pg8::Gemm g{(const bf16_t*)(ws + O_Z + HALFROW), (const bf16_t*)(ws + O_MKB), 1024, 1024, 256}; pg8::AttnSched<0> S; S.init();
              EpiS E{(bf16_t*)(ws + O_Z), (float*)(ws + O_PSUM)}; pg8::gemm_phase(lds, g, S, E); }
            asm volatile("s_waitcnt vmcnt(0)" ::: "memory"); __syncthreads();
            if (threadIdx.x == 0) { __builtin_amdgcn_fence(__ATOMIC_ACQUIRE, "agent"); asm volatile("s_waitcnt vmcnt(0)" ::: "memory"); }
            __syncthreads();
            { pg8::Gemm g{(const bf16_t*)(ws + O_Z), (const bf16_t*)(ws + O_VT), 256, 2048, 256}; pg8::AttnSched<1> S; S.init();
              EpiO E{(const float*)(ws + O_PSUM), (bf16_t*)(ws + O_YMIX)}; pg8::gemm_phase(lds, g, S, E); }
            if (!sattn_first) phase_sattn(p, lds);
        } }
    XB_SYNC();
    { { pg8::Gemm g{(const bf16_t*)(ws + O_YMIX), (const bf16_t*)(ws + O_WO), 1024, 1024, 1024}; pg8::GridSched S; S.init(64, 4, 0, 1024, 1024);
            EpiRes E{nullptr, (bf16_t*)(ws + O_XB), (float*)(ws + O_RS4), 1.f}; pg8::gemm_phase(lds, g, S, E);
            SRes E2{nullptr, (bf16_t*)(ws + O_XB), (float*)(ws + O_RS4), 1.f, 0};
            small_gemm<4>(lds, (const bf16_t*)(ws + O_YMIX), 1024, (const bf16_t*)(ws + O_WO), 1024, 1024, NTOK, 4, 16, E2); } }
    XB_SYNC();
    { { pg8::Gemm g{(const bf16_t*)(ws + O_XB), (const bf16_t*)(ws + O_WGU2), 1024, 1024, 1024}; pg8::GridSched S; S.init(MT, 22, 0, 1024, 1024);
            EpiSwiglu E{(const float*)(ws + O_RS4), (bf16_t*)(ws + O_H)}; pg8::gemm_phase(lds, g, S, E); } }
    XB_SYNC();
    { { pg8::Gemm g{(const bf16_t*)(ws + O_H), (const bf16_t*)(ws + O_WD2), DFF, DFF, DFF}; pg8::GridSched S; S.init(64, 4, 0, DFF, DFF);
            EpiRes E{nullptr, (bf16_t*)(ws + O_XB), (float*)(ws + O_RS5), 0.5f}; pg8::gemm_phase(lds, g, S, E);
            SRes E2{nullptr, (bf16_t*)(ws + O_XB), (float*)(ws + O_RS5), 0.5f, 0};
            small_gemm<4>(lds, (const bf16_t*)(ws + O_H), DFF, (const bf16_t*)(ws + O_WD2), DFF, DFF, NTOK, 4, 16, E2); } }
    XB_SYNC();
    { phase_final(p); }
#undef XB_SYNC
}

constexpr size_t LDS_BYTES = pg8::STAGE_BYTES + 4096;

extern "C" void kernel_launch(void* const* d_in, const int* in_sizes, int n_in, void* d_out, int out_size, void* d_ws, size_t ws_size, hipStream_t stream) {
    static int grid_blocks = 0;
    if (!grid_blocks) {
        int dev = 0, cus = 0, per_cu = 0;
        hipGetDevice(&dev);
        hipDeviceGetAttribute(&cus, hipDeviceAttributeMultiprocessorCount, dev);
        hipFuncSetAttribute((const void*)mega, hipFuncAttributeMaxDynamicSharedMemorySize, (int)LDS_BYTES);
        hipOccupancyMaxActiveBlocksPerMultiprocessor(&per_cu, mega, 512, LDS_BYTES);
        if (per_cu < 1) { fprintf(stderr, "occupancy query returned %d\n", per_cu); per_cu = 1; }
        grid_blocks = cus * (per_cu > 1 ? 1 : per_cu);
        if (ws_size < WS_NEED) fprintf(stderr, "workspace too small: %zu < %zu\n", ws_size, (size_t)WS_NEED);
    }
    Params p{};
    for (int i = 0; i < 40; ++i) p.in[i] = (const float*)d_in[i];
    p.out = (float*)d_out; p.ws = (unsigned char*)d_ws;
    hipMemsetAsync((unsigned char*)d_ws + O_BAR, 0, XCD_BAR_WORDS * 4, stream);
    hipLaunchKernelGGL(mega, dim3(grid_blocks), dim3(512), LDS_BYTES, stream, p);
}
```

```cpp
#include <hip/hip_runtime.h>
#include <hip/hip_cooperative_groups.h>
#include <cstdio>
namespace cg = cooperative_groups;

#ifndef PHMASK
#define PHMASK 0xffff
#endif
#ifndef DUPMASK
#define DUPMASK 0
#endif
#ifndef ONE_LAUNCH
#define ONE_LAUNCH 1
#endif

#define LAS __attribute__((address_space(3)))
#define DEV __device__ __forceinline__
typedef unsigned short bf16_t;
typedef short bf16x8 __attribute__((ext_vector_type(8)));
typedef float f32x4 __attribute__((ext_vector_type(4)));
typedef unsigned u32x2 __attribute__((ext_vector_type(2)));
typedef unsigned u32x4 __attribute__((ext_vector_type(4)));

constexpr int DM = 1024, NTOK = 16384, NSMP = 128, MV = NTOK + NSMP, MP = 16640, SEQ = 2048;
constexpr int DFF = 2816, ZLD = 2848, BPROJ = 1824, NMEMR = 2048;
constexpr int NPH = 16;

constexpr size_t al256(size_t x) { return (x + 255) & ~(size_t)255; }
constexpr size_t O_WGU1 = 0;
constexpr size_t O_WD1 = O_WGU1 + al256((size_t)5632 * 1024 * 2);
constexpr size_t O_WIN = O_WD1 + al256((size_t)1024 * 2816 * 2);
constexpr size_t O_WOUT = O_WIN + al256((size_t)3072 * 1024 * 2);
constexpr size_t O_WQ = O_WOUT + 2097152, O_WK = O_WQ + 2097152, O_WV = O_WK + 2097152, O_WO = O_WV + 2097152;
constexpr size_t O_WGU2 = O_WO + 2097152;
constexpr size_t O_WD2 = O_WGU2 + al256((size_t)5632 * 1024 * 2);
constexpr size_t O_WLORA = O_WD2 + al256((size_t)1024 * 2816 * 2);
constexpr size_t O_MNB = O_WLORA + al256((size_t)1536 * 384 * 2);
constexpr size_t O_MKB = O_MNB + 4194304, O_VT = O_MKB + 4194304;
constexpr size_t O_RSTDM = O_VT + 4194304;
constexpr size_t RS_BYTES = (size_t)MP * 64;
constexpr size_t O_RS1 = O_RSTDM + 8192, O_RS2 = O_RS1 + RS_BYTES, O_RS3 = O_RS2 + RS_BYTES, O_RS4 = O_RS3 + RS_BYTES, O_RS5 = O_RS4 + RS_BYTES;
constexpr size_t O_PSUM = O_RS5 + RS_BYTES;
constexpr size_t HALFROW = (size_t)MP * 512 * 4;
constexpr size_t O_XB = O_PSUM + 1048576;
constexpr size_t O_XRES = O_XB + HALFROW;
constexpr size_t O_H = O_XRES + 2 * HALFROW;
constexpr size_t O_Z = O_H + al256((size_t)MP * DFF * 2);
constexpr size_t O_YMIX = O_Z + al256((size_t)MP * ZLD * 2);
constexpr size_t O_VAB = O_YMIX + HALFROW;
constexpr size_t O_LIN = O_VAB + HALFROW / 2;
constexpr size_t O_KK = O_LIN + al256((size_t)MP * 384 * 2);
constexpr size_t O_DEC = O_KK + HALFROW, O_KKA = O_DEC + HALFROW;
constexpr size_t O_BAR = O_KKA + HALFROW;
constexpr size_t WS_NEED = O_BAR + 16384;

constexpr size_t OUT_Y = 0, OUT_SP = (size_t)MV * 1024, OUT_SHP = OUT_SP + 262144, OUT_MK = OUT_SHP + 8 * 1824, OUT_MV = OUT_MK + 2097152,
                 OUT_SS = OUT_MV + 2097152, OUT_SHS = OUT_SS + 4194304, OUT_CV = OUT_SHS + 128 * 1824;

enum { I_XP = 0, I_XS, I_SRWKV, I_SSHIFT, I_CK, I_CV, I_MEM, I_LN1, I_G1, I_U1, I_D1, I_LNMIX, I_WIN, I_WOUT, I_SGUW, I_SGUB, I_SLNG, I_SLNB,
       I_MU, I_W0, I_W2, I_A0, I_A2, I_G2, I_KK, I_KA, I_RK, I_GNG, I_GNB, I_LNX, I_MEMN, I_XQ, I_XK, I_XV, I_XO, I_LN2, I_G2F, I_U2F, I_D2F, I_FIN };

struct Params { const float* in[40]; float* out; unsigned char* ws; };

DEV unsigned cvt_pk_bf16(float lo, float hi) { unsigned r; asm volatile("v_cvt_pk_bf16_f32 %0, %1, %2" : "=v"(r) : "v"(lo), "v"(hi)); return r; }
DEV float bf_lo(unsigned u) { return __uint_as_float(u << 16); }
DEV float bf_hi(unsigned u) { return __uint_as_float(u & 0xffff0000u); }
DEV f32x4 bf4(u32x2 u) { return (f32x4){__uint_as_float(u[0] << 16), __uint_as_float(u[0] & 0xffff0000u), __uint_as_float(u[1] << 16), __uint_as_float(u[1] & 0xffff0000u)}; }
DEV u32x2 pk4(f32x4 v) { u32x2 o; o[0] = cvt_pk_bf16(v[0], v[1]); o[1] = cvt_pk_bf16(v[2], v[3]); return o; }
DEV float bf2f(bf16_t b) { return __uint_as_float((unsigned)b << 16); }
DEV float sigmoidf_(float x) { return __builtin_amdgcn_rcpf(1.f + __expf(-x)); }
DEV float tanhf_(float y) { return 1.f - 2.f * __builtin_amdgcn_rcpf(1.f + __expf(2.f * y)); }
DEV float gelu_t(float x) { return 0.5f * x * (1.f + tanhf_(0.7978845608028654f * (x + 0.044715f * x * x * x))); }
DEV float wsum64(float v) {
#pragma unroll
    for (int o = 32; o >= 1; o >>= 1) v += __shfl_xor(v, o);
    return v;
}
DEV float wmax64(float v) {
#pragma unroll
    for (int o = 32; o >= 1; o >>= 1) v = fmaxf(v, __shfl_xor(v, o));
    return v;
}
template <int CTRL> DEV float dpp_f(float x) { return __builtin_bit_cast(float, __builtin_amdgcn_update_dpp(0, __builtin_bit_cast(int, x), CTRL, 0xf, 0xf, false)); }
DEV float rowsum16(float x) {
    x += dpp_f<0x128>(x); x += dpp_f<0x124>(x); x += dpp_f<0x122>(x); x += dpp_f<0x121>(x); return x;
}
DEV int fresh_tid() { int t = threadIdx.x; asm volatile("" : "+v"(t)); return t; }
DEV float rstd_of(const float* rs, int r) { const f32x4* q = (const f32x4*)(rs + (size_t)r * 16); const f32x4 p = (q[0] + q[1]) + (q[2] + q[3]); return rsqrtf(((p[0] + p[1]) + (p[2] + p[3])) * (1.f / 1024.f) + 1e-6f); }

#define XB_TMO      128
#define XB_XCNT(j)  (256  + 64 * (j))
#define XB_XSUB(j)  (1280 + 64 * (j))
#define XB_XGEN(j)  (2304 + 64 * (j))
#define XB_TOP      3328
#define XB_TOPGEN   3392
#define XCD_BAR_WORDS 3456
#define XB_SPIN_CAP (1u << 18)
DEV unsigned xb_ld(unsigned* p)              { return __hip_atomic_load(p, __ATOMIC_RELAXED, __HIP_MEMORY_SCOPE_AGENT); }
DEV unsigned xb_add(unsigned* p, unsigned v) { return __hip_atomic_fetch_add(p, v, __ATOMIC_RELAXED, __HIP_MEMORY_SCOPE_AGENT); }
DEV unsigned xb_xcc_id() { return (unsigned)__builtin_amdgcn_s_getreg((3 << 11) | 20) & 0xFu; }
#define XB_SPIN(cond, bar) do { unsigned _sp = 0; while (cond) { __builtin_amdgcn_s_sleep(1); \
    if ((++_sp & 255u) == 0u) { if (xb_ld(&(bar)[XB_TMO])) break; if (_sp > XB_SPIN_CAP) { atomicAdd(&(bar)[XB_TMO], 1u); break; } } } } while (0)
struct XcdBarrier { unsigned* bar; unsigned x; volatile LAS unsigned* st; };
DEV XcdBarrier xcd_barrier_post(unsigned* bar, volatile LAS unsigned* st) {
    XcdBarrier b; b.bar = bar; b.x = xb_xcc_id(); b.st = st;
    if (threadIdx.x == 0) (void)xb_add(&bar[XB_XCNT(b.x)], 1u);
    return b;
}
DEV void xcd_barrier_complete(unsigned* bar, unsigned x, unsigned& nloc, unsigned& nx) {
    const unsigned G = gridDim.x * gridDim.y * gridDim.z;
    unsigned sum, cnt, mine, sp = 0u;
    for (;;) {
        sum = 0u; cnt = 0u; mine = 0u;
#pragma unroll
        for (unsigned j = 0; j < 16; ++j) { const unsigned c = xb_ld(&bar[XB_XCNT(j)]); sum += c; cnt += (c > 0u) ? 1u : 0u; mine = (j == x) ? c : mine; }
        if (sum == G) break;
        __builtin_amdgcn_s_sleep(1);
        if ((++sp & 255u) == 0u) { if (xb_ld(&bar[XB_TMO])) break; if (sp > XB_SPIN_CAP) { atomicAdd(&bar[XB_TMO], 1u); break; } }
    }
    nloc = mine > 0u ? mine : 1u; nx = cnt > 0u ? cnt : 1u;
}
DEV void xcd_barrier(const XcdBarrier& b) {
    asm volatile("s_waitcnt vmcnt(0)" ::: "memory");
    __syncthreads();
    if (threadIdx.x == 0) {
        unsigned* bar = b.bar;
        __builtin_amdgcn_s_waitcnt(0);
        unsigned nloc = b.st[0], nx = b.st[1];
        if (nloc == 0u) { xcd_barrier_complete(bar, b.x, nloc, nx); b.st[0] = nloc; b.st[1] = nx; }
        const unsigned old = xb_add(&bar[XB_XSUB(b.x)], 1u);
        const unsigned gen = old / nloc;
        if (old + 1u == (gen + 1u) * nloc) {
            __builtin_amdgcn_fence(__ATOMIC_RELEASE, "agent");
            asm volatile("s_waitcnt vmcnt(0)" ::: "memory");
            const unsigned og = xb_add(&bar[XB_TOP], 1u);
            const unsigned tg = og / nx;
            if (og + 1u == (tg + 1u) * nx) xb_add(&bar[XB_TOPGEN], 1u);
            else XB_SPIN(xb_ld(&bar[XB_TOPGEN]) == tg, bar);
            __builtin_amdgcn_fence(__ATOMIC_ACQUIRE, "agent");
            xb_add(&bar[XB_XGEN(b.x)], 1u);
            asm volatile("s_waitcnt vmcnt(0)" ::: "memory");
        } else {
            XB_SPIN(xb_ld(&bar[XB_XGEN(b.x)]) == gen, bar);
            __builtin_amdgcn_fence(__ATOMIC_ACQUIRE, "agent");
            asm volatile("s_waitcnt vmcnt(0)" ::: "memory");
        }
    }
    __syncthreads();
}

namespace pg8 {
constexpr int BM = 256, BK = 64, HALF = 128, HTB = HALF * BK * 2, STAGE_BYTES = 8 * HTB, NXCD = 8, WGM = 8;
DEV int lds_byte(int r, int c) { const int st = (r >> 4) * 2 + (c >> 5), rr = r & 15, cc = c & 31, ob = rr * 64 + cc * 2; return st * 1024 + (ob ^ (((ob >> 9) & 1) << 5)); }
DEV void stage_rc(int b, int& R, int& C) { const int st = b / 1024, sb = b % 1024, swz = sb ^ (((sb >> 9) & 1) << 5); R = (st >> 1) * 16 + swz / 64; C = (st & 1) * 32 + (swz % 64) / 2; }

struct Unit { int pm, pn; long ao, bo; int x0, x1; };
struct Gemm { const bf16_t* A; const bf16_t* Bt; int lda, ldb, K; };

struct GridSched {
    int nM, nN, nwg, G, c; long ta, tb;
    DEV void init(int nM_, int nN_, int shift, int lda, int ldb) { nM = nM_; nN = nN_; nwg = nM * nN; G = (int)gridDim.x; c = ((int)blockIdx.x + G - (shift % G)) % G; ta = 256L * lda; tb = 256L * ldb; }
    DEV bool next(int i, Unit& u) const {
        const long L = (long)i * G + c; if (L >= nwg) return false;
        int wgid = (int)L; { const int q = nwg / NXCD, r = nwg % NXCD, xcd = wgid % NXCD, off = wgid / NXCD; wgid = (xcd < r ? xcd * (q + 1) : r * (q + 1) + (xcd - r) * q) + off; }
        const int nig = WGM * nN, gid = wgid / nig, fm = gid * WGM, gsz = (nM - fm) < WGM ? (nM - fm) : WGM;
        u.pm = fm + ((wgid % nig) % gsz); u.pn = (wgid % nig) / gsz; u.ao = u.pm * ta; u.bo = u.pn * tb; u.x0 = 0; u.x1 = 0; return true;
    }
};
struct LoraSched {
    int G, c;
    DEV void init() { G = (int)gridDim.x; c = (int)blockIdx.x; }
    DEV bool next(int i, Unit& u) const {
        const long L = (long)i * G + c; if (L >= 65 * 6) return false;
        const int pn = (int)L % 6, pm = (int)L / 6, off = (pn >= 4) ? 128 : 0;
        u.pm = pm; u.pn = pn; u.x0 = 0; u.x1 = 0; u.ao = (long)pm * 256 * 384 + off; u.bo = (long)pn * 256 * 384 + off; return true;
    }
};
template <int WHICH> struct AttnSched {
    int G, c;
    DEV void init() { G = (int)gridDim.x; c = (int)blockIdx.x; }
    DEV bool next(int i, Unit& u) const {
        const long L = (long)i * G + c; if (L >= 256) return false;
        const int xcd = (int)L & 7, idx = (int)L >> 3, bh = xcd * 4 + (idx >> 3), mt = idx & 7, b = bh >> 2, h = bh & 3;
        u.pm = mt; u.pn = 0; u.x0 = bh; u.x1 = mt;
        if (WHICH == 0) { u.ao = ((long)b * 2048 + mt * 256) * 1024 + h * 256; u.bo = ((long)b * 256) * 1024 + h * 256; }
        else { u.ao = ((long)bh * 2048 + mt * 256) * 256; u.bo = ((long)h * 256) * 2048 + b * 256; }
        return true;
    }
};

template <class Epi, class Sched>
DEV void gemm_phase(LAS unsigned char* lds, const Gemm g, const Sched& S, const Epi& E) {
    int tid_ = threadIdx.x; asm volatile("" : "+v"(tid_));
    const int tid = tid_, wid = __builtin_amdgcn_readfirstlane(tid >> 6), lane = tid & 63, wr = wid >> 2, wc = wid & 3, fr = lane & 15, fq = lane >> 4;
    int K = g.K, lda_ = g.lda, ldb_ = g.ldb; asm volatile("" : "+s"(K), "+s"(lda_), "+s"(ldb_)); const int nt = K / BK;
    unsigned voffA[2], voffB[2];
#pragma unroll
    for (int i = 0; i < 2; ++i) { int R, C; stage_rc(tid * 16 + i * 8192, R, C); voffA[i] = (unsigned)(R * lda_ + C) * 2u; voffB[i] = (unsigned)(R * ldb_ + C) * 2u; }
    const size_t kstep = (size_t)(BK * 2);
    const size_t hstepA = (size_t)HALF * lda_ * 2, hstepB = (size_t)HALF * ldb_ * 2;
    const unsigned ldsw = (unsigned)wid * 1024u;
    const int aoff = lds_byte(wr * 64 + fr, fq * 8), boff = lds_byte(wc * 32 + fr, fq * 8);
#define PG8_SA(b, h) (((b) * 2 + (h)) * HTB)
#define PG8_SB(b, h) ((4 + (b) * 2 + (h)) * HTB)
#define PG8_STAGE(bufoff, gbase, voff) do { _Pragma("unroll") for (int _i = 0; _i < 2; ++_i) \
        __builtin_amdgcn_global_load_lds((const unsigned*)((const char*)(gbase) + (voff)[_i]), (LAS unsigned*)(lds + (bufoff) + ldsw + _i * 8192), 16, 0, 0); } while (0)
#define PG8_LDA(dst, b, h) do { _Pragma("unroll") for (int m = 0; m < 4; ++m) _Pragma("unroll") for (int k = 0; k < 2; ++k) dst[m][k] = *(const LAS bf16x8*)(lds + PG8_SA(b, h) + aoff + m * 2048 + k * 1024); } while (0)
#define PG8_LDB(dst, b, h) do { _Pragma("unroll") for (int n = 0; n < 2; ++n) _Pragma("unroll") for (int k = 0; k < 2; ++k) dst[n][k] = *(const LAS bf16x8*)(lds + PG8_SB(b, h) + boff + n * 2048 + k * 1024); } while (0)
#define PG8_MMA(ai, bj, At, Bt) do { __builtin_amdgcn_s_setprio(1); _Pragma("unroll") for (int m = 0; m < 4; ++m) _Pragma("unroll") for (int n = 0; n < 2; ++n) _Pragma("unroll") for (int k = 0; k < 2; ++k) \
        acc[ai][bj][m][n] = __builtin_amdgcn_mfma_f32_16x16x32_bf16(Bt[n][k], At[m][k], acc[ai][bj][m][n], 0, 0, 0); __builtin_amdgcn_s_setprio(0); } while (0)
#define PG8_WAIT_V(n) asm volatile("s_waitcnt vmcnt(" #n ")" ::: "memory")
#define PG8_WAIT_L(n) asm volatile("s_waitcnt lgkmcnt(" #n ")" ::: "memory")
#define PG8_BAR __builtin_amdgcn_s_barrier()
#define PG8_SCHED __builtin_amdgcn_sched_barrier(0)
    Unit cur, nxt; int ui = 0;
    if (!S.next(0, cur)) return;
    f32x4 acc[2][2][4][2];
#pragma unroll
    for (int a = 0; a < 2; ++a)
#pragma unroll
        for (int b = 0; b < 2; ++b)
#pragma unroll
            for (int m = 0; m < 4; ++m)
#pragma unroll
                for (int n = 0; n < 2; ++n) acc[a][b][m][n] = (f32x4){0.f, 0.f, 0.f, 0.f};
    bf16x8 At[4][2], B0[2][2], B1[2][2];
    const char* cA = (const char*)g.A + (size_t)cur.ao * 2; const char* cB = (const char*)g.Bt + (size_t)cur.bo * 2;
    PG8_STAGE(PG8_SB(0, 0), cB, voffB); PG8_STAGE(PG8_SA(0, 0), cA, voffA); PG8_STAGE(PG8_SB(0, 1), cB + hstepB, voffB); PG8_STAGE(PG8_SA(0, 1), cA + hstepA, voffA);
    if (wr == 1) PG8_BAR;
    PG8_WAIT_V(4); PG8_BAR;
    PG8_STAGE(PG8_SB(1, 0), cB + kstep, voffB); PG8_STAGE(PG8_SA(1, 0), cA + kstep, voffA); PG8_STAGE(PG8_SB(1, 1), cB + hstepB + kstep, voffB);
    PG8_WAIT_V(6); PG8_BAR;
    for (;;) {
        const bool has_next = S.next(ui + 1, nxt);
        const char* nA = has_next ? (const char*)g.A + (size_t)nxt.ao * 2 : cA; const char* nB = has_next ? (const char*)g.Bt + (size_t)nxt.bo * 2 : cB;
#pragma unroll 1
        for (int t = 0; t < nt; t += 2) {
            const bool last = (t == nt - 2);
            const char* a1 = cA + (size_t)(t + 1) * kstep;
            const char* a2 = last ? nA : cA + (size_t)(t + 2) * kstep; const char* b2 = last ? nB : cB + (size_t)(t + 2) * kstep;
            const char* a3 = a2 + kstep; const char* b3 = b2 + kstep;
            PG8_LDB(B0, 0, 0); PG8_SCHED; PG8_LDA(At, 0, 0); PG8_STAGE(PG8_SA(1, 1), a1 + hstepA, voffA);
            PG8_WAIT_L(8); PG8_BAR; PG8_WAIT_L(0); PG8_MMA(0, 0, At, B0); PG8_BAR; PG8_SCHED;
            PG8_LDB(B1, 0, 1); PG8_STAGE(PG8_SB(0, 0), b2, voffB);
            PG8_BAR; PG8_WAIT_L(0); PG8_MMA(0, 1, At, B1); PG8_BAR;
            PG8_LDA(At, 0, 1); PG8_STAGE(PG8_SA(0, 0), a2, voffA);
            PG8_BAR; PG8_WAIT_L(0); PG8_MMA(1, 0, At, B0); PG8_BAR; PG8_SCHED;
            PG8_STAGE(PG8_SB(0, 1), b2 + hstepB, voffB);
            PG8_WAIT_V(6); PG8_BAR; PG8_MMA(1, 1, At, B1); PG8_BAR;
            PG8_LDB(B0, 1, 0); PG8_SCHED; PG8_LDA(At, 1, 0); PG8_STAGE(PG8_SA(0, 1), a2 + hstepA, voffA);
            PG8_WAIT_L(8); PG8_BAR; PG8_WAIT_L(0); PG8_MMA(0, 0, At, B0); PG8_BAR; PG8_SCHED;
            PG8_LDB(B1, 1, 1); PG8_STAGE(PG8_SB(1, 0), b3, voffB);
            PG8_BAR; PG8_WAIT_L(0); PG8_MMA(0, 1, At, B1); PG8_BAR;
            PG8_LDA(At, 1, 1); PG8_STAGE(PG8_SA(1, 0), a3, voffA);
            PG8_BAR; PG8_WAIT_L(0); PG8_MMA(1, 0, At, B0); PG8_BAR; PG8_SCHED;
            PG8_STAGE(PG8_SB(1, 1), b3 + hstepB, voffB);
            PG8_WAIT_V(6); PG8_BAR; PG8_MMA(1, 1, At, B1); PG8_BAR;
        }
        E(acc, cur, wr, wc, fr, fq);
        if (!has_next) break;
#pragma unroll
        for (int a = 0; a < 2; ++a)
#pragma unroll
            for (int b = 0; b < 2; ++b)
#pragma unroll
                for (int m = 0; m < 4; ++m)
#pragma unroll
                    for (int n = 0; n < 2; ++n) acc[a][b][m][n] = (f32x4){0.f, 0.f, 0.f, 0.f};
        cur = nxt; cA = nA; cB = nB; ++ui;
    }
    PG8_WAIT_V(0);
    if (wr == 0) PG8_BAR;
    PG8_BAR;
#undef PG8_SA
#undef PG8_SB
#undef PG8_STAGE
#undef PG8_LDA
#undef PG8_LDB
#undef PG8_MMA
#undef PG8_WAIT_V
#undef PG8_WAIT_L
#undef PG8_BAR
#undef PG8_SCHED
}
}
using pg8::Unit;

typedef const f32x4 (&AccRef)[2][2][4][2];

struct EpiSwiglu {
    const float* rs; bf16_t* H;
    DEV void operator()(AccRef acc, const Unit& u, int wr, int wc, int fr, int fq) const {
        const int row0 = u.pm * 256 + wr * 64 + fr, hc0 = u.pn * 128 + wc * 16 + 4 * fq;
#pragma unroll
        for (int ai = 0; ai < 2; ++ai)
#pragma unroll
            for (int m = 0; m < 4; ++m) {
                const int r = row0 + ai * 128 + m * 16; const float rstd = rstd_of(rs, r);
#pragma unroll
                for (int bj = 0; bj < 2; ++bj) {
                    float hv[4];
#pragma unroll
                    for (int i = 0; i < 4; ++i) { const float gt = acc[ai][bj][m][0][i] * rstd, up = acc[ai][bj][m][1][i] * rstd; hv[i] = gt * sigmoidf_(gt) * up; }
                    u32x2 o; o[0] = cvt_pk_bf16(hv[0], hv[1]); o[1] = cvt_pk_bf16(hv[2], hv[3]);
                    *(u32x2*)(H + (size_t)r * DFF + hc0 + bj * 64) = o;
                }
            }
    }
};

struct EpiRes {
    const float* res; bf16_t* xb; float* rs_out; float alpha;
    DEV void operator()(AccRef acc, const Unit& u, int wr, int wc, int fr, int fq) const {
        const int row0 = u.pm * 256 + wr * 64 + fr, col0 = u.pn * 256 + wc * 32 + 4 * fq;
#pragma unroll
        for (int ai = 0; ai < 2; ++ai)
#pragma unroll
            for (int mh = 0; mh < 2; ++mh) {
                f32x4 x[2][2][2];
#pragma unroll
                for (int m2 = 0; m2 < 2; ++m2)
#pragma unroll
                    for (int bj = 0; bj < 2; ++bj)
#pragma unroll
                        for (int n = 0; n < 2; ++n) { const size_t o = (size_t)(row0 + ai * 128 + (mh * 2 + m2) * 16) * 1024 + col0 + bj * 128 + n * 16;
                            x[m2][bj][n] = res ? *(const f32x4*)(res + o) : bf4(*(const u32x2*)(xb + o)); }
#pragma unroll
                for (int m2 = 0; m2 < 2; ++m2) {
                    const int m = mh * 2 + m2, r = row0 + ai * 128 + m * 16; float s = 0.f;
#pragma unroll
                    for (int bj = 0; bj < 2; ++bj)
#pragma unroll
                        for (int n = 0; n < 2; ++n) {
                            const int c = col0 + bj * 128 + n * 16; const f32x4 v = x[m2][bj][n] + alpha * acc[ai][bj][m][n];
                            *(u32x2*)(xb + (size_t)r * 1024 + c) = pk4(v);
                            s += v[0] * v[0] + v[1] * v[1] + v[2] * v[2] + v[3] * v[3];
                        }
                    s += __shfl_xor(s, 16); s += __shfl_xor(s, 32);
                    if (fq == 0) rs_out[(size_t)r * 16 + u.pn * 4 + wc] = s;
                }
            }
    }
};

struct EpiScale {
    const float* rs; bf16_t* O; int ldo, ncols;
    DEV void operator()(AccRef acc, const Unit& u, int wr, int wc, int fr, int fq) const {
        const int row0 = u.pm * 256 + wr * 64 + fr, col0 = u.pn * 256 + wc * 32 + 4 * fq;
#pragma unroll
        for (int ai = 0; ai < 2; ++ai)
#pragma unroll
            for (int m = 0; m < 4; ++m) {
                const int r = row0 + ai * 128 + m * 16; const float rstd = rstd_of(rs, r);
#pragma unroll
                for (int bj = 0; bj < 2; ++bj)
#pragma unroll
                    for (int n = 0; n < 2; ++n) {
                        const int c = col0 + bj * 128 + n * 16;
                        if (c < ncols) { const f32x4 v = acc[ai][bj][m][n] * rstd; u32x2 o; o[0] = cvt_pk_bf16(v[0], v[1]); o[1] = cvt_pk_bf16(v[2], v[3]); *(u32x2*)(O + (size_t)r * ldo + c) = o; }
                    }
            }
    }
};

struct EpiLora {
    const float* w0; const float* a0; const float* k_a; float* dec; bf16_t* kbuf; const bf16_t* kkbuf; bf16_t* kka; bf16_t* gb;
    template <int REGION> DEV void run(AccRef acc, const Unit& u, int wr, int wc, int fr, int fq) const {
        const int row0 = u.pm * 256 + wr * 64 + fr, cb = (u.pn & 1) * 256 + wc * 32 + 4 * fq;
        f32x4 pb0[2][2], pka[2][2];
#pragma unroll
        for (int bj = 0; bj < 2; ++bj)
#pragma unroll
            for (int n = 0; n < 2; ++n) { const int cc = cb + bj * 128 + n * 16; pb0[bj][n] = REGION == 0 ? *(const f32x4*)(w0 + cc) : (REGION == 1 ? *(const f32x4*)(a0 + cc) : (f32x4){0.f, 0.f, 0.f, 0.f}); pka[bj][n] = REGION == 1 ? *(const f32x4*)(k_a + cc) : (f32x4){0.f, 0.f, 0.f, 0.f}; }
#pragma unroll
        for (int ai = 0; ai < 2; ++ai)
#pragma unroll
            for (int m = 0; m < 4; ++m) {
                const int r = row0 + ai * 128 + m * 16;
                {
#pragma unroll
                    for (int bj = 0; bj < 2; ++bj)
#pragma unroll
                        for (int n = 0; n < 2; ++n) {
                            const int cc = cb + bj * 128 + n * 16; const f32x4 a = acc[ai][bj][m][n]; const size_t o = (size_t)r * 512 + cc;
                            if (REGION == 0) {
                                const f32x4 b0 = pb0[bj][n]; f32x4 d;
#pragma unroll
                                for (int i = 0; i < 4; ++i) d[i] = __expf(-0.60653066f * sigmoidf_(b0[i] + a[i]));
                                *(f32x4*)(dec + o) = d;
                            } else if (REGION == 1) {
                                const f32x4 b0 = pb0[bj][n], ka = pka[bj][n], kv = bf4(*(const u32x2*)(kbuf + o)), kkv = bf4(*(const u32x2*)(kkbuf + o)); f32x4 kn, kkan;
#pragma unroll
                                for (int i = 0; i < 4; ++i) { const float av = sigmoidf_(b0[i] + a[i]); kn[i] = kv[i] * (1.f + (av - 1.f) * ka[i]); kkan[i] = kkv[i] * av; }
                                *(u32x2*)(kbuf + o) = pk4(kn); *(u32x2*)(kka + o) = pk4(kkan);
                            } else {
                                u32x2 ov; ov[0] = cvt_pk_bf16(a[0], a[1]); ov[1] = cvt_pk_bf16(a[2], a[3]); *(u32x2*)(gb + o) = ov;
                            }
                        }
                }
            }
    }
    DEV void operator()(AccRef acc, const Unit& u, int wr, int wc, int fr, int fq) const {
        const int region = u.pn >> 1;
        if (region == 0) run<0>(acc, u, wr, wc, fr, fq); else if (region == 1) run<1>(acc, u, wr, wc, fr, fq); else run<2>(acc, u, wr, wc, fr, fq);
    }
};

struct EpiK {
    const float* rstdm; float* outk; bf16_t* mkb;
    DEV void operator()(AccRef acc, const Unit& u, int wr, int wc, int fr, int fq) const {
        const int row0 = u.pm * 256 + wr * 64 + fr, col0 = u.pn * 256 + wc * 32 + 4 * fq;
#pragma unroll
        for (int ai = 0; ai < 2; ++ai)
#pragma unroll
            for (int m = 0; m < 4; ++m) {
                const int r = row0 + ai * 128 + m * 16; const float rstd = rstdm[r];
#pragma unroll
                for (int bj = 0; bj < 2; ++bj)
#pragma unroll
                    for (int n = 0; n < 2; ++n) {
                        const int c = col0 + bj * 128 + n * 16; const f32x4 v = acc[ai][bj][m][n] * rstd;
                        *(f32x4*)(outk + (size_t)r * 1024 + c) = v;
                        u32x2 o; o[0] = cvt_pk_bf16(v[0], v[1]); o[1] = cvt_pk_bf16(v[2], v[3]); *(u32x2*)(mkb + (size_t)r * 1024 + c) = o;
                    }
            }
    }
};
struct EpiVT {
    const float* rstdm; float* outv; bf16_t* vt;
    DEV void operator()(AccRef acc, const Unit& u, int wr, int wc, int fr, int fq) const {
        const int row0 = u.pm * 256 + wr * 64 + fr, col0 = u.pn * 256 + wc * 32 + 4 * fq;
#pragma unroll
        for (int bj = 0; bj < 2; ++bj)
#pragma unroll
            for (int n = 0; n < 2; ++n) {
                const int c = col0 + bj * 128 + n * 16; const f32x4 rsd = *(const f32x4*)(rstdm + c);
#pragma unroll
                for (int ai = 0; ai < 2; ++ai)
#pragma unroll
                    for (int m = 0; m < 4; ++m) {
                        const int r = row0 + ai * 128 + m * 16; const f32x4 v = acc[ai][bj][m][n] * rsd;
                        u32x2 o; o[0] = cvt_pk_bf16(v[0], v[1]); o[1] = cvt_pk_bf16(v[2], v[3]); *(u32x2*)(vt + (size_t)r * 2048 + c) = o;
#pragma unroll
                        for (int i = 0; i < 4; ++i) outv[(size_t)(c + i) * 1024 + r] = v[i];
                    }
            }
    }
};
struct EpiS {
    bf16_t* P; float* psum;
    DEV void operator()(AccRef acc, const Unit& u, int wr, int wc, int fr, int fq) const {
        const size_t prow0 = (size_t)u.x0 * 2048 + u.x1 * 256;
#pragma unroll
        for (int ai = 0; ai < 2; ++ai)
#pragma unroll
            for (int m = 0; m < 4; ++m) {
                const int rl = ai * 128 + wr * 64 + m * 16 + fr; float s = 0.f;
#pragma unroll
                for (int bj = 0; bj < 2; ++bj)
#pragma unroll
                    for (int n = 0; n < 2; ++n) {
                        const f32x4 a = acc[ai][bj][m][n]; u32x2 o;
                        o[0] = cvt_pk_bf16(__expf(a[0]), __expf(a[1])); o[1] = cvt_pk_bf16(__expf(a[2]), __expf(a[3]));
                        s += bf_lo(o[0]) + bf_hi(o[0]) + bf_lo(o[1]) + bf_hi(o[1]);
                        *(u32x2*)(P + (prow0 + rl) * 256 + bj * 128 + wc * 32 + n * 16 + 4 * fq) = o;
                    }
                s += __shfl_xor(s, 16); s += __shfl_xor(s, 32);
                if (fq == 0) psum[(prow0 + rl) * 4 + wc] = s;
            }
    }
};
struct EpiO {
    const float* psum; bf16_t* O;
    DEV void operator()(AccRef acc, const Unit& u, int wr, int wc, int fr, int fq) const {
        const int bh = u.x0, b = bh >> 2, h = bh & 3; const size_t prow0 = (size_t)bh * 2048 + u.x1 * 256; const size_t m0 = (size_t)b * 2048 + u.x1 * 256;
#pragma unroll
        for (int ai = 0; ai < 2; ++ai)
#pragma unroll
            for (int m = 0; m < 4; ++m) {
                const int rl = ai * 128 + wr * 64 + m * 16 + fr; const f32x4 p = *(const f32x4*)(psum + (prow0 + rl) * 4); const float inv = __builtin_amdgcn_rcpf(p[0] + p[1] + p[2] + p[3]);
#pragma unroll
                for (int bj = 0; bj < 2; ++bj)
#pragma unroll
                    for (int n = 0; n < 2; ++n) {
                        const f32x4 v = acc[ai][bj][m][n] * inv; u32x2 o; o[0] = cvt_pk_bf16(v[0], v[1]); o[1] = cvt_pk_bf16(v[2], v[3]);
                        *(u32x2*)(O + (m0 + rl) * 1024 + h * 256 + bj * 128 + wc * 32 + n * 16 + 4 * fq) = o;
                    }
            }
    }
};

struct SRes {
    const float* res; bf16_t* xb; float* rs_out; float alpha; int res_row0;
    DEV void operator()(int r, int c, f32x4 a, int slab, int l15) const {
        const f32x4 x0 = res ? *(const f32x4*)(res + (size_t)(r - res_row0) * 1024 + c) : bf4(*(const u32x2*)(xb + (size_t)r * 1024 + c));
        const f32x4 x = x0 + alpha * a;
        *(u32x2*)(xb + (size_t)r * 1024 + c) = pk4(x);
        const float s = rowsum16(x[0] * x[0] + x[1] * x[1] + x[2] * x[2] + x[3] * x[3]);
        if (l15 == 0) rs_out[(size_t)r * 16 + slab] = s;
    }
};
struct SScale {
    const float* rs; bf16_t* O; int ldo, ncols, col_off;
    DEV void operator()(int r, int c, f32x4 a, int, int) const {
        const int cc = c + col_off;
        if (cc < ncols) { const f32x4 v = a * rstd_of(rs, r); u32x2 o; o[0] = cvt_pk_bf16(v[0], v[1]); o[1] = cvt_pk_bf16(v[2], v[3]); *(u32x2*)(O + (size_t)r * ldo + cc) = o; }
    }
};
template <int NB, class Epi>
DEV void small_gemm(LAS unsigned char* lds, const bf16_t* A, int lda, const bf16_t* Bt, int ldb, int K, int row_base, int nrg, int nslab, const Epi& E) {
    const int tid = fresh_tid(), lane = tid & 63, w = tid >> 6, l15 = lane & 15, kg = lane >> 4;
    LAS float* red = (LAS float*)lds;
    const int kw = K >> 3;
    for (int item = blockIdx.x; item < nrg * nslab; item += gridDim.x) {
        const int rgi = item % nrg, slab = item / nrg, r0 = row_base + rgi * 32, c0 = slab * 64;
        f32x4 acc[2][4];
#pragma unroll
        for (int rb = 0; rb < 2; ++rb)
#pragma unroll
            for (int n = 0; n < 4; ++n) acc[rb][n] = (f32x4){0.f, 0.f, 0.f, 0.f};
        const bf16_t* ap = A + (size_t)(r0 + l15) * lda + w * kw + kg * 8;
        const bf16_t* bp = Bt + (size_t)(c0 + l15) * ldb + w * kw + kg * 8;
#pragma unroll 4
        for (int k = 0; k < kw; k += 32) {
            const bf16x8 a0 = *(const bf16x8*)(ap + k), a1 = *(const bf16x8*)(ap + (size_t)16 * lda + k);
            bf16x8 b[NB];
#pragma unroll
            for (int n = 0; n < NB; ++n) b[n] = *(const bf16x8*)(bp + (size_t)(n * 16) * ldb + k);
#pragma unroll
            for (int n = 0; n < NB; ++n) { acc[0][n] = __builtin_amdgcn_mfma_f32_16x16x32_bf16(b[n], a0, acc[0][n], 0, 0, 0); acc[1][n] = __builtin_amdgcn_mfma_f32_16x16x32_bf16(b[n], a1, acc[1][n], 0, 0, 0); }
        }
        __syncthreads();
#pragma unroll
        for (int rb = 0; rb < 2; ++rb)
#pragma unroll
            for (int n = 0; n < 4; ++n) *(LAS f32x4*)(red + ((w * 32 + rb * 16 + l15) * 64 + n * 16 + 4 * kg)) = acc[rb][n];
        __syncthreads();
        const int row = tid >> 4, c4 = (tid & 15) * 4; f32x4 sum = (f32x4){0.f, 0.f, 0.f, 0.f};
#pragma unroll
        for (int ww = 0; ww < 8; ++ww) sum = sum + *(const LAS f32x4*)(red + ((ww * 32 + row) * 64 + c4));
        E(r0 + row, c0 + c4, sum, slab, tid & 15);
    }
}

DEV void ld8bf(const bf16_t* p, float (&v)[8]) { const u32x4 u = *(const u32x4*)p;
#pragma unroll
    for (int i = 0; i < 4; ++i) { v[2 * i] = bf_lo(u[i]); v[2 * i + 1] = bf_hi(u[i]); } }
DEV void ld8f(const float* p, float (&v)[8]) { const f32x4 a = *(const f32x4*)p, b = *(const f32x4*)(p + 4);
#pragma unroll
    for (int i = 0; i < 4; ++i) { v[i] = a[i]; v[4 + i] = b[i]; } }
DEV void st8f(float* p, const float (&v)[8]) { *(f32x4*)p = (f32x4){v[0], v[1], v[2], v[3]}; *(f32x4*)(p + 4) = (f32x4){v[4], v[5], v[6], v[7]}; }
DEV void st8bf(bf16_t* p, const float (&v)[8]) { u32x4 o; o[0] = cvt_pk_bf16(v[0], v[1]); o[1] = cvt_pk_bf16(v[2], v[3]); o[2] = cvt_pk_bf16(v[4], v[5]); o[3] = cvt_pk_bf16(v[6], v[7]); *(u32x4*)p = o; }

DEV void tr_job(const float* __restrict__ src, int Ks, int Ns, int Nd, bf16_t* __restrict__ dst, int mode, const float* __restrict__ gain, float scale, LAS float* tile) {
    const int nk = Ks / 64, nn = Nd / 64, ntile = nk * nn, ldd = Ks; const int t = fresh_tid();
    f32x4 v0, v1;
    auto gl = [&](int ti) { const int tk = ti % nk, tn = ti / nk;
        { const int id = t, k = id >> 4, gn = tn * 64 + (id & 15) * 4; v0 = (gn < Ns) ? *(const f32x4*)(src + (size_t)(tk * 64 + k) * Ns + gn) : (f32x4){0.f, 0.f, 0.f, 0.f}; if (gain) v0 = v0 * (gain[tk * 64 + k] * scale); }
        { const int id = t + 512, k = id >> 4, gn = tn * 64 + (id & 15) * 4; v1 = (gn < Ns) ? *(const f32x4*)(src + (size_t)(tk * 64 + k) * Ns + gn) : (f32x4){0.f, 0.f, 0.f, 0.f}; if (gain) v1 = v1 * (gain[tk * 64 + k] * scale); } };
    int ti = blockIdx.x;
    if (ti < ntile) gl(ti);
    for (; ti < ntile; ti += gridDim.x) {
        const int tk = ti % nk, tn = ti / nk;
        *(LAS f32x4*)(tile + (t >> 4) * 68 + (t & 15) * 4) = v0; *(LAS f32x4*)(tile + ((t + 512) >> 4) * 68 + (t & 15) * 4) = v1;
        if (ti + (int)gridDim.x < ntile) gl(ti + gridDim.x);
        __syncthreads();
        { const int n = t & 63, k8 = (t >> 6) * 8, gn = tn * 64 + n; float v[8];
#pragma unroll
          for (int j = 0; j < 8; ++j) v[j] = tile[(k8 + j) * 68 + n];
          const int drow = mode == 0 ? gn : ((gn >> 4) * 32 + (mode == 2 ? 16 : 0) + (gn & 15));
          st8bf(dst + (size_t)drow * ldd + tk * 64 + k8, v); }
        __syncthreads();
    }
}

DEV void phase_prep(const Params& p, LAS unsigned char* lds) {
    unsigned char* ws = p.ws; LAS float* tile = (LAS float*)lds;
    const int tid = fresh_tid(), lane = tid & 63, gw = blockIdx.x * 8 + (tid >> 6), nw = gridDim.x * 8;
    bf16_t* xb = (bf16_t*)(ws + O_XB); float* rs1 = (float*)(ws + O_RS1);
#pragma unroll 2
    for (int r = gw; r < MP; r += nw) {
        float ss = 0.f;
        if (r < MV) {
            const float* xr = r < NTOK ? p.in[I_XP] + (size_t)r * 1024 : p.in[I_XS] + (size_t)(r - NTOK) * 1024;
#pragma unroll
            for (int i = 0; i < 4; ++i) { const int c = lane * 4 + 256 * i; const f32x4 v = *(const f32x4*)(xr + c); ss += v[0] * v[0] + v[1] * v[1] + v[2] * v[2] + v[3] * v[3];
                u32x2 o; o[0] = cvt_pk_bf16(v[0], v[1]); o[1] = cvt_pk_bf16(v[2], v[3]); *(u32x2*)(xb + (size_t)r * 1024 + c) = o; }
            ss = wsum64(ss);
        } else {
#pragma unroll
            for (int i = 0; i < 4; ++i) { u32x2 o; o[0] = 0; o[1] = 0; *(u32x2*)(xb + (size_t)r * 1024 + lane * 4 + 256 * i) = o; }
        }
        if (lane < 16) { rs1[(size_t)r * 16 + lane] = lane == 0 ? ss : 0.f;
            if (r >= MV) { ((float*)(ws + O_RS2))[(size_t)r * 16 + lane] = 0.f; ((float*)(ws + O_RS3))[(size_t)r * 16 + lane] = 0.f; ((float*)(ws + O_RS4))[(size_t)r * 16 + lane] = 0.f; ((float*)(ws + O_RS5))[(size_t)r * 16 + lane] = 0.f; } }
    }
    bf16_t* mnb = (bf16_t*)(ws + O_MNB); float* rstdm = (float*)(ws + O_RSTDM);
    for (int r = gw; r < NMEMR; r += nw) {
        const float* xr = p.in[I_MEM] + (size_t)r * 1024; float ss = 0.f;
#pragma unroll
        for (int i = 0; i < 4; ++i) { const int c = lane * 4 + 256 * i; const f32x4 v = *(const f32x4*)(xr + c); ss += v[0] * v[0] + v[1] * v[1] + v[2] * v[2] + v[3] * v[3];
            u32x2 o; o[0] = cvt_pk_bf16(v[0], v[1]); o[1] = cvt_pk_bf16(v[2], v[3]); *(u32x2*)(mnb + (size_t)r * 1024 + c) = o; }
        ss = wsum64(ss);
        if (lane == 0) rstdm[r] = rsqrtf(ss * (1.f / 1024.f) + 1e-6f);
    }
    { bf16_t* wl = (bf16_t*)(ws + O_WLORA);
      for (int i = blockIdx.x * 512 + tid; i < 1536 * 384; i += gridDim.x * 512) {
          const int n = i / 384, k = i % 384, reg = n >> 9, c = n & 511; float v = 0.f;
          if (reg == 0 && k < 64) v = p.in[I_W2][k * 512 + c];
          else if (reg == 1 && k >= 64 && k < 128) v = p.in[I_A2][(k - 64) * 512 + c];
          else if (reg == 2 && k >= 128 && k < 288) v = p.in[I_G2][(k - 128) * 512 + c];
          wl[i] = (bf16_t)(cvt_pk_bf16(v, 0.f) & 0xffffu);
      } }
    tr_job(p.in[I_G1], 1024, 2816, 2816, (bf16_t*)(ws + O_WGU1), 1, p.in[I_LN1], 1.f, tile);
    tr_job(p.in[I_U1], 1024, 2816, 2816, (bf16_t*)(ws + O_WGU1), 2, p.in[I_LN1], 1.f, tile);
    tr_job(p.in[I_XK], 1024, 1024, 1024, (bf16_t*)(ws + O_WK), 0, p.in[I_MEMN], 1.f, tile);
    tr_job(p.in[I_XV], 1024, 1024, 1024, (bf16_t*)(ws + O_WV), 0, p.in[I_MEMN], 1.f, tile);
    tr_job(p.in[I_D1], 2816, 1024, 1024, (bf16_t*)(ws + O_WD1), 0, nullptr, 1.f, tile);
    tr_job(p.in[I_WIN], 1024, 2848, 3072, (bf16_t*)(ws + O_WIN), 0, p.in[I_LNMIX], 1.f, tile);
    tr_job(p.in[I_WOUT], 1024, 1024, 1024, (bf16_t*)(ws + O_WOUT), 0, nullptr, 1.f, tile);
    tr_job(p.in[I_XQ], 1024, 1024, 1024, (bf16_t*)(ws + O_WQ), 0, p.in[I_LNX], 0.0625f, tile);
    tr_job(p.in[I_XO], 1024, 1024, 1024, (bf16_t*)(ws + O_WO), 0, nullptr, 1.f, tile);
    tr_job(p.in[I_G2F], 1024, 2816, 2816, (bf16_t*)(ws + O_WGU2), 1, p.in[I_LN2], 1.f, tile);
    tr_job(p.in[I_U2F], 1024, 2816, 2816, (bf16_t*)(ws + O_WGU2), 2, p.in[I_LN2], 1.f, tile);
    tr_job(p.in[I_D2F], 2816, 1024, 1024, (bf16_t*)(ws + O_WD2), 0, nullptr, 1.f, tile);
}

DEV void phase_mixprep(const Params& p) {
    unsigned char* ws = p.ws; const int tid = fresh_tid(), lane = tid & 63, gw = blockIdx.x * 8 + (tid >> 6), nw = gridDim.x * 8;
    const bf16_t* z = (const bf16_t*)(ws + O_Z); bf16_t* vab = (bf16_t*)(ws + O_VAB); bf16_t* lin = (bf16_t*)(ws + O_LIN); bf16_t* ymix = (bf16_t*)(ws + O_YMIX);
    bf16_t* rbuf = (bf16_t*)(ws + O_H); bf16_t* kbuf = (bf16_t*)(ws + O_H + HALFROW); bf16_t* vbuf = (bf16_t*)(ws + O_XRES); bf16_t* kkbuf = (bf16_t*)(ws + O_KK);
    float lng[8], lnb[8], mu4[4][8], kkw[8];
    ld8f(p.in[I_SLNG] + lane * 8, lng); ld8f(p.in[I_SLNB] + lane * 8, lnb); ld8f(p.in[I_KK] + lane * 8, kkw);
#pragma unroll
    for (int it = 0; it < 4; ++it) { const int ch = lane + 64 * it; if (ch < 228) ld8f(p.in[I_MU] + ch * 8, mu4[it]); else {
#pragma unroll
        for (int i = 0; i < 8; ++i) mu4[it][i] = 0.f; } }
#pragma unroll 2
    for (int r = gw; r < MV; r += nw) {
        const bf16_t* zr = z + (size_t)r * ZLD; const bool smp = r >= NTOK; const int t = r & (SEQ - 1), si = r - NTOK;
        {
            const int c = lane * 8; float v[8]; ld8bf(zr + 512 + c, v); float s = 0.f;
#pragma unroll
            for (int i = 0; i < 8; ++i) { v[i] = gelu_t(v[i]); s += v[i]; }
            const float mu = wsum64(s) * (1.f / 512.f); float q = 0.f;
#pragma unroll
            for (int i = 0; i < 8; ++i) { v[i] -= mu; q += v[i] * v[i]; }
            const float rstd = rsqrtf(wsum64(q) * (1.f / 512.f) + 1e-5f);
#pragma unroll
            for (int i = 0; i < 8; ++i) v[i] = v[i] * rstd * lng[i] + lnb[i];
            st8bf(vab + (size_t)r * 512 + c, v);
            if (smp) {
                st8f(p.out + OUT_CV + (size_t)si * 512 + c, v);
                const int grp = c >> 6; const float w00 = p.in[I_SGUW][grp * 16384], b0 = p.in[I_SGUB][grp * 128]; float uu[8]; ld8bf(zr + c, uu);
#pragma unroll
                for (int i = 0; i < 8; ++i) uu[i] = gelu_t(uu[i]) * (w00 * v[i] + b0);
                st8bf(ymix + (size_t)r * 1024 + c, uu);
            }
        }
#pragma unroll
        for (int it = 0; it < 4; ++it) {
            const int ch = lane + 64 * it; if (ch >= 228) break;
            const int cb = ch * 8; float cur[8], prv[8], mu[8], zs[8]; ld8bf(zr + 1024 + cb, cur);
            if (smp) ld8f(p.in[I_SSHIFT] + (size_t)si * BPROJ + cb, prv);
            else if (t == 0) {
#pragma unroll
                for (int i = 0; i < 8; ++i) prv[i] = 0.f;
            } else ld8bf(zr - ZLD + 1024 + cb, prv);
#pragma unroll
            for (int i = 0; i < 8; ++i) { mu[i] = mu4[it][i]; zs[i] = cur[i] + (prv[i] - cur[i]) * mu[i]; }
            if (smp) st8f(p.out + OUT_SHS + (size_t)si * BPROJ + cb, cur);
            else if (t == SEQ - 1) st8f(p.out + OUT_SHP + (size_t)(r >> 11) * BPROJ + cb, cur);
            if (it == 0) st8bf(rbuf + (size_t)r * 512 + cb, zs);
            else if (it == 1) {
                const int c = cb - 512; st8bf(kbuf + (size_t)r * 512 + c, zs); float kk[8]; float ss = 0.f;
#pragma unroll
                for (int i = 0; i < 8; ++i) { kk[i] = zs[i] * kkw[i]; ss += kk[i] * kk[i]; }
                ss += __shfl_xor(ss, 1); ss += __shfl_xor(ss, 2); ss += __shfl_xor(ss, 4);
                const float rn = rsqrtf(fmaxf(ss, 1e-24f));
#pragma unroll
                for (int i = 0; i < 8; ++i) kk[i] *= rn;
                st8bf(kkbuf + (size_t)r * 512 + c, kk);
            } else if (it == 2) st8bf(vbuf + (size_t)r * 512 + (cb - 1024), zs);
            else {
                const int l = ch - 192; float o[8];
#pragma unroll
                for (int i = 0; i < 8; ++i) o[i] = l < 8 ? tanhf_(zs[i]) : (l < 16 ? zs[i] : sigmoidf_(zs[i]));
                st8bf(lin + (size_t)r * 384 + l * 8, o);
            }
        }
        if (lane >= 36 && lane < 48) { const float zero[8] = {0.f, 0.f, 0.f, 0.f, 0.f, 0.f, 0.f, 0.f}; st8bf(lin + (size_t)r * 384 + lane * 8, zero); }
    }
}

DEV void phase_chunkmix(const Params& p, LAS unsigned char* lds) {
    unsigned char* ws = p.ws; const int tid = fresh_tid(), lane = tid & 63, w = tid >> 6, l15 = lane & 15, kg = lane >> 4;
    const bf16_t* z = (const bf16_t*)(ws + O_Z); const bf16_t* vab = (const bf16_t*)(ws + O_VAB); bf16_t* ymix = (bf16_t*)(ws + O_YMIX);
    LAS bf16_t* vaT = (LAS bf16_t*)lds;
    for (int item = blockIdx.x; item < 1024; item += gridDim.x) {
        const int g = item & 7, bc = item >> 3; const size_t m0 = (size_t)bc * 128;
        const int trow = 16 * w + l15; const float* wrow = p.in[I_SGUW] + ((size_t)g * 128 + trow) * 128;
        const int nks = (16 * w + 16 + 31) >> 5;
        f32x4 ar[4][2];
#pragma unroll
        for (int ks = 0; ks < 4; ++ks) if (ks < nks) { ar[ks][0] = *(const f32x4*)(wrow + 32 * ks + kg * 8); ar[ks][1] = *(const f32x4*)(wrow + 32 * ks + kg * 8 + 4); }
        bf16_t zu[4][4]; float bs[4];
#pragma unroll
        for (int j = 0; j < 4; ++j) { const int t = 16 * w + kg * 4 + j; bs[j] = p.in[I_SGUB][g * 128 + t];
#pragma unroll
            for (int nb = 0; nb < 4; ++nb) zu[j][nb] = z[(m0 + t) * ZLD + g * 64 + nb * 16 + l15]; }
        __syncthreads();
#pragma unroll
        for (int i = 0; i < 2; ++i) { const int id = tid + 512 * i, s = id >> 3, d8 = (id & 7) * 8; const u32x4 u = *(const u32x4*)(vab + (m0 + s) * 512 + g * 64 + d8);
#pragma unroll
            for (int j = 0; j < 4; ++j) { vaT[(d8 + 2 * j) * 136 + s] = (bf16_t)(u[j] & 0xffffu); vaT[(d8 + 2 * j + 1) * 136 + s] = (bf16_t)(u[j] >> 16); } }
        __syncthreads();
        f32x4 acc[4];
#pragma unroll
        for (int nb = 0; nb < 4; ++nb) acc[nb] = (f32x4){0.f, 0.f, 0.f, 0.f};
#pragma unroll
        for (int ks = 0; ks < 4; ++ks) if (ks < nks) {
            const int s0 = 32 * ks + kg * 8; float a[8];
#pragma unroll
            for (int i = 0; i < 4; ++i) { a[i] = ar[ks][0][i]; a[4 + i] = ar[ks][1][i]; }
#pragma unroll
            for (int i = 0; i < 8; ++i) a[i] = (s0 + i <= trow) ? a[i] : 0.f;
            u32x4 au; au[0] = cvt_pk_bf16(a[0], a[1]); au[1] = cvt_pk_bf16(a[2], a[3]); au[2] = cvt_pk_bf16(a[4], a[5]); au[3] = cvt_pk_bf16(a[6], a[7]);
            const bf16x8 av = __builtin_bit_cast(bf16x8, au);
#pragma unroll
            for (int nb = 0; nb < 4; ++nb) { const bf16x8 bv = *(const LAS bf16x8*)(vaT + (nb * 16 + l15) * 136 + s0); acc[nb] = __builtin_amdgcn_mfma_f32_16x16x32_bf16(av, bv, acc[nb], 0, 0, 0); }
        }
#pragma unroll
        for (int j = 0; j < 4; ++j) { const int t = 16 * w + kg * 4 + j; const float bias = bs[j]; const size_t m = m0 + t;
#pragma unroll
            for (int nb = 0; nb < 4; ++nb) { const int d = g * 64 + nb * 16 + l15; const float u = gelu_t(bf2f(zu[j][nb])); ymix[m * 1024 + d] = (bf16_t)(cvt_pk_bf16(u * (acc[nb][j] + bias), 0.f) & 0xffffu); } }
    }
}

DEV void phase_scan(const Params& p, LAS unsigned char* lds) {
    unsigned char* ws = p.ws; const int tid = fresh_tid(), lane = tid & 63, w = tid >> 6, rg = lane >> 4, kq = lane & 15;
    const bf16_t* rbuf = (const bf16_t*)(ws + O_H); const bf16_t* kbuf = (const bf16_t*)(ws + O_H + HALFROW); const bf16_t* vbuf = (const bf16_t*)(ws + O_XRES);
    const bf16_t* kkbuf = (const bf16_t*)(ws + O_KK); const float* dec = (const float*)(ws + O_DEC); const bf16_t* kka = (const bf16_t*)(ws + O_KKA); bf16_t* obuf = (bf16_t*)(ws + O_Z);
    constexpr int SL = 16, NCH = SEQ / SL, LB = 5 * SL * 64;
    LAS float* L = (LAS float*)lds;
    LAS float* Lv = L + 2 * LB;
    LAS float* Lp = Lv + 2 * SL * 16;
#define SCAN_BAR() do { asm volatile("s_waitcnt lgkmcnt(0)" ::: "memory"); __builtin_amdgcn_s_barrier(); asm volatile("" ::: "memory"); } while (0)
    for (int item = blockIdx.x; item < 256; item += gridDim.x) {
        const int bh = item >> 2, q = item & 3, b = bh >> 3, h = bh & 7; const size_t m0 = (size_t)b * SEQ;
        if (w >= 4) {
            const int lt = tid - 256, ls = lt >> 4, lc = (lt & 15) * 4;
            f32x4 p1; u32x2 p0, p2, p3, p4, pv; pv[0] = 0u; pv[1] = 0u;
            auto gload = [&](int ch) { const size_t o = (m0 + ch * SL + ls) * 512 + h * 64 + lc;
                p0 = *(const u32x2*)(kkbuf + o); p1 = *(const f32x4*)(dec + o); p2 = *(const u32x2*)(kbuf + o); p3 = *(const u32x2*)(kka + o); p4 = *(const u32x2*)(rbuf + o);
                if (lt < 64) pv = *(const u32x2*)(vbuf + (m0 + ch * SL + (lt >> 2)) * 512 + h * 64 + q * 16 + (lt & 3) * 4); };
            auto fill = [&](int ch) { LAS float* d = L + (ch & 1) * LB + ls * 64 + lc;
                *(LAS f32x4*)d = bf4(p0); *(LAS f32x4*)(d + SL * 64) = p1; *(LAS f32x4*)(d + 2 * SL * 64) = bf4(p2); *(LAS f32x4*)(d + 3 * SL * 64) = bf4(p3); *(LAS f32x4*)(d + 4 * SL * 64) = bf4(p4);
                if (lt < 64) *(LAS f32x4*)(Lv + (ch & 1) * SL * 16 + lt * 4) = bf4(pv); };
            auto reduce_slab = [&](int ch) { const int st = lt >> 4, row = lt & 15; const LAS float* pp = Lp + (ch & 1) * SL * 256 + st * 256 + (row >> 2) * 64 + (row & 3) * 16;
                const f32x4 a = *(const LAS f32x4*)pp, b4 = *(const LAS f32x4*)(pp + 4), c = *(const LAS f32x4*)(pp + 8), d = *(const LAS f32x4*)(pp + 12); const f32x4 t = (a + b4) + (c + d);
                obuf[(m0 + ch * SL + st) * 512 + h * 64 + q * 16 + row] = (bf16_t)(cvt_pk_bf16((t[0] + t[1]) + (t[2] + t[3]), 0.f) & 0xffffu); };
            gload(0); fill(0); gload(1);
            SCAN_BAR();
            for (int ch = 0; ch < NCH; ++ch) {
                if (ch + 1 < NCH) fill(ch + 1);
                if (ch + 2 < NCH) gload(ch + 2);
                if (ch >= 1) reduce_slab(ch - 1);
                SCAN_BAR();
            }
            reduce_slab(NCH - 1);
            {
                const int sidx = item * 4 + (w - 4), si = sidx >> 3, hh = sidx & 7; const size_t o = (size_t)(NTOK + si) * 512 + hh * 64 + kq * 4;
                const f32x4 kk4 = bf4(*(const u32x2*)(kkbuf + o)), w4 = *(const f32x4*)(dec + o), k4 = bf4(*(const u32x2*)(kbuf + o)), ka4 = bf4(*(const u32x2*)(kka + o)), r4 = bf4(*(const u32x2*)(rbuf + o));
                const float* sin = p.in[I_SRWKV] + (size_t)sidx * 4096; float* sout = p.out + OUT_SS + (size_t)sidx * 4096;
                for (int ps = 0; ps < 16; ++ps) {
                    const int v = ps * 4 + rg; f32x4 S = *(const f32x4*)(sin + v * 64 + kq * 4); const float vv = bf2f(vbuf[(size_t)(NTOK + si) * 512 + hh * 64 + v]);
                    const float sa = -rowsum16(S[0] * kk4[0] + S[1] * kk4[1] + S[2] * kk4[2] + S[3] * kk4[3]);
                    S = S * w4 + vv * k4 + sa * ka4;
                    *(f32x4*)(sout + v * 64 + kq * 4) = S;
                    const float op = rowsum16(S[0] * r4[0] + S[1] * r4[1] + S[2] * r4[2] + S[3] * r4[3]);
                    if (kq == 0) obuf[(size_t)(NTOK + si) * 512 + hh * 64 + v] = (bf16_t)(cvt_pk_bf16(op, 0.f) & 0xffffu);
                }
            }
        } else {
            typedef float f32x2v __attribute__((ext_vector_type(2)));
            f32x2v Sa = (f32x2v){0.f, 0.f}, Sb = (f32x2v){0.f, 0.f}; const int row = w * 4 + rg;
            SCAN_BAR();
            for (int ch = 0; ch < NCH; ++ch) {
                const LAS float* Lc = L + (ch & 1) * LB + kq * 4; const LAS float* Lvc = Lv + (ch & 1) * SL * 16 + row;
                LAS float* dst = Lp + (ch & 1) * SL * 256 + w * 64 + lane;
                f32x4 kk4 = *(const LAS f32x4*)Lc, w4 = *(const LAS f32x4*)(Lc + SL * 64), k4 = *(const LAS f32x4*)(Lc + 2 * SL * 64), ka4 = *(const LAS f32x4*)(Lc + 3 * SL * 64), r4 = *(const LAS f32x4*)(Lc + 4 * SL * 64);
                float vv = Lvc[0];
#pragma unroll
                for (int s = 0; s < SL; ++s) {
                    const int sn = s < SL - 1 ? s + 1 : SL - 1; const LAS float* bp = Lc + sn * 64;
                    const f32x4 nkk4 = *(const LAS f32x4*)bp, nw4 = *(const LAS f32x4*)(bp + SL * 64), nk4 = *(const LAS f32x4*)(bp + 2 * SL * 64), nka4 = *(const LAS f32x4*)(bp + 3 * SL * 64), nr4 = *(const LAS f32x4*)(bp + 4 * SL * 64);
                    const float nvv = Lvc[sn * 16];
                    f32x2v t = Sa * kk4.lo; t = Sb * kk4.hi + t;
                    const float sa = -rowsum16(t[0] + t[1]);
                    Sa = (Sa * w4.lo + vv * k4.lo) + sa * ka4.lo;
                    Sb = (Sb * w4.hi + vv * k4.hi) + sa * ka4.hi;
                    f32x2v u = Sa * r4.lo; u = Sb * r4.hi + u;
                    dst[s * 256] = u[0] + u[1];
                    kk4 = nkk4; w4 = nw4; k4 = nk4; ka4 = nka4; r4 = nr4; vv = nvv;
                }
                SCAN_BAR();
            }
            const float S0 = Sa[0], S1 = Sa[1], S2 = Sb[0], S3 = Sb[1];
            *(f32x4*)(p.out + OUT_SP + ((size_t)bh * 64 + q * 16 + row) * 64 + kq * 4) = (f32x4){S0, S1, S2, S3};
        }
        __syncthreads();
    }
#undef SCAN_BAR
}

DEV void phase_finalize(const Params& p) {
    unsigned char* ws = p.ws; const int tid = fresh_tid(), lane = tid & 63, gw = blockIdx.x * 8 + (tid >> 6), nw = gridDim.x * 8;
    const bf16_t* rbuf = (const bf16_t*)(ws + O_H); const bf16_t* kbuf = (const bf16_t*)(ws + O_H + HALFROW); const bf16_t* gb = (const bf16_t*)(ws + O_H + 2 * HALFROW);
    const bf16_t* vbuf = (const bf16_t*)(ws + O_XRES); const bf16_t* obuf = (const bf16_t*)(ws + O_Z); bf16_t* ymix = (bf16_t*)(ws + O_YMIX);
    const int c = lane * 8; float rk[8], gg[8], gbb[8]; ld8f(p.in[I_RK] + c, rk); ld8f(p.in[I_GNG] + c, gg); ld8f(p.in[I_GNB] + c, gbb);
#pragma unroll 2
    for (int r = gw; r < MV; r += nw) {
        const size_t o = (size_t)r * 512 + c; float ov[8], rv[8], kv[8], vv[8], gv[8]; ld8bf(obuf + o, ov); ld8bf(rbuf + o, rv); ld8bf(kbuf + o, kv); ld8bf(vbuf + o, vv); ld8bf(gb + o, gv);
        float s = 0.f, bs = 0.f;
#pragma unroll
        for (int i = 0; i < 8; ++i) { s += ov[i]; bs += rv[i] * kv[i] * rk[i]; }
        s += __shfl_xor(s, 1); s += __shfl_xor(s, 2); s += __shfl_xor(s, 4); bs += __shfl_xor(bs, 1); bs += __shfl_xor(bs, 2); bs += __shfl_xor(bs, 4);
        const float mu = s * (1.f / 64.f); float q = 0.f;
#pragma unroll
        for (int i = 0; i < 8; ++i) { ov[i] -= mu; q += ov[i] * ov[i]; }
        q += __shfl_xor(q, 1); q += __shfl_xor(q, 2); q += __shfl_xor(q, 4);
        const float rstd = rsqrtf(q * (1.f / 64.f) + 64e-5f); float y[8];
#pragma unroll
        for (int i = 0; i < 8; ++i) y[i] = (ov[i] * rstd * gg[i] + gbb[i] + bs * vv[i]) * gv[i];
        st8bf(ymix + (size_t)r * 1024 + 512 + c, y);
    }
}

DEV void phase_sattn(const Params& p, LAS unsigned char* lds) {
    unsigned char* ws = p.ws; const int tid = fresh_tid(), lane = tid & 63, w = tid >> 6, kgrp = lane >> 4, dl = lane & 15;
    const bf16_t* qb = (const bf16_t*)(ws + O_Z + HALFROW); bf16_t* ob = (bf16_t*)(ws + O_YMIX);
    LAS float* pw = (LAS float*)lds;
    LAS float* wm = pw + 256;
    LAS float* wacc = wm + 16;
    for (int item = blockIdx.x; item < 512; item += gridDim.x) {
        const int si = item >> 2, h = item & 3; const float* Kp = p.in[I_CK] + (size_t)si * 262144 + h * 256; const float* Vp = p.in[I_CV] + (size_t)si * 262144 + h * 256;
        float q[16]; { float a[8], b[8]; ld8bf(qb + (size_t)(NTOK + si) * 1024 + h * 256 + dl * 16, a); ld8bf(qb + (size_t)(NTOK + si) * 1024 + h * 256 + dl * 16 + 8, b);
#pragma unroll
            for (int i = 0; i < 8; ++i) { q[i] = a[i]; q[8 + i] = b[i]; } }
        float sc[8];
#pragma unroll
        for (int j = 0; j < 8; ++j) {
            const float* kr = Kp + (size_t)(w * 32 + kgrp + 4 * j) * 1024 + dl * 16; float d = 0.f;
#pragma unroll
            for (int i = 0; i < 4; ++i) { const f32x4 k4 = *(const f32x4*)(kr + 4 * i); d += k4[0] * q[4 * i] + k4[1] * q[4 * i + 1] + k4[2] * q[4 * i + 2] + k4[3] * q[4 * i + 3]; }
            sc[j] = rowsum16(d);
        }
        float mx = sc[0];
#pragma unroll
        for (int j = 1; j < 8; ++j) mx = fmaxf(mx, sc[j]);
        mx = fmaxf(mx, __shfl_xor(mx, 16)); mx = fmaxf(mx, __shfl_xor(mx, 32));
        float sum = 0.f;
#pragma unroll
        for (int j = 0; j < 8; ++j) { sc[j] = __expf(sc[j] - mx); sum += sc[j]; }
        sum += __shfl_xor(sum, 16); sum += __shfl_xor(sum, 32);
        __syncthreads();
        if (dl == 0) {
#pragma unroll
            for (int j = 0; j < 8; ++j) pw[w * 32 + kgrp + 4 * j] = sc[j];
        }
        if (lane == 0) { wm[w] = mx; wm[8 + w] = sum; }
        asm volatile("s_waitcnt lgkmcnt(0)" ::: "memory"); __builtin_amdgcn_wave_barrier();
        f32x4 acc = (f32x4){0.f, 0.f, 0.f, 0.f};
#pragma unroll 16
        for (int j = 0; j < 32; ++j) { const f32x4 v4 = *(const f32x4*)(Vp + (size_t)(w * 32 + j) * 1024 + lane * 4); acc = acc + pw[w * 32 + j] * v4; }
        *(LAS f32x4*)(wacc + w * 256 + lane * 4) = acc;
        __syncthreads();
        if (tid < 256) {
            float M = wm[0];
#pragma unroll
            for (int j = 1; j < 8; ++j) M = fmaxf(M, wm[j]);
            float L = 0.f, o = 0.f;
#pragma unroll
            for (int j = 0; j < 8; ++j) { const float f = __expf(wm[j] - M); L += wm[8 + j] * f; o += wacc[j * 256 + tid] * f; }
            ob[(size_t)(NTOK + si) * 1024 + h * 256 + tid] = (bf16_t)(cvt_pk_bf16(o * __builtin_amdgcn_rcpf(L), 0.f) & 0xffffu);
        }
    }
}

DEV void phase_final(const Params& p) {
    unsigned char* ws = p.ws; const int tid = fresh_tid(), lane = tid & 63, gw = blockIdx.x * 8 + (tid >> 6), nw = gridDim.x * 8;
    const bf16_t* xb = (const bf16_t*)(ws + O_XB); const float* rs5 = (const float*)(ws + O_RS5);
    float g[16]; { float a[8], b[8]; ld8f(p.in[I_FIN] + lane * 8, a); ld8f(p.in[I_FIN] + 512 + lane * 8, b);
#pragma unroll
        for (int i = 0; i < 8; ++i) { g[i] = a[i]; g[8 + i] = b[i]; } }
#pragma unroll 2
    for (int r = gw; r < MV; r += nw) {
        const float rstd = rstd_of(rs5, r);
#pragma unroll
        for (int hf = 0; hf < 2; ++hf) { const int c = hf * 512 + lane * 8; float v[8]; ld8bf(xb + (size_t)r * 1024 + c, v);
#pragma unroll
            for (int i = 0; i < 8; ++i) v[i] = v[i] * rstd * g[hf * 8 + i];
            st8f(p.out + OUT_Y + (size_t)r * 1024 + c, v); }
    }
}

__global__ void __launch_bounds__(512, 2) mega(Params p) {
    extern __shared__ __attribute__((aligned(16))) unsigned char shm[];
    LAS unsigned char* lds = (LAS unsigned char*)shm;
    unsigned char* ws = p.ws;
    const int MT = MP / 256;
    {
        volatile LAS unsigned* st = (volatile LAS unsigned*)(lds + pg8::STAGE_BYTES);
        if (threadIdx.x < 2) st[threadIdx.x] = 0u;
        __syncthreads();
        if (threadIdx.x == 0) (void)xb_add(&((unsigned*)(ws + O_BAR))[XB_XCNT(xb_xcc_id())], 1u);
    }
#define XB_SYNC() do { XcdBarrier xb_; xb_.bar = (unsigned*)(p.ws + O_BAR); xb_.x = xb_xcc_id(); xb_.st = (volatile LAS unsigned*)(lds + pg8::STAGE_BYTES); xcd_barrier(xb_); } while (0)
    { phase_prep(p, lds); }
    XB_SYNC();
    { {
            { pg8::Gemm g{(const bf16_t*)(ws + O_XB), (const bf16_t*)(ws + O_WGU1), 1024, 1024, 1024}; pg8::GridSched S; S.init(MT, 22, 0, 1024, 1024);
              EpiSwiglu E{(const float*)(ws + O_RS1), (bf16_t*)(ws + O_H)}; pg8::gemm_phase(lds, g, S, E); }
            { pg8::Gemm g{(const bf16_t*)(ws + O_MNB), (const bf16_t*)(ws + O_WK), 1024, 1024, 1024}; pg8::GridSched S; S.init(8, 4, MT * 22, 1024, 1024);
              EpiK E{(const float*)(ws + O_RSTDM), p.out + OUT_MK, (bf16_t*)(ws + O_MKB)}; pg8::gemm_phase(lds, g, S, E); }
            { pg8::Gemm g{(const bf16_t*)(ws + O_WV), (const bf16_t*)(ws + O_MNB), 1024, 1024, 1024}; pg8::GridSched S; S.init(4, 8, MT * 22 + 32, 1024, 1024);
              EpiVT E{(const float*)(ws + O_RSTDM), p.out + OUT_MV, (bf16_t*)(ws + O_VT)}; pg8::gemm_phase(lds, g, S, E); }
        } }
    XB_SYNC();
    { { pg8::Gemm g{(const bf16_t*)(ws + O_H), (const bf16_t*)(ws + O_WD1), DFF, DFF, DFF}; pg8::GridSched S; S.init(64, 4, 0, DFF, DFF);
            EpiRes E{p.in[I_XP], (bf16_t*)(ws + O_XB), (float*)(ws + O_RS2), 0.5f}; pg8::gemm_phase(lds, g, S, E);
            SRes E2{p.in[I_XS], (bf16_t*)(ws + O_XB), (float*)(ws + O_RS2), 0.5f, NTOK};
            small_gemm<4>(lds, (const bf16_t*)(ws + O_H), DFF, (const bf16_t*)(ws + O_WD1), DFF, DFF, NTOK, 4, 16, E2); } }
    XB_SYNC();
    { { pg8::Gemm g{(const bf16_t*)(ws + O_XB), (const bf16_t*)(ws + O_WIN), 1024, 1024, 1024}; pg8::GridSched S; S.init(MT, 11, 0, 1024, 1024);
            EpiScale E{(const float*)(ws + O_RS2), (bf16_t*)(ws + O_Z), ZLD, ZLD}; pg8::gemm_phase(lds, g, S, E);
            SScale E2{(const float*)(ws + O_RS2), (bf16_t*)(ws + O_Z), ZLD, ZLD, 2816};
            small_gemm<2>(lds, (const bf16_t*)(ws + O_XB), 1024, (const bf16_t*)(ws + O_WIN) + (size_t)2816 * 1024, 1024, 1024, 0, MV / 32, 1, E2); } }
    XB_SYNC();
    { phase_mixprep(p); }
    XB_SYNC();
    { { pg8::Gemm g{(const bf16_t*)(ws + O_LIN), (const bf16_t*)(ws + O_WLORA), 384, 384, 256}; pg8::LoraSched S; S.init();
            EpiLora E{p.in[I_W0], p.in[I_A0], p.in[I_KA], (float*)(ws + O_DEC), (bf16_t*)(ws + O_H + HALFROW), (const bf16_t*)(ws + O_KK), (bf16_t*)(ws + O_KKA), (bf16_t*)(ws + O_H + 2 * HALFROW)};
            pg8::gemm_phase(lds, g, S, E); phase_chunkmix(p, lds); } }
    XB_SYNC();
    { phase_scan(p, lds); }
    XB_SYNC();
    { phase_finalize(p); }
    XB_SYNC();
    { { pg8::Gemm g{(const bf16_t*)(ws + O_YMIX), (const bf16_t*)(ws + O_WOUT), 1024, 1024, 1024}; pg8::GridSched S; S.init(64, 4, 0, 1024, 1024);
            EpiRes E{nullptr, (bf16_t*)(ws + O_XB), (float*)(ws + O_RS3), 1.f}; pg8::gemm_phase(lds, g, S, E);
            SRes E2{nullptr, (bf16_t*)(ws + O_XB), (float*)(ws + O_RS3), 1.f, 0};
            small_gemm<4>(lds, (const bf16_t*)(ws + O_YMIX), 1024, (const bf16_t*)(ws + O_WOUT), 1024, 1024, NTOK, 4, 16, E2); } }
    XB_SYNC();
    { { pg8::Gemm g{(const bf16_t*)(ws + O_XB), (const bf16_t*)(ws + O_WQ), 1024, 1024, 1024}; pg8::GridSched S; S.init(64, 4, 0, 1024, 1024);
            EpiScale E{(const float*)(ws + O_RS3), (bf16_t*)(ws + O_Z + HALFROW), 1024, 1024}; pg8::gemm_phase(lds, g, S, E);
            SScale E2{(const float*)(ws + O_RS3), (bf16_t*)(ws + O_Z + HALFROW), 1024, 1024, 0};
            small_gemm<4>(lds, (const bf16_t*)(ws + O_XB), 1024, (const bf16_t*)(ws + O_WQ), 1024, 1024, NTOK, 4, 16, E2); } }
    XB_SYNC();
    { {
            const bool sattn_first = ((blockIdx.x >> 3) & 1) != 0;
            if (sattn_first) phase_sattn(p, lds);
            { pg8::Gemm g{(const bf16_t*)(ws + O_Z + HALFROW), (const bf16_t*)(ws + O_MKB), 1024, 1024, 256}; pg8::AttnSched<0> S; S.init();
              EpiS E{(bf16_t*)(ws + O_Z), (float*)(ws + O_PSUM)}; pg8::gemm_phase(lds, g, S, E); }
            asm volatile("s_waitcnt vmcnt(0)" ::: "memory"); __syncthreads();
            if (threadIdx.x == 0) { __builtin_amdgcn_fence(__ATOMIC_ACQUIRE, "agent"); asm volatile("s_waitcnt vmcnt(0)" ::: "memory"); }
            __syncthreads();
            { pg8::Gemm g{(const bf16_t*)(ws + O_Z), (const bf16_t*)(ws + O_VT), 256, 2048, 256}; pg8::AttnSched<1> S; S.init();
              EpiO E{(const float*)(ws + O_PSUM), (bf16_t*)(ws + O_YMIX)}; pg8::gemm_phase(lds, g, S, E); }
            if (!sattn_first) phase_sattn(p, lds);
        } }
    XB_SYNC();
    { { pg8::Gemm g{(const bf16_t*)(ws + O_YMIX), (const bf16_t*)(ws + O_WO), 1024, 1024, 1024}; pg8::GridSched S; S.init(64, 4, 0, 1024, 1024);
            EpiRes E{nullptr, (bf16_t*)(ws + O_XB), (float*)(ws + O_RS4), 1.f}; pg8::gemm_phase(lds, g, S, E);
            SRes E2{nullptr, (bf16_t*)(ws + O_XB), (float*)(ws + O_RS4), 1.f, 0};
            small_gemm<4>(lds, (const bf16_t*)(ws + O_YMIX), 1024, (const bf16_t*)(ws + O_WO), 1024, 1024, NTOK, 4, 16, E2); } }
    XB_SYNC();
    { { pg8::Gemm g{(const bf16_t*)(ws + O_XB), (const bf16_t*)(ws + O_WGU2), 1024, 1024, 1024}; pg8::GridSched S; S.init(MT, 22, 0, 1024, 1024);
            EpiSwiglu E{(const float*)(ws + O_RS4), (bf16_t*)(ws + O_H)}; pg8::gemm_phase(lds, g, S, E); } }
    XB_SYNC();
    { { pg8::Gemm g{(const bf16_t*)(ws + O_H), (const bf16_t*)(ws + O_WD2), DFF, DFF, DFF}; pg8::GridSched S; S.init(64, 4, 0, DFF, DFF);
            EpiRes E{nullptr, (bf16_t*)(ws + O_XB), (float*)(ws + O_RS5), 0.5f}; pg8::gemm_phase(lds, g, S, E);
            SRes E2{nullptr, (bf16_t*)(ws + O_XB), (float*)(ws + O_RS5), 0.5f, 0};
            small_gemm<4>(lds, (const bf16_t*)(ws + O_H), DFF, (const bf16_t*)(ws + O_WD2), DFF, DFF, NTOK, 4, 16, E2); } }
    XB_SYNC();
    { phase_final(p); }
#undef XB_SYNC
}

constexpr size_t LDS_BYTES = pg8::STAGE_BYTES + 4096;

extern "C" void kernel_launch(void* const* d_in, const int* in_sizes, int n_in, void* d_out, int out_size, void* d_ws, size_t ws_size, hipStream_t stream) {
    static int grid_blocks = 0;
    if (!grid_blocks) {
        int dev = 0, cus = 0, per_cu = 0;
        hipGetDevice(&dev);
        hipDeviceGetAttribute(&cus, hipDeviceAttributeMultiprocessorCount, dev);
        hipFuncSetAttribute((const void*)mega, hipFuncAttributeMaxDynamicSharedMemorySize, (int)LDS_BYTES);
        hipOccupancyMaxActiveBlocksPerMultiprocessor(&per_cu, mega, 512, LDS_BYTES);
        if (per_cu < 1) { fprintf(stderr, "occupancy query returned %d\n", per_cu); per_cu = 1; }
        grid_blocks = cus * (per_cu > 1 ? 1 : per_cu);
        if (ws_size < WS_NEED) fprintf(stderr, "workspace too small: %zu < %zu\n", ws_size, (size_t)WS_NEED);
    }
    Params p{};
    for (int i = 0; i < 40; ++i) p.in[i] = (const float*)d_in[i];
    p.out = (float*)d_out; p.ws = (unsigned char*)d_ws;
    hipMemsetAsync((unsigned char*)d_ws + O_BAR, 0, XCD_BAR_WORDS * 4, stream);
    hipLaunchKernelGGL(mega, dim3(grid_blocks), dim3(512), LDS_BYTES, stream, p);
}
```

```cpp
#include <hip/hip_runtime.h>
#include <hip/hip_cooperative_groups.h>
#include <cstdio>
namespace cg = cooperative_groups;

#ifndef PHMASK
#define PHMASK 0xffff
#endif
#ifndef DUPMASK
#define DUPMASK 0
#endif
#ifndef ONE_LAUNCH
#define ONE_LAUNCH 1
#endif

#define LAS __attribute__((address_space(3)))
#define DEV __device__ __forceinline__
typedef unsigned short bf16_t;
typedef short bf16x8 __attribute__((ext_vector_type(8)));
typedef float f32x4 __attribute__((ext_vector_type(4)));
typedef unsigned u32x2 __attribute__((ext_vector_type(2)));
typedef unsigned u32x4 __attribute__((ext_vector_type(4)));

constexpr int DM = 1024, NTOK = 16384, NSMP = 128, MV = NTOK + NSMP, MP = 16640, SEQ = 2048;
constexpr int DFF = 2816, ZLD = 2848, BPROJ = 1824, NMEMR = 2048;
constexpr int NPH = 16;

constexpr size_t al256(size_t x) { return (x + 255) & ~(size_t)255; }
constexpr size_t O_WGU1 = 0;
constexpr size_t O_WD1 = O_WGU1 + al256((size_t)5632 * 1024 * 2);
constexpr size_t O_WIN = O_WD1 + al256((size_t)1024 * 2816 * 2);
constexpr size_t O_WOUT = O_WIN + al256((size_t)3072 * 1024 * 2);
constexpr size_t O_WQ = O_WOUT + 2097152, O_WK = O_WQ + 2097152, O_WV = O_WK + 2097152, O_WO = O_WV + 2097152;
constexpr size_t O_WGU2 = O_WO + 2097152;
constexpr size_t O_WD2 = O_WGU2 + al256((size_t)5632 * 1024 * 2);
constexpr size_t O_WLORA = O_WD2 + al256((size_t)1024 * 2816 * 2);
constexpr size_t O_MNB = O_WLORA + al256((size_t)1536 * 384 * 2);
constexpr size_t O_MKB = O_MNB + 4194304, O_VT = O_MKB + 4194304;
constexpr size_t O_RSTDM = O_VT + 4194304;
constexpr size_t RS_BYTES = (size_t)MP * 64;
constexpr size_t O_RS1 = O_RSTDM + 8192, O_RS2 = O_RS1 + RS_BYTES, O_RS3 = O_RS2 + RS_BYTES, O_RS4 = O_RS3 + RS_BYTES, O_RS5 = O_RS4 + RS_BYTES;
constexpr size_t O_PSUM = O_RS5 + RS_BYTES;
constexpr size_t HALFROW = (size_t)MP * 512 * 4;
constexpr size_t O_XB = O_PSUM + 1048576;
constexpr size_t O_XRES = O_XB + HALFROW;
constexpr size_t O_H = O_XRES + 2 * HALFROW;
constexpr size_t O_Z = O_H + al256((size_t)MP * DFF * 2);
constexpr size_t O_YMIX = O_Z + al256((size_t)MP * ZLD * 2);
constexpr size_t O_VAB = O_YMIX + HALFROW;
constexpr size_t O_LIN = O_VAB + HALFROW / 2;
constexpr size_t O_KK = O_LIN + al256((size_t)MP * 384 * 2);
constexpr size_t O_DEC = O_KK + HALFROW, O_KKA = O_DEC + HALFROW;
constexpr size_t O_BAR = O_KKA + HALFROW;
constexpr size_t WS_NEED = O_BAR + 16384;

constexpr size_t OUT_Y = 0, OUT_SP = (size_t)MV * 1024, OUT_SHP = OUT_SP + 262144, OUT_MK = OUT_SHP + 8 * 1824, OUT_MV = OUT_MK + 2097152,
                 OUT_SS = OUT_MV + 2097152, OUT_SHS = OUT_SS + 4194304, OUT_CV = OUT_SHS + 128 * 1824;

enum { I_XP = 0, I_XS, I_SRWKV, I_SSHIFT, I_CK, I_CV, I_MEM, I_LN1, I_G1, I_U1, I_D1, I_LNMIX, I_WIN, I_WOUT, I_SGUW, I_SGUB, I_SLNG, I_SLNB,
       I_MU, I_W0, I_W2, I_A0, I_A2, I_G2, I_KK, I_KA, I_RK, I_GNG, I_GNB, I_LNX, I_MEMN, I_XQ, I_XK, I_XV, I_XO, I_LN2, I_G2F, I_U2F, I_D2F, I_FIN };

struct Params { const float* in[40]; float* out; unsigned char* ws; };

DEV unsigned cvt_pk_bf16(float lo, float hi) { unsigned r; asm volatile("v_cvt_pk_bf16_f32 %0, %1, %2" : "=v"(r) : "v"(lo), "v"(hi)); return r; }
DEV float bf_lo(unsigned u) { return __uint_as_float(u << 16); }
DEV float bf_hi(unsigned u) { return __uint_as_float(u & 0xffff0000u); }
DEV f32x4 bf4(u32x2 u) { return (f32x4){__uint_as_float(u[0] << 16), __uint_as_float(u[0] & 0xffff0000u), __uint_as_float(u[1] << 16), __uint_as_float(u[1] & 0xffff0000u)}; }
DEV u32x2 pk4(f32x4 v) { u32x2 o; o[0] = cvt_pk_bf16(v[0], v[1]); o[1] = cvt_pk_bf16(v[2], v[3]); return o; }
DEV float bf2f(bf16_t b) { return __uint_as_float((unsigned)b << 16); }
DEV float sigmoidf_(float x) { return __builtin_amdgcn_rcpf(1.f + __expf(-x)); }
DEV float tanhf_(float y) { return 1.f - 2.f * __builtin_amdgcn_rcpf(1.f + __expf(2.f * y)); }
DEV float gelu_t(float x) { return 0.5f * x * (1.f + tanhf_(0.7978845608028654f * (x + 0.044715f * x * x * x))); }
DEV float wsum64(float v) {
#pragma unroll
    for (int o = 32; o >= 1; o >>= 1) v += __shfl_xor(v, o);
    return v;
}
DEV float wmax64(float v) {
#pragma unroll
    for (int o = 32; o >= 1; o >>= 1) v = fmaxf(v, __shfl_xor(v, o));
    return v;
}
template <int CTRL> DEV float dpp_f(float x) { return __builtin_bit_cast(float, __builtin_amdgcn_update_dpp(0, __builtin_bit_cast(int, x), CTRL, 0xf, 0xf, false)); }
DEV float rowsum16(float x) {
    x += dpp_f<0x128>(x); x += dpp_f<0x124>(x); x += dpp_f<0x122>(x); x += dpp_f<0x121>(x); return x;
}
DEV int fresh_tid() { int t = threadIdx.x; asm volatile("" : "+v"(t)); return t; }
DEV float rstd_of(const float* rs, int r) { const f32x4* q = (const f32x4*)(rs + (size_t)r * 16); const f32x4 p = (q[0] + q[1]) + (q[2] + q[3]); return rsqrtf(((p[0] + p[1]) + (p[2] + p[3])) * (1.f / 1024.f) + 1e-6f); }

#define XB_TMO      128
#define XB_XCNT(j)  (256  + 64 * (j))
#define XB_XSUB(j)  (1280 + 64 * (j))
#define XB_XGEN(j)  (2304 + 64 * (j))
#define XB_TOP      3328
#define XB_TOPGEN   3392
#define XCD_BAR_WORDS 3456
#define XB_SPIN_CAP (1u << 18)
DEV unsigned xb_ld(unsigned* p)              { return __hip_atomic_load(p, __ATOMIC_RELAXED, __HIP_MEMORY_SCOPE_AGENT); }
DEV unsigned xb_add(unsigned* p, unsigned v) { return __hip_atomic_fetch_add(p, v, __ATOMIC_RELAXED, __HIP_MEMORY_SCOPE_AGENT); }
DEV unsigned xb_xcc_id() { return (unsigned)__builtin_amdgcn_s_getreg((3 << 11) | 20) & 0xFu; }
#define XB_SPIN(cond, bar) do { unsigned _sp = 0; while (cond) { __builtin_amdgcn_s_sleep(1); \
    if ((++_sp & 255u) == 0u) { if (xb_ld(&(bar)[XB_TMO])) break; if (_sp > XB_SPIN_CAP) { atomicAdd(&(bar)[XB_TMO], 1u); break; } } } } while (0)
struct XcdBarrier { unsigned* bar; unsigned x; volatile LAS unsigned* st; };
DEV XcdBarrier xcd_barrier_post(unsigned* bar, volatile LAS unsigned* st) {
    XcdBarrier b; b.bar = bar; b.x = xb_xcc_id(); b.st = st;
    if (threadIdx.x == 0) (void)xb_add(&bar[XB_XCNT(b.x)], 1u);
    return b;
}
DEV void xcd_barrier_complete(unsigned* bar, unsigned x, unsigned& nloc, unsigned& nx) {
    const unsigned G = gridDim.x * gridDim.y * gridDim.z;
    unsigned sum, cnt, mine, sp = 0u;
    for (;;) {
        sum = 0u; cnt = 0u; mine = 0u;
#pragma unroll
        for (unsigned j = 0; j < 16; ++j) { const unsigned c = xb_ld(&bar[XB_XCNT(j)]); sum += c; cnt += (c > 0u) ? 1u : 0u; mine = (j == x) ? c : mine; }
        if (sum == G) break;
        __builtin_amdgcn_s_sleep(1);
        if ((++sp & 255u) == 0u) { if (xb_ld(&bar[XB_TMO])) break; if (sp > XB_SPIN_CAP) { atomicAdd(&bar[XB_TMO], 1u); break; } }
    }
    nloc = mine > 0u ? mine : 1u; nx = cnt > 0u ? cnt : 1u;
}
DEV void xcd_barrier(const XcdBarrier& b) {
    asm volatile("s_waitcnt vmcnt(0)" ::: "memory");
    __syncthreads();
    if (threadIdx.x == 0) {
        unsigned* bar = b.bar;
        __builtin_amdgcn_s_waitcnt(0);
        unsigned nloc = b.st[0], nx = b.st[1];
        if (nloc == 0u) { xcd_barrier_complete(bar, b.x, nloc, nx); b.st[0] = nloc; b.st[1] = nx; }
        const unsigned old = xb_add(&bar[XB_XSUB(b.x)], 1u);
        const unsigned gen = old / nloc;
        if (old + 1u == (gen + 1u) * nloc) {
            __builtin_amdgcn_fence(__ATOMIC_RELEASE, "agent");
            asm volatile("s_waitcnt vmcnt(0)" ::: "memory");
            const unsigned og = xb_add(&bar[XB_TOP], 1u);
            const unsigned tg = og / nx;
            if (og + 1u == (tg + 1u) * nx) xb_add(&bar[XB_TOPGEN], 1u);
            else XB_SPIN(xb_ld(&bar[XB_TOPGEN]) == tg, bar);
            __builtin_amdgcn_fence(__ATOMIC_ACQUIRE, "agent");
            xb_add(&bar[XB_XGEN(b.x)], 1u);
            asm volatile("s_waitcnt vmcnt(0)" ::: "memory");
        } else {
            XB_SPIN(xb_ld(&bar[XB_XGEN(b.x)]) == gen, bar);
            __builtin_amdgcn_fence(__ATOMIC_ACQUIRE, "agent");
            asm volatile("s_waitcnt vmcnt(0)" ::: "memory");
        }
    }
    __syncthreads();
}

namespace pg8 {
constexpr int BM = 256, BK = 64, HALF = 128, HTB = HALF * BK * 2, STAGE_BYTES = 8 * HTB, NXCD = 8, WGM = 8;
DEV int lds_byte(int r, int c) { const int st = (r >> 4) * 2 + (c >> 5), rr = r & 15, cc = c & 31, ob = rr * 64 + cc * 2; return st * 1024 + (ob ^ (((ob >> 9) & 1) << 5)); }
DEV void stage_rc(int b, int& R, int& C) { const int st = b / 1024, sb = b % 1024, swz = sb ^ (((sb >> 9) & 1) << 5); R = (st >> 1) * 16 + swz / 64; C = (st & 1) * 32 + (swz % 64) / 2; }

struct Unit { int pm, pn; long ao, bo; int x0, x1; };
struct Gemm { const bf16_t* A; const bf16_t* Bt; int lda, ldb, K; };

struct GridSched {
    int nM, nN, nwg, G, c; long ta, tb;
    DEV void init(int nM_, int nN_, int shift, int lda, int ldb) { nM = nM_; nN = nN_; nwg = nM * nN; G = (int)gridDim.x; c = ((int)blockIdx.x + G - (shift % G)) % G; ta = 256L * lda; tb = 256L * ldb; }
    DEV bool next(int i, Unit& u) const {
        const long L = (long)i * G + c; if (L >= nwg) return false;
        int wgid = (int)L; { const int q = nwg / NXCD, r = nwg % NXCD, xcd = wgid % NXCD, off = wgid / NXCD; wgid = (xcd < r ? xcd * (q + 1) : r * (q + 1) + (xcd - r) * q) + off; }
        const int nig = WGM * nN, gid = wgid / nig, fm = gid * WGM, gsz = (nM - fm) < WGM ? (nM - fm) : WGM;
        u.pm = fm + ((wgid % nig) % gsz); u.pn = (wgid % nig) / gsz; u.ao = u.pm * ta; u.bo = u.pn * tb; u.x0 = 0; u.x1 = 0; return true;
    }
};
struct LoraSched {
    int G, c;
    DEV void init() { G = (int)gridDim.x; c = (int)blockIdx.x; }
    DEV bool next(int i, Unit& u) const {
        const long L = (long)i * G + c; if (L >= 65 * 6) return false;
        const int pn = (int)L % 6, pm = (int)L / 6, off = (pn >= 4) ? 128 : 0;
        u.pm = pm; u.pn = pn; u.x0 = 0; u.x1 = 0; u.ao = (long)pm * 256 * 384 + off; u.bo = (long)pn * 256 * 384 + off; return true;
    }
};
template <int WHICH> struct AttnSched {
    int G, c;
    DEV void init() { G = (int)gridDim.x; c = (int)blockIdx.x; }
    DEV bool next(int i, Unit& u) const {
        const long L = (long)i * G + c; if (L >= 256) return false;
        const int xcd = (int)L & 7, idx = (int)L >> 3, bh = xcd * 4 + (idx >> 3), mt = idx & 7, b = bh >> 2, h = bh & 3;
        u.pm = mt; u.pn = 0; u.x0 = bh; u.x1 = mt;
        if (WHICH == 0) { u.ao = ((long)b * 2048 + mt * 256) * 1024 + h * 256; u.bo = ((long)b * 256) * 1024 + h * 256; }
        else { u.ao = ((long)bh * 2048 + mt * 256) * 256; u.bo = ((long)h * 256) * 2048 + b * 256; }
        return true;
    }
};

template <class Epi, class Sched>
DEV void gemm_phase(LAS unsigned char* lds, const Gemm g, const Sched& S, const Epi& E) {
    int tid_ = threadIdx.x; asm volatile("" : "+v"(tid_));
    const int tid = tid_, wid = __builtin_amdgcn_readfirstlane(tid >> 6), lane = tid & 63, wr = wid >> 2, wc = wid & 3, fr = lane & 15, fq = lane >> 4;
    int K = g.K, lda_ = g.lda, ldb_ = g.ldb; asm volatile("" : "+s"(K), "+s"(lda_), "+s"(ldb_)); const int nt = K / BK;
    unsigned voffA[2], voffB[2];
#pragma unroll
    for (int i = 0; i < 2; ++i) { int R, C; stage_rc(tid * 16 + i * 8192, R, C); voffA[i] = (unsigned)(R * lda_ + C) * 2u; voffB[i] = (unsigned)(R * ldb_ + C) * 2u; }
    const size_t kstep = (size_t)(BK * 2);
    const size_t hstepA = (size_t)HALF * lda_ * 2, hstepB = (size_t)HALF * ldb_ * 2;
    const unsigned ldsw = (unsigned)wid * 1024u;
    const int aoff = lds_byte(wr * 64 + fr, fq * 8), boff = lds_byte(wc * 32 + fr, fq * 8);
#define PG8_SA(b, h) (((b) * 2 + (h)) * HTB)
#define PG8_SB(b, h) ((4 + (b) * 2 + (h)) * HTB)
#define PG8_STAGE(bufoff, gbase, voff) do { _Pragma("unroll") for (int _i = 0; _i < 2; ++_i) \
        __builtin_amdgcn_global_load_lds((const unsigned*)((const char*)(gbase) + (voff)[_i]), (LAS unsigned*)(lds + (bufoff) + ldsw + _i * 8192), 16, 0, 0); } while (0)
#define PG8_LDA(dst, b, h) do { _Pragma("unroll") for (int m = 0; m < 4; ++m) _Pragma("unroll") for (int k = 0; k < 2; ++k) dst[m][k] = *(const LAS bf16x8*)(lds + PG8_SA(b, h) + aoff + m * 2048 + k * 1024); } while (0)
#define PG8_LDB(dst, b, h) do { _Pragma("unroll") for (int n = 0; n < 2; ++n) _Pragma("unroll") for (int k = 0; k < 2; ++k) dst[n][k] = *(const LAS bf16x8*)(lds + PG8_SB(b, h) + boff + n * 2048 + k * 1024); } while (0)
#define PG8_MMA(ai, bj, At, Bt) do { __builtin_amdgcn_s_setprio(1); _Pragma("unroll") for (int m = 0; m < 4; ++m) _Pragma("unroll") for (int n = 0; n < 2; ++n) _Pragma("unroll") for (int k = 0; k < 2; ++k) \
        acc[ai][bj][m][n] = __builtin_amdgcn_mfma_f32_16x16x32_bf16(Bt[n][k], At[m][k], acc[ai][bj][m][n], 0, 0, 0); __builtin_amdgcn_s_setprio(0); } while (0)
#define PG8_WAIT_V(n) asm volatile("s_waitcnt vmcnt(" #n ")" ::: "memory")
#define PG8_WAIT_L(n) asm volatile("s_waitcnt lgkmcnt(" #n ")" ::: "memory")
#define PG8_BAR __builtin_amdgcn_s_barrier()
#define PG8_SCHED __builtin_amdgcn_sched_barrier(0)
    Unit cur, nxt; int ui = 0;
    if (!S.next(0, cur)) return;
    f32x4 acc[2][2][4][2];
#pragma unroll
    for (int a = 0; a < 2; ++a)
#pragma unroll
        for (int b = 0; b < 2; ++b)
#pragma unroll
            for (int m = 0; m < 4; ++m)
#pragma unroll
                for (int n = 0; n < 2; ++n) acc[a][b][m][n] = (f32x4){0.f, 0.f, 0.f, 0.f};
    bf16x8 At[4][2], B0[2][2], B1[2][2];
    const char* cA = (const char*)g.A + (size_t)cur.ao * 2; const char* cB = (const char*)g.Bt + (size_t)cur.bo * 2;
    PG8_STAGE(PG8_SB(0, 0), cB, voffB); PG8_STAGE(PG8_SA(0, 0), cA, voffA); PG8_STAGE(PG8_SB(0, 1), cB + hstepB, voffB); PG8_STAGE(PG8_SA(0, 1), cA + hstepA, voffA);
    if (wr == 1) PG8_BAR;
    PG8_WAIT_V(4); PG8_BAR;
    PG8_STAGE(PG8_SB(1, 0), cB + kstep, voffB); PG8_STAGE(PG8_SA(1, 0), cA + kstep, voffA); PG8_STAGE(PG8_SB(1, 1), cB + hstepB + kstep, voffB);
    PG8_WAIT_V(6); PG8_BAR;
    for (;;) {
        const bool has_next = S.next(ui + 1, nxt);
        const char* nA = has_next ? (const char*)g.A + (size_t)nxt.ao * 2 : cA; const char* nB = has_next ? (const char*)g.Bt + (size_t)nxt.bo * 2 : cB;
#pragma unroll 1
        for (int t = 0; t < nt; t += 2) {
            const bool last = (t == nt - 2);
            const char* a1 = cA + (size_t)(t + 1) * kstep;
            const char* a2 = last ? nA : cA + (size_t)(t + 2) * kstep; const char* b2 = last ? nB : cB + (size_t)(t + 2) * kstep;
            const char* a3 = a2 + kstep; const char* b3 = b2 + kstep;
            PG8_LDB(B0, 0, 0); PG8_SCHED; PG8_LDA(At, 0, 0); PG8_STAGE(PG8_SA(1, 1), a1 + hstepA, voffA);
            PG8_WAIT_L(8); PG8_BAR; PG8_WAIT_L(0); PG8_MMA(0, 0, At, B0); PG8_BAR; PG8_SCHED;
            PG8_LDB(B1, 0, 1); PG8_STAGE(PG8_SB(0, 0), b2, voffB);
            PG8_BAR; PG8_WAIT_L(0); PG8_MMA(0, 1, At, B1); PG8_BAR;
            PG8_LDA(At, 0, 1); PG8_STAGE(PG8_SA(0, 0), a2, voffA);
            PG8_BAR; PG8_WAIT_L(0); PG8_MMA(1, 0, At, B0); PG8_BAR; PG8_SCHED;
            PG8_STAGE(PG8_SB(0, 1), b2 + hstepB, voffB);
            PG8_WAIT_V(6); PG8_BAR; PG8_MMA(1, 1, At, B1); PG8_BAR;
            PG8_LDB(B0, 1, 0); PG8_SCHED; PG8_LDA(At, 1, 0); PG8_STAGE(PG8_SA(0, 1), a2 + hstepA, voffA);
            PG8_WAIT_L(8); PG8_BAR; PG8_WAIT_L(0); PG8_MMA(0, 0, At, B0); PG8_BAR; PG8_SCHED;
            PG8_LDB(B1, 1, 1); PG8_STAGE(PG8_SB(1, 0), b3, voffB);
            PG8_BAR; PG8_WAIT_L(0); PG8_MMA(0, 1, At, B1); PG8_BAR;
            PG8_LDA(At, 1, 1); PG8_STAGE(PG8_SA(1, 0), a3, voffA);
            PG8_BAR; PG8_WAIT_L(0); PG8_MMA(1, 0, At, B0); PG8_BAR; PG8_SCHED;
            PG8_STAGE(PG8_SB(1, 1), b3 + hstepB, voffB);
            PG8_WAIT_V(6); PG8_BAR; PG8_MMA(1, 1, At, B1); PG8_BAR;
        }
        E(acc, cur, wr, wc, fr, fq);
        if (!has_next) break;
#pragma unroll
        for (int a = 0; a < 2; ++a)
#pragma unroll
            for (int b = 0; b < 2; ++b)
#pragma unroll
                for (int m = 0; m < 4; ++m)
#pragma unroll
                    for (int n = 0; n < 2; ++n) acc[a][b][m][n] = (f32x4){0.f, 0.f, 0.f, 0.f};
        cur = nxt; cA = nA; cB = nB; ++ui;
    }
    PG8_WAIT_V(0);
    if (wr == 0) PG8_BAR;
    PG8_BAR;
#undef PG8_SA
#undef PG8_SB
#undef PG8_STAGE
#undef PG8_LDA
#undef PG8_LDB
#undef PG8_MMA
#undef PG8_WAIT_V
#undef PG8_WAIT_L
#undef PG8_BAR
#undef PG8_SCHED
}
}
using pg8::Unit;

typedef const f32x4 (&AccRef)[2][2][4][2];

struct EpiSwiglu {
    const float* rs; bf16_t* H;
    DEV void operator()(AccRef acc, const Unit& u, int wr, int wc, int fr, int fq) const {
        const int row0 = u.pm * 256 + wr * 64 + fr, hc0 = u.pn * 128 + wc * 16 + 4 * fq;
#pragma unroll
        for (int ai = 0; ai < 2; ++ai)
#pragma unroll
            for (int m = 0; m < 4; ++m) {
                const int r = row0 + ai * 128 + m * 16; const float rstd = rstd_of(rs, r);
#pragma unroll
                for (int bj = 0; bj < 2; ++bj) {
                    float hv[4];
#pragma unroll
                    for (int i = 0; i < 4; ++i) { const float gt = acc[ai][bj][m][0][i] * rstd, up = acc[ai][bj][m][1][i] * rstd; hv[i] = gt * sigmoidf_(gt) * up; }
                    u32x2 o; o[0] = cvt_pk_bf16(hv[0], hv[1]); o[1] = cvt_pk_bf16(hv[2], hv[3]);
                    *(u32x2*)(H + (size_t)r * DFF + hc0 + bj * 64) = o;
                }
            }
    }
};

struct EpiRes {
    const float* res; bf16_t* xb; float* rs_out; float alpha;
    DEV void operator()(AccRef acc, const Unit& u, int wr, int wc, int fr, int fq) const {
        const int row0 = u.pm * 256 + wr * 64 + fr, col0 = u.pn * 256 + wc * 32 + 4 * fq;
#pragma unroll
        for (int ai = 0; ai < 2; ++ai)
#pragma unroll
            for (int mh = 0; mh < 2; ++mh) {
                f32x4 x[2][2][2];
#pragma unroll
                for (int m2 = 0; m2 < 2; ++m2)
#pragma unroll
                    for (int bj = 0; bj < 2; ++bj)
#pragma unroll
                        for (int n = 0; n < 2; ++n) { const size_t o = (size_t)(row0 + ai * 128 + (mh * 2 + m2) * 16) * 1024 + col0 + bj * 128 + n * 16;
                            x[m2][bj][n] = res ? *(const f32x4*)(res + o) : bf4(*(const u32x2*)(xb + o)); }
#pragma unroll
                for (int m2 = 0; m2 < 2; ++m2) {
                    const int m = mh * 2 + m2, r = row0 + ai * 128 + m * 16; float s = 0.f;
#pragma unroll
                    for (int bj = 0; bj < 2; ++bj)
#pragma unroll
                        for (int n = 0; n < 2; ++n) {
                            const int c = col0 + bj * 128 + n * 16; const f32x4 v = x[m2][bj][n] + alpha * acc[ai][bj][m][n];
                            *(u32x2*)(xb + (size_t)r * 1024 + c) = pk4(v);
                            s += v[0] * v[0] + v[1] * v[1] + v[2] * v[2] + v[3] * v[3];
                        }
                    s += __shfl_xor(s, 16); s += __shfl_xor(s, 32);
                    if (fq == 0) rs_out[(size_t)r * 16 + u.pn * 4 + wc] = s;
                }
            }
    }
};

struct EpiScale {
    const float* rs; bf16_t* O; int ldo, ncols;
    DEV void operator()(AccRef acc, const Unit& u, int wr, int wc, int fr, int fq) const {
        const int row0 = u.pm * 256 + wr * 64 + fr, col0 = u.pn * 256 + wc * 32 + 4 * fq;
#pragma unroll
        for (int ai = 0; ai < 2; ++ai)
#pragma unroll
            for (int m = 0; m < 4; ++m) {
                const int r = row0 + ai * 128 + m * 16; const float rstd = rstd_of(rs, r);
#pragma unroll
                for (int bj = 0; bj < 2; ++bj)
#pragma unroll
                    for (int n = 0; n < 2; ++n) {
                        const int c = col0 + bj * 128 + n * 16;
                        if (c < ncols) { const f32x4 v = acc[ai][bj][m][n] * rstd; u32x2 o; o[0] = cvt_pk_bf16(v[0], v[1]); o[1] = cvt_pk_bf16(v[2], v[3]); *(u32x2*)(O + (size_t)r * ldo + c) = o; }
                    }
            }
    }
};

struct EpiLora {
    const float* w0; const float* a0; const float* k_a; float* dec; bf16_t* kbuf; const bf16_t* kkbuf; bf16_t* kka; bf16_t* gb;
    template <int REGION> DEV void run(AccRef acc, const Unit& u, int wr, int wc, int fr, int fq) const {
        const int row0 = u.pm * 256 + wr * 64 + fr, cb = (u.pn & 1) * 256 + wc * 32 + 4 * fq;
        f32x4 pb0[2][2], pka[2][2];
#pragma unroll
        for (int bj = 0; bj < 2; ++bj)
#pragma unroll
            for (int n = 0; n < 2; ++n) { const int cc = cb + bj * 128 + n * 16; pb0[bj][n] = REGION == 0 ? *(const f32x4*)(w0 + cc) : (REGION == 1 ? *(const f32x4*)(a0 + cc) : (f32x4){0.f, 0.f, 0.f, 0.f}); pka[bj][n] = REGION == 1 ? *(const f32x4*)(k_a + cc) : (f32x4){0.f, 0.f, 0.f, 0.f}; }
#pragma unroll
        for (int ai = 0; ai < 2; ++ai)
#pragma unroll
            for (int m = 0; m < 4; ++m) {
                const int r = row0 + ai * 128 + m * 16;
                {
#pragma unroll
                    for (int bj = 0; bj < 2; ++bj)
#pragma unroll
                        for (int n = 0; n < 2; ++n) {
                            const int cc = cb + bj * 128 + n * 16; const f32x4 a = acc[ai][bj][m][n]; const size_t o = (size_t)r * 512 + cc;
                            if (REGION == 0) {
                                const f32x4 b0 = pb0[bj][n]; f32x4 d;
#pragma unroll
                                for (int i = 0; i < 4; ++i) d[i] = __expf(-0.60653066f * sigmoidf_(b0[i] + a[i]));
                                *(f32x4*)(dec + o) = d;
                            } else if (REGION == 1) {
                                const f32x4 b0 = pb0[bj][n], ka = pka[bj][n], kv = bf4(*(const u32x2*)(kbuf + o)), kkv = bf4(*(const u32x2*)(kkbuf + o)); f32x4 kn, kkan;
#pragma unroll
                                for (int i = 0; i < 4; ++i) { const float av = sigmoidf_(b0[i] + a[i]); kn[i] = kv[i] * (1.f + (av - 1.f) * ka[i]); kkan[i] = kkv[i] * av; }
                                *(u32x2*)(kbuf + o) = pk4(kn); *(u32x2*)(kka + o) = pk4(kkan);
                            } else {
                                u32x2 ov; ov[0] = cvt_pk_bf16(a[0], a[1]); ov[1] = cvt_pk_bf16(a[2], a[3]); *(u32x2*)(gb + o) = ov;
                            }
                        }
                }
            }
    }
    DEV void operator()(AccRef acc, const Unit& u, int wr, int wc, int fr, int fq) const {
        const int region = u.pn >> 1;
        if (region == 0) run<0>(acc, u, wr, wc, fr, fq); else if (region == 1) run<1>(acc, u, wr, wc, fr, fq); else run<2>(acc, u, wr, wc, fr, fq);
    }
};

struct EpiK {
    const float* rstdm; float* outk; bf16_t* mkb;
    DEV void operator()(AccRef acc, const Unit& u, int wr, int wc, int fr, int fq) const {
        const int row0 = u.pm * 256 + wr * 64 + fr, col0 = u.pn * 256 + wc * 32 + 4 * fq;
#pragma unroll
        for (int ai = 0; ai < 2; ++ai)
#pragma unroll
            for (int m = 0; m < 4; ++m) {
                const int r = row0 + ai * 128 + m * 16; const float rstd = rstdm[r];
#pragma unroll
                for (int bj = 0; bj < 2; ++bj)
#pragma unroll
                    for (int n = 0; n < 2; ++n) {
                        const int c = col0 + bj * 128 + n * 16; const f32x4 v = acc[ai][bj][m][n] * rstd;
                        *(f32x4*)(outk + (size_t)r * 1024 + c) = v;
                        u32x2 o; o[0] = cvt_pk_bf16(v[0], v[1]); o[1] = cvt_pk_bf16(v[2], v[3]); *(u32x2*)(mkb + (size_t)r * 1024 + c) = o;
                    }
            }
    }
};
struct EpiVT {
    const float* rstdm; float* outv; bf16_t* vt;
    DEV void operator()(AccRef acc, const Unit& u, int wr, int wc, int fr, int fq) const {
        const int row0 = u.pm * 256 + wr * 64 + fr, col0 = u.pn * 256 + wc * 32 + 4 * fq;
#pragma unroll
        for (int bj = 0; bj < 2; ++bj)
#pragma unroll
            for (int n = 0; n < 2; ++n) {
                const int c = col0 + bj * 128 + n * 16; const f32x4 rsd = *(const f32x4*)(rstdm + c);
#pragma unroll
                for (int ai = 0; ai < 2; ++ai)
#pragma unroll
                    for (int m = 0; m < 4; ++m) {
                        const int r = row0 + ai * 128 + m * 16; const f32x4 v = acc[ai][bj][m][n] * rsd;
                        u32x2 o; o[0] = cvt_pk_bf16(v[0], v[1]); o[1] = cvt_pk_bf16(v[2], v[3]); *(u32x2*)(vt + (size_t)r * 2048 + c) = o;
#pragma unroll
                        for (int i = 0; i < 4; ++i) outv[(size_t)(c + i) * 1024 + r] = v[i];
                    }
            }
    }
};
struct EpiS {
    bf16_t* P; float* psum;
    DEV void operator()(AccRef acc, const Unit& u, int wr, int wc, int fr, int fq) const {
        const size_t prow0 = (size_t)u.x0 * 2048 + u.x1 * 256;
#pragma unroll
        for (int ai = 0; ai < 2; ++ai)
#pragma unroll
            for (int m = 0; m < 4; ++m) {
                const int rl = ai * 128 + wr * 64 + m * 16 + fr; float s = 0.f;
#pragma unroll
                for (int bj = 0; bj < 2; ++bj)
#pragma unroll
                    for (int n = 0; n < 2; ++n) {
                        const f32x4 a = acc[ai][bj][m][n]; u32x2 o;
                        o[0] = cvt_pk_bf16(__expf(a[0]), __expf(a[1])); o[1] = cvt_pk_bf16(__expf(a[2]), __expf(a[3]));
                        s += bf_lo(o[0]) + bf_hi(o[0]) + bf_lo(o[1]) + bf_hi(o[1]);
                        *(u32x2*)(P + (prow0 + rl) * 256 + bj * 128 + wc * 32 + n * 16 + 4 * fq) = o;
                    }
                s += __shfl_xor(s, 16); s += __shfl_xor(s, 32);
                if (fq == 0) psum[(prow0 + rl) * 4 + wc] = s;
            }
    }
};
struct EpiO {
    const float* psum; bf16_t* O;
    DEV void operator()(AccRef acc, const Unit& u, int wr, int wc, int fr, int fq) const {
        const int bh = u.x0, b = bh >> 2, h = bh & 3; const size_t prow0 = (size_t)bh * 2048 + u.x1 * 256; const size_t m0 = (size_t)b * 2048 + u.x1 * 256;
#pragma unroll
        for (int ai = 0; ai < 2; ++ai)
#pragma unroll
            for (int m = 0; m < 4; ++m) {
                const int rl = ai * 128 + wr * 64 + m * 16 + fr; const f32x4 p = *(const f32x4*)(psum + (prow0 + rl) * 4); const float inv = __builtin_amdgcn_rcpf(p[0] + p[1] + p[2] + p[3]);
#pragma unroll
                for (int bj = 0; bj < 2; ++bj)
#pragma unroll
                    for (int n = 0; n < 2; ++n) {
                        const f32x4 v = acc[ai][bj][m][n] * inv; u32x2 o; o[0] = cvt_pk_bf16(v[0], v[1]); o[1] = cvt_pk_bf16(v[2], v[3]);
                        *(u32x2*)(O + (m0 + rl) * 1024 + h * 256 + bj * 128 + wc * 32 + n * 16 + 4 * fq) = o;
                    }
            }
    }
};

struct SRes {
    const float* res; bf16_t* xb; float* rs_out; float alpha; int res_row0;
    DEV void operator()(int r, int c, f32x4 a, int slab, int l15) const {
        const f32x4 x0 = res ? *(const f32x4*)(res + (size_t)(r - res_row0) * 1024 + c) : bf4(*(const u32x2*)(xb + (size_t)r * 1024 + c));
        const f32x4 x = x0 + alpha * a;
        *(u32x2*)(xb + (size_t)r * 1024 + c) = pk4(x);
        const float s = rowsum16(x[0] * x[0] + x[1] * x[1] + x[2] * x[2] + x[3] * x[3]);
        if (l15 == 0) rs_out[(size_t)r * 16 + slab] = s;
    }
};
struct SScale {
    const float* rs; bf16_t* O; int ldo, ncols, col_off;
    DEV void operator()(int r, int c, f32x4 a, int, int) const {
        const int cc = c + col_off;
        if (cc < ncols) { const f32x4 v = a * rstd_of(rs, r); u32x2 o; o[0] = cvt_pk_bf16(v[0], v[1]); o[1] = cvt_pk_bf16(v[2], v[3]); *(u32x2*)(O + (size_t)r * ldo + cc) = o; }
    }
};
template <int NB, class Epi>
DEV void small_gemm(LAS unsigned char* lds, const bf16_t* A, int lda, const bf16_t* Bt, int ldb, int K, int row_base, int nrg, int nslab, const Epi& E) {
    const int tid = fresh_tid(), lane = tid & 63, w = tid >> 6, l15 = lane & 15, kg = lane >> 4;
    LAS float* red = (LAS float*)lds;
    const int kw = K >> 3;
    for (int item = blockIdx.x; item < nrg * nslab; item += gridDim.x) {
        const int rgi = item % nrg, slab = item / nrg, r0 = row_base + rgi * 32, c0 = slab * 64;
        f32x4 acc[2][4];
#pragma unroll
        for (int rb = 0; rb < 2; ++rb)
#pragma unroll
            for (int n = 0; n < 4; ++n) acc[rb][n] = (f32x4){0.f, 0.f, 0.f, 0.f};
        const bf16_t* ap = A + (size_t)(r0 + l15) * lda + w * kw + kg * 8;
        const bf16_t* bp = Bt + (size_t)(c0 + l15) * ldb + w * kw + kg * 8;
#pragma unroll 4
        for (int k = 0; k < kw; k += 32) {
            const bf16x8 a0 = *(const bf16x8*)(ap + k), a1 = *(const bf16x8*)(ap + (size_t)16 * lda + k);
            bf16x8 b[NB];
#pragma unroll
            for (int n = 0; n < NB; ++n) b[n] = *(const bf16x8*)(bp + (size_t)(n * 16) * ldb + k);
#pragma unroll
            for (int n = 0; n < NB; ++n) { acc[0][n] = __builtin_amdgcn_mfma_f32_16x16x32_bf16(b[n], a0, acc[0][n], 0, 0, 0); acc[1][n] = __builtin_amdgcn_mfma_f32_16x16x32_bf16(b[n], a1, acc[1][n], 0, 0, 0); }
        }
        __syncthreads();
#pragma unroll
        for (int rb = 0; rb < 2; ++rb)
#pragma unroll
            for (int n = 0; n < 4; ++n) *(LAS f32x4*)(red + ((w * 32 + rb * 16 + l15) * 64 + n * 16 + 4 * kg)) = acc[rb][n];
        __syncthreads();
        const int row = tid >> 4, c4 = (tid & 15) * 4; f32x4 sum = (f32x4){0.f, 0.f, 0.f, 0.f};
#pragma unroll
        for (int ww = 0; ww < 8; ++ww) sum = sum + *(const LAS f32x4*)(red + ((ww * 32 + row) * 64 + c4));
        E(r0 + row, c0 + c4, sum, slab, tid & 15);
    }
}

DEV void ld8bf(const bf16_t* p, float (&v)[8]) { const u32x4 u = *(const u32x4*)p;
#pragma unroll
    for (int i = 0; i < 4; ++i) { v[2 * i] = bf_lo(u[i]); v[2 * i + 1] = bf_hi(u[i]); } }
DEV void ld8f(const float* p, float (&v)[8]) { const f32x4 a = *(const f32x4*)p, b = *(const f32x4*)(p + 4);
#pragma unroll
    for (int i = 0; i < 4; ++i) { v[i] = a[i]; v[4 + i] = b[i]; } }
DEV void st8f(float* p, const float (&v)[8]) { *(f32x4*)p = (f32x4){v[0], v[1], v[2], v[3]}; *(f32x4*)(p + 4) = (f32x4){v[4], v[5], v[6], v[7]}; }
DEV void st8bf(bf16_t* p, const float (&v)[8]) { u32x4 o; o[0] = cvt_pk_bf16(v[0], v[1]); o[1] = cvt_pk_bf16(v[2], v[3]); o[2] = cvt_pk_bf16(v[4], v[5]); o[3] = cvt_pk_bf16(v[6], v[7]); *(u32x4*)p = o; }

DEV void tr_job(const float* __restrict__ src, int Ks, int Ns, int Nd, bf16_t* __restrict__ dst, int mode, const float* __restrict__ gain, float scale, LAS float* tile) {
    const int nk = Ks / 64, nn = Nd / 64, ntile = nk * nn, ldd = Ks; const int t = fresh_tid();
    f32x4 v0, v1;
    auto gl = [&](int ti) { const int tk = ti % nk, tn = ti / nk;
        { const int id = t, k = id >> 4, gn = tn * 64 + (id & 15) * 4; v0 = (gn < Ns) ? *(const f32x4*)(src + (size_t)(tk * 64 + k) * Ns + gn) : (f32x4){0.f, 0.f, 0.f, 0.f}; if (gain) v0 = v0 * (gain[tk * 64 + k] * scale); }
        { const int id = t + 512, k = id >> 4, gn = tn * 64 + (id & 15) * 4; v1 = (gn < Ns) ? *(const f32x4*)(src + (size_t)(tk * 64 + k) * Ns + gn) : (f32x4){0.f, 0.f, 0.f, 0.f}; if (gain) v1 = v1 * (gain[tk * 64 + k] * scale); } };
    int ti = blockIdx.x;
    if (ti < ntile) gl(ti);
    for (; ti < ntile; ti += gridDim.x) {
        const int tk = ti % nk, tn = ti / nk;
        *(LAS f32x4*)(tile + (t >> 4) * 68 + (t & 15) * 4) = v0; *(LAS f32x4*)(tile + ((t + 512) >> 4) * 68 + (t & 15) * 4) = v1;
        if (ti + (int)gridDim.x < ntile) gl(ti + gridDim.x);
        __syncthreads();
        { const int n = t & 63, k8 = (t >> 6) * 8, gn = tn * 64 + n; float v[8];
#pragma unroll
          for (int j = 0; j < 8; ++j) v[j] = tile[(k8 + j) * 68 + n];
          const int drow = mode == 0 ? gn : ((gn >> 4) * 32 + (mode == 2 ? 16 : 0) + (gn & 15));
          st8bf(dst + (size_t)drow * ldd + tk * 64 + k8, v); }
        __syncthreads();
    }
}

DEV void phase_prep(const Params& p, LAS unsigned char* lds) {
    unsigned char* ws = p.ws; LAS float* tile = (LAS float*)lds;
    const int tid = fresh_tid(), lane = tid & 63, gw = blockIdx.x * 8 + (tid >> 6), nw = gridDim.x * 8;
    bf16_t* xb = (bf16_t*)(ws + O_XB); float* rs1 = (float*)(ws + O_RS1);
#pragma unroll 2
    for (int r = gw; r < MP; r += nw) {
        float ss = 0.f;
        if (r < MV) {
            const float* xr = r < NTOK ? p.in[I_XP] + (size_t)r * 1024 : p.in[I_XS] + (size_t)(r - NTOK) * 1024;
#pragma unroll
            for (int i = 0; i < 4; ++i) { const int c = lane * 4 + 256 * i; const f32x4 v = *(const f32x4*)(xr + c); ss += v[0] * v[0] + v[1] * v[1] + v[2] * v[2] + v[3] * v[3];
                u32x2 o; o[0] = cvt_pk_bf16(v[0], v[1]); o[1] = cvt_pk_bf16(v[2], v[3]); *(u32x2*)(xb + (size_t)r * 1024 + c) = o; }
            ss = wsum64(ss);
        } else {
#pragma unroll
            for (int i = 0; i < 4; ++i) { u32x2 o; o[0] = 0; o[1] = 0; *(u32x2*)(xb + (size_t)r * 1024 + lane * 4 + 256 * i) = o; }
        }
        if (lane < 16) { rs1[(size_t)r * 16 + lane] = lane == 0 ? ss : 0.f;
            if (r >= MV) { ((float*)(ws + O_RS2))[(size_t)r * 16 + lane] = 0.f; ((float*)(ws + O_RS3))[(size_t)r * 16 + lane] = 0.f; ((float*)(ws + O_RS4))[(size_t)r * 16 + lane] = 0.f; ((float*)(ws + O_RS5))[(size_t)r * 16 + lane] = 0.f; } }
    }
    bf16_t* mnb = (bf16_t*)(ws + O_MNB); float* rstdm = (float*)(ws + O_RSTDM);
    for (int r = gw; r < NMEMR; r += nw) {
        const float* xr = p.in[I_MEM] + (size_t)r * 1024; float ss = 0.f;
#pragma unroll
        for (int i = 0; i < 4; ++i) { const int c = lane * 4 + 256 * i; const f32x4 v = *(const f32x4*)(xr + c); ss += v[0] * v[0] + v[1] * v[1] + v[2] * v[2] + v[3] * v[3];
            u32x2 o; o[0] = cvt_pk_bf16(v[0], v[1]); o[1] = cvt_pk_bf16(v[2], v[3]); *(u32x2*)(mnb + (size_t)r * 1024 + c) = o; }
        ss = wsum64(ss);
        if (lane == 0) rstdm[r] = rsqrtf(ss * (1.f / 1024.f) + 1e-6f);
    }
    { bf16_t* wl = (bf16_t*)(ws + O_WLORA);
      for (int i = blockIdx.x * 512 + tid; i < 1536 * 384; i += gridDim.x * 512) {
          const int n = i / 384, k = i % 384, reg = n >> 9, c = n & 511; float v = 0.f;
          if (reg == 0 && k < 64) v = p.in[I_W2][k * 512 + c];
          else if (reg == 1 && k >= 64 && k < 128) v = p.in[I_A2][(k - 64) * 512 + c];
          else if (reg == 2 && k >= 128 && k < 288) v = p.in[I_G2][(k - 128) * 512 + c];
          wl[i] = (bf16_t)(cvt_pk_bf16(v, 0.f) & 0xffffu);
      } }
    tr_job(p.in[I_G1], 1024, 2816, 2816, (bf16_t*)(ws + O_WGU1), 1, p.in[I_LN1], 1.f, tile);
    tr_job(p.in[I_U1], 1024, 2816, 2816, (bf16_t*)(ws + O_WGU1), 2, p.in[I_LN1], 1.f, tile);
    tr_job(p.in[I_XK], 1024, 1024, 1024, (bf16_t*)(ws + O_WK), 0, p.in[I_MEMN], 1.f, tile);
    tr_job(p.in[I_XV], 1024, 1024, 1024, (bf16_t*)(ws + O_WV), 0, p.in[I_MEMN], 1.f, tile);
    tr_job(p.in[I_D1], 2816, 1024, 1024, (bf16_t*)(ws + O_WD1), 0, nullptr, 1.f, tile);
    tr_job(p.in[I_WIN], 1024, 2848, 3072, (bf16_t*)(ws + O_WIN), 0, p.in[I_LNMIX], 1.f, tile);
    tr_job(p.in[I_WOUT], 1024, 1024, 1024, (bf16_t*)(ws + O_WOUT), 0, nullptr, 1.f, tile);
    tr_job(p.in[I_XQ], 1024, 1024, 1024, (bf16_t*)(ws + O_WQ), 0, p.in[I_LNX], 0.0625f, tile);
    tr_job(p.in[I_XO], 1024, 1024, 1024, (bf16_t*)(ws + O_WO), 0, nullptr, 1.f, tile);
    tr_job(p.in[I_G2F], 1024, 2816, 2816, (bf16_t*)(ws + O_WGU2), 1, p.in[I_LN2], 1.f, tile);
    tr_job(p.in[I_U2F], 1024, 2816, 2816, (bf16_t*)(ws + O_WGU2), 2, p.in[I_LN2], 1.f, tile);
    tr_job(p.in[I_D2F], 2816, 1024, 1024, (bf16_t*)(ws + O_WD2), 0, nullptr, 1.f, tile);
}

DEV void phase_mixprep(const Params& p) {
    unsigned char* ws = p.ws; const int tid = fresh_tid(), lane = tid & 63, gw = blockIdx.x * 8 + (tid >> 6), nw = gridDim.x * 8;
    const bf16_t* z = (const bf16_t*)(ws + O_Z); bf16_t* vab = (bf16_t*)(ws + O_VAB); bf16_t* lin = (bf16_t*)(ws + O_LIN); bf16_t* ymix = (bf16_t*)(ws + O_YMIX);
    bf16_t* rbuf = (bf16_t*)(ws + O_H); bf16_t* kbuf = (bf16_t*)(ws + O_H + HALFROW); bf16_t* vbuf = (bf16_t*)(ws + O_XRES); bf16_t* kkbuf = (bf16_t*)(ws + O_KK);
    float lng[8], lnb[8], mu4[4][8], kkw[8];
    ld8f(p.in[I_SLNG] + lane * 8, lng); ld8f(p.in[I_SLNB] + lane * 8, lnb); ld8f(p.in[I_KK] + lane * 8, kkw);
#pragma unroll
    for (int it = 0; it < 4; ++it) { const int ch = lane + 64 * it; if (ch < 228) ld8f(p.in[I_MU] + ch * 8, mu4[it]); else {
#pragma unroll
        for (int i = 0; i < 8; ++i) mu4[it][i] = 0.f; } }
#pragma unroll 2
    for (int r = gw; r < MV; r += nw) {
        const bf16_t* zr = z + (size_t)r * ZLD; const bool smp = r >= NTOK; const int t = r & (SEQ - 1), si = r - NTOK;
        {
            const int c = lane * 8; float v[8]; ld8bf(zr + 512 + c, v); float s = 0.f;
#pragma unroll
            for (int i = 0; i < 8; ++i) { v[i] = gelu_t(v[i]); s += v[i]; }
            const float mu = wsum64(s) * (1.f / 512.f); float q = 0.f;
#pragma unroll
            for (int i = 0; i < 8; ++i) { v[i] -= mu; q += v[i] * v[i]; }
            const float rstd = rsqrtf(wsum64(q) * (1.f / 512.f) + 1e-5f);
#pragma unroll
            for (int i = 0; i < 8; ++i) v[i] = v[i] * rstd * lng[i] + lnb[i];
            st8bf(vab + (size_t)r * 512 + c, v);
            if (smp) {
                st8f(p.out + OUT_CV + (size_t)si * 512 + c, v);
                const int grp = c >> 6; const float w00 = p.in[I_SGUW][grp * 16384], b0 = p.in[I_SGUB][grp * 128]; float uu[8]; ld8bf(zr + c, uu);
#pragma unroll
                for (int i = 0; i < 8; ++i) uu[i] = gelu_t(uu[i]) * (w00 * v[i] + b0);
                st8bf(ymix + (size_t)r * 1024 + c, uu);
            }
        }
#pragma unroll
        for (int it = 0; it < 4; ++it) {
            const int ch = lane + 64 * it; if (ch >= 228) break;
            const int cb = ch * 8; float cur[8], prv[8], mu[8], zs[8]; ld8bf(zr + 1024 + cb, cur);
            if (smp) ld8f(p.in[I_SSHIFT] + (size_t)si * BPROJ + cb, prv);
            else if (t == 0) {
#pragma unroll
                for (int i = 0; i < 8; ++i) prv[i] = 0.f;
            } else ld8bf(zr - ZLD + 1024 + cb, prv);
#pragma unroll
            for (int i = 0; i < 8; ++i) { mu[i] = mu4[it][i]; zs[i] = cur[i] + (prv[i] - cur[i]) * mu[i]; }
            if (smp) st8f(p.out + OUT_SHS + (size_t)si * BPROJ + cb, cur);
            else if (t == SEQ - 1) st8f(p.out + OUT_SHP + (size_t)(r >> 11) * BPROJ + cb, cur);
            if (it == 0) st8bf(rbuf + (size_t)r * 512 + cb, zs);
            else if (it == 1) {
                const int c = cb - 512; st8bf(kbuf + (size_t)r * 512 + c, zs); float kk[8]; float ss = 0.f;
#pragma unroll
                for (int i = 0; i < 8; ++i) { kk[i] = zs[i] * kkw[i]; ss += kk[i] * kk[i]; }
                ss += __shfl_xor(ss, 1); ss += __shfl_xor(ss, 2); ss += __shfl_xor(ss, 4);
                const float rn = rsqrtf(fmaxf(ss, 1e-24f));
#pragma unroll
                for (int i = 0; i < 8; ++i) kk[i] *= rn;
                st8bf(kkbuf + (size_t)r * 512 + c, kk);
            } else if (it == 2) st8bf(vbuf + (size_t)r * 512 + (cb - 1024), zs);
            else {
                const int l = ch - 192; float o[8];
#pragma unroll
                for (int i = 0; i < 8; ++i) o[i] = l < 8 ? tanhf_(zs[i]) : (l < 16 ? zs[i] : sigmoidf_(zs[i]));
                st8bf(lin + (size_t)r * 384 + l * 8, o);
            }
        }
        if (lane >= 36 && lane < 48) { const float zero[8] = {0.f, 0.f, 0.f, 0.f, 0.f, 0.f, 0.f, 0.f}; st8bf(lin + (size_t)r * 384 + lane * 8, zero); }
    }
}

DEV void phase_chunkmix(const Params& p, LAS unsigned char* lds) {
    unsigned char* ws = p.ws; const int tid = fresh_tid(), lane = tid & 63, w = tid >> 6, l15 = lane & 15, kg = lane >> 4;
    const bf16_t* z = (const bf16_t*)(ws + O_Z); const bf16_t* vab = (const bf16_t*)(ws + O_VAB); bf16_t* ymix = (bf16_t*)(ws + O_YMIX);
    LAS bf16_t* vaT = (LAS bf16_t*)lds;
    for (int item = blockIdx.x; item < 1024; item += gridDim.x) {
        const int g = item & 7, bc = item >> 3; const size_t m0 = (size_t)bc * 128;
        const int trow = 16 * w + l15; const float* wrow = p.in[I_SGUW] + ((size_t)g * 128 + trow) * 128;
        const int nks = (16 * w + 16 + 31) >> 5;
        f32x4 ar[4][2];
#pragma unroll
        for (int ks = 0; ks < 4; ++ks) if (ks < nks) { ar[ks][0] = *(const f32x4*)(wrow + 32 * ks + kg * 8); ar[ks][1] = *(const f32x4*)(wrow + 32 * ks + kg * 8 + 4); }
        bf16_t zu[4][4]; float bs[4];
#pragma unroll
        for (int j = 0; j < 4; ++j) { const int t = 16 * w + kg * 4 + j; bs[j] = p.in[I_SGUB][g * 128 + t];
#pragma unroll
            for (int nb = 0; nb < 4; ++nb) zu[j][nb] = z[(m0 + t) * ZLD + g * 64 + nb * 16 + l15]; }
        __syncthreads();
#pragma unroll
        for (int i = 0; i < 2; ++i) { const int id = tid + 512 * i, s = id >> 3, d8 = (id & 7) * 8; const u32x4 u = *(const u32x4*)(vab + (m0 + s) * 512 + g * 64 + d8);
#pragma unroll
            for (int j = 0; j < 4; ++j) { vaT[(d8 + 2 * j) * 136 + s] = (bf16_t)(u[j] & 0xffffu); vaT[(d8 + 2 * j + 1) * 136 + s] = (bf16_t)(u[j] >> 16); } }
        __syncthreads();
        f32x4 acc[4];
#pragma unroll
        for (int nb = 0; nb < 4; ++nb) acc[nb] = (f32x4){0.f, 0.f, 0.f, 0.f};
#pragma unroll
        for (int ks = 0; ks < 4; ++ks) if (ks < nks) {
            const int s0 = 32 * ks + kg * 8; float a[8];
#pragma unroll
            for (int i = 0; i < 4; ++i) { a[i] = ar[ks][0][i]; a[4 + i] = ar[ks][1][i]; }
#pragma unroll
            for (int i = 0; i < 8; ++i) a[i] = (s0 + i <= trow) ? a[i] : 0.f;
            u32x4 au; au[0] = cvt_pk_bf16(a[0], a[1]); au[1] = cvt_pk_bf16(a[2], a[3]); au[2] = cvt_pk_bf16(a[4], a[5]); au[3] = cvt_pk_bf16(a[6], a[7]);
            const bf16x8 av = __builtin_bit_cast(bf16x8, au);
#pragma unroll
            for (int nb = 0; nb < 4; ++nb) { const bf16x8 bv = *(const LAS bf16x8*)(vaT + (nb * 16 + l15) * 136 + s0); acc[nb] = __builtin_amdgcn_mfma_f32_16x16x32_bf16(av, bv, acc[nb], 0, 0, 0); }
        }
#pragma unroll
        for (int j = 0; j < 4; ++j) { const int t = 16 * w + kg * 4 + j; const float bias = bs[j]; const size_t m = m0 + t;
#pragma unroll
            for (int nb = 0; nb < 4; ++nb) { const int d = g * 64 + nb * 16 + l15; const float u = gelu_t(bf2f(zu[j][nb])); ymix[m * 1024 + d] = (bf16_t)(cvt_pk_bf16(u * (acc[nb][j] + bias), 0.f) & 0xffffu); } }
    }
}

DEV void phase_scan(const Params& p, LAS unsigned char* lds) {
    unsigned char* ws = p.ws; const int tid = fresh_tid(), lane = tid & 63, w = tid >> 6, rg = lane >> 4, kq = lane & 15;
    const bf16_t* rbuf = (const bf16_t*)(ws + O_H); const bf16_t* kbuf = (const bf16_t*)(ws + O_H + HALFROW); const bf16_t* vbuf = (const bf16_t*)(ws + O_XRES);
    const bf16_t* kkbuf = (const bf16_t*)(ws + O_KK); const float* dec = (const float*)(ws + O_DEC); const bf16_t* kka = (const bf16_t*)(ws + O_KKA); bf16_t* obuf = (bf16_t*)(ws + O_Z);
    constexpr int SL = 16, NCH = SEQ / SL, LB = 5 * SL * 64;
    LAS float* L = (LAS float*)lds;
    LAS float* Lv = L + 2 * LB;
    LAS float* Lp = Lv + 2 * SL * 16;
#define SCAN_BAR() do { asm volatile("s_waitcnt lgkmcnt(0)" ::: "memory"); __builtin_amdgcn_s_barrier(); asm volatile("" ::: "memory"); } while (0)
    for (int item = blockIdx.x; item < 256; item += gridDim.x) {
        const int bh = item >> 2, q = item & 3, b = bh >> 3, h = bh & 7; const size_t m0 = (size_t)b * SEQ;
        if (w >= 4) {
            const int lt = tid - 256, ls = lt >> 4, lc = (lt & 15) * 4;
            f32x4 p1; u32x2 p0, p2, p3, p4, pv; pv[0] = 0u; pv[1] = 0u;
            auto gload = [&](int ch) { const size_t o = (m0 + ch * SL + ls) * 512 + h * 64 + lc;
                p0 = *(const u32x2*)(kkbuf + o); p1 = *(const f32x4*)(dec + o); p2 = *(const u32x2*)(kbuf + o); p3 = *(const u32x2*)(kka + o); p4 = *(const u32x2*)(rbuf + o);
                if (lt < 64) pv = *(const u32x2*)(vbuf + (m0 + ch * SL + (lt >> 2)) * 512 + h * 64 + q * 16 + (lt & 3) * 4); };
            auto fill = [&](int ch) { LAS float* d = L + (ch & 1) * LB + ls * 64 + lc;
                *(LAS f32x4*)d = bf4(p0); *(LAS f32x4*)(d + SL * 64) = p1; *(LAS f32x4*)(d + 2 * SL * 64) = bf4(p2); *(LAS f32x4*)(d + 3 * SL * 64) = bf4(p3); *(LAS f32x4*)(d + 4 * SL * 64) = bf4(p4);
                if (lt < 64) *(LAS f32x4*)(Lv + (ch & 1) * SL * 16 + lt * 4) = bf4(pv); };
            auto reduce_slab = [&](int ch) { const int st = lt >> 4, row = lt & 15; const LAS float* pp = Lp + (ch & 1) * SL * 256 + st * 256 + (row >> 2) * 64 + (row & 3) * 16;
                const f32x4 a = *(const LAS f32x4*)pp, b4 = *(const LAS f32x4*)(pp + 4), c = *(const LAS f32x4*)(pp + 8), d = *(const LAS f32x4*)(pp + 12); const f32x4 t = (a + b4) + (c + d);
                obuf[(m0 + ch * SL + st) * 512 + h * 64 + q * 16 + row] = (bf16_t)(cvt_pk_bf16((t[0] + t[1]) + (t[2] + t[3]), 0.f) & 0xffffu); };
            gload(0); fill(0); gload(1);
            SCAN_BAR();
            for (int ch = 0; ch < NCH; ++ch) {
                if (ch + 1 < NCH) fill(ch + 1);
                if (ch + 2 < NCH) gload(ch + 2);
                if (ch >= 1) reduce_slab(ch - 1);
                SCAN_BAR();
            }
            reduce_slab(NCH - 1);
            {
                const int sidx = item * 4 + (w - 4), si = sidx >> 3, hh = sidx & 7; const size_t o = (size_t)(NTOK + si) * 512 + hh * 64 + kq * 4;
                const f32x4 kk4 = bf4(*(const u32x2*)(kkbuf + o)), w4 = *(const f32x4*)(dec + o), k4 = bf4(*(const u32x2*)(kbuf + o)), ka4 = bf4(*(const u32x2*)(kka + o)), r4 = bf4(*(const u32x2*)(rbuf + o));
                const float* sin = p.in[I_SRWKV] + (size_t)sidx * 4096; float* sout = p.out + OUT_SS + (size_t)sidx * 4096;
                for (int ps = 0; ps < 16; ++ps) {
                    const int v = ps * 4 + rg; f32x4 S = *(const f32x4*)(sin + v * 64 + kq * 4); const float vv = bf2f(vbuf[(size_t)(NTOK + si) * 512 + hh * 64 + v]);
                    const float sa = -rowsum16(S[0] * kk4[0] + S[1] * kk4[1] + S[2] * kk4[2] + S[3] * kk4[3]);
                    S = S * w4 + vv * k4 + sa * ka4;
                    *(f32x4*)(sout + v * 64 + kq * 4) = S;
                    const float op = rowsum16(S[0] * r4[0] + S[1] * r4[1] + S[2] * r4[2] + S[3] * r4[3]);
                    if (kq == 0) obuf[(size_t)(NTOK + si) * 512 + hh * 64 + v] = (bf16_t)(cvt_pk_bf16(op, 0.f) & 0xffffu);
                }
            }
        } else {
            typedef float f32x2v __attribute__((ext_vector_type(2)));
            f32x2v Sa = (f32x2v){0.f, 0.f}, Sb = (f32x2v){0.f, 0.f}; const int row = w * 4 + rg;
            SCAN_BAR();
            for (int ch = 0; ch < NCH; ++ch) {
                const LAS float* Lc = L + (ch & 1) * LB + kq * 4; const LAS float* Lvc = Lv + (ch & 1) * SL * 16 + row;
                LAS float* dst = Lp + (ch & 1) * SL * 256 + w * 64 + lane;
                f32x4 kk4 = *(const LAS f32x4*)Lc, w4 = *(const LAS f32x4*)(Lc + SL * 64), k4 = *(const LAS f32x4*)(Lc + 2 * SL * 64), ka4 = *(const LAS f32x4*)(Lc + 3 * SL * 64), r4 = *(const LAS f32x4*)(Lc + 4 * SL * 64);
                float vv = Lvc[0];
#pragma unroll
                for (int s = 0; s < SL; ++s) {
                    const int sn = s < SL - 1 ? s + 1 : SL - 1; const LAS float* bp = Lc + sn * 64;
                    const f32x4 nkk4 = *(const LAS f32x4*)bp, nw4 = *(const LAS f32x4*)(bp + SL * 64), nk4 = *(const LAS f32x4*)(bp + 2 * SL * 64), nka4 = *(const LAS f32x4*)(bp + 3 * SL * 64), nr4 = *(const LAS f32x4*)(bp + 4 * SL * 64);
                    const float nvv = Lvc[sn * 16];
                    f32x2v t = Sa * kk4.lo; t = Sb * kk4.hi + t;
                    const float sa = -rowsum16(t[0] + t[1]);
                    Sa = (Sa * w4.lo + vv * k4.lo) + sa * ka4.lo;
                    Sb = (Sb * w4.hi + vv * k4.hi) + sa * ka4.hi;
                    f32x2v u = Sa * r4.lo; u = Sb * r4.hi + u;
                    dst[s * 256] = u[0] + u[1];
                    kk4 = nkk4; w4 = nw4; k4 = nk4; ka4 = nka4; r4 = nr4; vv = nvv;
                }
                SCAN_BAR();
            }
            const float S0 = Sa[0], S1 = Sa[1], S2 = Sb[0], S3 = Sb[1];
            *(f32x4*)(p.out + OUT_SP + ((size_t)bh * 64 + q * 16 + row) * 64 + kq * 4) = (f32x4){S0, S1, S2, S3};
        }
        __syncthreads();
    }
#undef SCAN_BAR
}

DEV void phase_finalize(const Params& p) {
    unsigned char* ws = p.ws; const int tid = fresh_tid(), lane = tid & 63, gw = blockIdx.x * 8 + (tid >> 6), nw = gridDim.x * 8;
    const bf16_t* rbuf = (const bf16_t*)(ws + O_H); const bf16_t* kbuf = (const bf16_t*)(ws + O_H + HALFROW); const bf16_t* gb = (const bf16_t*)(ws + O_H + 2 * HALFROW);
    const bf16_t* vbuf = (const bf16_t*)(ws + O_XRES); const bf16_t* obuf = (const bf16_t*)(ws + O_Z); bf16_t* ymix = (bf16_t*)(ws + O_YMIX);
    const int c = lane * 8; float rk[8], gg[8], gbb[8]; ld8f(p.in[I_RK] + c, rk); ld8f(p.in[I_GNG] + c, gg); ld8f(p.in[I_GNB] + c, gbb);
#pragma unroll 2
    for (int r = gw; r < MV; r += nw) {
        const size_t o = (size_t)r * 512 + c; float ov[8], rv[8], kv[8], vv[8], gv[8]; ld8bf(obuf + o, ov); ld8bf(rbuf + o, rv); ld8bf(kbuf + o, kv); ld8bf(vbuf + o, vv); ld8bf(gb + o, gv);
        float s = 0.f, bs = 0.f;
#pragma unroll
        for (int i = 0; i < 8; ++i) { s += ov[i]; bs += rv[i] * kv[i] * rk[i]; }
        s += __shfl_xor(s, 1); s += __shfl_xor(s, 2); s += __shfl_xor(s, 4); bs += __shfl_xor(bs, 1); bs += __shfl_xor(bs, 2); bs += __shfl_xor(bs, 4);
        const float mu = s * (1.f / 64.f); float q = 0.f;
#pragma unroll
        for (int i = 0; i < 8; ++i) { ov[i] -= mu; q += ov[i] * ov[i]; }
        q += __shfl_xor(q, 1); q += __shfl_xor(q, 2); q += __shfl_xor(q, 4);
        const float rstd = rsqrtf(q * (1.f / 64.f) + 64e-5f); float y[8];
#pragma unroll
        for (int i = 0; i < 8; ++i) y[i] = (ov[i] * rstd * gg[i] + gbb[i] + bs * vv[i]) * gv[i];
        st8bf(ymix + (size_t)r * 1024 + 512 + c, y);
    }
}

DEV void phase_sattn(const Params& p, LAS unsigned char* lds) {
    unsigned char* ws = p.ws; const int tid = fresh_tid(), lane = tid & 63, w = tid >> 6, kgrp = lane >> 4, dl = lane & 15;
    const bf16_t* qb = (const bf16_t*)(ws + O_Z + HALFROW); bf16_t* ob = (bf16_t*)(ws + O_YMIX);
    LAS float* pw = (LAS float*)lds;
    LAS float* wm = pw + 256;
    LAS float* wacc = wm + 16;
    for (int item = blockIdx.x; item < 512; item += gridDim.x) {
        const int si = item >> 2, h = item & 3; const float* Kp = p.in[I_CK] + (size_t)si * 262144 + h * 256; const float* Vp = p.in[I_CV] + (size_t)si * 262144 + h * 256;
        float q[16]; { float a[8], b[8]; ld8bf(qb + (size_t)(NTOK + si) * 1024 + h * 256 + dl * 16, a); ld8bf(qb + (size_t)(NTOK + si) * 1024 + h * 256 + dl * 16 + 8, b);
#pragma unroll
            for (int i = 0; i < 8; ++i) { q[i] = a[i]; q[8 + i] = b[i]; } }
        float sc[8];
#pragma unroll
        for (int j = 0; j < 8; ++j) {
            const float* kr = Kp + (size_t)(w * 32 + kgrp + 4 * j) * 1024 + dl * 16; float d = 0.f;
#pragma unroll
            for (int i = 0; i < 4; ++i) { const f32x4 k4 = *(const f32x4*)(kr + 4 * i); d += k4[0] * q[4 * i] + k4[1] * q[4 * i + 1] + k4[2] * q[4 * i + 2] + k4[3] * q[4 * i + 3]; }
            sc[j] = rowsum16(d);
        }
        float mx = sc[0];
#pragma unroll
        for (int j = 1; j < 8; ++j) mx = fmaxf(mx, sc[j]);
        mx = fmaxf(mx, __shfl_xor(mx, 16)); mx = fmaxf(mx, __shfl_xor(mx, 32));
        float sum = 0.f;
#pragma unroll
        for (int j = 0; j < 8; ++j) { sc[j] = __expf(sc[j] - mx); sum += sc[j]; }
        sum += __shfl_xor(sum, 16); sum += __shfl_xor(sum, 32);
        __syncthreads();
        if (dl == 0) {
#pragma unroll
            for (int j = 0; j < 8; ++j) pw[w * 32 + kgrp + 4 * j] = sc[j];
        }
        if (lane == 0) { wm[w] = mx; wm[8 + w] = sum; }
        asm volatile("s_waitcnt lgkmcnt(0)" ::: "memory"); __builtin_amdgcn_wave_barrier();
        f32x4 acc = (f32x4){0.f, 0.f, 0.f, 0.f};
#pragma unroll 32
        for (int j = 0; j < 32; ++j) { const f32x4 v4 = *(const f32x4*)(Vp + (size_t)(w * 32 + j) * 1024 + lane * 4); acc = acc + pw[w * 32 + j] * v4; }
        *(LAS f32x4*)(wacc + w * 256 + lane * 4) = acc;
        __syncthreads();
        if (tid < 256) {
            float M = wm[0];
#pragma unroll
            for (int j = 1; j < 8; ++j) M = fmaxf(M, wm[j]);
            float L = 0.f, o = 0.f;
#pragma unroll
            for (int j = 0; j < 8; ++j) { const float f = __expf(wm[j] - M); L += wm[8 + j] * f; o += wacc[j * 256 + tid] * f; }
            ob[(size_t)(NTOK + si) * 1024 + h * 256 + tid] = (bf16_t)(cvt_pk_bf16(o * __builtin_amdgcn_rcpf(L), 0.f) & 0xffffu);
        }
    }
}

DEV void phase_final(const Params& p) {
    unsigned char* ws = p.ws; const int tid = fresh_tid(), lane = tid & 63, gw = blockIdx.x * 8 + (tid >> 6), nw = gridDim.x * 8;
    const bf16_t* xb = (const bf16_t*)(ws + O_XB); const float* rs5 = (const float*)(ws + O_RS5);
    float g[16]; { float a[8], b[8]; ld8f(p.in[I_FIN] + lane * 8, a); ld8f(p.in[I_FIN] + 512 + lane * 8, b);
#pragma unroll
        for (int i = 0; i < 8; ++i) { g[i] = a[i]; g[8 + i] = b[i]; } }
#pragma unroll 2
    for (int r = gw; r < MV; r += nw) {
        const float rstd = rstd_of(rs5, r);
#pragma unroll
        for (int hf = 0; hf < 2; ++hf) { const int c = hf * 512 + lane * 8; float v[8]; ld8bf(xb + (size_t)r * 1024 + c, v);
#pragma unroll
            for (int i = 0; i < 8; ++i) v[i] = v[i] * rstd * g[hf * 8 + i];
            st8f(p.out + OUT_Y + (size_t)r * 1024 + c, v); }
    }
}

__global__ void __launch_bounds__(512, 2) mega(Params p) {
    extern __shared__ __attribute__((aligned(16))) unsigned char shm[];
    LAS unsigned char* lds = (LAS unsigned char*)shm;
    unsigned char* ws = p.ws;
    const int MT = MP / 256;
    {
        volatile LAS unsigned* st = (volatile LAS unsigned*)(lds + pg8::STAGE_BYTES);
        if (threadIdx.x < 2) st[threadIdx.x] = 0u;
        __syncthreads();
        if (threadIdx.x == 0) (void)xb_add(&((unsigned*)(ws + O_BAR))[XB_XCNT(xb_xcc_id())], 1u);
    }
#define XB_SYNC() do { XcdBarrier xb_; xb_.bar = (unsigned*)(p.ws + O_BAR); xb_.x = xb_xcc_id(); xb_.st = (volatile LAS unsigned*)(lds + pg8::STAGE_BYTES); xcd_barrier(xb_); } while (0)
    { phase_prep(p, lds); }
    XB_SYNC();
    { {
            { pg8::Gemm g{(const bf16_t*)(ws + O_XB), (const bf16_t*)(ws + O_WGU1), 1024, 1024, 1024}; pg8::GridSched S; S.init(MT, 22, 0, 1024, 1024);
              EpiSwiglu E{(const float*)(ws + O_RS1), (bf16_t*)(ws + O_H)}; pg8::gemm_phase(lds, g, S, E); }
            { pg8::Gemm g{(const bf16_t*)(ws + O_MNB), (const bf16_t*)(ws + O_WK), 1024, 1024, 1024}; pg8::GridSched S; S.init(8, 4, MT * 22, 1024, 1024);
              EpiK E{(const float*)(ws + O_RSTDM), p.out + OUT_MK, (bf16_t*)(ws + O_MKB)}; pg8::gemm_phase(lds, g, S, E); }
            { pg8::Gemm g{(const bf16_t*)(ws + O_WV), (const bf16_t*)(ws + O_MNB), 1024, 1024, 1024}; pg8::GridSched S; S.init(4, 8, MT * 22 + 32, 1024, 1024);
              EpiVT E{(const float*)(ws + O_RSTDM), p.out + OUT_MV, (bf16_t*)(ws + O_VT)}; pg8::gemm_phase(lds, g, S, E); }
        } }
    XB_SYNC();
    { { pg8::Gemm g{(const bf16_t*)(ws + O_H), (const bf16_t*)(ws + O_WD1), DFF, DFF, DFF}; pg8::GridSched S; S.init(64, 4, 0, DFF, DFF);
            EpiRes E{p.in[I_XP], (bf16_t*)(ws + O_XB), (float*)(ws + O_RS2), 0.5f}; pg8::gemm_phase(lds, g, S, E);
            SRes E2{p.in[I_XS], (bf16_t*)(ws + O_XB), (float*)(ws + O_RS2), 0.5f, NTOK};
            small_gemm<4>(lds, (const bf16_t*)(ws + O_H), DFF, (const bf16_t*)(ws + O_WD1), DFF, DFF, NTOK, 4, 16, E2); } }
    XB_SYNC();
    { { pg8::Gemm g{(const bf16_t*)(ws + O_XB), (const bf16_t*)(ws + O_WIN), 1024, 1024, 1024}; pg8::GridSched S; S.init(MT, 11, 0, 1024, 1024);
            EpiScale E{(const float*)(ws + O_RS2), (bf16_t*)(ws + O_Z), ZLD, ZLD}; pg8::gemm_phase(lds, g, S, E);
            SScale E2{(const float*)(ws + O_RS2), (bf16_t*)(ws + O_Z), ZLD, ZLD, 2816};
            small_gemm<2>(lds, (const bf16_t*)(ws + O_XB), 1024, (const bf16_t*)(ws + O_WIN) + (size_t)2816 * 1024, 1024, 1024, 0, MV / 32, 1, E2); } }
    XB_SYNC();
    { phase_mixprep(p); }
    XB_SYNC();
    { { pg8::Gemm g{(const bf16_t*)(ws + O_LIN), (const bf16_t*)(ws + O_WLORA), 384, 384, 256}; pg8::LoraSched S; S.init();
            EpiLora E{p.in[I_W0], p.in[I_A0], p.in[I_KA], (float*)(ws + O_DEC), (bf16_t*)(ws + O_H + HALFROW), (const bf16_t*)(ws + O_KK), (bf16_t*)(ws + O_KKA), (bf16_t*)(ws + O_H + 2 * HALFROW)};
            pg8::gemm_phase(lds, g, S, E); phase_chunkmix(p, lds); } }
    XB_SYNC();
    { phase_scan(p, lds); }
    XB_SYNC();
    { phase_finalize(p); }
    XB_SYNC();
    { { pg8::Gemm g{(const bf16_t*)(ws + O_YMIX), (const bf16_t*)(ws + O_WOUT), 1024, 1024, 1024}; pg8::GridSched S; S.init(64, 4, 0, 1024, 1024);
            EpiRes E{nullptr, (bf16_t*)(ws + O_XB), (float*)(ws + O_RS3), 1.f}; pg8::gemm_phase(lds, g, S, E);
            SRes E2{nullptr, (bf16_t*)(ws + O_XB), (float*)(ws + O_RS3), 1.f, 0};
            small_gemm<4>(lds, (const bf16_t*)(ws + O_YMIX), 1024, (const bf16_t*)(ws + O_WOUT), 1024, 1024, NTOK, 4, 16, E2); } }
    XB_SYNC();
    { { pg8::Gemm g{(const bf16_t*)(ws + O_XB), (const bf16_t*)(ws + O_WQ), 1024, 1024, 1024}; pg8::GridSched S; S.init(64, 4, 0, 1024, 1024);
            EpiScale E{(const float*)(ws + O_RS3), (bf16_t*)(ws + O_Z + HALFROW), 1024, 1024}; pg8::gemm_phase(lds, g, S, E);
            SScale E2{(const float*)(ws + O_RS3), (bf16_t*)(ws + O_Z + HALFROW), 1024, 1024, 0};
            small_gemm<4>(lds, (const bf16_t*)(ws + O_XB), 1024, (const bf16_t*)(ws + O_WQ), 1024, 1024, NTOK, 4, 16, E2); } }
    XB_SYNC();
    { {
            const bool sattn_first = ((blockIdx.x >> 3) & 1) != 0;
            if (sattn_first) phase_sattn(p, lds);
            { pg8::Gemm g{(const bf16_t*)(ws + O_Z + HALFROW), (const bf16_t*)(ws + O_MKB), 1024, 1024, 256}; pg8::AttnSched<0> S; S.init();
              EpiS E{(bf16_t*)(ws + O_Z), (float*)(ws + O_PSUM)}; pg8::gemm_phase(lds, g, S, E); }
            asm volatile("s_waitcnt vmcnt(0)" ::: "memory"); __syncthreads();
            if (threadIdx.x == 0) { __builtin_amdgcn_fence(__ATOMIC_ACQUIRE, "agent"); asm volatile("s_waitcnt vmcnt(0)" ::: "memory"); }
            __syncthreads();
            { pg8::Gemm g{(const bf16_t*)(ws + O_Z), (const bf16_t*)(ws + O_VT), 256, 2048, 256}; pg8::AttnSched<1> S; S.init();
              EpiO E{(const float*)(ws + O_PSUM), (bf16_t*)(ws + O_YMIX)}; pg8::gemm_phase(lds, g, S, E); }
            if (!sattn_first) phase_sattn(p, lds);
        } }
    XB_SYNC();
    { { pg8::Gemm g{(const bf16_t*)(ws + O_YMIX), (const bf16_t*)(ws + O_WO), 1024, 1024, 1024}; pg8::GridSched S; S.init(64, 4, 0, 1024, 1024);
            EpiRes E{nullptr, (bf16_t*)(ws + O_XB), (float*)(ws + O_RS4), 1.f}; pg8::gemm_phase(lds, g, S, E);
            SRes E2{nullptr, (bf16_t*)(ws + O_XB), (float*)(ws + O_RS4), 1.f, 0};
            small_gemm<4>(lds, (const bf16_t*)(ws + O_YMIX), 1024, (const bf16_t*)(ws + O_WO), 1024, 1024, NTOK, 4, 16, E2); } }
    XB_SYNC();
    { { pg8::Gemm g{(const bf16_t*)(ws + O_XB), (const bf16_t*)(ws + O_WGU2), 1024, 1024, 1024}; pg8::GridSched S; S.init(MT, 22, 0, 1024, 1024);
            EpiSwiglu E{(const float*)(ws + O_RS4), (bf16_t*)(ws + O_H)}; pg8::gemm_phase(lds, g, S, E); } }
    XB_SYNC();
    { { pg8::Gemm g{(const bf16_t*)(ws + O_H), (const bf16_t*)(ws + O_WD2), DFF, DFF, DFF}; pg8::GridSched S; S.init(64, 4, 0, DFF, DFF);
            EpiRes E{nullptr, (bf16_t*)(ws + O_XB), (float*)(ws + O_RS5), 0.5f}; pg8::gemm_phase(lds, g, S, E);
            SRes E2{nullptr, (bf16_t*)(ws + O_XB), (float*)(ws + O_RS5), 0.5f, 0};
            small_gemm<4>(lds, (const bf16_t*)(ws + O_H), DFF, (const bf16_t*)(ws + O_WD2), DFF, DFF, NTOK, 4, 16, E2); } }
    XB_SYNC();
    { phase_final(p); }
#undef XB_SYNC
}

constexpr size_t LDS_BYTES = pg8::STAGE_BYTES + 4096;

extern "C" void kernel_launch(void* const* d_in, const int* in_sizes, int n_in, void* d_out, int out_size, void* d_ws, size_t ws_size, hipStream_t stream) {
    static int grid_blocks = 0;
    if (!grid_blocks) {
        int dev = 0, cus = 0, per_cu = 0;
        hipGetDevice(&dev);
        hipDeviceGetAttribute(&cus, hipDeviceAttributeMultiprocessorCount, dev);
        hipFuncSetAttribute((const void*)mega, hipFuncAttributeMaxDynamicSharedMemorySize, (int)LDS_BYTES);
        hipOccupancyMaxActiveBlocksPerMultiprocessor(&per_cu, mega, 512, LDS_BYTES);
        if (per_cu < 1) { fprintf(stderr, "occupancy query returned %d\n", per_cu); per_cu = 1; }
        grid_blocks = cus * (per_cu > 1 ? 1 : per_cu);
        if (ws_size < WS_NEED) fprintf(stderr, "workspace too small: %zu < %zu\n", ws_size, (size_t)WS_NEED);
    }
    Params p{};
    for (int i = 0; i < 40; ++i) p.in[i] = (const float*)d_in[i];
    p.out = (float*)d_out; p.ws = (unsigned char*)d_ws;
    hipMemsetAsync((unsigned char*)d_ws + O_BAR, 0, XCD_BAR_WORDS * 4, stream);
    hipLaunchKernelGGL(mega, dim3(grid_blocks), dim3(512), LDS_BYTES, stream, p);
}
```
